# Optimizing an MI355X kernel written in HIP

```python
import math
import jax, jax.numpy as jnp
from jax import lax
import numpy as np

D_MODEL = 1024
BATCH = 8
SEQ = 2048
DEPTH = 4
DEC_BATCH = 128
DEC_SEQ = 1
PAST_LEN = 16384
PAGE_SIZE = 128

MIX_W = D_MODEL
H_A = D_MODEL // 256
DK = 128
DV = 128
W_A = H_A * DV
QKV_DIM = 2 * H_A * DK + H_A * DV
CONV_W = 4
DN_CHUNK = 64
W_B = MIX_W - W_A
H_B = 4
DH_B = W_B // H_B
GM_CHUNK = 128
D_FF = 4 * D_MODEL
OFF_G = QKV_DIM
OFF_A = OFF_G + W_A
OFF_B = OFF_A + H_A
OFF_U = OFF_B + H_A
OFF_V = OFF_U + W_B
PROJ_DIM = OFF_V + W_B
EPS = 1e-6

kernel_name = "hymba_gdn_gmlp_decode_step"


def rmsnorm(x, g):
    xf = x.astype(jnp.float32)
    y = xf * lax.rsqrt(jnp.mean(xf * xf, axis=-1, keepdims=True) + EPS)
    return (y * g.astype(jnp.float32)).astype(x.dtype)


def l2norm(x):
    return x * lax.rsqrt(jnp.sum(x * x, axis=-1, keepdims=True) + EPS)


def causal_conv(x, buf, w):
    L = x.shape[1]
    xp = jnp.concatenate([buf.astype(x.dtype), x], axis=1)
    y = xp[:, 0:L] * w[0]
    for j in range(1, CONV_W):
        y = y + xp[:, j:j + L] * w[j]
    return y, xp[:, L:]


def gated_delta_chunked(q, k, v, gdec, beta, S0):
    B, L, H, _ = q.shape
    C = DN_CHUNK
    N = L // C
    q = q.reshape(B, N, C, H, DK)
    k = k.reshape(B, N, C, H, DK)
    v = v.reshape(B, N, C, H, DV)
    beta = beta.reshape(B, N, C, H)
    gc = jnp.cumsum(gdec.reshape(B, N, C, H), axis=2)
    gct = jnp.swapaxes(gc, 2, 3)
    idx = jnp.arange(C)
    lower = idx[:, None] >= idx[None, :]
    strict = idx[:, None] > idx[None, :]
    diff = gct[..., :, None] - gct[..., None, :]
    decay = jnp.where(lower, jnp.exp(jnp.where(lower, diff, 0.0)), 0.0)
    k_beta = k * beta[..., None]
    v_beta = v * beta[..., None]
    kk = jnp.einsum('bnihd,bnjhd->bnhij', k_beta, k) * decay
    eye = jnp.eye(C, dtype=jnp.float32)
    A = eye + jnp.where(strict, kk, 0.0)
    T = lax.linalg.triangular_solve(A, jnp.broadcast_to(eye, A.shape), left_side=True,
                                    lower=True, unit_diagonal=True)
    u = jnp.einsum('bnhij,bnjhd->bnhid', T, v_beta)
    w = jnp.einsum('bnhij,bnjhd->bnhid', T, k_beta * jnp.exp(gc)[..., None])
    qk = jnp.einsum('bnihd,bnjhd->bnhij', q, k) * decay

    def step(S, inp):
        q_n, k_n, u_n, w_n, qk_n, g_n = inp
        v_new = u_n - jnp.einsum('bhid,bhde->bhie', w_n, S)
        o = (jnp.einsum('bihd,bhde->bhie', q_n, S) * jnp.exp(g_n)[..., None]
             + jnp.einsum('bhij,bhje->bhie', qk_n, v_new))
        g_last = g_n[..., -1]
        k_dec = k_n * jnp.swapaxes(jnp.exp(g_last[..., None] - g_n), 1, 2)[..., None]
        S = S * jnp.exp(g_last)[..., None, None] + jnp.einsum('bihd,bhie->bhde', k_dec, v_new)
        return S, o

    xs = (jnp.moveaxis(q, 1, 0), jnp.moveaxis(k, 1, 0), jnp.moveaxis(u, 1, 0),
          jnp.moveaxis(w, 1, 0), jnp.moveaxis(qk, 1, 0), jnp.moveaxis(gct, 1, 0))
    S, o = lax.scan(step, S0, xs)
    o = jnp.transpose(o, (1, 0, 3, 2, 4)).reshape(B, L, H, DV)
    return o, S


def gated_delta_recurrent(q, k, v, gdec, beta, S0):
    def step(S, inp):
        q_t, k_t, v_t, g_t, b_t = inp
        S = S * jnp.exp(g_t)[..., None, None]
        kv = jnp.einsum('bhd,bhde->bhe', k_t, S)
        delta = (v_t - kv) * b_t[..., None]
        S = S + jnp.einsum('bhd,bhe->bhde', k_t, delta)
        o = jnp.einsum('bhd,bhde->bhe', q_t, S)
        return S, o

    xs = (jnp.moveaxis(q, 1, 0), jnp.moveaxis(k, 1, 0), jnp.moveaxis(v, 1, 0),
          jnp.moveaxis(gdec, 1, 0), jnp.moveaxis(beta, 1, 0))
    S, o = lax.scan(step, S0, xs)
    return jnp.moveaxis(o, 0, 1), S


def spatial_gate(u, vb, w_s, b_s):
    B, L, _ = u.shape
    c = min(L, GM_CHUNK)
    idx = jnp.arange(c)
    wm = jnp.where(idx[:, None] >= idx[None, :], w_s[:, :c, :c], 0.0).astype(vb.dtype)
    vc = vb.reshape(B, L // c, c, H_B, DH_B)
    s = jnp.einsum('hij,bnjhd->bnihd', wm, vc) + jnp.swapaxes(b_s[:, :c], 0, 1)[:, :, None].astype(vb.dtype)
    return u * s.reshape(B, L, W_B)


def mixer(h, conv_buf, S0, w_in, conv_w, A_log, dt_bias, o_norm_g, v_norm_g, w_s, b_s, w_o, chunked):
    B, L, _ = h.shape
    p = h @ w_in
    qkv, new_buf = causal_conv(p[..., :QKV_DIM], conv_buf, conv_w)
    qkv = jax.nn.silu(qkv).astype(jnp.float32)
    q = l2norm(qkv[..., :H_A * DK].reshape(B, L, H_A, DK)) * (DK ** -0.5)
    k = l2norm(qkv[..., H_A * DK:2 * H_A * DK].reshape(B, L, H_A, DK))
    v = qkv[..., 2 * H_A * DK:].reshape(B, L, H_A, DV)
    a = p[..., OFF_A:OFF_B].astype(jnp.float32)
    bl = p[..., OFF_B:OFF_U].astype(jnp.float32)
    gdec = -jnp.exp(A_log.astype(jnp.float32)) * jax.nn.softplus(a + dt_bias.astype(jnp.float32))
    beta = jax.nn.sigmoid(bl)
    S0f = S0.astype(jnp.float32)
    if chunked:
        o, S = gated_delta_chunked(q, k, v, gdec, beta, S0f)
    else:
        o, S = gated_delta_recurrent(q, k, v, gdec, beta, S0f)
    gate = p[..., OFF_G:OFF_A].astype(jnp.float32).reshape(B, L, H_A, DV)
    o_a = (rmsnorm(o, o_norm_g) * jax.nn.silu(gate)).reshape(B, L, W_A).astype(h.dtype)
    u = p[..., OFF_U:OFF_V]
    vb = rmsnorm(p[..., OFF_V:], v_norm_g)
    o_b = spatial_gate(u, vb, w_s, b_s)
    y = jnp.concatenate([o_a, o_b], axis=-1) @ w_o
    return y, new_buf, S.astype(S0.dtype), vb


def ffn(h, w_up, w_down):
    return jnp.square(jax.nn.relu(h @ w_up)) @ w_down


def setup_inputs(seed: int = 0) -> dict:
    key = jax.random.key(seed)
    ks = jax.random.split(key, 20)
    f32 = jnp.float32

    def nrm(k, shape, scale):
        return jax.random.normal(k, shape, f32) * scale

    dt = jnp.exp(jax.random.uniform(ks[8], (DEPTH, H_A), f32, math.log(1e-3), math.log(1e-1)))
    return {
        'x_prompt': nrm(ks[0], (BATCH, SEQ, D_MODEL), 1.0),
        'x_sample': nrm(ks[1], (DEC_BATCH, DEC_SEQ, D_MODEL), 1.0),
        'state_delta': nrm(ks[2], (DEPTH, DEC_BATCH, H_A, DK, DV), 0.05),
        'state_conv': nrm(ks[3], (DEPTH, DEC_BATCH, CONV_W - 1, QKV_DIM), 1.0),
        'norm_mix_g': 1.0 + nrm(ks[4], (DEPTH, D_MODEL), 0.05),
        'w_in': nrm(ks[5], (DEPTH, D_MODEL, PROJ_DIM), D_MODEL ** -0.5),
        'conv_w': nrm(ks[6], (DEPTH, CONV_W, QKV_DIM), CONV_W ** -0.5),
        'A_log': jnp.log(jax.random.uniform(ks[7], (DEPTH, H_A), f32, 1.0, 16.0)),
        'dt_bias': dt + jnp.log(-jnp.expm1(-dt)),
        'o_norm_g': 1.0 + nrm(ks[9], (DEPTH, DV), 0.05),
        'v_norm_g': 1.0 + nrm(ks[10], (DEPTH, W_B), 0.05),
        'w_s': nrm(ks[11], (DEPTH, H_B, GM_CHUNK, GM_CHUNK), GM_CHUNK ** -0.5),
        'b_s': 1.0 + nrm(ks[12], (DEPTH, H_B, GM_CHUNK), 0.1),
        'w_o': nrm(ks[13], (DEPTH, MIX_W, D_MODEL), MIX_W ** -0.5),
        'norm_ffn_g': 1.0 + nrm(ks[14], (DEPTH, D_MODEL), 0.05),
        'w_up': nrm(ks[15], (DEPTH, D_MODEL, D_FF), D_MODEL ** -0.5),
        'w_down': nrm(ks[16], (DEPTH, D_FF, D_MODEL), D_FF ** -0.5),
        'norm_f_g': 1.0 + nrm(ks[17], (D_MODEL,), 0.05),
    }


def reference(x_prompt, x_sample, state_delta, state_conv, norm_mix_g, w_in, conv_w, A_log,
              dt_bias, o_norm_g, v_norm_g, w_s, b_s, w_o, norm_ffn_g, w_up, w_down, norm_f_g):
    xp, xs = x_prompt, x_sample
    conv0 = jnp.zeros((xp.shape[0], CONV_W - 1, QKV_DIM), xp.dtype)
    S0p = jnp.zeros((xp.shape[0], H_A, DK, DV), state_delta.dtype)
    dp_list, cp_list, ds_list, cs_list, vs_list = [], [], [], [], []
    for l in range(DEPTH):
        lp = (w_in[l], conv_w[l], A_log[l], dt_bias[l], o_norm_g[l], v_norm_g[l], w_s[l], b_s[l], w_o[l])
        yp, cp, Sp, _ = mixer(rmsnorm(xp, norm_mix_g[l]), conv0, S0p, *lp, chunked=True)
        ys, cs, Ss, vrows = mixer(rmsnorm(xs, norm_mix_g[l]), state_conv[l], state_delta[l], *lp, chunked=False)
        xp = xp + yp
        xs = xs + ys
        xp = xp + ffn(rmsnorm(xp, norm_ffn_g[l]), w_up[l], w_down[l])
        xs = xs + ffn(rmsnorm(xs, norm_ffn_g[l]), w_up[l], w_down[l])
        dp_list.append(Sp)
        cp_list.append(cp)
        ds_list.append(Ss)
        cs_list.append(cs)
        vs_list.append(vrows)
    y_prompt = rmsnorm(xp, norm_f_g)
    y_sample = rmsnorm(xs, norm_f_g)
    new_delta_prompt = jnp.stack(dp_list)
    new_conv_prompt = jnp.stack(cp_list)
    new_delta_sample = jnp.stack(ds_list)
    new_conv_sample = jnp.stack(cs_list)
    new_gmlp_v_sample = jnp.stack(vs_list)
    return (y_prompt, y_sample, new_delta_prompt, new_conv_prompt, new_delta_sample, new_conv_sample, new_gmlp_v_sample)
```

```cpp
#include <hip/hip_runtime.h>
#include <hip/hip_cooperative_groups.h>
#include <cstdio>
namespace cg = cooperative_groups;

#define LAS __attribute__((address_space(3)))
#define DI __device__ __forceinline__
typedef unsigned short bf16_t;
typedef short bf16x8 __attribute__((ext_vector_type(8)));
typedef float f32x4 __attribute__((ext_vector_type(4)));
typedef float f32x2 __attribute__((ext_vector_type(2)));
typedef float f32x16 __attribute__((ext_vector_type(16)));
typedef unsigned u32x4 __attribute__((ext_vector_type(4)));
typedef unsigned u32x2 __attribute__((ext_vector_type(2)));
typedef __bf16 bf2_t __attribute__((ext_vector_type(2)));

#ifndef SUBSEL
#define SUBSEL -1
#endif
#define SUB(x) (SUBSEL < 0 || SUBSEL == (x))
#ifndef SUBSEL2
#define SUBSEL2 -1
#endif
#define SUB2(x) (SUBSEL2 < 0 || SUBSEL2 == (x))
constexpr int DM = 1024, NBATCH = 8, SEQ = 2048, MP = NBATCH * SEQ, DEPTH = 4, SBATCH = 128;
constexpr int NH = 4, QKV = 1536, NP = 3072, PROJ = 3080, FF = 4096, NPS = 3088;
constexpr float EPS = 1e-6f;
constexpr int IMG_BYTES = 55296;
constexpr int LDS_BYTES = 147456;
constexpr size_t O_YP = 0, O_YS = 16777216, O_DP = 16908288, O_CP = 19005440, O_DS = 19152896, O_CS = 52707328, O_VS = 55066624;
constexpr size_t WS_WIN = 65536;
constexpr size_t WS_WAB = WS_WIN + (size_t)DEPTH * NP * DM * 2;
constexpr size_t WS_WO = WS_WAB + (size_t)DEPTH * 16 * DM * 2;
constexpr size_t WS_WUP = WS_WO + (size_t)DEPTH * DM * DM * 2;
constexpr size_t WS_WDN = WS_WUP + (size_t)DEPTH * FF * DM * 2;
constexpr size_t WS_WM = WS_WDN + (size_t)DEPTH * FF * DM * 2;
constexpr size_t WS_XBUF = WS_WM + (size_t)DEPTH * 4 * 128 * 128 * 2;
constexpr size_t WS_XB16 = WS_XBUF + (size_t)MP * DM * 4;
constexpr size_t WS_SSQ = WS_XB16 + (size_t)MP * DM * 2;
constexpr size_t WS_UNION = WS_SSQ + (size_t)9 * MP * 16 * 4;
constexpr size_t WS_P = WS_UNION;
constexpr size_t WS_QN = WS_P + (size_t)MP * NP * 2;
constexpr size_t WS_KN = WS_QN + (size_t)MP * 512 * 2;
constexpr size_t WS_KNT = WS_UNION + (size_t)MP * FF * 2;
constexpr size_t WS_VT = WS_KNT + (size_t)MP * 512 * 2;
constexpr size_t WS_VBT = WS_VT + (size_t)MP * 512 * 2;
constexpr size_t WS_G = WS_VBT + (size_t)MP * 512 * 2;
constexpr size_t WS_BETA = WS_G + (size_t)MP * 4 * 4;
constexpr size_t WS_EG = WS_BETA + (size_t)MP * 4 * 4;
constexpr size_t WS_IMG = WS_EG + 4096;
constexpr size_t WS_UIMG = WS_IMG + (size_t)1024 * IMG_BYTES;
constexpr size_t WS_AMIX = WS_UIMG + (size_t)1024 * 32768;
constexpr size_t WS_XS = WS_AMIX + (size_t)MP * DM * 2;
constexpr size_t WS_PS = WS_XS + (size_t)SBATCH * DM * 4;
constexpr size_t WS_QS = WS_PS + (size_t)SBATCH * NPS * 4;
constexpr size_t WS_KS = WS_QS + (size_t)SBATCH * 512 * 4;
constexpr size_t WS_VS = WS_KS + (size_t)SBATCH * 512 * 4;
constexpr size_t WS_GS = WS_VS + (size_t)SBATCH * 512 * 4;
constexpr size_t WS_BS = WS_GS + (size_t)SBATCH * 4 * 4;
constexpr size_t WS_AMIXS = WS_BS + (size_t)SBATCH * 4 * 4;
constexpr size_t WS_HS = WS_AMIXS + (size_t)SBATCH * DM * 4;
constexpr size_t WS_XP = WS_HS + (size_t)SBATCH * FF * 4;
constexpr size_t WS_END = WS_XP + (size_t)4 * SBATCH * DM * 4;
static_assert(WS_QN + 2 * (size_t)MP * 512 * 2 == WS_KNT, "union");
static_assert(WS_END <= (size_t)536870912, "workspace");

DI unsigned pk2(float lo, float hi) { f32x2 v = {lo, hi}; return __builtin_bit_cast(unsigned, __builtin_convertvector(v, bf2_t)); }
DI float bflo(unsigned w) { return __uint_as_float(w << 16); }
DI float bfhi(unsigned w) { return __uint_as_float(w & 0xffff0000u); }
DI float bf2f(bf16_t b) { return __uint_as_float(((unsigned)b) << 16); }
DI bf16_t f2bf(float f) { return (bf16_t)(pk2(f, 0.f) & 0xffffu); }
DI float wave_sum(float v) {
#pragma unroll
    for (int o = 1; o < 64; o <<= 1) v += __shfl_xor(v, o);
    return v;
}
DI float silu_f(float x) { return x / (1.f + __expf(-x)); }
DI float sigmoid_f(float x) { return 1.f / (1.f + __expf(-x)); }
DI float softplus_f(float x) { return fmaxf(x, 0.f) + log1pf(__expf(-fabsf(x))); }
DI u32x4 pack8(const f32x16& x, int s) {
    u32x4 p; p.x = pk2(x[8 * s], x[8 * s + 1]); p.y = pk2(x[8 * s + 2], x[8 * s + 3]); p.z = pk2(x[8 * s + 4], x[8 * s + 5]); p.w = pk2(x[8 * s + 6], x[8 * s + 7]); return p;
}
DI float ssq_sum(const float* p) {
    const f32x4 a = *(const f32x4*)p, b = *(const f32x4*)(p + 4), c2 = *(const f32x4*)(p + 8), d2 = *(const f32x4*)(p + 12);
    return ((a.x + a.y) + (a.z + a.w)) + ((b.x + b.y) + (b.z + b.w)) + ((c2.x + c2.y) + (c2.z + c2.w)) + ((d2.x + d2.y) + (d2.z + d2.w));
}
DI int crow(int reg, int h) { return (reg & 3) + 8 * (reg >> 2) + 4 * h; }
#define MFMA32(a, b, c) __builtin_amdgcn_mfma_f32_32x32x16_bf16((a), (b), (c), 0, 0, 0)
#define MFMA16(a, b, c) __builtin_amdgcn_mfma_f32_16x16x32_bf16((a), (b), (c), 0, 0, 0)
DI bf16x8 as_bf(u32x4 v) { return __builtin_bit_cast(bf16x8, v); }
DI f32x16 zero16() { f32x16 z;
#pragma unroll
    for (int i = 0; i < 16; ++i) z[i] = 0.f; return z; }

namespace pg8 {
constexpr int BM = 256, BK = 64, HALF = 128, HTB = HALF * BK * 2, STAGE_BYTES = 8 * HTB, NXCD = 8, WGM = 8;
DI int lds_byte(int r, int c) { const int st = (r >> 4) * 2 + (c >> 5), rr = r & 15, cc = c & 31, ob = rr * 64 + cc * 2; return st * 1024 + (ob ^ (((ob >> 9) & 1) << 5)); }
DI void stage_rc(int b, int& R, int& C) { const int st = b / 1024, sb = b % 1024, swz = sb ^ (((sb >> 9) & 1) << 5); R = (st >> 1) * 16 + swz / 64; C = (st & 1) * 32 + (swz % 64) / 2; }
DI int perm32(int rho) { const int n = rho >> 4, i = rho & 15; return 8 * (i >> 2) + 4 * n + (i & 3); }
struct Unit { int pm, pn; };
struct Gemm { const bf16_t* A; const bf16_t* Bt; int M, N, K; };
struct StaticOrder {
    int nM, nN, nwg, G, c;
    DI void init(int M, int N, int G_, int c_) { nM = M / BM; nN = N / BM; nwg = nM * nN; G = G_; c = c_; }
    DI bool next(int i, Unit& u) const {
        const long L = (long)i * G + c; if (L >= nwg) return false;
        int wgid = (int)L; { const int q = nwg / NXCD, r = nwg % NXCD, xcd = wgid % NXCD, off = wgid / NXCD; wgid = (xcd < r ? xcd * (q + 1) : r * (q + 1) + (xcd - r) * q) + off; }
        const int nig = WGM * nN, gid = wgid / nig, fm = gid * WGM, gsz = (nM - fm) < WGM ? (nM - fm) : WGM;
        u.pm = fm + ((wgid % nig) % gsz); u.pn = (wgid % nig) / gsz; return true;
    }
};
template <class Epi>
DI void gemm_phase(LAS unsigned char* lds, const Gemm g, const StaticOrder& S, const Epi& E) {
    int tid = threadIdx.x; asm volatile("" : "+v"(tid));
    const int wid = __builtin_amdgcn_readfirstlane(tid >> 6), lane = tid & 63, wr = wid >> 2, wc = wid & 3, fr = lane & 15, fq = lane >> 4;
    const int K = g.K, nt = K / BK;
    unsigned voffA[2], voffB[2];
#pragma unroll
    for (int i = 0; i < 2; ++i) { int R, C; stage_rc(tid * 16 + i * 8192, R, C); const int Rb = (R & ~31) + perm32(R & 31);
        voffA[i] = (unsigned)(R * K + C) * 2u; voffB[i] = (unsigned)(Rb * K + C) * 2u; }
    const size_t kstep = (size_t)(BK * 2);
    const size_t hstep = (size_t)HALF * K * 2;
    const size_t tstep = 2 * hstep;
    const unsigned ldsw = (unsigned)wid * 1024u;
    const int aoff = lds_byte(wr * 64 + fr, fq * 8), boff = lds_byte(wc * 32 + fr, fq * 8);
#define PG8_SA(b, h) (((b) * 2 + (h)) * HTB)
#define PG8_SB(b, h) ((4 + (b) * 2 + (h)) * HTB)
#define PG8_STAGE(bufoff, gbase, voff) do { _Pragma("unroll") for (int _i = 0; _i < 2; ++_i) \
        __builtin_amdgcn_global_load_lds((const unsigned*)((const char*)(gbase) + (voff)[_i]), (LAS unsigned*)(lds + (bufoff) + ldsw + _i * 8192), 16, 0, 0); } while (0)
#define PG8_LDA(dst, b, h) do { _Pragma("unroll") for (int m = 0; m < 4; ++m) _Pragma("unroll") for (int k = 0; k < 2; ++k) dst[m][k] = *(const LAS bf16x8*)(lds + PG8_SA(b, h) + aoff + m * 2048 + k * 1024); } while (0)
#define PG8_LDB(dst, b, h) do { _Pragma("unroll") for (int n = 0; n < 2; ++n) _Pragma("unroll") for (int k = 0; k < 2; ++k) dst[n][k] = *(const LAS bf16x8*)(lds + PG8_SB(b, h) + boff + n * 2048 + k * 1024); } while (0)
#define PG8_MMA(ai, bj, At, Bt) do { __builtin_amdgcn_s_setprio(1); _Pragma("unroll") for (int m = 0; m < 4; ++m) _Pragma("unroll") for (int n = 0; n < 2; ++n) _Pragma("unroll") for (int k = 0; k < 2; ++k) \
        acc[ai][bj][m][n] = __builtin_amdgcn_mfma_f32_16x16x32_bf16(Bt[n][k], At[m][k], acc[ai][bj][m][n], 0, 0, 0); __builtin_amdgcn_s_setprio(0); } while (0)
#define PG8_WAIT_V(n) asm volatile("s_waitcnt vmcnt(" #n ")" ::: "memory")
#define PG8_WAIT_L(n) asm volatile("s_waitcnt lgkmcnt(" #n ")" ::: "memory")
#define PG8_BAR __builtin_amdgcn_s_barrier()
#define PG8_SCHED __builtin_amdgcn_sched_barrier(0)
    Unit cur, nxt; int ui = 0;
    if (!S.next(0, cur)) return;
    f32x4 acc[2][2][4][2];
#pragma unroll
    for (int a = 0; a < 2; ++a)
#pragma unroll
        for (int b = 0; b < 2; ++b)
#pragma unroll
            for (int m = 0; m < 4; ++m)
#pragma unroll
                for (int n = 0; n < 2; ++n) acc[a][b][m][n] = (f32x4){0.f, 0.f, 0.f, 0.f};
    bf16x8 At[4][2], B0[2][2], B1[2][2];
    const char* cA = (const char*)g.A + (size_t)cur.pm * tstep; const char* cB = (const char*)g.Bt + (size_t)cur.pn * tstep;
    PG8_STAGE(PG8_SB(0, 0), cB, voffB); PG8_STAGE(PG8_SA(0, 0), cA, voffA); PG8_STAGE(PG8_SB(0, 1), cB + hstep, voffB); PG8_STAGE(PG8_SA(0, 1), cA + hstep, voffA);
    if (wr == 1) PG8_BAR;
    PG8_WAIT_V(4); PG8_BAR;
    PG8_STAGE(PG8_SB(1, 0), cB + kstep, voffB); PG8_STAGE(PG8_SA(1, 0), cA + kstep, voffA); PG8_STAGE(PG8_SB(1, 1), cB + hstep + kstep, voffB);
    PG8_WAIT_V(6); PG8_BAR;
    for (;;) {
        const bool has_next = S.next(ui + 1, nxt);
        const char* nA = has_next ? (const char*)g.A + (size_t)nxt.pm * tstep : cA; const char* nB = has_next ? (const char*)g.Bt + (size_t)nxt.pn * tstep : cB;
        for (int t = 0; t < nt; t += 2) {
            const bool last = (t == nt - 2);
            const char* a1 = cA + (size_t)(t + 1) * kstep;
            const char* a2 = last ? nA : cA + (size_t)(t + 2) * kstep; const char* b2 = last ? nB : cB + (size_t)(t + 2) * kstep;
            const char* a3 = a2 + kstep; const char* b3 = b2 + kstep;
            PG8_LDB(B0, 0, 0); PG8_SCHED; PG8_LDA(At, 0, 0); PG8_STAGE(PG8_SA(1, 1), a1 + hstep, voffA);
            PG8_WAIT_L(8); PG8_BAR; PG8_WAIT_L(0); PG8_MMA(0, 0, At, B0); PG8_BAR; PG8_SCHED;
            PG8_LDB(B1, 0, 1); PG8_STAGE(PG8_SB(0, 0), b2, voffB);
            PG8_BAR; PG8_WAIT_L(0); PG8_MMA(0, 1, At, B1); PG8_BAR;
            PG8_LDA(At, 0, 1); PG8_STAGE(PG8_SA(0, 0), a2, voffA);
            PG8_BAR; PG8_WAIT_L(0); PG8_MMA(1, 0, At, B0); PG8_BAR; PG8_SCHED;
            PG8_STAGE(PG8_SB(0, 1), b2 + hstep, voffB);
            PG8_WAIT_V(6); PG8_BAR; PG8_MMA(1, 1, At, B1); PG8_BAR;
            PG8_LDB(B0, 1, 0); PG8_SCHED; PG8_LDA(At, 1, 0); PG8_STAGE(PG8_SA(0, 1), a2 + hstep, voffA);
            PG8_WAIT_L(8); PG8_BAR; PG8_WAIT_L(0); PG8_MMA(0, 0, At, B0); PG8_BAR; PG8_SCHED;
            PG8_LDB(B1, 1, 1); PG8_STAGE(PG8_SB(1, 0), b3, voffB);
            PG8_BAR; PG8_WAIT_L(0); PG8_MMA(0, 1, At, B1); PG8_BAR;
            PG8_LDA(At, 1, 1); PG8_STAGE(PG8_SA(1, 0), a3, voffA);
            PG8_BAR; PG8_WAIT_L(0); PG8_MMA(1, 0, At, B0); PG8_BAR; PG8_SCHED;
            PG8_STAGE(PG8_SB(1, 1), b3 + hstep, voffB);
            PG8_WAIT_V(6); PG8_BAR; PG8_MMA(1, 1, At, B1); PG8_BAR;
        }
        E(acc, cur, wr, wc, fr, fq);
        if (!has_next) break;
#pragma unroll
        for (int a = 0; a < 2; ++a)
#pragma unroll
            for (int b = 0; b < 2; ++b)
#pragma unroll
                for (int m = 0; m < 4; ++m)
#pragma unroll
                    for (int n = 0; n < 2; ++n) acc[a][b][m][n] = (f32x4){0.f, 0.f, 0.f, 0.f};
        cur = nxt; cA = nA; cB = nB; ++ui;
    }
    PG8_WAIT_V(0);
    if (wr == 0) PG8_BAR;
    PG8_BAR;
#undef PG8_SA
#undef PG8_SB
#undef PG8_STAGE
#undef PG8_LDA
#undef PG8_LDB
#undef PG8_MMA
#undef PG8_WAIT_V
#undef PG8_WAIT_L
#undef PG8_BAR
#undef PG8_SCHED
}
struct EpiScaleBf16 {
    bf16_t* O; int ldc; const float* ssq; int act;
    DI void operator()(const f32x4 (&acc)[2][2][4][2], const Unit& u, int wr, int wc, int fr, int fq) const {
        const int row0 = u.pm * BM + wr * 64 + fr, col0 = u.pn * BM + wc * 32 + 8 * fq;
#pragma unroll
        for (int ai = 0; ai < 2; ++ai)
#pragma unroll
            for (int m = 0; m < 4; ++m) { const int row = row0 + ai * HALF + m * 16; const float rs = rsqrtf(ssq_sum(ssq + (size_t)row * 16) * (1.0f / DM) + EPS);
                bf16_t* rowp = O + (size_t)row * ldc + col0;
#pragma unroll
                for (int bj = 0; bj < 2; ++bj) { f32x4 v0 = acc[ai][bj][m][0] * rs, v1 = acc[ai][bj][m][1] * rs;
                    if (act) {
#pragma unroll
                        for (int j = 0; j < 4; ++j) { const float a = fmaxf(v0[j], 0.f), b = fmaxf(v1[j], 0.f); v0[j] = a * a; v1[j] = b * b; } }
                    u32x4 w; w.x = pk2(v0[0], v0[1]); w.y = pk2(v0[2], v0[3]); w.z = pk2(v1[0], v1[1]); w.w = pk2(v1[2], v1[3]);
                    *(u32x4*)(rowp + bj * HALF) = w; } }
    }
};
struct EpiResid {
    const float* base; float* out; bf16_t* xb; float* ssq;
    DI void operator()(const f32x4 (&acc)[2][2][4][2], const Unit& u, int wr, int wc, int fr, int fq) const {
        const int row0 = u.pm * BM + wr * 64 + fr, col0 = u.pn * BM + wc * 32 + 8 * fq;
#pragma unroll
        for (int ai = 0; ai < 2; ++ai)
#pragma unroll
            for (int m = 0; m < 4; ++m) { const int row = row0 + ai * HALF + m * 16; const size_t off = (size_t)row * DM + col0; float ss = 0.f;
#pragma unroll
                for (int bj = 0; bj < 2; ++bj) {
                    const f32x4 b0 = *(const f32x4*)(base + off + bj * HALF), b1 = *(const f32x4*)(base + off + bj * HALF + 4);
                    const f32x4 o0 = b0 + acc[ai][bj][m][0], o1 = b1 + acc[ai][bj][m][1];
                    *(f32x4*)(out + off + bj * HALF) = o0; *(f32x4*)(out + off + bj * HALF + 4) = o1;
                    u32x4 w; w.x = pk2(o0[0], o0[1]); w.y = pk2(o0[2], o0[3]); w.z = pk2(o1[0], o1[1]); w.w = pk2(o1[2], o1[3]);
                    *(u32x4*)(xb + off + bj * HALF) = w;
                    ss += (o0[0] * o0[0] + o0[1] * o0[1]) + (o0[2] * o0[2] + o0[3] * o0[3]) + (o1[0] * o1[0] + o1[1] * o1[1]) + (o1[2] * o1[2] + o1[3] * o1[3]); }
                ss += __shfl_xor(ss, 16); ss += __shfl_xor(ss, 32);
                if (fq == 0) ssq[(size_t)row * 16 + u.pn * 4 + wc] = ss;
                asm volatile("" ::: "memory"); }
    }
};
}

struct Args { const float* in[18]; float* out; unsigned char* ws; int ph_lo, ph_hi; };
struct Ctx {
    const float *x_prompt, *x_sample, *state_delta, *state_conv, *norm_mix_g, *w_in, *conv_w, *A_log, *dt_bias, *o_norm_g, *v_norm_g, *w_s, *b_s, *w_o, *norm_ffn_g, *w_up, *w_down, *norm_f_g;
    float* out; unsigned char* ws;
    int lane, wave, gw, ngw;
};
#define WSP(T, off) ((T*)(c.ws + (off)))

DI void transpose_item(const float* W, int K, int N, const float* kscale, bf16_t* WT, bf16_t* WAB, int mode, int item, int nblk, LAS float* scr, int lane) {
    const int kb = item / nblk, nb = item % nblk, k0 = 64 * kb, n0 = 32 * nb;
    const int nl = lane & 31, nsrc = n0 + nl;
#pragma unroll 8
    for (int i = 0; i < 32; ++i) { const int kk = 2 * i + (lane >> 5);
        float v = 0.f; if (nsrc < N) { v = W[(size_t)(k0 + kk) * N + nsrc]; if (kscale) v *= kscale[k0 + kk]; }
        scr[kk * 33 + nl] = v; }
    asm volatile("s_waitcnt lgkmcnt(0)" ::: "memory");
    const int cch = lane & 7;
#pragma unroll
    for (int j = 0; j < 4; ++j) { const int n = (lane >> 3) + 8 * j, ns = n0 + n; const LAS float* s = scr + (8 * cch) * 33 + n;
        u32x4 o; o.x = pk2(s[0 * 33], s[1 * 33]); o.y = pk2(s[2 * 33], s[3 * 33]); o.z = pk2(s[4 * 33], s[5 * 33]); o.w = pk2(s[6 * 33], s[7 * 33]);
        if (ns < N) {
            bf16_t* rowp;
            if (mode == 0) rowp = WT + (size_t)ns * K;
            else rowp = ns < 2048 ? WT + (size_t)ns * K : (ns < 2056 ? WAB + (size_t)(ns - 2048) * K : WT + (size_t)(ns - 8) * K);
            *(u32x4*)(rowp + k0 + 8 * cch) = o; } }
    asm volatile("s_waitcnt lgkmcnt(0)" ::: "memory");
}
DI void phase_prologue(const Ctx& c, LAS unsigned char* lds) {
    LAS float* scr = (LAS float*)(lds + c.wave * 16384);
    constexpr int I_IN = 16 * 97, I_O = 16 * 32, I_UP = 16 * 128, I_DN = 64 * 32, I_L = I_IN + I_O + I_UP + I_DN;
    for (int it = c.gw; it < DEPTH * I_L; it += c.ngw) {
        const int l = it / I_L; int r = it % I_L;
        if (r < I_IN) { transpose_item(c.w_in + (size_t)l * DM * PROJ, DM, PROJ, c.norm_mix_g + l * DM, WSP(bf16_t, WS_WIN) + (size_t)l * NP * DM, WSP(bf16_t, WS_WAB) + (size_t)l * 16 * DM, 1, r, 97, scr, c.lane); continue; } r -= I_IN;
        if (r < I_O) { transpose_item(c.w_o + (size_t)l * DM * DM, DM, DM, nullptr, WSP(bf16_t, WS_WO) + (size_t)l * DM * DM, nullptr, 0, r, 32, scr, c.lane); continue; } r -= I_O;
        if (r < I_UP) { transpose_item(c.w_up + (size_t)l * DM * FF, DM, FF, c.norm_ffn_g + l * DM, WSP(bf16_t, WS_WUP) + (size_t)l * FF * DM, nullptr, 0, r, 128, scr, c.lane); continue; } r -= I_UP;
        transpose_item(c.w_down + (size_t)l * FF * DM, FF, DM, nullptr, WSP(bf16_t, WS_WDN) + (size_t)l * DM * FF, nullptr, 0, r, 32, scr, c.lane);
    }
    float* ssq = WSP(float, WS_SSQ);
    for (int m = c.gw; m < MP; m += c.ngw) {
        const f32x4* xr = (const f32x4*)(c.x_prompt + (size_t)m * DM) + c.lane; u32x2* o8 = (u32x2*)(WSP(bf16_t, WS_XB16) + (size_t)m * DM) + c.lane; float s = 0.f;
#pragma unroll
        for (int j = 0; j < 4; ++j) { const f32x4 v = xr[64 * j]; s += (v.x * v.x + v.y * v.y) + (v.z * v.z + v.w * v.w); u32x2 w; w.x = pk2(v.x, v.y); w.y = pk2(v.z, v.w); o8[64 * j] = w; }
        s = wave_sum(s); if (c.lane < 16) ssq[(size_t)m * 16 + c.lane] = c.lane == 0 ? s : 0.f;
    }
    const int gt = c.gw * 64 + c.lane, ngt = c.ngw * 64;
    float* xs = WSP(float, WS_XS);
    for (int i = gt; i < SBATCH * DM; i += ngt) xs[i] = c.x_sample[i];
    bf16_t* wab = WSP(bf16_t, WS_WAB);
    for (int i = gt; i < DEPTH * 8 * DM; i += ngt) { const int l = i / (8 * DM), r = i % (8 * DM); wab[(size_t)l * 16 * DM + 8 * DM + r] = 0; }
    unsigned* wm = WSP(unsigned, WS_WM);
    for (int i = gt; i < DEPTH * 4 * 128 * 64; i += ngt) { const int e = 2 * i, ii = (e >> 7) & 127, jj = e & 127;
        const float a = ii >= jj ? c.w_s[e] : 0.f, b = ii >= jj + 1 ? c.w_s[e + 1] : 0.f; wm[i] = pk2(a, b); }
}

template <bool NORM, bool PARTS = false>
DI f32x4 sgemm_tile(const float* A, int lda, const bf16_t* Bt, int ldb, int r0, int n0, int k0, int klen, int lane, float& rstd, const float* xp = nullptr) {
    const int fr = lane & 15, fq = lane >> 4;
    const float* ap = A + (size_t)(r0 + fr) * lda + k0 + 8 * fq;
    const bf16_t* bp = Bt + (size_t)(n0 + fr) * ldb + k0 + 8 * fq;
    f32x4 acc = {0.f, 0.f, 0.f, 0.f}; float ss = 0.f;
#pragma unroll 8
    for (int k = 0; k < klen; k += 32) {
        f32x4 a0 = *(const f32x4*)(ap + k), a1 = *(const f32x4*)(ap + k + 4);
        if (PARTS) { const float* pp = xp + (size_t)(r0 + fr) * lda + k0 + 8 * fq + k;
#pragma unroll
            for (int q = 0; q < 4; ++q) { a0 += *(const f32x4*)(pp + (size_t)q * SBATCH * DM); a1 += *(const f32x4*)(pp + (size_t)q * SBATCH * DM + 4); } }
        const bf16x8 b = *(const bf16x8*)(bp + k);
        if (NORM) ss += (a0.x * a0.x + a0.y * a0.y) + (a0.z * a0.z + a0.w * a0.w) + (a1.x * a1.x + a1.y * a1.y) + (a1.z * a1.z + a1.w * a1.w);
        u32x4 a; a.x = pk2(a0.x, a0.y); a.y = pk2(a0.z, a0.w); a.z = pk2(a1.x, a1.y); a.w = pk2(a1.z, a1.w);
        acc = MFMA16(as_bf(a), b, acc);
    }
    if (NORM) { ss += __shfl_xor(ss, 16); ss += __shfl_xor(ss, 32); rstd = rsqrtf(ss * (1.0f / DM) + EPS); }
    return acc;
}
DI void sgemm1(const Ctx& c, int l) {
    const float* xs = WSP(float, WS_XS); float* ps = WSP(float, WS_PS);
    const int fr = c.lane & 15, fq = c.lane >> 4;
    for (int t = c.gw; t < 8 * 193; t += c.ngw) { const int rt = t & 7, ntile = t >> 3; float rstd;
        const bf16_t* Bt = ntile < 192 ? WSP(bf16_t, WS_WIN) + (size_t)l * NP * DM + (size_t)ntile * 16 * DM : WSP(bf16_t, WS_WAB) + (size_t)l * 16 * DM;
        const f32x4 acc = l > 0 ? sgemm_tile<true, true>(xs, DM, Bt, DM, rt * 16, 0, 0, DM, c.lane, rstd, WSP(float, WS_XP)) : sgemm_tile<true>(xs, DM, Bt, DM, rt * 16, 0, 0, DM, c.lane, rstd);
#pragma unroll
        for (int j = 0; j < 4; ++j) { const float rs = __shfl(rstd, 4 * fq + j); ps[(size_t)(rt * 16 + 4 * fq + j) * NPS + ntile * 16 + fr] = acc[j] * rs; } }
}
DI void sgemm2(const Ctx& c, int l) {
    const float* am = WSP(float, WS_AMIXS); float* xs = WSP(float, WS_XS);
    const int fr = c.lane & 15, fq = c.lane >> 4;
    for (int t = c.gw; t < 8 * 64; t += c.ngw) { const int rt = t & 7, ntile = t >> 3; float rstd;
        const f32x4 acc = sgemm_tile<false>(am, DM, WSP(bf16_t, WS_WO) + (size_t)l * DM * DM, DM, rt * 16, ntile * 16, 0, DM, c.lane, rstd);
#pragma unroll
        for (int j = 0; j < 4; ++j) { const size_t o = (size_t)(rt * 16 + 4 * fq + j) * DM + ntile * 16 + fr; float v = xs[o] + acc[j];
            if (l > 0) { const float* xp = WSP(float, WS_XP) + o; v += (xp[0] + xp[(size_t)SBATCH * DM]) + (xp[(size_t)2 * SBATCH * DM] + xp[(size_t)3 * SBATCH * DM]); }
            xs[o] = v; } }
}
DI void sgemm3(const Ctx& c, int l) {
    const float* xs = WSP(float, WS_XS); float* hs = WSP(float, WS_HS);
    const int fr = c.lane & 15, fq = c.lane >> 4;
    for (int t = c.gw; t < 8 * 256; t += c.ngw) { const int rt = t & 7, ntile = t >> 3; float rstd;
        const f32x4 acc = sgemm_tile<true>(xs, DM, WSP(bf16_t, WS_WUP) + (size_t)l * FF * DM, DM, rt * 16, ntile * 16, 0, DM, c.lane, rstd);
#pragma unroll
        for (int j = 0; j < 4; ++j) { const float rs = __shfl(rstd, 4 * fq + j); const float v = fmaxf(acc[j] * rs, 0.f); hs[(size_t)(rt * 16 + 4 * fq + j) * FF + ntile * 16 + fr] = v * v; } }
}
DI void sgemm4(const Ctx& c, int l) {
    const float* hs = WSP(float, WS_HS); float* xp = WSP(float, WS_XP);
    const int fr = c.lane & 15, fq = c.lane >> 4;
    for (int t = c.gw; t < 8 * 64 * 4; t += c.ngw) { const int rt = t & 7, ntile = (t >> 3) & 63, kq = t >> 9; float rstd;
        const f32x4 acc = sgemm_tile<false>(hs, FF, WSP(bf16_t, WS_WDN) + (size_t)l * DM * FF, FF, rt * 16, ntile * 16, kq * 1024, 1024, c.lane, rstd);
#pragma unroll
        for (int j = 0; j < 4; ++j) xp[(size_t)kq * SBATCH * DM + (size_t)(rt * 16 + 4 * fq + j) * DM + ntile * 16 + fr] = acc[j]; }
}

DI void b0_task_ab(const Ctx& c, int l, int b, int n) {
    const int fr = c.lane & 15, fq = c.lane >> 4, tok0 = b * SEQ + n * 64;
    const bf16_t* ap = WSP(bf16_t, WS_XB16) + (size_t)(tok0 + fr) * DM + 8 * fq;
    const bf16_t* bp = WSP(bf16_t, WS_WAB) + (size_t)l * 16 * DM + (size_t)fr * DM + 8 * fq;
    f32x4 acc[4];
#pragma unroll
    for (int mt = 0; mt < 4; ++mt) acc[mt] = (f32x4){0.f, 0.f, 0.f, 0.f};
#pragma unroll 4
    for (int k = 0; k < DM; k += 32) {
        const bf16x8 bf = *(const bf16x8*)(bp + k);
#pragma unroll
        for (int mt = 0; mt < 4; ++mt) { const bf16x8 a = *(const bf16x8*)(ap + (size_t)mt * 16 * DM + k); acc[mt] = MFMA16(a, bf, acc[mt]); }
    }
    const float* ssq = WSP(float, WS_SSQ) + (size_t)(2 * l) * MP * 16;
    float* gb = WSP(float, WS_G); float* bb = WSP(float, WS_BETA);
    if (fr < 8) { const int hh = fr & 3; const float al = -__expf(c.A_log[l * 4 + hh]), dtb = c.dt_bias[l * 4 + hh];
#pragma unroll
        for (int mt = 0; mt < 4; ++mt)
#pragma unroll
            for (int j = 0; j < 4; ++j) { const int tok = tok0 + 16 * mt + 4 * fq + j; const float v = acc[mt][j] * rsqrtf(ssq_sum(ssq + (size_t)tok * 16) * (1.0f / DM) + EPS);
                if (fr < 4) gb[tok * 4 + hh] = al * softplus_f(v + dtb); else bb[tok * 4 + hh] = sigmoid_f(v); } }
}
DI void conv8(const bf16_t* prow, const float* cw, int pos, int i, float (&y)[8], u32x4& cur) {
    u32x4 rws[4];
#pragma unroll
    for (int j = 0; j < 4; ++j) { rws[j] = (u32x4){0u, 0u, 0u, 0u}; if (pos - 3 + j >= 0) rws[j] = *(const u32x4*)(prow + (long)(j - 3) * NP + 8 * i); }
#pragma unroll
    for (int e = 0; e < 8; ++e) { float a = 0.f;
#pragma unroll
        for (int j = 0; j < 4; ++j) { const unsigned w = rws[j][e >> 1]; const float pv = (e & 1) ? bfhi(w) : bflo(w); a += pv * cw[j * QKV + 8 * i + e]; }
        y[e] = silu_f(a); }
    cur = rws[3];
}
DI void b0_task_conv(const Ctx& c, int l, int b, int n, int s, int hh) {
    const int pos = n * 64 + c.lane, tok = b * SEQ + pos, cb = s * 512 + hh * 128;
    const bf16_t* prow = WSP(bf16_t, WS_P) + (size_t)tok * NP + cb;
    const float* cw = c.conv_w + (size_t)l * 4 * QKV + cb;
    float* ocp = c.out + O_CP + ((size_t)(l * NBATCH + b) * 3) * QKV + cb;
    float ss = 0.f;
    if (s < 2) {
#pragma unroll 2
        for (int i = 0; i < 16; ++i) { float y[8]; u32x4 cur; conv8(prow, cw, pos, i, y, cur);
#pragma unroll
            for (int e = 0; e < 8; ++e) ss += y[e] * y[e]; } }
    const float sc = s == 0 ? rsqrtf(ss + EPS) * 0.08838834764831845f : (s == 1 ? rsqrtf(ss + EPS) : 1.0f);
    const size_t unit = (size_t)((b * 4 + hh) * 32 + n);
    bf16_t* o = (s == 0 ? WSP(bf16_t, WS_QN) : WSP(bf16_t, WS_KN)) + (size_t)tok * 512 + hh * 128;
    bf16_t* ot = (s == 1 ? WSP(bf16_t, WS_KNT) : WSP(bf16_t, WS_VT)) + unit * 128 * 64 + c.lane;
#pragma unroll 2
    for (int i = 0; i < 16; ++i) { float y[8]; u32x4 cur; conv8(prow, cw, pos, i, y, cur);
        if (n == 31 && c.lane >= 61) {
#pragma unroll
            for (int e = 0; e < 8; ++e) { const unsigned w = cur[e >> 1]; ocp[(size_t)(c.lane - 61) * QKV + 8 * i + e] = (e & 1) ? bfhi(w) : bflo(w); } }
        if (s < 2) { u32x4 w; w.x = pk2(y[0] * sc, y[1] * sc); w.y = pk2(y[2] * sc, y[3] * sc); w.z = pk2(y[4] * sc, y[5] * sc); w.w = pk2(y[6] * sc, y[7] * sc); *(u32x4*)(o + 8 * i) = w; }
        if (s >= 1) {
#pragma unroll
            for (int e = 0; e < 8; ++e) ot[(8 * i + e) * 64] = f2bf(y[e] * sc); } }
}
DI void b0_task_vb(const Ctx& c, int l, int b, int n) {
    const int tok = b * SEQ + n * 64 + c.lane;
    const bf16_t* prow = WSP(bf16_t, WS_P) + (size_t)tok * NP + 2560;
    float ss = 0.f;
#pragma unroll 8
    for (int i = 0; i < 64; ++i) { const u32x4 w = *(const u32x4*)(prow + 8 * i);
#pragma unroll
        for (int e = 0; e < 4; ++e) { const float a = bflo(w[e]), bq = bfhi(w[e]); ss += a * a + bq * bq; } }
    const float rs = rsqrtf(ss * (1.0f / 512.0f) + EPS);
    const float* vg = c.v_norm_g + l * 512;
    bf16_t* vbt = WSP(bf16_t, WS_VBT) + (size_t)((b * 16 + (n >> 1)) * 4) * 128 * 128 + (n & 1) * 64 + c.lane;
#pragma unroll 4
    for (int i = 0; i < 64; ++i) { const u32x4 w = *(const u32x4*)(prow + 8 * i);
#pragma unroll
        for (int e = 0; e < 8; ++e) { const int ch = 8 * i + e; const float pv = (e & 1) ? bfhi(w[e >> 1]) : bflo(w[e >> 1]);
            vbt[(size_t)ch * 128] = f2bf(pv * rs * vg[ch]); } }
}
DI void b0_task_sample(const Ctx& c, int l, int bs) {
    const float* ps = WSP(float, WS_PS) + (size_t)bs * NPS;
    if (c.lane < 4) { const int hh = c.lane;
        WSP(float, WS_GS)[bs * 4 + hh] = -__expf(c.A_log[l * 4 + hh]) * softplus_f(ps[3072 + hh] + c.dt_bias[l * 4 + hh]);
        WSP(float, WS_BS)[bs * 4 + hh] = sigmoid_f(ps[3076 + hh]); }
    const float* sc = c.state_conv + (size_t)(l * SBATCH + bs) * 3 * QKV;
    const float* cw = c.conv_w + (size_t)l * 4 * QKV;
    float* ocs = c.out + O_CS + (size_t)(l * SBATCH + bs) * 3 * QKV;
    float* qkvs = WSP(float, WS_QS) + bs * 512;
#pragma unroll 1
    for (int sh = 0; sh < 12; ++sh) {
        float y[2];
#pragma unroll
        for (int t = 0; t < 2; ++t) { const int ch = sh * 128 + t * 64 + c.lane; const float s0 = sc[ch], s1 = sc[QKV + ch], s2 = sc[2 * QKV + ch], cur = ps[ch];
            ocs[ch] = s1; ocs[QKV + ch] = s2; ocs[2 * QKV + ch] = cur;
            y[t] = silu_f(s0 * cw[ch] + s1 * cw[QKV + ch] + s2 * cw[2 * QKV + ch] + cur * cw[3 * QKV + ch]); }
        float scale = 1.0f;
        if (sh < 8) { const float ssum = wave_sum(y[0] * y[0] + y[1] * y[1]); scale = rsqrtf(ssum + EPS) * (sh < 4 ? 0.08838834764831845f : 1.0f); }
        float* o = qkvs + (size_t)(sh >> 2) * SBATCH * 512 + (sh & 3) * 128;
        o[c.lane] = y[0] * scale; o[64 + c.lane] = y[1] * scale;
    }
    float pv[8]; float ss = 0.f;
#pragma unroll
    for (int i = 0; i < 8; ++i) { pv[i] = ps[2560 + c.lane + 64 * i]; ss += pv[i] * pv[i]; }
    ss = wave_sum(ss); const float rs = rsqrtf(ss * (1.0f / 512.0f) + EPS);
    float* am = WSP(float, WS_AMIXS) + (size_t)bs * DM; float* ovs = c.out + O_VS + (size_t)(l * SBATCH + bs) * 512;
#pragma unroll
    for (int i = 0; i < 8; ++i) { const int ch = c.lane + 64 * i, hb = ch >> 7; const float vb = pv[i] * rs * c.v_norm_g[l * 512 + ch];
        ovs[ch] = vb; am[512 + ch] = ps[2048 + ch] * (c.w_s[(size_t)(l * 4 + hb) * 128 * 128] * vb + c.b_s[(l * 4 + hb) * 128]); }
}
DI void phase_b0(const Ctx& c, int l) {
    constexpr int NPT = 256 * 14;
    for (int t = c.gw; t < NPT + SBATCH; t += c.ngw) {
        if (t >= NPT) { if (SUB(0)) b0_task_sample(c, l, t - NPT); continue; }
        const int chunk = t / 14, k = t % 14, b = chunk >> 5, n = chunk & 31;
        if (k == 0) { if (SUB(1)) b0_task_ab(c, l, b, n); }
        else if (k == 13) { if (SUB(2)) b0_task_vb(c, l, b, n); }
        else { if (SUB(3)) b0_task_conv(c, l, b, n, (k - 1) >> 2, (k - 1) & 3); }
    }
}

DI void b1_prep(const Ctx& c, int l, int unit, LAS unsigned char* wl, LAS float* sg, LAS float* sb) {
    int lane = c.lane; asm volatile("" : "+v"(lane));
    const int r = lane & 31, h = lane >> 5;
    const int n = unit & 31, bh = unit >> 5, hh = bh & 3, b = bh >> 2, tok0 = b * SEQ + n * 64;
    const float bt = WSP(float, WS_BETA)[(tok0 + lane) * 4 + hh];
    float gc = WSP(float, WS_G)[(tok0 + lane) * 4 + hh];
#pragma unroll
    for (int o = 1; o < 64; o <<= 1) { const float t = __shfl_up(gc, o); if (lane >= o) gc += t; }
    sg[lane] = gc; sb[lane] = bt;
    const float glast = __shfl(gc, 63);
    if (lane == 0) WSP(float, WS_EG)[unit] = __expf(glast);
    unsigned char* img = c.ws + WS_IMG + (size_t)unit * IMG_BYTES;
    const bf16_t* Kn = WSP(bf16_t, WS_KN) + (size_t)tok0 * 512 + hh * 128;
    const bf16_t* Qn = WSP(bf16_t, WS_QN) + (size_t)tok0 * 512 + hh * 128;
    const bf16_t* KnT = WSP(bf16_t, WS_KNT) + (size_t)unit * 128 * 64;
    const bf16_t* VT = WSP(bf16_t, WS_VT) + (size_t)unit * 128 * 64;
    LAS float* L = (LAS float*)wl;
    {
        bf16x8 Kf[2][8];
#pragma unroll
        for (int t = 0; t < 2; ++t)
#pragma unroll
            for (int ks = 0; ks < 8; ++ks) Kf[t][ks] = *(const bf16x8*)(Kn + (size_t)(32 * t + r) * 512 + 16 * ks + 8 * h);
#pragma unroll
        for (int tt = 0; tt < 3; ++tt) { const int mt = tt == 0 ? 0 : 1, nt = tt == 2 ? 1 : 0;
            f32x16 acc = zero16();
#pragma unroll
            for (int ks = 0; ks < 8; ++ks) acc = MFMA32(Kf[mt][ks], Kf[nt][ks], acc);
            const int j = 32 * nt + r; const float gj = sg[j];
#pragma unroll
            for (int g4 = 0; g4 < 4; ++g4) { const f32x4 gi4 = *(const LAS f32x4*)(sg + 32 * mt + 8 * g4 + 4 * h), bi4 = *(const LAS f32x4*)(sb + 32 * mt + 8 * g4 + 4 * h);
#pragma unroll
                for (int q = 0; q < 4; ++q) { const int i = 32 * mt + 8 * g4 + 4 * h + q; const float arg = i > j ? gi4[q] - gj : 0.f;
                    L[i * 64 + j] = i > j ? acc[4 * g4 + q] * bi4[q] * __expf(arg) : 0.f; } } }
#pragma unroll
        for (int mt = 0; mt < 2; ++mt) {
            bf16x8 Qf[8];
#pragma unroll
            for (int ks = 0; ks < 8; ++ks) Qf[ks] = *(const bf16x8*)(Qn + (size_t)(32 * mt + r) * 512 + 16 * ks + 8 * h);
            const int i = 32 * mt + r; const float gi = sg[i];
#pragma unroll
            for (int mp = 0; mp <= mt; ++mp) {
                f32x16 acc = zero16();
#pragma unroll
                for (int ks = 0; ks < 8; ++ks) acc = MFMA32(Kf[mp][ks], Qf[ks], acc);
#pragma unroll
                for (int g4 = 0; g4 < 4; ++g4) { const f32x4 gj4 = *(const LAS f32x4*)(sg + 32 * mp + 8 * g4 + 4 * h);
#pragma unroll
                    for (int q = 0; q < 4; ++q) { const int j = 32 * mp + 8 * g4 + 4 * h + q; const float arg = i >= j ? gi - gj4[q] : 0.f;
                        acc[4 * g4 + q] = i >= j ? acc[4 * g4 + q] * __expf(arg) : 0.f; } }
                const int fb = (mt == 0 ? 0 : 1 + mp) * 2;
#pragma unroll
                for (int s = 0; s < 2; ++s) *(u32x4*)(img + 49152 + (fb + s) * 1024 + lane * 16) = pack8(acc, s);
            }
        }
    }
    float Tr[64];
    {
        f32x4 lb[2][16];
#pragma unroll
        for (int i = 0; i < 64; ++i) {
            if (i + 1 < 64) {
#pragma unroll
                for (int j4 = 0; j4 < (i + 1 + 3) / 4; ++j4) lb[(i + 1) & 1][j4] = *(const LAS f32x4*)(L + (i + 1) * 64 + 4 * j4); }
            asm volatile("" ::: "memory");
            float a0 = lane == i ? 1.f : 0.f, a1 = 0.f;
#pragma unroll
            for (int j4 = 0; j4 < (i + 3) / 4; ++j4) {
#pragma unroll
                for (int q = 0; q < 4; ++q) { const int j = 4 * j4 + q; if (j < i) { if (q & 1) a1 -= lb[i & 1][j4][q] * Tr[j]; else a0 -= lb[i & 1][j4][q] * Tr[j]; } } }
            Tr[i] = a0 + a1;
        }
    }
    LAS bf16_t* T1 = (LAS bf16_t*)wl;
    asm volatile("" ::: "memory");
    {
        const float sc1 = bt * __expf(gc);
#pragma unroll
        for (int i = 0; i < 64; ++i) T1[i * 72 + lane] = f2bf(Tr[i] * sc1);
        bf16x8 Tf[2][4];
#pragma unroll
        for (int mt = 0; mt < 2; ++mt)
#pragma unroll
            for (int ks = 0; ks < 4; ++ks) Tf[mt][ks] = *(const LAS bf16x8*)(T1 + (32 * mt + r) * 72 + 16 * ks + 8 * h);
#pragma unroll
        for (int dt = 0; dt < 4; ++dt) {
            bf16x8 Kt[4];
#pragma unroll
            for (int ks = 0; ks < 4; ++ks) Kt[ks] = *(const bf16x8*)(KnT + (size_t)(32 * dt + r) * 64 + 16 * ks + 8 * h);
#pragma unroll
            for (int mt = 0; mt < 2; ++mt) { f32x16 acc = zero16();
#pragma unroll
                for (int ks = 0; ks < 2 * (mt + 1); ++ks) acc = MFMA32(Kt[ks], Tf[mt][ks], acc);
                acc = -acc;
#pragma unroll
                for (int s = 0; s < 2; ++s) *(u32x4*)(img + ((mt * 4 + dt) * 2 + s) * 1024 + lane * 16) = pack8(acc, s); }
        }
    }
    asm volatile("" ::: "memory");
    {
#pragma unroll
        for (int i = 0; i < 64; ++i) T1[i * 72 + lane] = f2bf(Tr[i] * bt);
        bf16x8 Tf[2][4];
#pragma unroll
        for (int mt = 0; mt < 2; ++mt)
#pragma unroll
            for (int ks = 0; ks < 4; ++ks) Tf[mt][ks] = *(const LAS bf16x8*)(T1 + (32 * mt + r) * 72 + 16 * ks + 8 * h);
        float* uimg = WSP(float, WS_UIMG) + (size_t)unit * 8192;
#pragma unroll
        for (int et = 0; et < 4; ++et) {
            bf16x8 Vt[4];
#pragma unroll
            for (int ks = 0; ks < 4; ++ks) Vt[ks] = *(const bf16x8*)(VT + (size_t)(32 * et + r) * 64 + 16 * ks + 8 * h);
#pragma unroll
            for (int mt = 0; mt < 2; ++mt) { f32x16 acc = zero16();
#pragma unroll
                for (int ks = 0; ks < 2 * (mt + 1); ++ks) acc = MFMA32(Tf[mt][ks], Vt[ks], acc);
#pragma unroll
                for (int g4 = 0; g4 < 4; ++g4) *(f32x4*)(uimg + ((et * 2 + mt) * 4 + g4) * 256 + lane * 4) = (f32x4){acc[4 * g4], acc[4 * g4 + 1], acc[4 * g4 + 2], acc[4 * g4 + 3]}; }
        }
    }
    asm volatile("" ::: "memory");
#pragma unroll
    for (int mt = 0; mt < 2; ++mt) { const float ei = __expf(sg[32 * mt + r]);
#pragma unroll
        for (int dt = 0; dt < 4; ++dt)
#pragma unroll
            for (int s = 0; s < 2; ++s) { const bf16_t* qp = Qn + (size_t)(32 * mt + r) * 512 + 32 * dt + 16 * s + 4 * h;
                const u32x2 p0 = *(const u32x2*)qp, p1 = *(const u32x2*)(qp + 8);
                u32x4 w; w.x = pk2(bflo(p0.x) * ei, bfhi(p0.x) * ei); w.y = pk2(bflo(p0.y) * ei, bfhi(p0.y) * ei); w.z = pk2(bflo(p1.x) * ei, bfhi(p1.x) * ei); w.w = pk2(bflo(p1.y) * ei, bfhi(p1.y) * ei);
                *(u32x4*)(img + 16384 + ((mt * 4 + dt) * 2 + s) * 1024 + lane * 16) = w; } }
#pragma unroll
    for (int mp = 0; mp < 2; ++mp)
#pragma unroll
        for (int s = 0; s < 2; ++s) { const f32x4 ga = *(const LAS f32x4*)(sg + 32 * mp + 16 * s + 4 * h), gb = *(const LAS f32x4*)(sg + 32 * mp + 16 * s + 8 + 4 * h);
            float sc[8];
#pragma unroll
            for (int q = 0; q < 4; ++q) { sc[q] = __expf(glast - ga[q]); sc[4 + q] = __expf(glast - gb[q]); }
#pragma unroll
            for (int dt = 0; dt < 4; ++dt) { const bf16_t* kp = KnT + (size_t)(32 * dt + r) * 64 + 32 * mp + 16 * s + 4 * h;
                const u32x2 p0 = *(const u32x2*)kp, p1 = *(const u32x2*)(kp + 8);
                u32x4 w; w.x = pk2(bflo(p0.x) * sc[0], bfhi(p0.x) * sc[1]); w.y = pk2(bflo(p0.y) * sc[2], bfhi(p0.y) * sc[3]); w.z = pk2(bflo(p1.x) * sc[4], bfhi(p1.x) * sc[5]); w.w = pk2(bflo(p1.y) * sc[6], bfhi(p1.y) * sc[7]);
                *(u32x4*)(img + 32768 + ((dt * 2 + mp) * 2 + s) * 1024 + lane * 16) = w; } }
}
DI void b1_gmlp(const Ctx& c, int l, int unit) {
    int lane = c.lane; asm volatile("" : "+v"(lane));
    const int r = lane & 31, h = lane >> 5;
    const int hb = unit & 3, cc = (unit >> 2) & 15, b = unit >> 6, tokc0 = b * SEQ + cc * 128;
    const bf16_t* A = WSP(bf16_t, WS_VBT) + (size_t)unit * 128 * 128;
    const bf16_t* B = WSP(bf16_t, WS_WM) + (size_t)(l * 4 + hb) * 128 * 128;
    const bf16_t* P = WSP(bf16_t, WS_P); bf16_t* AM = WSP(bf16_t, WS_AMIX);
#pragma unroll
    for (int nt = 0; nt < 4; ++nt) {
        f32x16 acc[4];
#pragma unroll
        for (int mt = 0; mt < 4; ++mt) acc[mt] = zero16();
#pragma unroll
        for (int ks = 0; ks < 2 * (nt + 1); ++ks) { const bf16x8 bf = *(const bf16x8*)(B + (size_t)(32 * nt + r) * 128 + 16 * ks + 8 * h);
#pragma unroll
            for (int mt = 0; mt < 4; ++mt) { const bf16x8 af = *(const bf16x8*)(A + (size_t)(32 * mt + r) * 128 + 16 * ks + 8 * h); acc[mt] = MFMA32(af, bf, acc[mt]); } }
        const int tok = tokc0 + 32 * nt + r; const float bsi = c.b_s[(l * 4 + hb) * 128 + 32 * nt + r];
#pragma unroll
        for (int mt = 0; mt < 4; ++mt)
#pragma unroll
            for (int g4 = 0; g4 < 4; ++g4) { const int dch0 = 32 * mt + 8 * g4 + 4 * h;
                const u32x2 u4 = *(const u32x2*)(P + (size_t)tok * NP + 2048 + hb * 128 + dch0);
                u32x2 w; w.x = pk2(bflo(u4.x) * (acc[mt][4 * g4] + bsi), bfhi(u4.x) * (acc[mt][4 * g4 + 1] + bsi)); w.y = pk2(bflo(u4.y) * (acc[mt][4 * g4 + 2] + bsi), bfhi(u4.y) * (acc[mt][4 * g4 + 3] + bsi));
                *(u32x2*)(AM + (size_t)tok * DM + 512 + hb * 128 + dch0) = w; }
    }
}
DI void phase_b1(const Ctx& c, int l, LAS unsigned char* lds) {
    LAS unsigned char* wl = lds + c.wave * 16384; LAS float* sg = (LAS float*)(lds + 131072 + c.wave * 512); LAS float* sb = sg + 64;
    for (int t = c.gw; t < 1024 + 512; t += c.ngw) {
        if (t < 1024) { if (SUB(0)) b1_prep(c, l, t, wl, sg, sb); } else { if (SUB(1)) b1_gmlp(c, l, t - 1024); }
    }
}

constexpr int OB_STRIDE = 136;
constexpr int LDS_OBUF = 2 * IMG_BYTES, OBUF_BYTES = 64 * OB_STRIDE * 2;
static_assert(LDS_OBUF + 2 * OBUF_BYTES <= LDS_BYTES, "scan LDS");
DI void scan_post(const Ctx& c, int l, int b, int hh, int n, const LAS bf16_t* ob, int lid) {
    const int i = lid >> 2, q = lid & 3, tok = b * SEQ + n * 64 + i;
    u32x4 ov[4]; float ss = 0.f;
#pragma unroll
    for (int x = 0; x < 4; ++x) { ov[x] = *(const LAS u32x4*)(ob + i * OB_STRIDE + 32 * q + 8 * x);
#pragma unroll
        for (int e = 0; e < 4; ++e) { const float a = bflo(ov[x][e]), bq = bfhi(ov[x][e]); ss += a * a + bq * bq; } }
    ss += __shfl_xor(ss, 1); ss += __shfl_xor(ss, 2);
    const float rs = rsqrtf(ss * (1.0f / 128.0f) + EPS);
    const bf16_t* gp = WSP(bf16_t, WS_P) + (size_t)tok * NP + 1536 + hh * 128 + 32 * q;
    bf16_t* op = WSP(bf16_t, WS_AMIX) + (size_t)tok * DM + hh * 128 + 32 * q;
    const float* og = c.o_norm_g + l * 128 + 32 * q;
#pragma unroll
    for (int x = 0; x < 4; ++x) { const u32x4 gt = *(const u32x4*)(gp + 8 * x); u32x4 w;
#pragma unroll
        for (int e = 0; e < 4; ++e) { const float o0 = bflo(ov[x][e]) * rs * og[8 * x + 2 * e] * silu_f(bflo(gt[e])), o1 = bfhi(ov[x][e]) * rs * og[8 * x + 2 * e + 1] * silu_f(bfhi(gt[e])); w[e] = pk2(o0, o1); }
        *(u32x4*)(op + 8 * x) = w; }
}
DI void scan_block(const Ctx& c, int l, int bh, LAS unsigned char* lds) {
    const int wave = c.wave, b = bh >> 2, hh = bh & 3;
    const unsigned char* img0 = c.ws + WS_IMG + (size_t)bh * 32 * IMG_BYTES;
    if (wave >= 4) { if (SUB2(0)) {
        int lane = c.lane; asm volatile("" : "+v"(lane));
        const int lw = wave - 4, lid = lw * 64 + lane;
        u32x4 regs[14];
#pragma unroll
        for (int i = 0; i < 14; ++i) { const int ch = lw + 4 * i; if (ch < 54) regs[i] = *(const u32x4*)(img0 + ch * 1024 + lane * 16); }
#pragma unroll
        for (int i = 0; i < 14; ++i) { const int ch = lw + 4 * i; if (ch < 54) *(LAS u32x4*)(lds + ch * 1024 + lane * 16) = regs[i]; }
        __syncthreads();
        for (int n = 0; n < 32; ++n) {
            if (n + 1 < 32) {
#pragma unroll
                for (int i = 0; i < 14; ++i) { const int ch = lw + 4 * i; if (ch < 54) regs[i] = *(const u32x4*)(img0 + (size_t)(n + 1) * IMG_BYTES + ch * 1024 + lane * 16); } }
            if (n >= 1) scan_post(c, l, b, hh, n - 1, (const LAS bf16_t*)(lds + LDS_OBUF + ((n - 1) & 1) * OBUF_BYTES), lid);
            if (n + 1 < 32) {
#pragma unroll
                for (int i = 0; i < 14; ++i) { const int ch = lw + 4 * i; if (ch < 54) *(LAS u32x4*)(lds + ((n + 1) & 1) * IMG_BYTES + ch * 1024 + lane * 16) = regs[i]; } }
            __syncthreads();
        }
        scan_post(c, l, b, hh, 31, (const LAS bf16_t*)(lds + LDS_OBUF + (31 & 1) * OBUF_BYTES), lid);
    } } else if (SUB2(1)) {
        int lane = c.lane; asm volatile("" : "+v"(lane));
        const int ws = wave, r = lane & 31, h = lane >> 5;
        f32x16 S[4];
#pragma unroll
        for (int dt = 0; dt < 4; ++dt) S[dt] = zero16();
        const float* uimg0 = WSP(float, WS_UIMG) + (size_t)bh * 32 * 8192 + (size_t)ws * 2 * 4 * 256 + lane * 4;
        const float* egp = WSP(float, WS_EG) + bh * 32;
        f32x16 un[2];
#pragma unroll
        for (int mt = 0; mt < 2; ++mt)
#pragma unroll
            for (int g4 = 0; g4 < 4; ++g4) { const f32x4 v = *(const f32x4*)(uimg0 + (mt * 4 + g4) * 256); un[mt][4 * g4] = v.x; un[mt][4 * g4 + 1] = v.y; un[mt][4 * g4 + 2] = v.z; un[mt][4 * g4 + 3] = v.w; }
        float eg_n = egp[0];
        __syncthreads();
        for (int n = 0; n < 32; ++n) {
            const LAS unsigned char* buf = lds + (n & 1) * IMG_BYTES + lane * 16;
            f32x16 av[2], ao[2]; av[0] = un[0]; av[1] = un[1]; ao[0] = zero16(); ao[1] = zero16();
            const float eg = eg_n;
            if (n + 1 < 32) { const float* up = uimg0 + (size_t)(n + 1) * 8192;
#pragma unroll
                for (int mt = 0; mt < 2; ++mt)
#pragma unroll
                    for (int g4 = 0; g4 < 4; ++g4) { const f32x4 v = *(const f32x4*)(up + (mt * 4 + g4) * 256); un[mt][4 * g4] = v.x; un[mt][4 * g4 + 1] = v.y; un[mt][4 * g4 + 2] = v.z; un[mt][4 * g4 + 3] = v.w; }
                eg_n = egp[n + 1]; }
#pragma unroll
            for (int pass = 0; pass < 2; ++pass) {
                const LAS unsigned char* fb = buf + pass * 16384;
                bf16x8 fg[2][2];
#pragma unroll
                for (int mt = 0; mt < 2; ++mt) fg[0][mt] = *(const LAS bf16x8*)(fb + (mt * 8) * 1024);
#pragma unroll
                for (int gI = 0; gI < 8; ++gI) { const int dt = gI >> 1, s = gI & 1;
                    if (gI + 1 < 8) {
#pragma unroll
                        for (int mt = 0; mt < 2; ++mt) fg[(gI + 1) & 1][mt] = *(const LAS bf16x8*)(fb + (mt * 8 + gI + 1) * 1024); }
                    asm volatile("" ::: "memory");
                    const bf16x8 sb = as_bf(pack8(S[dt], s));
                    if (pass == 0) { av[0] = MFMA32(fg[gI & 1][0], sb, av[0]); av[1] = MFMA32(fg[gI & 1][1], sb, av[1]); }
                    else { ao[0] = MFMA32(fg[gI & 1][0], sb, ao[0]); ao[1] = MFMA32(fg[gI & 1][1], sb, ao[1]); } }
            }
            bf16x8 vb[2][2];
#pragma unroll
            for (int mp = 0; mp < 2; ++mp)
#pragma unroll
                for (int s = 0; s < 2; ++s) vb[mp][s] = as_bf(pack8(av[mp], s));
            {
                bf16x8 qf[6];
#pragma unroll
                for (int f = 0; f < 6; ++f) qf[f] = *(const LAS bf16x8*)(buf + 49152 + f * 1024);
                asm volatile("" ::: "memory");
#pragma unroll
                for (int s = 0; s < 2; ++s) { ao[0] = MFMA32(qf[s], vb[0][s], ao[0]); ao[1] = MFMA32(qf[2 + s], vb[0][s], ao[1]); ao[1] = MFMA32(qf[4 + s], vb[1][s], ao[1]); }
            }
            LAS bf16_t* ob = (LAS bf16_t*)(lds + LDS_OBUF + (n & 1) * OBUF_BYTES);
#pragma unroll
            for (int mt = 0; mt < 2; ++mt)
#pragma unroll
                for (int reg = 0; reg < 16; ++reg) ob[(32 * mt + crow(reg, h)) * OB_STRIDE + 32 * ws + r] = f2bf(ao[mt][reg]);
            bf16x8 kf[2][4];
#pragma unroll
            for (int f = 0; f < 4; ++f) kf[0][f] = *(const LAS bf16x8*)(buf + 32768 + f * 1024);
#pragma unroll
            for (int dt = 0; dt < 4; ++dt) {
                if (dt + 1 < 4) {
#pragma unroll
                    for (int f = 0; f < 4; ++f) kf[(dt + 1) & 1][f] = *(const LAS bf16x8*)(buf + 32768 + ((dt + 1) * 4 + f) * 1024); }
                asm volatile("" ::: "memory");
                S[dt] = S[dt] * eg;
#pragma unroll
                for (int mp = 0; mp < 2; ++mp)
#pragma unroll
                    for (int s = 0; s < 2; ++s) S[dt] = MFMA32(kf[dt & 1][mp * 2 + s], vb[mp][s], S[dt]); }
            __syncthreads();
        }
        const char* od = (const char*)(c.out + O_DP + (size_t)(l * 32 + bh) * 128 * 128);
        unsigned voff = (unsigned)((4 * h) * 128 + 32 * ws + r) * 4u;
        asm volatile("" : "+v"(voff));
#pragma unroll
        for (int dt = 0; dt < 4; ++dt)
#pragma unroll
            for (int reg = 0; reg < 16; ++reg) *(float*)(od + (32 * dt + (reg & 3) + 8 * (reg >> 2)) * 512 + voff) = S[dt][reg];
    }
}
DI void sample_recurrent(const Ctx& c, int l, int unit) {
    const int lane = c.lane, bs = unit >> 2, hh = unit & 3, e2 = 2 * lane;
    const float* S0 = c.state_delta + (size_t)((l * SBATCH + bs) * 4 + hh) * 128 * 128 + e2;
    float* S1 = c.out + O_DS + (size_t)((l * SBATCH + bs) * 4 + hh) * 128 * 128 + e2;
    const float* q = WSP(float, WS_QS) + bs * 512 + hh * 128; const float* k = WSP(float, WS_KS) + bs * 512 + hh * 128; const float* v = WSP(float, WS_VS) + bs * 512 + hh * 128;
    const float eg = __expf(WSP(float, WS_GS)[bs * 4 + hh]), beta = WSP(float, WS_BS)[bs * 4 + hh];
    f32x2 kv = {0.f, 0.f};
#pragma unroll 8
    for (int d = 0; d < 128; ++d) { const f32x2 s = *(const f32x2*)(S0 + d * 128); kv += s * k[d]; }
    const f32x2 v2 = *(const f32x2*)(v + e2);
    const f32x2 delta = (v2 - kv * eg) * beta;
    f32x2 oo = {0.f, 0.f};
#pragma unroll 8
    for (int d = 0; d < 128; ++d) { const f32x2 s = *(const f32x2*)(S0 + d * 128); const f32x2 sn = s * eg + delta * k[d]; oo += sn * q[d]; *(f32x2*)(S1 + d * 128) = sn; }
    const float ss = wave_sum(oo.x * oo.x + oo.y * oo.y); const float rs = rsqrtf(ss * (1.0f / 128.0f) + EPS);
    const float* ps = WSP(float, WS_PS) + (size_t)bs * NPS + 1536 + hh * 128 + e2; float* am = WSP(float, WS_AMIXS) + (size_t)bs * DM + hh * 128 + e2;
    const float* og = c.o_norm_g + l * 128 + e2;
    am[0] = oo.x * rs * og[0] * silu_f(ps[0]); am[1] = oo.y * rs * og[1] * silu_f(ps[1]);
}
DI void phase_scan(const Ctx& c, int l, LAS unsigned char* lds) {
    if (blockIdx.x < 32) { if (SUB(0)) scan_block(c, l, blockIdx.x, lds); return; }
    const int w0 = (blockIdx.x - 32) * 8 + c.wave, nw = (gridDim.x - 32) * 8;
    for (int u = w0; u < SBATCH * 4; u += nw) { if (SUB(1)) sample_recurrent(c, l, u); }
}

DI void phase_final(const Ctx& c) {
    for (int m = c.gw; m < MP + SBATCH; m += c.ngw) {
        const float* src = m < MP ? WSP(float, WS_XBUF) + (size_t)m * DM : WSP(float, WS_XS) + (size_t)(m - MP) * DM;
        float* dst = m < MP ? c.out + O_YP + (size_t)m * DM : c.out + O_YS + (size_t)(m - MP) * DM;
        const f32x4* xr = (const f32x4*)src + c.lane; const f32x4* gr = (const f32x4*)c.norm_f_g + c.lane; f32x4 v[4]; float s = 0.f;
#pragma unroll
        for (int j = 0; j < 4; ++j) { v[j] = xr[64 * j];
            if (m >= MP) { const f32x4* pp = (const f32x4*)(WSP(float, WS_XP) + (size_t)(m - MP) * DM) + c.lane + 64 * j;
#pragma unroll
                for (int q = 0; q < 4; ++q) v[j] += pp[(size_t)q * SBATCH * DM / 4]; }
            s += (v[j].x * v[j].x + v[j].y * v[j].y) + (v[j].z * v[j].z + v[j].w * v[j].w); }
        const float rs = rsqrtf(wave_sum(s) * (1.0f / DM) + EPS);
#pragma unroll
        for (int j = 0; j < 4; ++j) ((f32x4*)dst + c.lane)[64 * j] = v[j] * rs * gr[64 * j];
    }
}

#ifndef ONLY
#define ONLY -1
#endif
#define EN(x) (ONLY < 0 || ONLY == (x))
__global__ void __launch_bounds__(512, 2) hymba_fwd(Args args) {
    extern __shared__ __attribute__((aligned(16))) unsigned char lds_raw[];
    LAS unsigned char* lds = (LAS unsigned char*)lds_raw;
    cg::grid_group grid = cg::this_grid();
    Ctx c;
    c.x_prompt = args.in[0]; c.x_sample = args.in[1]; c.state_delta = args.in[2]; c.state_conv = args.in[3]; c.norm_mix_g = args.in[4]; c.w_in = args.in[5]; c.conv_w = args.in[6];
    c.A_log = args.in[7]; c.dt_bias = args.in[8]; c.o_norm_g = args.in[9]; c.v_norm_g = args.in[10]; c.w_s = args.in[11]; c.b_s = args.in[12]; c.w_o = args.in[13]; c.norm_ffn_g = args.in[14];
    c.w_up = args.in[15]; c.w_down = args.in[16]; c.norm_f_g = args.in[17]; c.out = args.out; c.ws = args.ws;
    c.lane = threadIdx.x & 63; c.wave = __builtin_amdgcn_readfirstlane(threadIdx.x >> 6); c.gw = blockIdx.x * 8 + c.wave; c.ngw = gridDim.x * 8;
    const int G = gridDim.x;
    for (int ph = args.ph_lo; ph < args.ph_hi; ++ph) {
        { int tl = threadIdx.x; asm volatile("" : "+v"(tl)); c.lane = tl & 63; }
        if (ph == 0) { if (EN(0)) phase_prologue(c, lds); }
        else if (ph == 29) { if (EN(8)) phase_final(c); }
        else {
            const int l = (ph - 1) / 7, s = (ph - 1) % 7;
            float* ssq = WSP(float, WS_SSQ);
            if (s == 0) { if (EN(1)) { sgemm1(c, l);
                pg8::Gemm g{WSP(bf16_t, WS_XB16), WSP(bf16_t, WS_WIN) + (size_t)l * NP * DM, MP, NP, DM}; pg8::StaticOrder S; S.init(MP, NP, G, blockIdx.x);
                pg8::EpiScaleBf16 E{WSP(bf16_t, WS_P), NP, ssq + (size_t)(2 * l) * MP * 16, 0}; pg8::gemm_phase(lds, g, S, E); } }
            else if (s == 1) { if (EN(2)) phase_b0(c, l); }
            else if (s == 2) { if (EN(3)) phase_b1(c, l, lds); }
            else if (s == 3) { if (EN(4)) phase_scan(c, l, lds); }
            else if (s == 4) { if (EN(5)) { sgemm2(c, l);
                pg8::Gemm g{WSP(bf16_t, WS_AMIX), WSP(bf16_t, WS_WO) + (size_t)l * DM * DM, MP, DM, DM}; pg8::StaticOrder S; S.init(MP, DM, G, blockIdx.x);
                pg8::EpiResid E{l == 0 ? c.x_prompt : WSP(float, WS_XBUF), WSP(float, WS_XBUF), WSP(bf16_t, WS_XB16), ssq + (size_t)(2 * l + 1) * MP * 16}; pg8::gemm_phase(lds, g, S, E); } }
            else if (s == 5) { if (EN(6)) { sgemm3(c, l);
                pg8::Gemm g{WSP(bf16_t, WS_XB16), WSP(bf16_t, WS_WUP) + (size_t)l * FF * DM, MP, FF, DM}; pg8::StaticOrder S; S.init(MP, FF, G, blockIdx.x);
                pg8::EpiScaleBf16 E{WSP(bf16_t, WS_UNION), FF, ssq + (size_t)(2 * l + 1) * MP * 16, 1}; pg8::gemm_phase(lds, g, S, E); } }
            else { if (EN(7)) { sgemm4(c, l);
                pg8::Gemm g{WSP(bf16_t, WS_UNION), WSP(bf16_t, WS_WDN) + (size_t)l * DM * FF, MP, DM, FF}; pg8::StaticOrder S; S.init(MP, DM, G, blockIdx.x);
                pg8::EpiResid E{WSP(float, WS_XBUF), WSP(float, WS_XBUF), WSP(bf16_t, WS_XB16), ssq + (size_t)(2 * l + 2) * MP * 16}; pg8::gemm_phase(lds, g, S, E); } }
        }
        if (ph + 1 < args.ph_hi) {
            __builtin_amdgcn_fence(__ATOMIC_RELEASE, "agent"); asm volatile("s_waitcnt vmcnt(0) lgkmcnt(0)" ::: "memory");
            grid.sync();
            __builtin_amdgcn_fence(__ATOMIC_ACQUIRE, "agent"); }
    }
}

extern "C" void kernel_launch(void* const* d_in, const int* in_sizes, int n_in, void* d_out, int out_size, void* d_ws, size_t ws_size, hipStream_t stream) {
    static int grid = 0;
    if (grid == 0) {
        int dev = 0, cus = 0, per_cu = 0;
        (void)hipGetDevice(&dev); (void)hipDeviceGetAttribute(&cus, hipDeviceAttributeMultiprocessorCount, dev);
        if (hipFuncSetAttribute((const void*)hymba_fwd, hipFuncAttributeMaxDynamicSharedMemorySize, LDS_BYTES) != hipSuccess) fprintf(stderr, "kernel_launch: hipFuncSetAttribute failed\n");
        if (hipOccupancyMaxActiveBlocksPerMultiprocessor(&per_cu, (const void*)hymba_fwd, 512, LDS_BYTES) != hipSuccess || per_cu < 1) { fprintf(stderr, "kernel_launch: occupancy query says %d\n", per_cu); per_cu = 1; }
        (void)hipGetLastError();
        grid = cus * 1;
        if (ws_size < WS_END) fprintf(stderr, "kernel_launch: workspace too small: %zu < %zu\n", ws_size, (size_t)WS_END);
    }
    Args a{};
    for (int i = 0; i < 18; ++i) a.in[i] = (const float*)d_in[i];
    a.out = (float*)d_out; a.ws = (unsigned char*)d_ws; a.ph_lo = 0; a.ph_hi = 30;
    void* kargs[] = {&a};
    hipError_t e = hipLaunchCooperativeKernel((const void*)hymba_fwd, dim3(grid), dim3(512), kargs, LDS_BYTES, stream);
    if (e != hipSuccess) fprintf(stderr, "kernel_launch: cooperative launch failed: %s (grid %d)\n", hipGetErrorString(e), grid);
}
```

```cpp
#include <hip/hip_runtime.h>
#include <hip/hip_cooperative_groups.h>
#include <cstdio>
namespace cg = cooperative_groups;

#define LAS __attribute__((address_space(3)))
#define DI __device__ __forceinline__
typedef unsigned short bf16_t;
typedef short bf16x8 __attribute__((ext_vector_type(8)));
typedef float f32x4 __attribute__((ext_vector_type(4)));
typedef float f32x2 __attribute__((ext_vector_type(2)));
typedef float f32x16 __attribute__((ext_vector_type(16)));
typedef unsigned u32x4 __attribute__((ext_vector_type(4)));
typedef unsigned u32x2 __attribute__((ext_vector_type(2)));
typedef __bf16 bf2_t __attribute__((ext_vector_type(2)));

#ifndef SUBSEL
#define SUBSEL -1
#endif
#define SUB(x) (SUBSEL < 0 || SUBSEL == (x))
#ifndef SUBSEL2
#define SUBSEL2 -1
#endif
#define SUB2(x) (SUBSEL2 < 0 || SUBSEL2 == (x))
constexpr int DM = 1024, NBATCH = 8, SEQ = 2048, MP = NBATCH * SEQ, DEPTH = 4, SBATCH = 128;
constexpr int NH = 4, QKV = 1536, NP = 3072, PROJ = 3080, FF = 4096, NPS = 3088;
constexpr float EPS = 1e-6f;
constexpr int IMG_BYTES = 55296;
constexpr int LDS_BYTES = 147456;
constexpr size_t O_YP = 0, O_YS = 16777216, O_DP = 16908288, O_CP = 19005440, O_DS = 19152896, O_CS = 52707328, O_VS = 55066624;
constexpr size_t WS_WIN = 65536;
constexpr size_t WS_WAB = WS_WIN + (size_t)DEPTH * NP * DM * 2;
constexpr size_t WS_WO = WS_WAB + (size_t)DEPTH * 16 * DM * 2;
constexpr size_t WS_WUP = WS_WO + (size_t)DEPTH * DM * DM * 2;
constexpr size_t WS_WDN = WS_WUP + (size_t)DEPTH * FF * DM * 2;
constexpr size_t WS_WM = WS_WDN + (size_t)DEPTH * FF * DM * 2;
constexpr size_t WS_XBUF = WS_WM + (size_t)DEPTH * 4 * 128 * 128 * 2;
constexpr size_t WS_XB16 = WS_XBUF + (size_t)MP * DM * 4;
constexpr size_t WS_SSQ = WS_XB16 + (size_t)MP * DM * 2;
constexpr size_t WS_UNION = WS_SSQ + (size_t)9 * MP * 16 * 4;
constexpr size_t WS_P = WS_UNION;
constexpr size_t WS_QN = WS_P + (size_t)MP * NP * 2;
constexpr size_t WS_KN = WS_QN + (size_t)MP * 512 * 2;
constexpr size_t WS_KNT = WS_UNION + (size_t)MP * FF * 2;
constexpr size_t WS_VT = WS_KNT + (size_t)MP * 512 * 2;
constexpr size_t WS_VBT = WS_VT + (size_t)MP * 512 * 2;
constexpr size_t WS_G = WS_VBT + (size_t)MP * 512 * 2;
constexpr size_t WS_BETA = WS_G + (size_t)MP * 4 * 4;
constexpr size_t WS_EG = WS_BETA + (size_t)MP * 4 * 4;
constexpr size_t WS_IMG = WS_EG + 4096;
constexpr size_t WS_UIMG = WS_IMG + (size_t)1024 * IMG_BYTES;
constexpr size_t WS_AMIX = WS_UIMG + (size_t)1024 * 32768;
constexpr size_t WS_XS = WS_AMIX + (size_t)MP * DM * 2;
constexpr size_t WS_PS = WS_XS + (size_t)SBATCH * DM * 4;
constexpr size_t WS_QS = WS_PS + (size_t)SBATCH * NPS * 4;
constexpr size_t WS_KS = WS_QS + (size_t)SBATCH * 512 * 4;
constexpr size_t WS_VS = WS_KS + (size_t)SBATCH * 512 * 4;
constexpr size_t WS_GS = WS_VS + (size_t)SBATCH * 512 * 4;
constexpr size_t WS_BS = WS_GS + (size_t)SBATCH * 4 * 4;
constexpr size_t WS_AMIXS = WS_BS + (size_t)SBATCH * 4 * 4;
constexpr size_t WS_HS = WS_AMIXS + (size_t)SBATCH * DM * 4;
constexpr size_t WS_XP = WS_HS + (size_t)SBATCH * FF * 4;
constexpr size_t WS_END = WS_XP + (size_t)4 * SBATCH * DM * 4;
static_assert(WS_QN + 2 * (size_t)MP * 512 * 2 == WS_KNT, "union");
static_assert(WS_END <= (size_t)536870912, "workspace");

DI unsigned pk2(float lo, float hi) { f32x2 v = {lo, hi}; return __builtin_bit_cast(unsigned, __builtin_convertvector(v, bf2_t)); }
DI float bflo(unsigned w) { return __uint_as_float(w << 16); }
DI float bfhi(unsigned w) { return __uint_as_float(w & 0xffff0000u); }
DI float bf2f(bf16_t b) { return __uint_as_float(((unsigned)b) << 16); }
DI bf16_t f2bf(float f) { return (bf16_t)(pk2(f, 0.f) & 0xffffu); }
DI float wave_sum(float v) {
#pragma unroll
    for (int o = 1; o < 64; o <<= 1) v += __shfl_xor(v, o);
    return v;
}
DI float silu_f(float x) { return x / (1.f + __expf(-x)); }
DI float sigmoid_f(float x) { return 1.f / (1.f + __expf(-x)); }
DI float softplus_f(float x) { return fmaxf(x, 0.f) + log1pf(__expf(-fabsf(x))); }
DI u32x4 pack8(const f32x16& x, int s) {
    u32x4 p; p.x = pk2(x[8 * s], x[8 * s + 1]); p.y = pk2(x[8 * s + 2], x[8 * s + 3]); p.z = pk2(x[8 * s + 4], x[8 * s + 5]); p.w = pk2(x[8 * s + 6], x[8 * s + 7]); return p;
}
DI float ssq_sum(const float* p) {
    const f32x4 a = *(const f32x4*)p, b = *(const f32x4*)(p + 4), c2 = *(const f32x4*)(p + 8), d2 = *(const f32x4*)(p + 12);
    return ((a.x + a.y) + (a.z + a.w)) + ((b.x + b.y) + (b.z + b.w)) + ((c2.x + c2.y) + (c2.z + c2.w)) + ((d2.x + d2.y) + (d2.z + d2.w));
}
DI int crow(int reg, int h) { return (reg & 3) + 8 * (reg >> 2) + 4 * h; }
#define MFMA32(a, b, c) __builtin_amdgcn_mfma_f32_32x32x16_bf16((a), (b), (c), 0, 0, 0)
#define MFMA16(a, b, c) __builtin_amdgcn_mfma_f32_16x16x32_bf16((a), (b), (c), 0, 0, 0)
DI bf16x8 as_bf(u32x4 v) { return __builtin_bit_cast(bf16x8, v); }
DI f32x16 zero16() { f32x16 z;
#pragma unroll
    for (int i = 0; i < 16; ++i) z[i] = 0.f; return z; }

namespace pg8 {
constexpr int BM = 256, BK = 64, HALF = 128, HTB = HALF * BK * 2, STAGE_BYTES = 8 * HTB, NXCD = 8, WGM = 8;
DI int lds_byte(int r, int c) { const int st = (r >> 4) * 2 + (c >> 5), rr = r & 15, cc = c & 31, ob = rr * 64 + cc * 2; return st * 1024 + (ob ^ (((ob >> 9) & 1) << 5)); }
DI void stage_rc(int b, int& R, int& C) { const int st = b / 1024, sb = b % 1024, swz = sb ^ (((sb >> 9) & 1) << 5); R = (st >> 1) * 16 + swz / 64; C = (st & 1) * 32 + (swz % 64) / 2; }
DI int perm32(int rho) { const int n = rho >> 4, i = rho & 15; return 8 * (i >> 2) + 4 * n + (i & 3); }
struct Unit { int pm, pn; };
struct Gemm { const bf16_t* A; const bf16_t* Bt; int M, N, K; };
struct StaticOrder {
    int nM, nN, nwg, G, c;
    DI void init(int M, int N, int G_, int c_) { nM = M / BM; nN = N / BM; nwg = nM * nN; G = G_; c = c_; }
    DI bool next(int i, Unit& u) const {
        const long L = (long)i * G + c; if (L >= nwg) return false;
        int wgid = (int)L; { const int q = nwg / NXCD, r = nwg % NXCD, xcd = wgid % NXCD, off = wgid / NXCD; wgid = (xcd < r ? xcd * (q + 1) : r * (q + 1) + (xcd - r) * q) + off; }
        const int nig = WGM * nN, gid = wgid / nig, fm = gid * WGM, gsz = (nM - fm) < WGM ? (nM - fm) : WGM;
        u.pm = fm + ((wgid % nig) % gsz); u.pn = (wgid % nig) / gsz; return true;
    }
};
template <class Epi>
DI void gemm_phase(LAS unsigned char* lds, const Gemm g, const StaticOrder& S, const Epi& E) {
    int tid = threadIdx.x; asm volatile("" : "+v"(tid));
    const int wid = __builtin_amdgcn_readfirstlane(tid >> 6), lane = tid & 63, wr = wid >> 2, wc = wid & 3, fr = lane & 15, fq = lane >> 4;
    const int K = g.K, nt = K / BK;
    unsigned voffA[2], voffB[2];
#pragma unroll
    for (int i = 0; i < 2; ++i) { int R, C; stage_rc(tid * 16 + i * 8192, R, C); const int Rb = (R & ~31) + perm32(R & 31);
        voffA[i] = (unsigned)(R * K + C) * 2u; voffB[i] = (unsigned)(Rb * K + C) * 2u; }
    const size_t kstep = (size_t)(BK * 2);
    const size_t hstep = (size_t)HALF * K * 2;
    const size_t tstep = 2 * hstep;
    const unsigned ldsw = (unsigned)wid * 1024u;
    const int aoff = lds_byte(wr * 64 + fr, fq * 8), boff = lds_byte(wc * 32 + fr, fq * 8);
#define PG8_SA(b, h) (((b) * 2 + (h)) * HTB)
#define PG8_SB(b, h) ((4 + (b) * 2 + (h)) * HTB)
#define PG8_STAGE(bufoff, gbase, voff) do { _Pragma("unroll") for (int _i = 0; _i < 2; ++_i) \
        __builtin_amdgcn_global_load_lds((const unsigned*)((const char*)(gbase) + (voff)[_i]), (LAS unsigned*)(lds + (bufoff) + ldsw + _i * 8192), 16, 0, 0); } while (0)
#define PG8_LDA(dst, b, h) do { _Pragma("unroll") for (int m = 0; m < 4; ++m) _Pragma("unroll") for (int k = 0; k < 2; ++k) dst[m][k] = *(const LAS bf16x8*)(lds + PG8_SA(b, h) + aoff + m * 2048 + k * 1024); } while (0)
#define PG8_LDB(dst, b, h) do { _Pragma("unroll") for (int n = 0; n < 2; ++n) _Pragma("unroll") for (int k = 0; k < 2; ++k) dst[n][k] = *(const LAS bf16x8*)(lds + PG8_SB(b, h) + boff + n * 2048 + k * 1024); } while (0)
#define PG8_MMA(ai, bj, At, Bt) do { __builtin_amdgcn_s_setprio(1); _Pragma("unroll") for (int m = 0; m < 4; ++m) _Pragma("unroll") for (int n = 0; n < 2; ++n) _Pragma("unroll") for (int k = 0; k < 2; ++k) \
        acc[ai][bj][m][n] = __builtin_amdgcn_mfma_f32_16x16x32_bf16(Bt[n][k], At[m][k], acc[ai][bj][m][n], 0, 0, 0); __builtin_amdgcn_s_setprio(0); } while (0)
#define PG8_WAIT_V(n) asm volatile("s_waitcnt vmcnt(" #n ")" ::: "memory")
#define PG8_WAIT_L(n) asm volatile("s_waitcnt lgkmcnt(" #n ")" ::: "memory")
#define PG8_BAR __builtin_amdgcn_s_barrier()
#define PG8_SCHED __builtin_amdgcn_sched_barrier(0)
    Unit cur, nxt; int ui = 0;
    if (!S.next(0, cur)) return;
    f32x4 acc[2][2][4][2];
#pragma unroll
    for (int a = 0; a < 2; ++a)
#pragma unroll
        for (int b = 0; b < 2; ++b)
#pragma unroll
            for (int m = 0; m < 4; ++m)
#pragma unroll
                for (int n = 0; n < 2; ++n) acc[a][b][m][n] = (f32x4){0.f, 0.f, 0.f, 0.f};
    bf16x8 At[4][2], B0[2][2], B1[2][2];
    const char* cA = (const char*)g.A + (size_t)cur.pm * tstep; const char* cB = (const char*)g.Bt + (size_t)cur.pn * tstep;
    PG8_STAGE(PG8_SB(0, 0), cB, voffB); PG8_STAGE(PG8_SA(0, 0), cA, voffA); PG8_STAGE(PG8_SB(0, 1), cB + hstep, voffB); PG8_STAGE(PG8_SA(0, 1), cA + hstep, voffA);
    if (wr == 1) PG8_BAR;
    PG8_WAIT_V(4); PG8_BAR;
    PG8_STAGE(PG8_SB(1, 0), cB + kstep, voffB); PG8_STAGE(PG8_SA(1, 0), cA + kstep, voffA); PG8_STAGE(PG8_SB(1, 1), cB + hstep + kstep, voffB);
    PG8_WAIT_V(6); PG8_BAR;
    for (;;) {
        const bool has_next = S.next(ui + 1, nxt);
        const char* nA = has_next ? (const char*)g.A + (size_t)nxt.pm * tstep : cA; const char* nB = has_next ? (const char*)g.Bt + (size_t)nxt.pn * tstep : cB;
        for (int t = 0; t < nt; t += 2) {
            const bool last = (t == nt - 2);
            const char* a1 = cA + (size_t)(t + 1) * kstep;
            const char* a2 = last ? nA : cA + (size_t)(t + 2) * kstep; const char* b2 = last ? nB : cB + (size_t)(t + 2) * kstep;
            const char* a3 = a2 + kstep; const char* b3 = b2 + kstep;
            PG8_LDB(B0, 0, 0); PG8_SCHED; PG8_LDA(At, 0, 0); PG8_STAGE(PG8_SA(1, 1), a1 + hstep, voffA);
            PG8_WAIT_L(8); PG8_BAR; PG8_WAIT_L(0); PG8_MMA(0, 0, At, B0); PG8_BAR; PG8_SCHED;
            PG8_LDB(B1, 0, 1); PG8_STAGE(PG8_SB(0, 0), b2, voffB);
            PG8_BAR; PG8_WAIT_L(0); PG8_MMA(0, 1, At, B1); PG8_BAR;
            PG8_LDA(At, 0, 1); PG8_STAGE(PG8_SA(0, 0), a2, voffA);
            PG8_BAR; PG8_WAIT_L(0); PG8_MMA(1, 0, At, B0); PG8_BAR; PG8_SCHED;
            PG8_STAGE(PG8_SB(0, 1), b2 + hstep, voffB);
            PG8_WAIT_V(6); PG8_BAR; PG8_MMA(1, 1, At, B1); PG8_BAR;
            PG8_LDB(B0, 1, 0); PG8_SCHED; PG8_LDA(At, 1, 0); PG8_STAGE(PG8_SA(0, 1), a2 + hstep, voffA);
            PG8_WAIT_L(8); PG8_BAR; PG8_WAIT_L(0); PG8_MMA(0, 0, At, B0); PG8_BAR; PG8_SCHED;
            PG8_LDB(B1, 1, 1); PG8_STAGE(PG8_SB(1, 0), b3, voffB);
            PG8_BAR; PG8_WAIT_L(0); PG8_MMA(0, 1, At, B1); PG8_BAR;
            PG8_LDA(At, 1, 1); PG8_STAGE(PG8_SA(1, 0), a3, voffA);
            PG8_BAR; PG8_WAIT_L(0); PG8_MMA(1, 0, At, B0); PG8_BAR; PG8_SCHED;
            PG8_STAGE(PG8_SB(1, 1), b3 + hstep, voffB);
            PG8_WAIT_V(6); PG8_BAR; PG8_MMA(1, 1, At, B1); PG8_BAR;
        }
        E(acc, cur, wr, wc, fr, fq);
        if (!has_next) break;
#pragma unroll
        for (int a = 0; a < 2; ++a)
#pragma unroll
            for (int b = 0; b < 2; ++b)
#pragma unroll
                for (int m = 0; m < 4; ++m)
#pragma unroll
                    for (int n = 0; n < 2; ++n) acc[a][b][m][n] = (f32x4){0.f, 0.f, 0.f, 0.f};
        cur = nxt; cA = nA; cB = nB; ++ui;
    }
    PG8_WAIT_V(0);
    if (wr == 0) PG8_BAR;
    PG8_BAR;
#undef PG8_SA
#undef PG8_SB
#undef PG8_STAGE
#undef PG8_LDA
#undef PG8_LDB
#undef PG8_MMA
#undef PG8_WAIT_V
#undef PG8_WAIT_L
#undef PG8_BAR
#undef PG8_SCHED
}
struct EpiScaleBf16 {
    bf16_t* O; int ldc; const float* ssq; int act;
    DI void operator()(const f32x4 (&acc)[2][2][4][2], const Unit& u, int wr, int wc, int fr, int fq) const {
        const int row0 = u.pm * BM + wr * 64 + fr, col0 = u.pn * BM + wc * 32 + 8 * fq;
#pragma unroll
        for (int ai = 0; ai < 2; ++ai)
#pragma unroll
            for (int m = 0; m < 4; ++m) { const int row = row0 + ai * HALF + m * 16; const float rs = rsqrtf(ssq_sum(ssq + (size_t)row * 16) * (1.0f / DM) + EPS);
                bf16_t* rowp = O + (size_t)row * ldc + col0;
#pragma unroll
                for (int bj = 0; bj < 2; ++bj) { f32x4 v0 = acc[ai][bj][m][0] * rs, v1 = acc[ai][bj][m][1] * rs;
                    if (act) {
#pragma unroll
                        for (int j = 0; j < 4; ++j) { const float a = fmaxf(v0[j], 0.f), b = fmaxf(v1[j], 0.f); v0[j] = a * a; v1[j] = b * b; } }
                    u32x4 w; w.x = pk2(v0[0], v0[1]); w.y = pk2(v0[2], v0[3]); w.z = pk2(v1[0], v1[1]); w.w = pk2(v1[2], v1[3]);
                    *(u32x4*)(rowp + bj * HALF) = w; } }
    }
};
struct EpiResid {
    const float* base; float* out; bf16_t* xb; float* ssq;
    DI void operator()(const f32x4 (&acc)[2][2][4][2], const Unit& u, int wr, int wc, int fr, int fq) const {
        const int row0 = u.pm * BM + wr * 64 + fr, col0 = u.pn * BM + wc * 32 + 8 * fq;
#pragma unroll
        for (int ai = 0; ai < 2; ++ai)
#pragma unroll
            for (int m = 0; m < 4; ++m) { const int row = row0 + ai * HALF + m * 16; const size_t off = (size_t)row * DM + col0; float ss = 0.f;
#pragma unroll
                for (int bj = 0; bj < 2; ++bj) {
                    const f32x4 b0 = *(const f32x4*)(base + off + bj * HALF), b1 = *(const f32x4*)(base + off + bj * HALF + 4);
                    const f32x4 o0 = b0 + acc[ai][bj][m][0], o1 = b1 + acc[ai][bj][m][1];
                    *(f32x4*)(out + off + bj * HALF) = o0; *(f32x4*)(out + off + bj * HALF + 4) = o1;
                    u32x4 w; w.x = pk2(o0[0], o0[1]); w.y = pk2(o0[2], o0[3]); w.z = pk2(o1[0], o1[1]); w.w = pk2(o1[2], o1[3]);
                    *(u32x4*)(xb + off + bj * HALF) = w;
                    ss += (o0[0] * o0[0] + o0[1] * o0[1]) + (o0[2] * o0[2] + o0[3] * o0[3]) + (o1[0] * o1[0] + o1[1] * o1[1]) + (o1[2] * o1[2] + o1[3] * o1[3]); }
                ss += __shfl_xor(ss, 16); ss += __shfl_xor(ss, 32);
                if (fq == 0) ssq[(size_t)row * 16 + u.pn * 4 + wc] = ss;
                asm volatile("" ::: "memory"); }
    }
};
}

struct Args { const float* in[18]; float* out; unsigned char* ws; int ph_lo, ph_hi; };
struct Ctx {
    const float *x_prompt, *x_sample, *state_delta, *state_conv, *norm_mix_g, *w_in, *conv_w, *A_log, *dt_bias, *o_norm_g, *v_norm_g, *w_s, *b_s, *w_o, *norm_ffn_g, *w_up, *w_down, *norm_f_g;
    float* out; unsigned char* ws;
    int lane, wave, gw, ngw;
};
#define WSP(T, off) ((T*)(c.ws + (off)))

DI void transpose_item(const float* W, int K, int N, const float* kscale, bf16_t* WT, bf16_t* WAB, int mode, int item, int nblk, LAS float* scr, int lane) {
    const int kb = item / nblk, nb = item % nblk, k0 = 64 * kb, n0 = 32 * nb;
    const int nl = lane & 31, nsrc = n0 + nl;
#pragma unroll 8
    for (int i = 0; i < 32; ++i) { const int kk = 2 * i + (lane >> 5);
        float v = 0.f; if (nsrc < N) { v = W[(size_t)(k0 + kk) * N + nsrc]; if (kscale) v *= kscale[k0 + kk]; }
        scr[kk * 33 + nl] = v; }
    asm volatile("s_waitcnt lgkmcnt(0)" ::: "memory");
    const int cch = lane & 7;
#pragma unroll
    for (int j = 0; j < 4; ++j) { const int n = (lane >> 3) + 8 * j, ns = n0 + n; const LAS float* s = scr + (8 * cch) * 33 + n;
        u32x4 o; o.x = pk2(s[0 * 33], s[1 * 33]); o.y = pk2(s[2 * 33], s[3 * 33]); o.z = pk2(s[4 * 33], s[5 * 33]); o.w = pk2(s[6 * 33], s[7 * 33]);
        if (ns < N) {
            bf16_t* rowp;
            if (mode == 0) rowp = WT + (size_t)ns * K;
            else rowp = ns < 2048 ? WT + (size_t)ns * K : (ns < 2056 ? WAB + (size_t)(ns - 2048) * K : WT + (size_t)(ns - 8) * K);
            *(u32x4*)(rowp + k0 + 8 * cch) = o; } }
    asm volatile("s_waitcnt lgkmcnt(0)" ::: "memory");
}
DI void phase_prologue(const Ctx& c, LAS unsigned char* lds) {
    LAS float* scr = (LAS float*)(lds + c.wave * 16384);
    constexpr int I_IN = 16 * 97, I_O = 16 * 32, I_UP = 16 * 128, I_DN = 64 * 32, I_L = I_IN + I_O + I_UP + I_DN;
    for (int it = c.gw; it < DEPTH * I_L; it += c.ngw) {
        const int l = it / I_L; int r = it % I_L;
        if (r < I_IN) { transpose_item(c.w_in + (size_t)l * DM * PROJ, DM, PROJ, c.norm_mix_g + l * DM, WSP(bf16_t, WS_WIN) + (size_t)l * NP * DM, WSP(bf16_t, WS_WAB) + (size_t)l * 16 * DM, 1, r, 97, scr, c.lane); continue; } r -= I_IN;
        if (r < I_O) { transpose_item(c.w_o + (size_t)l * DM * DM, DM, DM, nullptr, WSP(bf16_t, WS_WO) + (size_t)l * DM * DM, nullptr, 0, r, 32, scr, c.lane); continue; } r -= I_O;
        if (r < I_UP) { transpose_item(c.w_up + (size_t)l * DM * FF, DM, FF, c.norm_ffn_g + l * DM, WSP(bf16_t, WS_WUP) + (size_t)l * FF * DM, nullptr, 0, r, 128, scr, c.lane); continue; } r -= I_UP;
        transpose_item(c.w_down + (size_t)l * FF * DM, FF, DM, nullptr, WSP(bf16_t, WS_WDN) + (size_t)l * DM * FF, nullptr, 0, r, 32, scr, c.lane);
    }
    float* ssq = WSP(float, WS_SSQ);
    for (int m = c.gw; m < MP; m += c.ngw) {
        const f32x4* xr = (const f32x4*)(c.x_prompt + (size_t)m * DM) + c.lane; u32x2* o8 = (u32x2*)(WSP(bf16_t, WS_XB16) + (size_t)m * DM) + c.lane; float s = 0.f;
#pragma unroll
        for (int j = 0; j < 4; ++j) { const f32x4 v = xr[64 * j]; s += (v.x * v.x + v.y * v.y) + (v.z * v.z + v.w * v.w); u32x2 w; w.x = pk2(v.x, v.y); w.y = pk2(v.z, v.w); o8[64 * j] = w; }
        s = wave_sum(s); if (c.lane < 16) ssq[(size_t)m * 16 + c.lane] = c.lane == 0 ? s : 0.f;
    }
    const int gt = c.gw * 64 + c.lane, ngt = c.ngw * 64;
    float* xs = WSP(float, WS_XS);
    for (int i = gt; i < SBATCH * DM; i += ngt) xs[i] = c.x_sample[i];
    bf16_t* wab = WSP(bf16_t, WS_WAB);
    for (int i = gt; i < DEPTH * 8 * DM; i += ngt) { const int l = i / (8 * DM), r = i % (8 * DM); wab[(size_t)l * 16 * DM + 8 * DM + r] = 0; }
    unsigned* wm = WSP(unsigned, WS_WM);
    for (int i = gt; i < DEPTH * 4 * 128 * 64; i += ngt) { const int e = 2 * i, ii = (e >> 7) & 127, jj = e & 127;
        const float a = ii >= jj ? c.w_s[e] : 0.f, b = ii >= jj + 1 ? c.w_s[e + 1] : 0.f; wm[i] = pk2(a, b); }
}

template <bool NORM, bool PARTS = false>
DI f32x4 sgemm_tile(const float* A, int lda, const bf16_t* Bt, int ldb, int r0, int n0, int k0, int klen, int lane, float& rstd, const float* xp = nullptr) {
    const int fr = lane & 15, fq = lane >> 4;
    const float* ap = A + (size_t)(r0 + fr) * lda + k0 + 8 * fq;
    const bf16_t* bp = Bt + (size_t)(n0 + fr) * ldb + k0 + 8 * fq;
    f32x4 acc = {0.f, 0.f, 0.f, 0.f}; float ss = 0.f;
#pragma unroll 8
    for (int k = 0; k < klen; k += 32) {
        f32x4 a0 = *(const f32x4*)(ap + k), a1 = *(const f32x4*)(ap + k + 4);
        if (PARTS) { const float* pp = xp + (size_t)(r0 + fr) * lda + k0 + 8 * fq + k;
#pragma unroll
            for (int q = 0; q < 4; ++q) { a0 += *(const f32x4*)(pp + (size_t)q * SBATCH * DM); a1 += *(const f32x4*)(pp + (size_t)q * SBATCH * DM + 4); } }
        const bf16x8 b = *(const bf16x8*)(bp + k);
        if (NORM) ss += (a0.x * a0.x + a0.y * a0.y) + (a0.z * a0.z + a0.w * a0.w) + (a1.x * a1.x + a1.y * a1.y) + (a1.z * a1.z + a1.w * a1.w);
        u32x4 a; a.x = pk2(a0.x, a0.y); a.y = pk2(a0.z, a0.w); a.z = pk2(a1.x, a1.y); a.w = pk2(a1.z, a1.w);
        acc = MFMA16(as_bf(a), b, acc);
    }
    if (NORM) { ss += __shfl_xor(ss, 16); ss += __shfl_xor(ss, 32); rstd = rsqrtf(ss * (1.0f / DM) + EPS); }
    return acc;
}
DI void sgemm1(const Ctx& c, int l) {
    const float* xs = WSP(float, WS_XS); float* ps = WSP(float, WS_PS);
    const int fr = c.lane & 15, fq = c.lane >> 4;
    for (int t = c.gw; t < 8 * 193; t += c.ngw) { const int rt = t & 7, ntile = t >> 3; float rstd;
        const bf16_t* Bt = ntile < 192 ? WSP(bf16_t, WS_WIN) + (size_t)l * NP * DM + (size_t)ntile * 16 * DM : WSP(bf16_t, WS_WAB) + (size_t)l * 16 * DM;
        const f32x4 acc = l > 0 ? sgemm_tile<true, true>(xs, DM, Bt, DM, rt * 16, 0, 0, DM, c.lane, rstd, WSP(float, WS_XP)) : sgemm_tile<true>(xs, DM, Bt, DM, rt * 16, 0, 0, DM, c.lane, rstd);
#pragma unroll
        for (int j = 0; j < 4; ++j) { const float rs = __shfl(rstd, 4 * fq + j); ps[(size_t)(rt * 16 + 4 * fq + j) * NPS + ntile * 16 + fr] = acc[j] * rs; } }
}
DI void sgemm2(const Ctx& c, int l) {
    const float* am = WSP(float, WS_AMIXS); float* xs = WSP(float, WS_XS);
    const int fr = c.lane & 15, fq = c.lane >> 4;
    for (int t = c.gw; t < 8 * 64; t += c.ngw) { const int rt = t & 7, ntile = t >> 3; float rstd;
        const f32x4 acc = sgemm_tile<false>(am, DM, WSP(bf16_t, WS_WO) + (size_t)l * DM * DM, DM, rt * 16, ntile * 16, 0, DM, c.lane, rstd);
#pragma unroll
        for (int j = 0; j < 4; ++j) { const size_t o = (size_t)(rt * 16 + 4 * fq + j) * DM + ntile * 16 + fr; float v = xs[o] + acc[j];
            if (l > 0) { const float* xp = WSP(float, WS_XP) + o; v += (xp[0] + xp[(size_t)SBATCH * DM]) + (xp[(size_t)2 * SBATCH * DM] + xp[(size_t)3 * SBATCH * DM]); }
            xs[o] = v; } }
}
DI void sgemm3(const Ctx& c, int l) {
    const float* xs = WSP(float, WS_XS); float* hs = WSP(float, WS_HS);
    const int fr = c.lane & 15, fq = c.lane >> 4;
    for (int t = c.gw; t < 8 * 256; t += c.ngw) { const int rt = t & 7, ntile = t >> 3; float rstd;
        const f32x4 acc = sgemm_tile<true>(xs, DM, WSP(bf16_t, WS_WUP) + (size_t)l * FF * DM, DM, rt * 16, ntile * 16, 0, DM, c.lane, rstd);
#pragma unroll
        for (int j = 0; j < 4; ++j) { const float rs = __shfl(rstd, 4 * fq + j); const float v = fmaxf(acc[j] * rs, 0.f); hs[(size_t)(rt * 16 + 4 * fq + j) * FF + ntile * 16 + fr] = v * v; } }
}
DI void sgemm4(const Ctx& c, int l) {
    const float* hs = WSP(float, WS_HS); float* xp = WSP(float, WS_XP);
    const int fr = c.lane & 15, fq = c.lane >> 4;
    for (int t = c.gw; t < 8 * 64 * 4; t += c.ngw) { const int rt = t & 7, ntile = (t >> 3) & 63, kq = t >> 9; float rstd;
        const f32x4 acc = sgemm_tile<false>(hs, FF, WSP(bf16_t, WS_WDN) + (size_t)l * DM * FF, FF, rt * 16, ntile * 16, kq * 1024, 1024, c.lane, rstd);
#pragma unroll
        for (int j = 0; j < 4; ++j) xp[(size_t)kq * SBATCH * DM + (size_t)(rt * 16 + 4 * fq + j) * DM + ntile * 16 + fr] = acc[j]; }
}

DI void b0_task_ab(const Ctx& c, int l, int b, int n) {
    const int fr = c.lane & 15, fq = c.lane >> 4, tok0 = b * SEQ + n * 64;
    const bf16_t* ap = WSP(bf16_t, WS_XB16) + (size_t)(tok0 + fr) * DM + 8 * fq;
    const bf16_t* bp = WSP(bf16_t, WS_WAB) + (size_t)l * 16 * DM + (size_t)fr * DM + 8 * fq;
    f32x4 acc[4];
#pragma unroll
    for (int mt = 0; mt < 4; ++mt) acc[mt] = (f32x4){0.f, 0.f, 0.f, 0.f};
#pragma unroll 4
    for (int k = 0; k < DM; k += 32) {
        const bf16x8 bf = *(const bf16x8*)(bp + k);
#pragma unroll
        for (int mt = 0; mt < 4; ++mt) { const bf16x8 a = *(const bf16x8*)(ap + (size_t)mt * 16 * DM + k); acc[mt] = MFMA16(a, bf, acc[mt]); }
    }
    const float* ssq = WSP(float, WS_SSQ) + (size_t)(2 * l) * MP * 16;
    float* gb = WSP(float, WS_G); float* bb = WSP(float, WS_BETA);
    if (fr < 8) { const int hh = fr & 3; const float al = -__expf(c.A_log[l * 4 + hh]), dtb = c.dt_bias[l * 4 + hh];
#pragma unroll
        for (int mt = 0; mt < 4; ++mt)
#pragma unroll
            for (int j = 0; j < 4; ++j) { const int tok = tok0 + 16 * mt + 4 * fq + j; const float v = acc[mt][j] * rsqrtf(ssq_sum(ssq + (size_t)tok * 16) * (1.0f / DM) + EPS);
                if (fr < 4) gb[tok * 4 + hh] = al * softplus_f(v + dtb); else bb[tok * 4 + hh] = sigmoid_f(v); } }
}
DI void conv8(const bf16_t* prow, const float* cw, int pos, int i, float (&y)[8], u32x4& cur) {
    u32x4 rws[4];
#pragma unroll
    for (int j = 0; j < 4; ++j) { rws[j] = (u32x4){0u, 0u, 0u, 0u}; if (pos - 3 + j >= 0) rws[j] = *(const u32x4*)(prow + (long)(j - 3) * NP + 8 * i); }
#pragma unroll
    for (int e = 0; e < 8; ++e) { float a = 0.f;
#pragma unroll
        for (int j = 0; j < 4; ++j) { const unsigned w = rws[j][e >> 1]; const float pv = (e & 1) ? bfhi(w) : bflo(w); a += pv * cw[j * QKV + 8 * i + e]; }
        y[e] = silu_f(a); }
    cur = rws[3];
}
DI void b0_task_conv(const Ctx& c, int l, int b, int n, int s, int hh) {
    const int pos = n * 64 + c.lane, tok = b * SEQ + pos, cb = s * 512 + hh * 128;
    const bf16_t* prow = WSP(bf16_t, WS_P) + (size_t)tok * NP + cb;
    const float* cw = c.conv_w + (size_t)l * 4 * QKV + cb;
    float* ocp = c.out + O_CP + ((size_t)(l * NBATCH + b) * 3) * QKV + cb;
    float ss = 0.f;
    if (s < 2) {
#pragma unroll 2
        for (int i = 0; i < 16; ++i) { float y[8]; u32x4 cur; conv8(prow, cw, pos, i, y, cur);
#pragma unroll
            for (int e = 0; e < 8; ++e) ss += y[e] * y[e]; } }
    const float sc = s == 0 ? rsqrtf(ss + EPS) * 0.08838834764831845f : (s == 1 ? rsqrtf(ss + EPS) : 1.0f);
    const size_t unit = (size_t)((b * 4 + hh) * 32 + n);
    bf16_t* o = (s == 0 ? WSP(bf16_t, WS_QN) : WSP(bf16_t, WS_KN)) + (size_t)tok * 512 + hh * 128;
    bf16_t* ot = (s == 1 ? WSP(bf16_t, WS_KNT) : WSP(bf16_t, WS_VT)) + unit * 128 * 64 + c.lane;
#pragma unroll 2
    for (int i = 0; i < 16; ++i) { float y[8]; u32x4 cur; conv8(prow, cw, pos, i, y, cur);
        if (n == 31 && c.lane >= 61) {
#pragma unroll
            for (int e = 0; e < 8; ++e) { const unsigned w = cur[e >> 1]; ocp[(size_t)(c.lane - 61) * QKV + 8 * i + e] = (e & 1) ? bfhi(w) : bflo(w); } }
        if (s < 2) { u32x4 w; w.x = pk2(y[0] * sc, y[1] * sc); w.y = pk2(y[2] * sc, y[3] * sc); w.z = pk2(y[4] * sc, y[5] * sc); w.w = pk2(y[6] * sc, y[7] * sc); *(u32x4*)(o + 8 * i) = w; }
        if (s >= 1) {
#pragma unroll
            for (int e = 0; e < 8; ++e) ot[(8 * i + e) * 64] = f2bf(y[e] * sc); } }
}
DI void b0_task_vb(const Ctx& c, int l, int b, int n) {
    const int tok = b * SEQ + n * 64 + c.lane;
    const bf16_t* prow = WSP(bf16_t, WS_P) + (size_t)tok * NP + 2560;
    float ss = 0.f;
#pragma unroll 8
    for (int i = 0; i < 64; ++i) { const u32x4 w = *(const u32x4*)(prow + 8 * i);
#pragma unroll
        for (int e = 0; e < 4; ++e) { const float a = bflo(w[e]), bq = bfhi(w[e]); ss += a * a + bq * bq; } }
    const float rs = rsqrtf(ss * (1.0f / 512.0f) + EPS);
    const float* vg = c.v_norm_g + l * 512;
    bf16_t* vbt = WSP(bf16_t, WS_VBT) + (size_t)((b * 16 + (n >> 1)) * 4) * 128 * 128 + (n & 1) * 64 + c.lane;
#pragma unroll 4
    for (int i = 0; i < 64; ++i) { const u32x4 w = *(const u32x4*)(prow + 8 * i);
#pragma unroll
        for (int e = 0; e < 8; ++e) { const int ch = 8 * i + e; const float pv = (e & 1) ? bfhi(w[e >> 1]) : bflo(w[e >> 1]);
            vbt[(size_t)ch * 128] = f2bf(pv * rs * vg[ch]); } }
}
DI void b0_task_sample(const Ctx& c, int l, int bs) {
    const float* ps = WSP(float, WS_PS) + (size_t)bs * NPS;
    if (c.lane < 4) { const int hh = c.lane;
        WSP(float, WS_GS)[bs * 4 + hh] = -__expf(c.A_log[l * 4 + hh]) * softplus_f(ps[3072 + hh] + c.dt_bias[l * 4 + hh]);
        WSP(float, WS_BS)[bs * 4 + hh] = sigmoid_f(ps[3076 + hh]); }
    const float* sc = c.state_conv + (size_t)(l * SBATCH + bs) * 3 * QKV;
    const float* cw = c.conv_w + (size_t)l * 4 * QKV;
    float* ocs = c.out + O_CS + (size_t)(l * SBATCH + bs) * 3 * QKV;
    float* qkvs = WSP(float, WS_QS) + bs * 512;
#pragma unroll 1
    for (int sh = 0; sh < 12; ++sh) {
        float y[2];
#pragma unroll
        for (int t = 0; t < 2; ++t) { const int ch = sh * 128 + t * 64 + c.lane; const float s0 = sc[ch], s1 = sc[QKV + ch], s2 = sc[2 * QKV + ch], cur = ps[ch];
            ocs[ch] = s1; ocs[QKV + ch] = s2; ocs[2 * QKV + ch] = cur;
            y[t] = silu_f(s0 * cw[ch] + s1 * cw[QKV + ch] + s2 * cw[2 * QKV + ch] + cur * cw[3 * QKV + ch]); }
        float scale = 1.0f;
        if (sh < 8) { const float ssum = wave_sum(y[0] * y[0] + y[1] * y[1]); scale = rsqrtf(ssum + EPS) * (sh < 4 ? 0.08838834764831845f : 1.0f); }
        float* o = qkvs + (size_t)(sh >> 2) * SBATCH * 512 + (sh & 3) * 128;
        o[c.lane] = y[0] * scale; o[64 + c.lane] = y[1] * scale;
    }
    float pv[8]; float ss = 0.f;
#pragma unroll
    for (int i = 0; i < 8; ++i) { pv[i] = ps[2560 + c.lane + 64 * i]; ss += pv[i] * pv[i]; }
    ss = wave_sum(ss); const float rs = rsqrtf(ss * (1.0f / 512.0f) + EPS);
    float* am = WSP(float, WS_AMIXS) + (size_t)bs * DM; float* ovs = c.out + O_VS + (size_t)(l * SBATCH + bs) * 512;
#pragma unroll
    for (int i = 0; i < 8; ++i) { const int ch = c.lane + 64 * i, hb = ch >> 7; const float vb = pv[i] * rs * c.v_norm_g[l * 512 + ch];
        ovs[ch] = vb; am[512 + ch] = ps[2048 + ch] * (c.w_s[(size_t)(l * 4 + hb) * 128 * 128] * vb + c.b_s[(l * 4 + hb) * 128]); }
}
DI void phase_b0(const Ctx& c, int l) {
    constexpr int NPT = 256 * 14;
    for (int t = c.gw; t < NPT + SBATCH; t += c.ngw) {
        if (t >= NPT) { if (SUB(0)) b0_task_sample(c, l, t - NPT); continue; }
        const int chunk = t / 14, k = t % 14, b = chunk >> 5, n = chunk & 31;
        if (k == 0) { if (SUB(1)) b0_task_ab(c, l, b, n); }
        else if (k == 13) { if (SUB(2)) b0_task_vb(c, l, b, n); }
        else { if (SUB(3)) b0_task_conv(c, l, b, n, (k - 1) >> 2, (k - 1) & 3); }
    }
}

DI void b1_prep(const Ctx& c, int l, int unit, LAS unsigned char* wl, LAS float* sg, LAS float* sb) {
    int lane = c.lane; asm volatile("" : "+v"(lane));
    const int r = lane & 31, h = lane >> 5;
    const int n = unit & 31, bh = unit >> 5, hh = bh & 3, b = bh >> 2, tok0 = b * SEQ + n * 64;
    const float bt = WSP(float, WS_BETA)[(tok0 + lane) * 4 + hh];
    float gc = WSP(float, WS_G)[(tok0 + lane) * 4 + hh];
#pragma unroll
    for (int o = 1; o < 64; o <<= 1) { const float t = __shfl_up(gc, o); if (lane >= o) gc += t; }
    sg[lane] = gc; sb[lane] = bt;
    const float glast = __shfl(gc, 63);
    if (lane == 0) WSP(float, WS_EG)[unit] = __expf(glast);
    unsigned char* img = c.ws + WS_IMG + (size_t)unit * IMG_BYTES;
    const bf16_t* Kn = WSP(bf16_t, WS_KN) + (size_t)tok0 * 512 + hh * 128;
    const bf16_t* Qn = WSP(bf16_t, WS_QN) + (size_t)tok0 * 512 + hh * 128;
    const bf16_t* KnT = WSP(bf16_t, WS_KNT) + (size_t)unit * 128 * 64;
    const bf16_t* VT = WSP(bf16_t, WS_VT) + (size_t)unit * 128 * 64;
    LAS float* L = (LAS float*)wl;
    {
        bf16x8 Kf[2][8];
#pragma unroll
        for (int t = 0; t < 2; ++t)
#pragma unroll
            for (int ks = 0; ks < 8; ++ks) Kf[t][ks] = *(const bf16x8*)(Kn + (size_t)(32 * t + r) * 512 + 16 * ks + 8 * h);
#pragma unroll
        for (int tt = 0; tt < 3; ++tt) { const int mt = tt == 0 ? 0 : 1, nt = tt == 2 ? 1 : 0;
            f32x16 acc = zero16();
#pragma unroll
            for (int ks = 0; ks < 8; ++ks) acc = MFMA32(Kf[mt][ks], Kf[nt][ks], acc);
            const int j = 32 * nt + r; const float gj = sg[j];
#pragma unroll
            for (int g4 = 0; g4 < 4; ++g4) { const f32x4 gi4 = *(const LAS f32x4*)(sg + 32 * mt + 8 * g4 + 4 * h), bi4 = *(const LAS f32x4*)(sb + 32 * mt + 8 * g4 + 4 * h);
#pragma unroll
                for (int q = 0; q < 4; ++q) { const int i = 32 * mt + 8 * g4 + 4 * h + q; const float arg = i > j ? gi4[q] - gj : 0.f;
                    L[i * 64 + j] = i > j ? acc[4 * g4 + q] * bi4[q] * __expf(arg) : 0.f; } } }
#pragma unroll
        for (int mt = 0; mt < 2; ++mt) {
            bf16x8 Qf[8];
#pragma unroll
            for (int ks = 0; ks < 8; ++ks) Qf[ks] = *(const bf16x8*)(Qn + (size_t)(32 * mt + r) * 512 + 16 * ks + 8 * h);
            const int i = 32 * mt + r; const float gi = sg[i];
#pragma unroll
            for (int mp = 0; mp <= mt; ++mp) {
                f32x16 acc = zero16();
#pragma unroll
                for (int ks = 0; ks < 8; ++ks) acc = MFMA32(Kf[mp][ks], Qf[ks], acc);
#pragma unroll
                for (int g4 = 0; g4 < 4; ++g4) { const f32x4 gj4 = *(const LAS f32x4*)(sg + 32 * mp + 8 * g4 + 4 * h);
#pragma unroll
                    for (int q = 0; q < 4; ++q) { const int j = 32 * mp + 8 * g4 + 4 * h + q; const float arg = i >= j ? gi - gj4[q] : 0.f;
                        acc[4 * g4 + q] = i >= j ? acc[4 * g4 + q] * __expf(arg) : 0.f; } }
                const int fb = (mt == 0 ? 0 : 1 + mp) * 2;
#pragma unroll
                for (int s = 0; s < 2; ++s) *(u32x4*)(img + 49152 + (fb + s) * 1024 + lane * 16) = pack8(acc, s);
            }
        }
    }
    float Tr[64];
    {
        f32x4 lb[2][16];
#pragma unroll
        for (int i = 0; i < 64; ++i) {
            if (i + 1 < 64) {
#pragma unroll
                for (int j4 = 0; j4 < (i + 1 + 3) / 4; ++j4) lb[(i + 1) & 1][j4] = *(const LAS f32x4*)(L + (i + 1) * 64 + 4 * j4); }
            asm volatile("" ::: "memory");
            float a0 = lane == i ? 1.f : 0.f, a1 = 0.f;
#pragma unroll
            for (int j4 = 0; j4 < (i + 3) / 4; ++j4) {
#pragma unroll
                for (int q = 0; q < 4; ++q) { const int j = 4 * j4 + q; if (j < i) { if (q & 1) a1 -= lb[i & 1][j4][q] * Tr[j]; else a0 -= lb[i & 1][j4][q] * Tr[j]; } } }
            Tr[i] = a0 + a1;
        }
    }
    LAS bf16_t* T1 = (LAS bf16_t*)wl;
    asm volatile("" ::: "memory");
    {
        const float sc1 = bt * __expf(gc);
#pragma unroll
        for (int i = 0; i < 64; ++i) T1[i * 72 + lane] = f2bf(Tr[i] * sc1);
        bf16x8 Tf[2][4];
#pragma unroll
        for (int mt = 0; mt < 2; ++mt)
#pragma unroll
            for (int ks = 0; ks < 4; ++ks) Tf[mt][ks] = *(const LAS bf16x8*)(T1 + (32 * mt + r) * 72 + 16 * ks + 8 * h);
#pragma unroll
        for (int dt = 0; dt < 4; ++dt) {
            bf16x8 Kt[4];
#pragma unroll
            for (int ks = 0; ks < 4; ++ks) Kt[ks] = *(const bf16x8*)(KnT + (size_t)(32 * dt + r) * 64 + 16 * ks + 8 * h);
#pragma unroll
            for (int mt = 0; mt < 2; ++mt) { f32x16 acc = zero16();
#pragma unroll
                for (int ks = 0; ks < 2 * (mt + 1); ++ks) acc = MFMA32(Kt[ks], Tf[mt][ks], acc);
                acc = -acc;
#pragma unroll
                for (int s = 0; s < 2; ++s) *(u32x4*)(img + ((mt * 4 + dt) * 2 + s) * 1024 + lane * 16) = pack8(acc, s); }
        }
    }
    asm volatile("" ::: "memory");
    {
#pragma unroll
        for (int i = 0; i < 64; ++i) T1[i * 72 + lane] = f2bf(Tr[i] * bt);
        bf16x8 Tf[2][4];
#pragma unroll
        for (int mt = 0; mt < 2; ++mt)
#pragma unroll
            for (int ks = 0; ks < 4; ++ks) Tf[mt][ks] = *(const LAS bf16x8*)(T1 + (32 * mt + r) * 72 + 16 * ks + 8 * h);
        float* uimg = WSP(float, WS_UIMG) + (size_t)unit * 8192;
#pragma unroll
        for (int et = 0; et < 4; ++et) {
            bf16x8 Vt[4];
#pragma unroll
            for (int ks = 0; ks < 4; ++ks) Vt[ks] = *(const bf16x8*)(VT + (size_t)(32 * et + r) * 64 + 16 * ks + 8 * h);
#pragma unroll
            for (int mt = 0; mt < 2; ++mt) { f32x16 acc = zero16();
#pragma unroll
                for (int ks = 0; ks < 2 * (mt + 1); ++ks) acc = MFMA32(Tf[mt][ks], Vt[ks], acc);
#pragma unroll
                for (int g4 = 0; g4 < 4; ++g4) *(f32x4*)(uimg + ((et * 2 + mt) * 4 + g4) * 256 + lane * 4) = (f32x4){acc[4 * g4], acc[4 * g4 + 1], acc[4 * g4 + 2], acc[4 * g4 + 3]}; }
        }
    }
    asm volatile("" ::: "memory");
#pragma unroll
    for (int mt = 0; mt < 2; ++mt) { const float ei = __expf(sg[32 * mt + r]);
#pragma unroll
        for (int dt = 0; dt < 4; ++dt)
#pragma unroll
            for (int s = 0; s < 2; ++s) { const bf16_t* qp = Qn + (size_t)(32 * mt + r) * 512 + 32 * dt + 16 * s + 4 * h;
                const u32x2 p0 = *(const u32x2*)qp, p1 = *(const u32x2*)(qp + 8);
                u32x4 w; w.x = pk2(bflo(p0.x) * ei, bfhi(p0.x) * ei); w.y = pk2(bflo(p0.y) * ei, bfhi(p0.y) * ei); w.z = pk2(bflo(p1.x) * ei, bfhi(p1.x) * ei); w.w = pk2(bflo(p1.y) * ei, bfhi(p1.y) * ei);
                *(u32x4*)(img + 16384 + ((mt * 4 + dt) * 2 + s) * 1024 + lane * 16) = w; } }
#pragma unroll
    for (int mp = 0; mp < 2; ++mp)
#pragma unroll
        for (int s = 0; s < 2; ++s) { const f32x4 ga = *(const LAS f32x4*)(sg + 32 * mp + 16 * s + 4 * h), gb = *(const LAS f32x4*)(sg + 32 * mp + 16 * s + 8 + 4 * h);
            float sc[8];
#pragma unroll
            for (int q = 0; q < 4; ++q) { sc[q] = __expf(glast - ga[q]); sc[4 + q] = __expf(glast - gb[q]); }
#pragma unroll
            for (int dt = 0; dt < 4; ++dt) { const bf16_t* kp = KnT + (size_t)(32 * dt + r) * 64 + 32 * mp + 16 * s + 4 * h;
                const u32x2 p0 = *(const u32x2*)kp, p1 = *(const u32x2*)(kp + 8);
                u32x4 w; w.x = pk2(bflo(p0.x) * sc[0], bfhi(p0.x) * sc[1]); w.y = pk2(bflo(p0.y) * sc[2], bfhi(p0.y) * sc[3]); w.z = pk2(bflo(p1.x) * sc[4], bfhi(p1.x) * sc[5]); w.w = pk2(bflo(p1.y) * sc[6], bfhi(p1.y) * sc[7]);
                *(u32x4*)(img + 32768 + ((dt * 2 + mp) * 2 + s) * 1024 + lane * 16) = w; } }
}
DI void b1_gmlp(const Ctx& c, int l, int unit) {
    int lane = c.lane; asm volatile("" : "+v"(lane));
    const int r = lane & 31, h = lane >> 5;
    const int hb = unit & 3, cc = (unit >> 2) & 15, b = unit >> 6, tokc0 = b * SEQ + cc * 128;
    const bf16_t* A = WSP(bf16_t, WS_VBT) + (size_t)unit * 128 * 128;
    const bf16_t* B = WSP(bf16_t, WS_WM) + (size_t)(l * 4 + hb) * 128 * 128;
    const bf16_t* P = WSP(bf16_t, WS_P); bf16_t* AM = WSP(bf16_t, WS_AMIX);
#pragma unroll
    for (int nt = 0; nt < 4; ++nt) {
        f32x16 acc[4];
#pragma unroll
        for (int mt = 0; mt < 4; ++mt) acc[mt] = zero16();
#pragma unroll
        for (int ks = 0; ks < 2 * (nt + 1); ++ks) { const bf16x8 bf = *(const bf16x8*)(B + (size_t)(32 * nt + r) * 128 + 16 * ks + 8 * h);
#pragma unroll
            for (int mt = 0; mt < 4; ++mt) { const bf16x8 af = *(const bf16x8*)(A + (size_t)(32 * mt + r) * 128 + 16 * ks + 8 * h); acc[mt] = MFMA32(af, bf, acc[mt]); } }
        const int tok = tokc0 + 32 * nt + r; const float bsi = c.b_s[(l * 4 + hb) * 128 + 32 * nt + r];
#pragma unroll
        for (int mt = 0; mt < 4; ++mt)
#pragma unroll
            for (int g4 = 0; g4 < 4; ++g4) { const int dch0 = 32 * mt + 8 * g4 + 4 * h;
                const u32x2 u4 = *(const u32x2*)(P + (size_t)tok * NP + 2048 + hb * 128 + dch0);
                u32x2 w; w.x = pk2(bflo(u4.x) * (acc[mt][4 * g4] + bsi), bfhi(u4.x) * (acc[mt][4 * g4 + 1] + bsi)); w.y = pk2(bflo(u4.y) * (acc[mt][4 * g4 + 2] + bsi), bfhi(u4.y) * (acc[mt][4 * g4 + 3] + bsi));
                *(u32x2*)(AM + (size_t)tok * DM + 512 + hb * 128 + dch0) = w; }
    }
}
DI void phase_b1(const Ctx& c, int l, LAS unsigned char* lds) {
    LAS unsigned char* wl = lds + c.wave * 16384; LAS float* sg = (LAS float*)(lds + 131072 + c.wave * 512); LAS float* sb = sg + 64;
    for (int t = c.gw; t < 1024 + 512; t += c.ngw) {
        if (t < 1024) { if (SUB(0)) b1_prep(c, l, t, wl, sg, sb); } else { if (SUB(1)) b1_gmlp(c, l, t - 1024); }
    }
}

constexpr int OB_STRIDE = 136;
constexpr int LDS_OBUF = 2 * IMG_BYTES, OBUF_BYTES = 64 * OB_STRIDE * 2;
static_assert(LDS_OBUF + 2 * OBUF_BYTES <= LDS_BYTES, "scan LDS");
DI void scan_post(const Ctx& c, int l, int b, int hh, int n, const LAS bf16_t* ob, int lid) {
    const int i = lid >> 2, q = lid & 3, tok = b * SEQ + n * 64 + i;
    u32x4 ov[4]; float ss = 0.f;
#pragma unroll
    for (int x = 0; x < 4; ++x) { ov[x] = *(const LAS u32x4*)(ob + i * OB_STRIDE + 32 * q + 8 * x);
#pragma unroll
        for (int e = 0; e < 4; ++e) { const float a = bflo(ov[x][e]), bq = bfhi(ov[x][e]); ss += a * a + bq * bq; } }
    ss += __shfl_xor(ss, 1); ss += __shfl_xor(ss, 2);
    const float rs = rsqrtf(ss * (1.0f / 128.0f) + EPS);
    const bf16_t* gp = WSP(bf16_t, WS_P) + (size_t)tok * NP + 1536 + hh * 128 + 32 * q;
    bf16_t* op = WSP(bf16_t, WS_AMIX) + (size_t)tok * DM + hh * 128 + 32 * q;
    const float* og = c.o_norm_g + l * 128 + 32 * q;
#pragma unroll
    for (int x = 0; x < 4; ++x) { const u32x4 gt = *(const u32x4*)(gp + 8 * x); u32x4 w;
#pragma unroll
        for (int e = 0; e < 4; ++e) { const float o0 = bflo(ov[x][e]) * rs * og[8 * x + 2 * e] * silu_f(bflo(gt[e])), o1 = bfhi(ov[x][e]) * rs * og[8 * x + 2 * e + 1] * silu_f(bfhi(gt[e])); w[e] = pk2(o0, o1); }
        *(u32x4*)(op + 8 * x) = w; }
}
DI void scan_block(const Ctx& c, int l, int bh, LAS unsigned char* lds) {
    const int wave = c.wave, b = bh >> 2, hh = bh & 3;
    const unsigned char* img0 = c.ws + WS_IMG + (size_t)bh * 32 * IMG_BYTES;
    if (wave >= 4) { if (SUB2(0)) {
        int lane = c.lane; asm volatile("" : "+v"(lane));
        const int lw = wave - 4, lid = lw * 64 + lane;
        u32x4 regs[14];
#pragma unroll
        for (int i = 0; i < 14; ++i) { const int ch = lw + 4 * i; if (ch < 54) regs[i] = *(const u32x4*)(img0 + ch * 1024 + lane * 16); }
#pragma unroll
        for (int i = 0; i < 14; ++i) { const int ch = lw + 4 * i; if (ch < 54) *(LAS u32x4*)(lds + ch * 1024 + lane * 16) = regs[i]; }
        __syncthreads();
        for (int n = 0; n < 32; ++n) {
            if (n + 1 < 32) {
#pragma unroll
                for (int i = 0; i < 14; ++i) { const int ch = lw + 4 * i; if (ch < 54) regs[i] = *(const u32x4*)(img0 + (size_t)(n + 1) * IMG_BYTES + ch * 1024 + lane * 16); } }
            if (n >= 1) scan_post(c, l, b, hh, n - 1, (const LAS bf16_t*)(lds + LDS_OBUF + ((n - 1) & 1) * OBUF_BYTES), lid);
            if (n + 1 < 32) {
#pragma unroll
                for (int i = 0; i < 14; ++i) { const int ch = lw + 4 * i; if (ch < 54) *(LAS u32x4*)(lds + ((n + 1) & 1) * IMG_BYTES + ch * 1024 + lane * 16) = regs[i]; } }
            __syncthreads();
        }
        scan_post(c, l, b, hh, 31, (const LAS bf16_t*)(lds + LDS_OBUF + (31 & 1) * OBUF_BYTES), lid);
    } } else if (SUB2(1)) {
        int lane = c.lane; asm volatile("" : "+v"(lane));
        const int ws = wave, r = lane & 31, h = lane >> 5;
        f32x16 S[4];
#pragma unroll
        for (int dt = 0; dt < 4; ++dt) S[dt] = zero16();
        const float* uimg0 = WSP(float, WS_UIMG) + (size_t)bh * 32 * 8192 + (size_t)ws * 2 * 4 * 256 + lane * 4;
        const float* egp = WSP(float, WS_EG) + bh * 32;
        f32x16 un[2];
#pragma unroll
        for (int mt = 0; mt < 2; ++mt)
#pragma unroll
            for (int g4 = 0; g4 < 4; ++g4) { const f32x4 v = *(const f32x4*)(uimg0 + (mt * 4 + g4) * 256); un[mt][4 * g4] = v.x; un[mt][4 * g4 + 1] = v.y; un[mt][4 * g4 + 2] = v.z; un[mt][4 * g4 + 3] = v.w; }
        float eg_n = egp[0];
        __syncthreads();
        for (int n = 0; n < 32; ++n) {
            const LAS unsigned char* buf = lds + (n & 1) * IMG_BYTES + lane * 16;
            f32x16 av[2], ao[2]; av[0] = un[0]; av[1] = un[1]; ao[0] = zero16(); ao[1] = zero16();
            const float eg = eg_n;
            if (n + 1 < 32) { const float* up = uimg0 + (size_t)(n + 1) * 8192;
#pragma unroll
                for (int mt = 0; mt < 2; ++mt)
#pragma unroll
                    for (int g4 = 0; g4 < 4; ++g4) { const f32x4 v = *(const f32x4*)(up + (mt * 4 + g4) * 256); un[mt][4 * g4] = v.x; un[mt][4 * g4 + 1] = v.y; un[mt][4 * g4 + 2] = v.z; un[mt][4 * g4 + 3] = v.w; }
                eg_n = egp[n + 1]; }
#pragma unroll
            for (int pass = 0; pass < 2; ++pass) {
                const LAS unsigned char* fb = buf + pass * 16384;
                bf16x8 fg[2][2];
#pragma unroll
                for (int mt = 0; mt < 2; ++mt) fg[0][mt] = *(const LAS bf16x8*)(fb + (mt * 8) * 1024);
#pragma unroll
                for (int gI = 0; gI < 8; ++gI) { const int dt = gI >> 1, s = gI & 1;
                    if (gI + 1 < 8) {
#pragma unroll
                        for (int mt = 0; mt < 2; ++mt) fg[(gI + 1) & 1][mt] = *(const LAS bf16x8*)(fb + (mt * 8 + gI + 1) * 1024); }
                    asm volatile("" ::: "memory");
                    const bf16x8 sb = as_bf(pack8(S[dt], s));
                    if (pass == 0) { av[0] = MFMA32(fg[gI & 1][0], sb, av[0]); av[1] = MFMA32(fg[gI & 1][1], sb, av[1]); }
                    else { ao[0] = MFMA32(fg[gI & 1][0], sb, ao[0]); ao[1] = MFMA32(fg[gI & 1][1], sb, ao[1]); } }
            }
            bf16x8 vb[2][2];
#pragma unroll
            for (int mp = 0; mp < 2; ++mp)
#pragma unroll
                for (int s = 0; s < 2; ++s) vb[mp][s] = as_bf(pack8(av[mp], s));
            {
                bf16x8 qf[6];
#pragma unroll
                for (int f = 0; f < 6; ++f) qf[f] = *(const LAS bf16x8*)(buf + 49152 + f * 1024);
                asm volatile("" ::: "memory");
#pragma unroll
                for (int s = 0; s < 2; ++s) { ao[0] = MFMA32(qf[s], vb[0][s], ao[0]); ao[1] = MFMA32(qf[2 + s], vb[0][s], ao[1]); ao[1] = MFMA32(qf[4 + s], vb[1][s], ao[1]); }
            }
            LAS bf16_t* ob = (LAS bf16_t*)(lds + LDS_OBUF + (n & 1) * OBUF_BYTES);
#pragma unroll
            for (int mt = 0; mt < 2; ++mt)
#pragma unroll
                for (int reg = 0; reg < 16; ++reg) ob[(32 * mt + crow(reg, h)) * OB_STRIDE + 32 * ws + r] = f2bf(ao[mt][reg]);
            bf16x8 kf[2][4];
#pragma unroll
            for (int f = 0; f < 4; ++f) kf[0][f] = *(const LAS bf16x8*)(buf + 32768 + f * 1024);
#pragma unroll
            for (int dt = 0; dt < 4; ++dt) {
                if (dt + 1 < 4) {
#pragma unroll
                    for (int f = 0; f < 4; ++f) kf[(dt + 1) & 1][f] = *(const LAS bf16x8*)(buf + 32768 + ((dt + 1) * 4 + f) * 1024); }
                asm volatile("" ::: "memory");
                S[dt] = S[dt] * eg;
#pragma unroll
                for (int mp = 0; mp < 2; ++mp)
#pragma unroll
                    for (int s = 0; s < 2; ++s) S[dt] = MFMA32(kf[dt & 1][mp * 2 + s], vb[mp][s], S[dt]); }
            __syncthreads();
        }
        const char* od = (const char*)(c.out + O_DP + (size_t)(l * 32 + bh) * 128 * 128);
        unsigned voff = (unsigned)((4 * h) * 128 + 32 * ws + r) * 4u;
        asm volatile("" : "+v"(voff));
#pragma unroll
        for (int dt = 0; dt < 4; ++dt)
#pragma unroll
            for (int reg = 0; reg < 16; ++reg) *(float*)(od + (32 * dt + (reg & 3) + 8 * (reg >> 2)) * 512 + voff) = S[dt][reg];
    }
}
DI void sample_recurrent(const Ctx& c, int l, int unit) {
    const int lane = c.lane, bs = unit >> 2, hh = unit & 3, e2 = 2 * lane;
    const float* S0 = c.state_delta + (size_t)((l * SBATCH + bs) * 4 + hh) * 128 * 128 + e2;
    float* S1 = c.out + O_DS + (size_t)((l * SBATCH + bs) * 4 + hh) * 128 * 128 + e2;
    const float* q = WSP(float, WS_QS) + bs * 512 + hh * 128; const float* k = WSP(float, WS_KS) + bs * 512 + hh * 128; const float* v = WSP(float, WS_VS) + bs * 512 + hh * 128;
    const float eg = __expf(WSP(float, WS_GS)[bs * 4 + hh]), beta = WSP(float, WS_BS)[bs * 4 + hh];
    f32x2 kv = {0.f, 0.f};
#pragma unroll 8
    for (int d = 0; d < 128; ++d) { const f32x2 s = *(const f32x2*)(S0 + d * 128); kv += s * k[d]; }
    const f32x2 v2 = *(const f32x2*)(v + e2);
    const f32x2 delta = (v2 - kv * eg) * beta;
    f32x2 oo = {0.f, 0.f};
#pragma unroll 8
    for (int d = 0; d < 128; ++d) { const f32x2 s = *(const f32x2*)(S0 + d * 128); const f32x2 sn = s * eg + delta * k[d]; oo += sn * q[d]; *(f32x2*)(S1 + d * 128) = sn; }
    const float ss = wave_sum(oo.x * oo.x + oo.y * oo.y); const float rs = rsqrtf(ss * (1.0f / 128.0f) + EPS);
    const float* ps = WSP(float, WS_PS) + (size_t)bs * NPS + 1536 + hh * 128 + e2; float* am = WSP(float, WS_AMIXS) + (size_t)bs * DM + hh * 128 + e2;
    const float* og = c.o_norm_g + l * 128 + e2;
    am[0] = oo.x * rs * og[0] * silu_f(ps[0]); am[1] = oo.y * rs * og[1] * silu_f(ps[1]);
}
DI void phase_scan(const Ctx& c, int l, LAS unsigned char* lds) {
    if (blockIdx.x < 32) { if (SUB(0)) scan_block(c, l, blockIdx.x, lds); return; }
    const int w0 = (blockIdx.x - 32) * 8 + c.wave, nw = (gridDim.x - 32) * 8;
    for (int u = w0; u < SBATCH * 4; u += nw) { if (SUB(1)) sample_recurrent(c, l, u); }
}

DI void phase_final(const Ctx& c) {
    for (int m = c.gw; m < MP + SBATCH; m += c.ngw) {
        const float* src = m < MP ? WSP(float, WS_XBUF) + (size_t)m * DM : WSP(float, WS_XS) + (size_t)(m - MP) * DM;
        float* dst = m < MP ? c.out + O_YP + (size_t)m * DM : c.out + O_YS + (size_t)(m - MP) * DM;
        const f32x4* xr = (const f32x4*)src + c.lane; const f32x4* gr = (const f32x4*)c.norm_f_g + c.lane; f32x4 v[4]; float s = 0.f;
#pragma unroll
        for (int j = 0; j < 4; ++j) { v[j] = xr[64 * j];
            if (m >= MP) { const f32x4* pp = (const f32x4*)(WSP(float, WS_XP) + (size_t)(m - MP) * DM) + c.lane + 64 * j;
#pragma unroll
                for (int q = 0; q < 4; ++q) v[j] += pp[(size_t)q * SBATCH * DM / 4]; }
            s += (v[j].x * v[j].x + v[j].y * v[j].y) + (v[j].z * v[j].z + v[j].w * v[j].w); }
        const float rs = rsqrtf(wave_sum(s) * (1.0f / DM) + EPS);
#pragma unroll
        for (int j = 0; j < 4; ++j) ((f32x4*)dst + c.lane)[64 * j] = v[j] * rs * gr[64 * j];
    }
}

#define XB_TMO      128
#define XB_XCNT(j)  (256  + 64 * (j))
#define XB_XSUB(j)  (1280 + 64 * (j))
#define XB_XGEN(j)  (2304 + 64 * (j))
#define XB_TOP      3328
#define XB_TOPGEN   3392
#define XCD_BAR_WORDS 3456
#define XB_SPIN_CAP (1u << 18)

__device__ __forceinline__ unsigned xb_ld(unsigned* p)              { return __hip_atomic_load(p, __ATOMIC_RELAXED, __HIP_MEMORY_SCOPE_AGENT); }
__device__ __forceinline__ unsigned xb_add(unsigned* p, unsigned v) { return __hip_atomic_fetch_add(p, v, __ATOMIC_RELAXED, __HIP_MEMORY_SCOPE_AGENT); }
__device__ __forceinline__ unsigned xb_xcc_id() { return (unsigned)__builtin_amdgcn_s_getreg((3 << 11) | 20) & 0xFu; }
#define XB_SPIN(cond, bar) do { unsigned _sp = 0; while (cond) { __builtin_amdgcn_s_sleep(1); \
    if ((++_sp & 255u) == 0u) { if (xb_ld(&(bar)[XB_TMO])) break; if (_sp > XB_SPIN_CAP) { atomicAdd(&(bar)[XB_TMO], 1u); break; } } } } while (0)

struct XcdBarrier {
    unsigned* bar; unsigned x;
    volatile LAS unsigned* st;
};

__device__ __forceinline__ XcdBarrier xcd_barrier_post(unsigned* bar, volatile LAS unsigned* st) {
    XcdBarrier b; b.bar = bar; b.x = xb_xcc_id(); b.st = st;
    if (threadIdx.x == 0) (void)xb_add(&bar[XB_XCNT(b.x)], 1u);
    return b;
}
__device__ __forceinline__ void xcd_barrier_complete(unsigned* bar, unsigned x, unsigned& nloc, unsigned& nx) {
    const unsigned G = gridDim.x * gridDim.y * gridDim.z;
    unsigned sum, cnt, mine, sp = 0u;
    for (;;) {
        sum = 0u; cnt = 0u; mine = 0u;
#pragma unroll
        for (unsigned j = 0; j < 16; ++j) { const unsigned c = xb_ld(&bar[XB_XCNT(j)]); sum += c; cnt += (c > 0u) ? 1u : 0u; mine = (j == x) ? c : mine; }
        if (sum == G) break;
        __builtin_amdgcn_s_sleep(1);
        if ((++sp & 255u) == 0u) { if (xb_ld(&bar[XB_TMO])) break; if (sp > XB_SPIN_CAP) { atomicAdd(&bar[XB_TMO], 1u); break; } }
    }
    nloc = mine > 0u ? mine : 1u; nx = cnt > 0u ? cnt : 1u;
}

__device__ __forceinline__ void xcd_barrier(const XcdBarrier& b) {
    asm volatile("s_waitcnt vmcnt(0)" ::: "memory");
    __syncthreads();
    if (threadIdx.x == 0) {
        unsigned* bar = b.bar;
        __builtin_amdgcn_s_waitcnt(0);
        unsigned nloc = b.st[0], nx = b.st[1];
        if (nloc == 0u) { xcd_barrier_complete(bar, b.x, nloc, nx); b.st[0] = nloc; b.st[1] = nx; }
        const unsigned old = xb_add(&bar[XB_XSUB(b.x)], 1u);
        const unsigned gen = old / nloc;
        if (old + 1u == (gen + 1u) * nloc) {
            __builtin_amdgcn_fence(__ATOMIC_RELEASE, "agent");
            asm volatile("s_waitcnt vmcnt(0)" ::: "memory");
            const unsigned og = xb_add(&bar[XB_TOP], 1u);
            const unsigned tg = og / nx;
            if (og + 1u == (tg + 1u) * nx) xb_add(&bar[XB_TOPGEN], 1u);
            else XB_SPIN(xb_ld(&bar[XB_TOPGEN]) == tg, bar);
            __builtin_amdgcn_fence(__ATOMIC_ACQUIRE, "agent");
            xb_add(&bar[XB_XGEN(b.x)], 1u);
            asm volatile("s_waitcnt vmcnt(0)" ::: "memory");
        } else {
            XB_SPIN(xb_ld(&bar[XB_XGEN(b.x)]) == gen, bar);
            __builtin_amdgcn_fence(__ATOMIC_ACQUIRE, "agent");
            asm volatile("s_waitcnt vmcnt(0)" ::: "memory");
        }
    }
    __syncthreads();
}
#ifndef ONLY
#define ONLY -1
#endif
#ifndef REPMASK
#define REPMASK 0
#endif
#define EN(x) (ONLY < 0 || ONLY == (x))
__global__ void __launch_bounds__(512, 2) hymba_fwd(Args args) {
    extern __shared__ __attribute__((aligned(16))) unsigned char lds_raw[];
    LAS unsigned char* lds = (LAS unsigned char*)lds_raw;
    cg::grid_group grid = cg::this_grid();
    Ctx c;
    c.x_prompt = args.in[0]; c.x_sample = args.in[1]; c.state_delta = args.in[2]; c.state_conv = args.in[3]; c.norm_mix_g = args.in[4]; c.w_in = args.in[5]; c.conv_w = args.in[6];
    c.A_log = args.in[7]; c.dt_bias = args.in[8]; c.o_norm_g = args.in[9]; c.v_norm_g = args.in[10]; c.w_s = args.in[11]; c.b_s = args.in[12]; c.w_o = args.in[13]; c.norm_ffn_g = args.in[14];
    c.w_up = args.in[15]; c.w_down = args.in[16]; c.norm_f_g = args.in[17]; c.out = args.out; c.ws = args.ws;
    c.lane = threadIdx.x & 63; c.wave = __builtin_amdgcn_readfirstlane(threadIdx.x >> 6); c.gw = blockIdx.x * 8 + c.wave; c.ngw = gridDim.x * 8;
    const int G = gridDim.x;
    volatile LAS unsigned* bst = (volatile LAS unsigned*)(lds + LDS_BYTES - 16);
    if (threadIdx.x < 2) bst[threadIdx.x] = 0u;
    __syncthreads();
    XcdBarrier xbar = xcd_barrier_post((unsigned*)args.ws, bst);
    for (int step = 2 * args.ph_lo; step < 2 * args.ph_hi; ++step) {
        const int ph = step >> 1;
        const int ptype = ph == 0 ? 0 : (ph == 29 ? 8 : 1 + (ph - 1) % 7);
        if ((step & 1) && !((REPMASK >> ptype) & 1)) continue;
        { int tl = threadIdx.x; asm volatile("" : "+v"(tl)); c.lane = tl & 63; }
        if (step & 1) __syncthreads();
        if (ph == 0) { if (EN(0)) phase_prologue(c, lds); }
        else if (ph == 29) { if (EN(8)) phase_final(c); }
        else {
            const int l = (ph - 1) / 7, s = (ph - 1) % 7;
            float* ssq = WSP(float, WS_SSQ);
            if (s == 0) { if (EN(1)) { sgemm1(c, l);
                pg8::Gemm g{WSP(bf16_t, WS_XB16), WSP(bf16_t, WS_WIN) + (size_t)l * NP * DM, MP, NP, DM}; pg8::StaticOrder S; S.init(MP, NP, G, blockIdx.x);
                pg8::EpiScaleBf16 E{WSP(bf16_t, WS_P), NP, ssq + (size_t)(2 * l) * MP * 16, 0}; pg8::gemm_phase(lds, g, S, E); } }
            else if (s == 1) { if (EN(2)) phase_b0(c, l); }
            else if (s == 2) { if (EN(3)) phase_b1(c, l, lds); }
            else if (s == 3) { if (EN(4)) phase_scan(c, l, lds); }
            else if (s == 4) { if (EN(5)) { sgemm2(c, l);
                pg8::Gemm g{WSP(bf16_t, WS_AMIX), WSP(bf16_t, WS_WO) + (size_t)l * DM * DM, MP, DM, DM}; pg8::StaticOrder S; S.init(MP, DM, G, blockIdx.x);
                pg8::EpiResid E{l == 0 ? c.x_prompt : WSP(float, WS_XBUF), WSP(float, WS_XBUF), WSP(bf16_t, WS_XB16), ssq + (size_t)(2 * l + 1) * MP * 16}; pg8::gemm_phase(lds, g, S, E); } }
            else if (s == 5) { if (EN(6)) { sgemm3(c, l);
                pg8::Gemm g{WSP(bf16_t, WS_XB16), WSP(bf16_t, WS_WUP) + (size_t)l * FF * DM, MP, FF, DM}; pg8::StaticOrder S; S.init(MP, FF, G, blockIdx.x);
                pg8::EpiScaleBf16 E{WSP(bf16_t, WS_UNION), FF, ssq + (size_t)(2 * l + 1) * MP * 16, 1}; pg8::gemm_phase(lds, g, S, E); } }
            else { if (EN(7)) { sgemm4(c, l);
                pg8::Gemm g{WSP(bf16_t, WS_UNION), WSP(bf16_t, WS_WDN) + (size_t)l * DM * FF, MP, DM, FF}; pg8::StaticOrder S; S.init(MP, DM, G, blockIdx.x);
                pg8::EpiResid E{WSP(float, WS_XBUF), WSP(float, WS_XBUF), WSP(bf16_t, WS_XB16), ssq + (size_t)(2 * l + 2) * MP * 16}; pg8::gemm_phase(lds, g, S, E); } }
        }
        if (!(step & 1) && ((REPMASK >> ptype) & 1)) continue;
        if ((REPMASK >> 9) & 1) { if (ph + 1 < args.ph_hi) xcd_barrier(xbar); }
        if (ph + 1 < args.ph_hi) {
            if (ph == 0) {
                __builtin_amdgcn_fence(__ATOMIC_RELEASE, "agent"); asm volatile("s_waitcnt vmcnt(0) lgkmcnt(0)" ::: "memory");
                grid.sync();
                __builtin_amdgcn_fence(__ATOMIC_ACQUIRE, "agent");
            } else xcd_barrier(xbar);
        }
    }
}

extern "C" void kernel_launch(void* const* d_in, const int* in_sizes, int n_in, void* d_out, int out_size, void* d_ws, size_t ws_size, hipStream_t stream) {
    static int grid = 0;
    if (grid == 0) {
        int dev = 0, cus = 0, per_cu = 0;
        (void)hipGetDevice(&dev); (void)hipDeviceGetAttribute(&cus, hipDeviceAttributeMultiprocessorCount, dev);
        if (hipFuncSetAttribute((const void*)hymba_fwd, hipFuncAttributeMaxDynamicSharedMemorySize, LDS_BYTES) != hipSuccess) fprintf(stderr, "kernel_launch: hipFuncSetAttribute failed\n");
        if (hipOccupancyMaxActiveBlocksPerMultiprocessor(&per_cu, (const void*)hymba_fwd, 512, LDS_BYTES) != hipSuccess || per_cu < 1) { fprintf(stderr, "kernel_launch: occupancy query says %d\n", per_cu); per_cu = 1; }
        (void)hipGetLastError();
        grid = cus * 1;
        if (ws_size < WS_END) fprintf(stderr, "kernel_launch: workspace too small: %zu < %zu\n", ws_size, (size_t)WS_END);
    }
    (void)hipMemsetAsync(d_ws, 0, 65536, stream);
    Args a{};
    for (int i = 0; i < 18; ++i) a.in[i] = (const float*)d_in[i];
    a.out = (float*)d_out; a.ws = (unsigned char*)d_ws; a.ph_lo = 0; a.ph_hi = 30;
    void* kargs[] = {&a};
    hipError_t e = hipLaunchCooperativeKernel((const void*)hymba_fwd, dim3(grid), dim3(512), kargs, LDS_BYTES, stream);
    if (e != hipSuccess) fprintf(stderr, "kernel_launch: cooperative launch failed: %s (grid %d)\n", hipGetErrorString(e), grid);
}
```

```cpp
#include <hip/hip_runtime.h>
#include <hip/hip_cooperative_groups.h>
#include <cstdio>
namespace cg = cooperative_groups;

#define LAS __attribute__((address_space(3)))
#define DI __device__ __forceinline__
typedef unsigned short bf16_t;
typedef short bf16x8 __attribute__((ext_vector_type(8)));
typedef float f32x4 __attribute__((ext_vector_type(4)));
typedef float f32x2 __attribute__((ext_vector_type(2)));
typedef float f32x16 __attribute__((ext_vector_type(16)));
typedef unsigned u32x4 __attribute__((ext_vector_type(4)));
typedef unsigned u32x2 __attribute__((ext_vector_type(2)));
typedef __bf16 bf2_t __attribute__((ext_vector_type(2)));

#ifndef SUBSEL
#define SUBSEL -1
#endif
#define SUB(x) (SUBSEL < 0 || SUBSEL == (x))
#ifndef SUBSEL2
#define SUBSEL2 -1
#endif
#define SUB2(x) (SUBSEL2 < 0 || SUBSEL2 == (x))
constexpr int DM = 1024, NBATCH = 8, SEQ = 2048, MP = NBATCH * SEQ, DEPTH = 4, SBATCH = 128;
constexpr int NH = 4, QKV = 1536, NP = 3072, PROJ = 3080, FF = 4096, NPS = 3088;
constexpr float EPS = 1e-6f;
constexpr int IMG_BYTES = 55296;
constexpr int LDS_BYTES = 147456;
constexpr size_t O_YP = 0, O_YS = 16777216, O_DP = 16908288, O_CP = 19005440, O_DS = 19152896, O_CS = 52707328, O_VS = 55066624;
constexpr size_t WS_WIN = 65536;
constexpr size_t WS_WAB = WS_WIN + (size_t)DEPTH * NP * DM * 2;
constexpr size_t WS_WO = WS_WAB + (size_t)DEPTH * 16 * DM * 2;
constexpr size_t WS_WUP = WS_WO + (size_t)DEPTH * DM * DM * 2;
constexpr size_t WS_WDN = WS_WUP + (size_t)DEPTH * FF * DM * 2;
constexpr size_t WS_WM = WS_WDN + (size_t)DEPTH * FF * DM * 2;
constexpr size_t WS_XBUF = WS_WM + (size_t)DEPTH * 4 * 128 * 128 * 2;
constexpr size_t WS_XB16 = WS_XBUF + (size_t)MP * DM * 4;
constexpr size_t WS_SSQ = WS_XB16 + (size_t)MP * DM * 2;
constexpr size_t WS_UNION = WS_SSQ + (size_t)9 * MP * 16 * 4;
constexpr size_t WS_P = WS_UNION;
constexpr size_t WS_QN = WS_P + (size_t)MP * NP * 2;
constexpr size_t WS_KN = WS_QN + (size_t)MP * 512 * 2;
constexpr size_t WS_KNT = WS_UNION + (size_t)MP * FF * 2;
constexpr size_t WS_VT = WS_KNT + (size_t)MP * 512 * 2;
constexpr size_t WS_VBT = WS_VT + (size_t)MP * 512 * 2;
constexpr size_t WS_G = WS_VBT + (size_t)MP * 512 * 2;
constexpr size_t WS_BETA = WS_G + (size_t)MP * 4 * 4;
constexpr size_t WS_EG = WS_BETA + (size_t)MP * 4 * 4;
constexpr size_t WS_IMG = WS_EG + 4096;
constexpr size_t WS_UIMG = WS_IMG + (size_t)1024 * IMG_BYTES;
constexpr size_t WS_AMIX = WS_UIMG + (size_t)1024 * 32768;
constexpr size_t WS_XS = WS_AMIX + (size_t)MP * DM * 2;
constexpr size_t WS_PS = WS_XS + (size_t)SBATCH * DM * 4;
constexpr size_t WS_QS = WS_PS + (size_t)SBATCH * NPS * 4;
constexpr size_t WS_KS = WS_QS + (size_t)SBATCH * 512 * 4;
constexpr size_t WS_VS = WS_KS + (size_t)SBATCH * 512 * 4;
constexpr size_t WS_GS = WS_VS + (size_t)SBATCH * 512 * 4;
constexpr size_t WS_BS = WS_GS + (size_t)SBATCH * 4 * 4;
constexpr size_t WS_AMIXS = WS_BS + (size_t)SBATCH * 4 * 4;
constexpr size_t WS_HS = WS_AMIXS + (size_t)SBATCH * DM * 4;
constexpr size_t WS_XP = WS_HS + (size_t)SBATCH * FF * 4;
constexpr size_t WS_VSS = WS_XP + (size_t)4 * SBATCH * DM * 4;
constexpr size_t WS_END = WS_VSS + (size_t)MP * 8 * 4;
static_assert(WS_QN + 2 * (size_t)MP * 512 * 2 == WS_KNT, "union");
static_assert(WS_END <= (size_t)536870912, "workspace");

DI unsigned pk2(float lo, float hi) { f32x2 v = {lo, hi}; return __builtin_bit_cast(unsigned, __builtin_convertvector(v, bf2_t)); }
DI float bflo(unsigned w) { return __uint_as_float(w << 16); }
DI float bfhi(unsigned w) { return __uint_as_float(w & 0xffff0000u); }
DI float bf2f(bf16_t b) { return __uint_as_float(((unsigned)b) << 16); }
DI bf16_t f2bf(float f) { return (bf16_t)(pk2(f, 0.f) & 0xffffu); }
DI float wave_sum(float v) {
#pragma unroll
    for (int o = 1; o < 64; o <<= 1) v += __shfl_xor(v, o);
    return v;
}
DI float silu_f(float x) { return x * __builtin_amdgcn_rcpf(1.f + __expf(-x)); }
DI float sigmoid_f(float x) { return __builtin_amdgcn_rcpf(1.f + __expf(-x)); }
DI float softplus_f(float x) { return fmaxf(x, 0.f) + log1pf(__expf(-fabsf(x))); }
DI u32x4 pack8(const f32x16& x, int s) {
    u32x4 p; p.x = pk2(x[8 * s], x[8 * s + 1]); p.y = pk2(x[8 * s + 2], x[8 * s + 3]); p.z = pk2(x[8 * s + 4], x[8 * s + 5]); p.w = pk2(x[8 * s + 6], x[8 * s + 7]); return p;
}
DI float ssq_sum(const float* p) {
    const f32x4 a = *(const f32x4*)p, b = *(const f32x4*)(p + 4), c2 = *(const f32x4*)(p + 8), d2 = *(const f32x4*)(p + 12);
    return ((a.x + a.y) + (a.z + a.w)) + ((b.x + b.y) + (b.z + b.w)) + ((c2.x + c2.y) + (c2.z + c2.w)) + ((d2.x + d2.y) + (d2.z + d2.w));
}
DI int crow(int reg, int h) { return (reg & 3) + 8 * (reg >> 2) + 4 * h; }
#define MFMA32(a, b, c) __builtin_amdgcn_mfma_f32_32x32x16_bf16((a), (b), (c), 0, 0, 0)
#define MFMA16(a, b, c) __builtin_amdgcn_mfma_f32_16x16x32_bf16((a), (b), (c), 0, 0, 0)
DI bf16x8 as_bf(u32x4 v) { return __builtin_bit_cast(bf16x8, v); }
DI f32x16 zero16() { f32x16 z;
#pragma unroll
    for (int i = 0; i < 16; ++i) z[i] = 0.f; return z; }

namespace pg8 {
constexpr int BM = 256, BK = 64, HALF = 128, HTB = HALF * BK * 2, STAGE_BYTES = 8 * HTB, NXCD = 8, WGM = 8;
DI int lds_byte(int r, int c) { const int st = (r >> 4) * 2 + (c >> 5), rr = r & 15, cc = c & 31, ob = rr * 64 + cc * 2; return st * 1024 + (ob ^ (((ob >> 9) & 1) << 5)); }
DI void stage_rc(int b, int& R, int& C) { const int st = b / 1024, sb = b % 1024, swz = sb ^ (((sb >> 9) & 1) << 5); R = (st >> 1) * 16 + swz / 64; C = (st & 1) * 32 + (swz % 64) / 2; }
DI int perm32(int rho) { const int n = rho >> 4, i = rho & 15; return 8 * (i >> 2) + 4 * n + (i & 3); }
struct Unit { int pm, pn; };
struct Gemm { const bf16_t* A; const bf16_t* Bt; int M, N, K; };
struct StaticOrder {
    int nM, nN, nwg, G, c;
    DI void init(int M, int N, int G_, int c_) { nM = M / BM; nN = N / BM; nwg = nM * nN; G = G_; c = c_; }
    DI bool next(int i, Unit& u) const {
        const long L = (long)i * G + c; if (L >= nwg) return false;
        int wgid = (int)L; { const int q = nwg / NXCD, r = nwg % NXCD, xcd = wgid % NXCD, off = wgid / NXCD; wgid = (xcd < r ? xcd * (q + 1) : r * (q + 1) + (xcd - r) * q) + off; }
        const int nig = WGM * nN, gid = wgid / nig, fm = gid * WGM, gsz = (nM - fm) < WGM ? (nM - fm) : WGM;
        u.pm = fm + ((wgid % nig) % gsz); u.pn = (wgid % nig) / gsz; return true;
    }
};
template <class Epi>
DI void gemm_phase(LAS unsigned char* lds, const Gemm g, const StaticOrder& S, const Epi& E) {
    int tid = threadIdx.x; asm volatile("" : "+v"(tid));
    const int wid = __builtin_amdgcn_readfirstlane(tid >> 6), lane = tid & 63, wr = wid >> 2, wc = wid & 3, fr = lane & 15, fq = lane >> 4;
    const int K = g.K, nt = K / BK;
    unsigned voffA[2], voffB[2];
#pragma unroll
    for (int i = 0; i < 2; ++i) { int R, C; stage_rc(tid * 16 + i * 8192, R, C); const int Rb = (R & ~31) + perm32(R & 31);
        voffA[i] = (unsigned)(R * K + C) * 2u; voffB[i] = (unsigned)(Rb * K + C) * 2u; }
    const size_t kstep = (size_t)(BK * 2);
    const size_t hstep = (size_t)HALF * K * 2;
    const size_t tstep = 2 * hstep;
    const unsigned ldsw = (unsigned)wid * 1024u;
    const int aoff = lds_byte(wr * 64 + fr, fq * 8), boff = lds_byte(wc * 32 + fr, fq * 8);
#define PG8_SA(b, h) (((b) * 2 + (h)) * HTB)
#define PG8_SB(b, h) ((4 + (b) * 2 + (h)) * HTB)
#define PG8_STAGE(bufoff, gbase, voff) do { _Pragma("unroll") for (int _i = 0; _i < 2; ++_i) \
        __builtin_amdgcn_global_load_lds((const unsigned*)((const char*)(gbase) + (voff)[_i]), (LAS unsigned*)(lds + (bufoff) + ldsw + _i * 8192), 16, 0, 0); } while (0)
#define PG8_LDA(dst, b, h) do { _Pragma("unroll") for (int m = 0; m < 4; ++m) _Pragma("unroll") for (int k = 0; k < 2; ++k) dst[m][k] = *(const LAS bf16x8*)(lds + PG8_SA(b, h) + aoff + m * 2048 + k * 1024); } while (0)
#define PG8_LDB(dst, b, h) do { _Pragma("unroll") for (int n = 0; n < 2; ++n) _Pragma("unroll") for (int k = 0; k < 2; ++k) dst[n][k] = *(const LAS bf16x8*)(lds + PG8_SB(b, h) + boff + n * 2048 + k * 1024); } while (0)
#define PG8_MMA(ai, bj, At, Bt) do { __builtin_amdgcn_s_setprio(1); _Pragma("unroll") for (int m = 0; m < 4; ++m) _Pragma("unroll") for (int n = 0; n < 2; ++n) _Pragma("unroll") for (int k = 0; k < 2; ++k) \
        acc[ai][bj][m][n] = __builtin_amdgcn_mfma_f32_16x16x32_bf16(Bt[n][k], At[m][k], acc[ai][bj][m][n], 0, 0, 0); __builtin_amdgcn_s_setprio(0); } while (0)
#define PG8_WAIT_V(n) asm volatile("s_waitcnt vmcnt(" #n ")" ::: "memory")
#define PG8_WAIT_L(n) asm volatile("s_waitcnt lgkmcnt(" #n ")" ::: "memory")
#define PG8_BAR __builtin_amdgcn_s_barrier()
#define PG8_SCHED __builtin_amdgcn_sched_barrier(0)
    Unit cur, nxt; int ui = 0;
    if (!S.next(0, cur)) return;
    f32x4 acc[2][2][4][2];
#pragma unroll
    for (int a = 0; a < 2; ++a)
#pragma unroll
        for (int b = 0; b < 2; ++b)
#pragma unroll
            for (int m = 0; m < 4; ++m)
#pragma unroll
                for (int n = 0; n < 2; ++n) acc[a][b][m][n] = (f32x4){0.f, 0.f, 0.f, 0.f};
    bf16x8 At[4][2], B0[2][2], B1[2][2];
    const char* cA = (const char*)g.A + (size_t)cur.pm * tstep; const char* cB = (const char*)g.Bt + (size_t)cur.pn * tstep;
    PG8_STAGE(PG8_SB(0, 0), cB, voffB); PG8_STAGE(PG8_SA(0, 0), cA, voffA); PG8_STAGE(PG8_SB(0, 1), cB + hstep, voffB); PG8_STAGE(PG8_SA(0, 1), cA + hstep, voffA);
    if (wr == 1) PG8_BAR;
    PG8_WAIT_V(4); PG8_BAR;
    PG8_STAGE(PG8_SB(1, 0), cB + kstep, voffB); PG8_STAGE(PG8_SA(1, 0), cA + kstep, voffA); PG8_STAGE(PG8_SB(1, 1), cB + hstep + kstep, voffB);
    PG8_WAIT_V(6); PG8_BAR;
    for (;;) {
        const bool has_next = S.next(ui + 1, nxt);
        const char* nA = has_next ? (const char*)g.A + (size_t)nxt.pm * tstep : cA; const char* nB = has_next ? (const char*)g.Bt + (size_t)nxt.pn * tstep : cB;
        for (int t = 0; t < nt; t += 2) {
            const bool last = (t == nt - 2);
            const char* a1 = cA + (size_t)(t + 1) * kstep;
            const char* a2 = last ? nA : cA + (size_t)(t + 2) * kstep; const char* b2 = last ? nB : cB + (size_t)(t + 2) * kstep;
            const char* a3 = a2 + kstep; const char* b3 = b2 + kstep;
            PG8_LDB(B0, 0, 0); PG8_SCHED; PG8_LDA(At, 0, 0); PG8_STAGE(PG8_SA(1, 1), a1 + hstep, voffA);
            PG8_WAIT_L(8); PG8_BAR; PG8_WAIT_L(0); PG8_MMA(0, 0, At, B0); PG8_BAR; PG8_SCHED;
            PG8_LDB(B1, 0, 1); PG8_STAGE(PG8_SB(0, 0), b2, voffB);
            PG8_BAR; PG8_WAIT_L(0); PG8_MMA(0, 1, At, B1); PG8_BAR;
            PG8_LDA(At, 0, 1); PG8_STAGE(PG8_SA(0, 0), a2, voffA);
            PG8_BAR; PG8_WAIT_L(0); PG8_MMA(1, 0, At, B0); PG8_BAR; PG8_SCHED;
            PG8_STAGE(PG8_SB(0, 1), b2 + hstep, voffB);
            PG8_WAIT_V(6); PG8_BAR; PG8_MMA(1, 1, At, B1); PG8_BAR;
            PG8_LDB(B0, 1, 0); PG8_SCHED; PG8_LDA(At, 1, 0); PG8_STAGE(PG8_SA(0, 1), a2 + hstep, voffA);
            PG8_WAIT_L(8); PG8_BAR; PG8_WAIT_L(0); PG8_MMA(0, 0, At, B0); PG8_BAR; PG8_SCHED;
            PG8_LDB(B1, 1, 1); PG8_STAGE(PG8_SB(1, 0), b3, voffB);
            PG8_BAR; PG8_WAIT_L(0); PG8_MMA(0, 1, At, B1); PG8_BAR;
            PG8_LDA(At, 1, 1); PG8_STAGE(PG8_SA(1, 0), a3, voffA);
            PG8_BAR; PG8_WAIT_L(0); PG8_MMA(1, 0, At, B0); PG8_BAR; PG8_SCHED;
            PG8_STAGE(PG8_SB(1, 1), b3 + hstep, voffB);
            PG8_WAIT_V(6); PG8_BAR; PG8_MMA(1, 1, At, B1); PG8_BAR;
        }
        E(acc, cur, wr, wc, fr, fq);
        if (!has_next) break;
#pragma unroll
        for (int a = 0; a < 2; ++a)
#pragma unroll
            for (int b = 0; b < 2; ++b)
#pragma unroll
                for (int m = 0; m < 4; ++m)
#pragma unroll
                    for (int n = 0; n < 2; ++n) acc[a][b][m][n] = (f32x4){0.f, 0.f, 0.f, 0.f};
        cur = nxt; cA = nA; cB = nB; ++ui;
    }
    PG8_WAIT_V(0);
    if (wr == 0) PG8_BAR;
    PG8_BAR;
#undef PG8_SA
#undef PG8_SB
#undef PG8_STAGE
#undef PG8_LDA
#undef PG8_LDB
#undef PG8_MMA
#undef PG8_WAIT_V
#undef PG8_WAIT_L
#undef PG8_BAR
#undef PG8_SCHED
}
struct EpiScaleBf16 {
    bf16_t* O; int ldc; const float* ssq; int act; float* vss;
    DI void operator()(const f32x4 (&acc)[2][2][4][2], const Unit& u, int wr, int wc, int fr, int fq) const {
        const int row0 = u.pm * BM + wr * 64 + fr, col0 = u.pn * BM + wc * 32 + 8 * fq;
#pragma unroll
        for (int ai = 0; ai < 2; ++ai)
#pragma unroll
            for (int m = 0; m < 4; ++m) { const int row = row0 + ai * HALF + m * 16; const float rs = rsqrtf(ssq_sum(ssq + (size_t)row * 16) * (1.0f / DM) + EPS);
                bf16_t* rowp = O + (size_t)row * ldc + col0; float vs = 0.f;
#pragma unroll
                for (int bj = 0; bj < 2; ++bj) { f32x4 v0 = acc[ai][bj][m][0] * rs, v1 = acc[ai][bj][m][1] * rs;
                    if (act) {
#pragma unroll
                        for (int j = 0; j < 4; ++j) { const float a = fmaxf(v0[j], 0.f), b = fmaxf(v1[j], 0.f); v0[j] = a * a; v1[j] = b * b; } }
                    u32x4 w; w.x = pk2(v0[0], v0[1]); w.y = pk2(v0[2], v0[3]); w.z = pk2(v1[0], v1[1]); w.w = pk2(v1[2], v1[3]);
                    *(u32x4*)(rowp + bj * HALF) = w;
                    vs += (v0[0] * v0[0] + v0[1] * v0[1]) + (v0[2] * v0[2] + v0[3] * v0[3]) + (v1[0] * v1[0] + v1[1] * v1[1]) + (v1[2] * v1[2] + v1[3] * v1[3]); }
                if (vss != nullptr && u.pn >= 10) { vs += __shfl_xor(vs, 16); vs += __shfl_xor(vs, 32); if (fq == 0) vss[(size_t)row * 8 + (u.pn - 10) * 4 + wc] = vs; } }
    }
};
struct EpiResid {
    const float* base; float* out; bf16_t* xb; float* ssq;
    DI void operator()(const f32x4 (&acc)[2][2][4][2], const Unit& u, int wr, int wc, int fr, int fq) const {
        const int row0 = u.pm * BM + wr * 64 + fr, col0 = u.pn * BM + wc * 32 + 8 * fq;
#pragma unroll
        for (int ai = 0; ai < 2; ++ai)
#pragma unroll
            for (int m = 0; m < 4; ++m) { const int row = row0 + ai * HALF + m * 16; const size_t off = (size_t)row * DM + col0; float ss = 0.f;
#pragma unroll
                for (int bj = 0; bj < 2; ++bj) {
                    const f32x4 b0 = *(const f32x4*)(base + off + bj * HALF), b1 = *(const f32x4*)(base + off + bj * HALF + 4);
                    const f32x4 o0 = b0 + acc[ai][bj][m][0], o1 = b1 + acc[ai][bj][m][1];
                    *(f32x4*)(out + off + bj * HALF) = o0; *(f32x4*)(out + off + bj * HALF + 4) = o1;
                    u32x4 w; w.x = pk2(o0[0], o0[1]); w.y = pk2(o0[2], o0[3]); w.z = pk2(o1[0], o1[1]); w.w = pk2(o1[2], o1[3]);
                    *(u32x4*)(xb + off + bj * HALF) = w;
                    ss += (o0[0] * o0[0] + o0[1] * o0[1]) + (o0[2] * o0[2] + o0[3] * o0[3]) + (o1[0] * o1[0] + o1[1] * o1[1]) + (o1[2] * o1[2] + o1[3] * o1[3]); }
                ss += __shfl_xor(ss, 16); ss += __shfl_xor(ss, 32);
                if (fq == 0) ssq[(size_t)row * 16 + u.pn * 4 + wc] = ss;
                asm volatile("" ::: "memory"); }
    }
};
}

struct Args { const float* in[18]; float* out; unsigned char* ws; int ph_lo, ph_hi; };
struct Ctx {
    const float *x_prompt, *x_sample, *state_delta, *state_conv, *norm_mix_g, *w_in, *conv_w, *A_log, *dt_bias, *o_norm_g, *v_norm_g, *w_s, *b_s, *w_o, *norm_ffn_g, *w_up, *w_down, *norm_f_g;
    float* out; unsigned char* ws;
    int lane, wave, gw, ngw;
};
#define WSP(T, off) ((T*)(c.ws + (off)))

DI void transpose_item(const float* W, int K, int N, const float* kscale, bf16_t* WT, bf16_t* WAB, int mode, int item, int nblk, LAS float* scr, int lane) {
    const int kb = item / nblk, nb = item % nblk, k0 = 64 * kb, n0 = 32 * nb;
    const int nl = lane & 31, nsrc = n0 + nl;
#pragma unroll 8
    for (int i = 0; i < 32; ++i) { const int kk = 2 * i + (lane >> 5);
        float v = 0.f; if (nsrc < N) { v = W[(size_t)(k0 + kk) * N + nsrc]; if (kscale) v *= kscale[k0 + kk]; }
        scr[kk * 33 + nl] = v; }
    asm volatile("s_waitcnt lgkmcnt(0)" ::: "memory");
    const int cch = lane & 7;
#pragma unroll
    for (int j = 0; j < 4; ++j) { const int n = (lane >> 3) + 8 * j, ns = n0 + n; const LAS float* s = scr + (8 * cch) * 33 + n;
        u32x4 o; o.x = pk2(s[0 * 33], s[1 * 33]); o.y = pk2(s[2 * 33], s[3 * 33]); o.z = pk2(s[4 * 33], s[5 * 33]); o.w = pk2(s[6 * 33], s[7 * 33]);
        if (ns < N) {
            bf16_t* rowp;
            if (mode == 0) rowp = WT + (size_t)ns * K;
            else rowp = ns < 2048 ? WT + (size_t)ns * K : (ns < 2056 ? WAB + (size_t)(ns - 2048) * K : WT + (size_t)(ns - 8) * K);
            *(u32x4*)(rowp + k0 + 8 * cch) = o; } }
    asm volatile("s_waitcnt lgkmcnt(0)" ::: "memory");
}
DI void phase_prologue(const Ctx& c, LAS unsigned char* lds) {
    LAS float* scr = (LAS float*)(lds + c.wave * 16384);
    constexpr int I_IN = 16 * 97, I_O = 16 * 32, I_UP = 16 * 128, I_DN = 64 * 32, I_L = I_IN + I_O + I_UP + I_DN;
    for (int it = c.gw; it < DEPTH * I_L; it += c.ngw) {
        const int l = it / I_L; int r = it % I_L;
        if (r < I_IN) { transpose_item(c.w_in + (size_t)l * DM * PROJ, DM, PROJ, c.norm_mix_g + l * DM, WSP(bf16_t, WS_WIN) + (size_t)l * NP * DM, WSP(bf16_t, WS_WAB) + (size_t)l * 16 * DM, 1, r, 97, scr, c.lane); continue; } r -= I_IN;
        if (r < I_O) { transpose_item(c.w_o + (size_t)l * DM * DM, DM, DM, nullptr, WSP(bf16_t, WS_WO) + (size_t)l * DM * DM, nullptr, 0, r, 32, scr, c.lane); continue; } r -= I_O;
        if (r < I_UP) { transpose_item(c.w_up + (size_t)l * DM * FF, DM, FF, c.norm_ffn_g + l * DM, WSP(bf16_t, WS_WUP) + (size_t)l * FF * DM, nullptr, 0, r, 128, scr, c.lane); continue; } r -= I_UP;
        transpose_item(c.w_down + (size_t)l * FF * DM, FF, DM, nullptr, WSP(bf16_t, WS_WDN) + (size_t)l * DM * FF, nullptr, 0, r, 32, scr, c.lane);
    }
    float* ssq = WSP(float, WS_SSQ);
    for (int m = c.gw; m < MP; m += c.ngw) {
        const f32x4* xr = (const f32x4*)(c.x_prompt + (size_t)m * DM) + c.lane; u32x2* o8 = (u32x2*)(WSP(bf16_t, WS_XB16) + (size_t)m * DM) + c.lane; float s = 0.f;
#pragma unroll
        for (int j = 0; j < 4; ++j) { const f32x4 v = xr[64 * j]; s += (v.x * v.x + v.y * v.y) + (v.z * v.z + v.w * v.w); u32x2 w; w.x = pk2(v.x, v.y); w.y = pk2(v.z, v.w); o8[64 * j] = w; }
        s = wave_sum(s); if (c.lane < 16) ssq[(size_t)m * 16 + c.lane] = c.lane == 0 ? s : 0.f;
    }
    const int gt = c.gw * 64 + c.lane, ngt = c.ngw * 64;
    float* xs = WSP(float, WS_XS);
    for (int i = gt; i < SBATCH * DM; i += ngt) xs[i] = c.x_sample[i];
    bf16_t* wab = WSP(bf16_t, WS_WAB);
    for (int i = gt; i < DEPTH * 8 * DM; i += ngt) { const int l = i / (8 * DM), r = i % (8 * DM); wab[(size_t)l * 16 * DM + 8 * DM + r] = 0; }
    unsigned* wm = WSP(unsigned, WS_WM);
    for (int i = gt; i < DEPTH * 4 * 128 * 64; i += ngt) { const int e = 2 * i, ii = (e >> 7) & 127, jj = e & 127;
        const float a = ii >= jj ? c.w_s[e] : 0.f, b = ii >= jj + 1 ? c.w_s[e + 1] : 0.f; wm[i] = pk2(a, b); }
}

template <bool NORM, bool PARTS = false>
DI f32x4 sgemm_tile(const float* A, int lda, const bf16_t* Bt, int ldb, int r0, int n0, int k0, int klen, int lane, float& rstd, const float* xp = nullptr) {
    const int fr = lane & 15, fq = lane >> 4;
    const float* ap = A + (size_t)(r0 + fr) * lda + k0 + 8 * fq;
    const bf16_t* bp = Bt + (size_t)(n0 + fr) * ldb + k0 + 8 * fq;
    f32x4 acc = {0.f, 0.f, 0.f, 0.f}; float ss = 0.f;
#pragma unroll 8
    for (int k = 0; k < klen; k += 32) {
        f32x4 a0 = *(const f32x4*)(ap + k), a1 = *(const f32x4*)(ap + k + 4);
        if (PARTS) { const float* pp = xp + (size_t)(r0 + fr) * lda + k0 + 8 * fq + k;
#pragma unroll
            for (int q = 0; q < 4; ++q) { a0 += *(const f32x4*)(pp + (size_t)q * SBATCH * DM); a1 += *(const f32x4*)(pp + (size_t)q * SBATCH * DM + 4); } }
        const bf16x8 b = *(const bf16x8*)(bp + k);
        if (NORM) ss += (a0.x * a0.x + a0.y * a0.y) + (a0.z * a0.z + a0.w * a0.w) + (a1.x * a1.x + a1.y * a1.y) + (a1.z * a1.z + a1.w * a1.w);
        u32x4 a; a.x = pk2(a0.x, a0.y); a.y = pk2(a0.z, a0.w); a.z = pk2(a1.x, a1.y); a.w = pk2(a1.z, a1.w);
        acc = MFMA16(as_bf(a), b, acc);
    }
    if (NORM) { ss += __shfl_xor(ss, 16); ss += __shfl_xor(ss, 32); rstd = rsqrtf(ss * (1.0f / DM) + EPS); }
    return acc;
}
DI void sgemm1(const Ctx& c, int l) {
    const float* xs = WSP(float, WS_XS); float* ps = WSP(float, WS_PS);
    const int fr = c.lane & 15, fq = c.lane >> 4;
    for (int t = c.gw; t < 8 * 193; t += c.ngw) { const int rt = t & 7, ntile = t >> 3; float rstd;
        const bf16_t* Bt = ntile < 192 ? WSP(bf16_t, WS_WIN) + (size_t)l * NP * DM + (size_t)ntile * 16 * DM : WSP(bf16_t, WS_WAB) + (size_t)l * 16 * DM;
        const f32x4 acc = l > 0 ? sgemm_tile<true, true>(xs, DM, Bt, DM, rt * 16, 0, 0, DM, c.lane, rstd, WSP(float, WS_XP)) : sgemm_tile<true>(xs, DM, Bt, DM, rt * 16, 0, 0, DM, c.lane, rstd);
#pragma unroll
        for (int j = 0; j < 4; ++j) { const float rs = __shfl(rstd, 4 * fq + j); ps[(size_t)(rt * 16 + 4 * fq + j) * NPS + ntile * 16 + fr] = acc[j] * rs; } }
}
DI void sgemm2(const Ctx& c, int l) {
    const float* am = WSP(float, WS_AMIXS); float* xs = WSP(float, WS_XS);
    const int fr = c.lane & 15, fq = c.lane >> 4;
    for (int t = c.gw; t < 8 * 64; t += c.ngw) { const int rt = t & 7, ntile = t >> 3; float rstd;
        const f32x4 acc = sgemm_tile<false>(am, DM, WSP(bf16_t, WS_WO) + (size_t)l * DM * DM, DM, rt * 16, ntile * 16, 0, DM, c.lane, rstd);
#pragma unroll
        for (int j = 0; j < 4; ++j) { const size_t o = (size_t)(rt * 16 + 4 * fq + j) * DM + ntile * 16 + fr; float v = xs[o] + acc[j];
            if (l > 0) { const float* xp = WSP(float, WS_XP) + o; v += (xp[0] + xp[(size_t)SBATCH * DM]) + (xp[(size_t)2 * SBATCH * DM] + xp[(size_t)3 * SBATCH * DM]); }
            xs[o] = v; } }
}
DI void sgemm3(const Ctx& c, int l) {
    const float* xs = WSP(float, WS_XS); float* hs = WSP(float, WS_HS);
    const int fr = c.lane & 15, fq = c.lane >> 4;
    for (int t = c.gw; t < 8 * 256; t += c.ngw) { const int rt = t & 7, ntile = t >> 3; float rstd;
        const f32x4 acc = sgemm_tile<true>(xs, DM, WSP(bf16_t, WS_WUP) + (size_t)l * FF * DM, DM, rt * 16, ntile * 16, 0, DM, c.lane, rstd);
#pragma unroll
        for (int j = 0; j < 4; ++j) { const float rs = __shfl(rstd, 4 * fq + j); const float v = fmaxf(acc[j] * rs, 0.f); hs[(size_t)(rt * 16 + 4 * fq + j) * FF + ntile * 16 + fr] = v * v; } }
}
DI void sgemm4(const Ctx& c, int l) {
    const float* hs = WSP(float, WS_HS); float* xp = WSP(float, WS_XP);
    const int fr = c.lane & 15, fq = c.lane >> 4;
    for (int t = c.gw; t < 8 * 64 * 4; t += c.ngw) { const int rt = t & 7, ntile = (t >> 3) & 63, kq = t >> 9; float rstd;
        const f32x4 acc = sgemm_tile<false>(hs, FF, WSP(bf16_t, WS_WDN) + (size_t)l * DM * FF, FF, rt * 16, ntile * 16, kq * 1024, 1024, c.lane, rstd);
#pragma unroll
        for (int j = 0; j < 4; ++j) xp[(size_t)kq * SBATCH * DM + (size_t)(rt * 16 + 4 * fq + j) * DM + ntile * 16 + fr] = acc[j]; }
}

DI void b0_task_ab(const Ctx& c, int l, int b, int n) {
    const int fr = c.lane & 15, fq = c.lane >> 4, tok0 = b * SEQ + n * 64;
    const bf16_t* ap = WSP(bf16_t, WS_XB16) + (size_t)(tok0 + fr) * DM + 8 * fq;
    const bf16_t* bp = WSP(bf16_t, WS_WAB) + (size_t)l * 16 * DM + (size_t)fr * DM + 8 * fq;
    f32x4 acc[4];
#pragma unroll
    for (int mt = 0; mt < 4; ++mt) acc[mt] = (f32x4){0.f, 0.f, 0.f, 0.f};
#pragma unroll 4
    for (int k = 0; k < DM; k += 32) {
        const bf16x8 bf = *(const bf16x8*)(bp + k);
#pragma unroll
        for (int mt = 0; mt < 4; ++mt) { const bf16x8 a = *(const bf16x8*)(ap + (size_t)mt * 16 * DM + k); acc[mt] = MFMA16(a, bf, acc[mt]); }
    }
    const float* ssq = WSP(float, WS_SSQ) + (size_t)(2 * l) * MP * 16;
    float* gb = WSP(float, WS_G); float* bb = WSP(float, WS_BETA);
    if (fr < 8) { const int hh = fr & 3; const float al = -__expf(c.A_log[l * 4 + hh]), dtb = c.dt_bias[l * 4 + hh];
#pragma unroll
        for (int mt = 0; mt < 4; ++mt)
#pragma unroll
            for (int j = 0; j < 4; ++j) { const int tok = tok0 + 16 * mt + 4 * fq + j; const float v = acc[mt][j] * rsqrtf(ssq_sum(ssq + (size_t)tok * 16) * (1.0f / DM) + EPS);
                if (fr < 4) gb[tok * 4 + hh] = al * softplus_f(v + dtb); else bb[tok * 4 + hh] = sigmoid_f(v); } }
}
constexpr int B0_STRIDE = 272, B0_WAVE_LDS = 18432;
DI void b0_task_conv(const Ctx& c, int l, int b, int n, int s, int hh, LAS unsigned char* wl) {
    int lane = c.lane; asm volatile("" : "+v"(lane));
    const int tok0 = b * SEQ + n * 64, cb = s * 512 + hh * 128, piece = lane & 15;
    const bf16_t* P = WSP(bf16_t, WS_P) + (size_t)tok0 * NP + cb + piece * 8;
#pragma unroll
    for (int k = 0; k < 17; ++k) { const int row = 4 * k + (lane >> 4);
        if (row < 67) { u32x4 v = (u32x4){0u, 0u, 0u, 0u}; if (n > 0 || row >= 3) v = *(const u32x4*)(P + (long)(row - 3) * NP);
            *(LAS u32x4*)(wl + row * B0_STRIDE + piece * 16) = v; } }
    const float* cw = c.conv_w + (size_t)l * 4 * QKV + cb;
    float wv[4][2];
#pragma unroll
    for (int j = 0; j < 4; ++j) { wv[j][0] = cw[j * QKV + lane]; wv[j][1] = cw[j * QKV + 64 + lane]; }
    float* ocp = c.out + O_CP + ((size_t)(l * NBATCH + b) * 3) * QKV + cb;
    float ss = 0.f;
#pragma unroll
    for (int hf = 0; hf < 2; ++hf)
#pragma unroll 2
    for (int i8 = 0; i8 < 8; ++i8) { const int i = hf * 8 + i8;
        u32x4 rws[4];
#pragma unroll
        for (int j = 0; j < 4; ++j) rws[j] = *(const LAS u32x4*)(wl + (lane + j) * B0_STRIDE + i * 16);
        float y[8];
#pragma unroll
        for (int e = 0; e < 8; ++e) { const int ch = 8 * i + e; float a = 0.f;
#pragma unroll
            for (int j = 0; j < 4; ++j) { const float wsel = wv[j][hf]; const float w = __builtin_bit_cast(float, __builtin_amdgcn_readlane(__builtin_bit_cast(int, wsel), ch & 63));
                const unsigned pw = rws[j][e >> 1]; a += ((e & 1) ? bfhi(pw) : bflo(pw)) * w; }
            y[e] = silu_f(a); ss += y[e] * y[e]; }
        if (n == 31 && lane >= 61) {
#pragma unroll
            for (int e = 0; e < 8; ++e) { const unsigned pw = rws[3][e >> 1]; ocp[(size_t)(lane - 61) * QKV + 8 * i + e] = (e & 1) ? bfhi(pw) : bflo(pw); } }
        u32x4 w; w.x = pk2(y[0], y[1]); w.y = pk2(y[2], y[3]); w.z = pk2(y[4], y[5]); w.w = pk2(y[6], y[7]);
        *(LAS u32x4*)(wl + (lane + 3) * B0_STRIDE + i * 16) = w;
    }
    const float sc = s == 0 ? rsqrtf(ss + EPS) * 0.08838834764831845f : (s == 1 ? rsqrtf(ss + EPS) : 1.0f);
    const size_t unit = (size_t)((b * 4 + hh) * 32 + n);
    bf16_t* ot = (s == 1 ? WSP(bf16_t, WS_KNT) : WSP(bf16_t, WS_VT)) + unit * 128 * 64 + lane;
#pragma unroll 2
    for (int i = 0; i < 16; ++i) { const u32x4 v = *(const LAS u32x4*)(wl + (lane + 3) * B0_STRIDE + i * 16); u32x4 w;
#pragma unroll
        for (int e = 0; e < 4; ++e) w[e] = pk2(bflo(v[e]) * sc, bfhi(v[e]) * sc);
        if (s < 2) *(LAS u32x4*)(wl + (lane + 3) * B0_STRIDE + i * 16) = w;
        if (s >= 1) {
#pragma unroll
            for (int e = 0; e < 8; ++e) ot[(8 * i + e) * 64] = (bf16_t)((e & 1) ? (w[e >> 1] >> 16) : (w[e >> 1] & 0xffffu)); } }
    if (s < 2) { bf16_t* o = (s == 0 ? WSP(bf16_t, WS_QN) : WSP(bf16_t, WS_KN)) + (size_t)tok0 * 512 + hh * 128 + piece * 8;
#pragma unroll
        for (int k = 0; k < 16; ++k) { const int row = 4 * k + (lane >> 4); *(u32x4*)(o + (size_t)row * 512) = *(const LAS u32x4*)(wl + (row + 3) * B0_STRIDE + piece * 16); } }
}
DI void b0_task_vb(const Ctx& c, int l, int b, int n, int hb, LAS unsigned char* wl) {
    int lane = c.lane; asm volatile("" : "+v"(lane));
    const int tok0 = b * SEQ + n * 64, piece = lane & 15;
    const bf16_t* P = WSP(bf16_t, WS_P) + (size_t)tok0 * NP + 2560 + hb * 128 + piece * 8;
#pragma unroll
    for (int k = 0; k < 16; ++k) { const int row = 4 * k + (lane >> 4); *(LAS u32x4*)(wl + row * B0_STRIDE + piece * 16) = *(const u32x4*)(P + (size_t)row * NP); }
    const float* vp = WSP(float, WS_VSS) + (size_t)(tok0 + lane) * 8; const f32x4 p0 = *(const f32x4*)vp, p1 = *(const f32x4*)(vp + 4);
    const float rs = rsqrtf((((p0.x + p0.y) + (p0.z + p0.w)) + ((p1.x + p1.y) + (p1.z + p1.w))) * (1.0f / 512.0f) + EPS);
    const float* vg = c.v_norm_g + l * 512 + hb * 128;
    bf16_t* vbt = WSP(bf16_t, WS_VBT) + ((size_t)((b * 16 + (n >> 1)) * 4 + hb) * 128) * 128 + (n & 1) * 64 + lane;
#pragma unroll 2
    for (int i = 0; i < 16; ++i) { const u32x4 v = *(const LAS u32x4*)(wl + lane * B0_STRIDE + i * 16);
#pragma unroll
        for (int e = 0; e < 8; ++e) { const float pv = (e & 1) ? bfhi(v[e >> 1]) : bflo(v[e >> 1]); vbt[(size_t)(8 * i + e) * 128] = f2bf(pv * rs * vg[8 * i + e]); } }
}
DI void b0_task_sample(const Ctx& c, int l, int bs) {
    const float* ps = WSP(float, WS_PS) + (size_t)bs * NPS;
    if (c.lane < 4) { const int hh = c.lane;
        WSP(float, WS_GS)[bs * 4 + hh] = -__expf(c.A_log[l * 4 + hh]) * softplus_f(ps[3072 + hh] + c.dt_bias[l * 4 + hh]);
        WSP(float, WS_BS)[bs * 4 + hh] = sigmoid_f(ps[3076 + hh]); }
    const float* sc = c.state_conv + (size_t)(l * SBATCH + bs) * 3 * QKV;
    const float* cw = c.conv_w + (size_t)l * 4 * QKV;
    float* ocs = c.out + O_CS + (size_t)(l * SBATCH + bs) * 3 * QKV;
    float* qkvs = WSP(float, WS_QS) + bs * 512;
#pragma unroll 1
    for (int sh = 0; sh < 12; ++sh) {
        float y[2];
#pragma unroll
        for (int t = 0; t < 2; ++t) { const int ch = sh * 128 + t * 64 + c.lane; const float s0 = sc[ch], s1 = sc[QKV + ch], s2 = sc[2 * QKV + ch], cur = ps[ch];
            ocs[ch] = s1; ocs[QKV + ch] = s2; ocs[2 * QKV + ch] = cur;
            y[t] = silu_f(s0 * cw[ch] + s1 * cw[QKV + ch] + s2 * cw[2 * QKV + ch] + cur * cw[3 * QKV + ch]); }
        float scale = 1.0f;
        if (sh < 8) { const float ssum = wave_sum(y[0] * y[0] + y[1] * y[1]); scale = rsqrtf(ssum + EPS) * (sh < 4 ? 0.08838834764831845f : 1.0f); }
        float* o = qkvs + (size_t)(sh >> 2) * SBATCH * 512 + (sh & 3) * 128;
        o[c.lane] = y[0] * scale; o[64 + c.lane] = y[1] * scale;
    }
    float pv[8]; float ss = 0.f;
#pragma unroll
    for (int i = 0; i < 8; ++i) { pv[i] = ps[2560 + c.lane + 64 * i]; ss += pv[i] * pv[i]; }
    ss = wave_sum(ss); const float rs = rsqrtf(ss * (1.0f / 512.0f) + EPS);
    float* am = WSP(float, WS_AMIXS) + (size_t)bs * DM; float* ovs = c.out + O_VS + (size_t)(l * SBATCH + bs) * 512;
#pragma unroll
    for (int i = 0; i < 8; ++i) { const int ch = c.lane + 64 * i, hb = ch >> 7; const float vb = pv[i] * rs * c.v_norm_g[l * 512 + ch];
        ovs[ch] = vb; am[512 + ch] = ps[2048 + ch] * (c.w_s[(size_t)(l * 4 + hb) * 128 * 128] * vb + c.b_s[(l * 4 + hb) * 128]); }
}
DI void phase_b0(const Ctx& c, int l, LAS unsigned char* lds) {
    constexpr int NPT = 256 * 17;
    LAS unsigned char* wl = lds + c.wave * B0_WAVE_LDS;
    for (int t = c.gw; t < NPT + SBATCH; t += c.ngw) {
        if (t >= NPT) { if (SUB(0)) b0_task_sample(c, l, t - NPT); continue; }
        const int chunk = t / 17, k = t % 17, b = chunk >> 5, n = chunk & 31;
        if (k == 0) { if (SUB(1)) b0_task_ab(c, l, b, n); }
        else if (k >= 13) { if (SUB(2)) b0_task_vb(c, l, b, n, k - 13, wl); }
        else { if (SUB(3)) b0_task_conv(c, l, b, n, (k - 1) >> 2, (k - 1) & 3, wl); }
    }
}

DI void b1_prep(const Ctx& c, int l, int unit, LAS unsigned char* wl, LAS float* sg, LAS float* sb) {
    int lane = c.lane; asm volatile("" : "+v"(lane));
    const int r = lane & 31, h = lane >> 5;
    const int n = unit & 31, bh = unit >> 5, hh = bh & 3, b = bh >> 2, tok0 = b * SEQ + n * 64;
    const float bt = WSP(float, WS_BETA)[(tok0 + lane) * 4 + hh];
    float gc = WSP(float, WS_G)[(tok0 + lane) * 4 + hh];
#pragma unroll
    for (int o = 1; o < 64; o <<= 1) { const float t = __shfl_up(gc, o); if (lane >= o) gc += t; }
    sg[lane] = gc; sb[lane] = bt;
    const float glast = __shfl(gc, 63);
    if (lane == 0) WSP(float, WS_EG)[unit] = __expf(glast);
    unsigned char* img = c.ws + WS_IMG + (size_t)unit * IMG_BYTES;
    const bf16_t* Kn = WSP(bf16_t, WS_KN) + (size_t)tok0 * 512 + hh * 128;
    const bf16_t* Qn = WSP(bf16_t, WS_QN) + (size_t)tok0 * 512 + hh * 128;
    const bf16_t* KnT = WSP(bf16_t, WS_KNT) + (size_t)unit * 128 * 64;
    const bf16_t* VT = WSP(bf16_t, WS_VT) + (size_t)unit * 128 * 64;
    LAS float* L = (LAS float*)wl;
    {
        bf16x8 Kf[2][8];
#pragma unroll
        for (int t = 0; t < 2; ++t)
#pragma unroll
            for (int ks = 0; ks < 8; ++ks) Kf[t][ks] = *(const bf16x8*)(Kn + (size_t)(32 * t + r) * 512 + 16 * ks + 8 * h);
#pragma unroll
        for (int tt = 0; tt < 3; ++tt) { const int mt = tt == 0 ? 0 : 1, nt = tt == 2 ? 1 : 0;
            f32x16 acc = zero16();
#pragma unroll
            for (int ks = 0; ks < 8; ++ks) acc = MFMA32(Kf[mt][ks], Kf[nt][ks], acc);
            const int j = 32 * nt + r; const float gj = sg[j];
#pragma unroll
            for (int g4 = 0; g4 < 4; ++g4) { const f32x4 gi4 = *(const LAS f32x4*)(sg + 32 * mt + 8 * g4 + 4 * h), bi4 = *(const LAS f32x4*)(sb + 32 * mt + 8 * g4 + 4 * h);
#pragma unroll
                for (int q = 0; q < 4; ++q) { const int i = 32 * mt + 8 * g4 + 4 * h + q; const float arg = i > j ? gi4[q] - gj : 0.f;
                    L[i * 64 + j] = i > j ? acc[4 * g4 + q] * bi4[q] * __expf(arg) : 0.f; } } }
#pragma unroll
        for (int mt = 0; mt < 2; ++mt) {
            bf16x8 Qf[8];
#pragma unroll
            for (int ks = 0; ks < 8; ++ks) Qf[ks] = *(const bf16x8*)(Qn + (size_t)(32 * mt + r) * 512 + 16 * ks + 8 * h);
            const int i = 32 * mt + r; const float gi = sg[i];
#pragma unroll
            for (int mp = 0; mp <= mt; ++mp) {
                f32x16 acc = zero16();
#pragma unroll
                for (int ks = 0; ks < 8; ++ks) acc = MFMA32(Kf[mp][ks], Qf[ks], acc);
#pragma unroll
                for (int g4 = 0; g4 < 4; ++g4) { const f32x4 gj4 = *(const LAS f32x4*)(sg + 32 * mp + 8 * g4 + 4 * h);
#pragma unroll
                    for (int q = 0; q < 4; ++q) { const int j = 32 * mp + 8 * g4 + 4 * h + q; const float arg = i >= j ? gi - gj4[q] : 0.f;
                        acc[4 * g4 + q] = i >= j ? acc[4 * g4 + q] * __expf(arg) : 0.f; } }
                const int fb = (mt == 0 ? 0 : 1 + mp) * 2;
#pragma unroll
                for (int s = 0; s < 2; ++s) *(u32x4*)(img + 49152 + (fb + s) * 1024 + lane * 16) = pack8(acc, s);
            }
        }
    }
    float Tr[64];
    {
        f32x4 lb[2][16];
#pragma unroll
        for (int i = 0; i < 64; ++i) {
            if (i + 1 < 64) {
#pragma unroll
                for (int j4 = 0; j4 < (i + 1 + 3) / 4; ++j4) lb[(i + 1) & 1][j4] = *(const LAS f32x4*)(L + (i + 1) * 64 + 4 * j4); }
            asm volatile("" ::: "memory");
            float a0 = lane == i ? 1.f : 0.f, a1 = 0.f;
#pragma unroll
            for (int j4 = 0; j4 < (i + 3) / 4; ++j4) {
#pragma unroll
                for (int q = 0; q < 4; ++q) { const int j = 4 * j4 + q; if (j < i) { if (q & 1) a1 -= lb[i & 1][j4][q] * Tr[j]; else a0 -= lb[i & 1][j4][q] * Tr[j]; } } }
            Tr[i] = a0 + a1;
        }
    }
    LAS bf16_t* T1 = (LAS bf16_t*)wl;
    asm volatile("" ::: "memory");
    {
        const float sc1 = bt * __expf(gc);
#pragma unroll
        for (int i = 0; i < 64; ++i) T1[i * 72 + lane] = f2bf(Tr[i] * sc1);
        bf16x8 Tf[2][4];
#pragma unroll
        for (int mt = 0; mt < 2; ++mt)
#pragma unroll
            for (int ks = 0; ks < 4; ++ks) Tf[mt][ks] = *(const LAS bf16x8*)(T1 + (32 * mt + r) * 72 + 16 * ks + 8 * h);
#pragma unroll
        for (int dt = 0; dt < 4; ++dt) {
            bf16x8 Kt[4];
#pragma unroll
            for (int ks = 0; ks < 4; ++ks) Kt[ks] = *(const bf16x8*)(KnT + (size_t)(32 * dt + r) * 64 + 16 * ks + 8 * h);
#pragma unroll
            for (int mt = 0; mt < 2; ++mt) { f32x16 acc = zero16();
#pragma unroll
                for (int ks = 0; ks < 2 * (mt + 1); ++ks) acc = MFMA32(Kt[ks], Tf[mt][ks], acc);
                acc = -acc;
#pragma unroll
                for (int s = 0; s < 2; ++s) *(u32x4*)(img + ((mt * 4 + dt) * 2 + s) * 1024 + lane * 16) = pack8(acc, s); }
        }
    }
    asm volatile("" ::: "memory");
    {
#pragma unroll
        for (int i = 0; i < 64; ++i) T1[i * 72 + lane] = f2bf(Tr[i] * bt);
        bf16x8 Tf[2][4];
#pragma unroll
        for (int mt = 0; mt < 2; ++mt)
#pragma unroll
            for (int ks = 0; ks < 4; ++ks) Tf[mt][ks] = *(const LAS bf16x8*)(T1 + (32 * mt + r) * 72 + 16 * ks + 8 * h);
        float* uimg = WSP(float, WS_UIMG) + (size_t)unit * 8192;
#pragma unroll
        for (int et = 0; et < 4; ++et) {
            bf16x8 Vt[4];
#pragma unroll
            for (int ks = 0; ks < 4; ++ks) Vt[ks] = *(const bf16x8*)(VT + (size_t)(32 * et + r) * 64 + 16 * ks + 8 * h);
#pragma unroll
            for (int mt = 0; mt < 2; ++mt) { f32x16 acc = zero16();
#pragma unroll
                for (int ks = 0; ks < 2 * (mt + 1); ++ks) acc = MFMA32(Tf[mt][ks], Vt[ks], acc);
#pragma unroll
                for (int g4 = 0; g4 < 4; ++g4) *(f32x4*)(uimg + ((et * 2 + mt) * 4 + g4) * 256 + lane * 4) = (f32x4){acc[4 * g4], acc[4 * g4 + 1], acc[4 * g4 + 2], acc[4 * g4 + 3]}; }
        }
    }
    asm volatile("" ::: "memory");
#pragma unroll
    for (int mt = 0; mt < 2; ++mt) { const float ei = __expf(sg[32 * mt + r]);
#pragma unroll
        for (int dt = 0; dt < 4; ++dt)
#pragma unroll
            for (int s = 0; s < 2; ++s) { const bf16_t* qp = Qn + (size_t)(32 * mt + r) * 512 + 32 * dt + 16 * s + 4 * h;
                const u32x2 p0 = *(const u32x2*)qp, p1 = *(const u32x2*)(qp + 8);
                u32x4 w; w.x = pk2(bflo(p0.x) * ei, bfhi(p0.x) * ei); w.y = pk2(bflo(p0.y) * ei, bfhi(p0.y) * ei); w.z = pk2(bflo(p1.x) * ei, bfhi(p1.x) * ei); w.w = pk2(bflo(p1.y) * ei, bfhi(p1.y) * ei);
                *(u32x4*)(img + 16384 + ((mt * 4 + dt) * 2 + s) * 1024 + lane * 16) = w; } }
#pragma unroll
    for (int mp = 0; mp < 2; ++mp)
#pragma unroll
        for (int s = 0; s < 2; ++s) { const f32x4 ga = *(const LAS f32x4*)(sg + 32 * mp + 16 * s + 4 * h), gb = *(const LAS f32x4*)(sg + 32 * mp + 16 * s + 8 + 4 * h);
            float sc[8];
#pragma unroll
            for (int q = 0; q < 4; ++q) { sc[q] = __expf(glast - ga[q]); sc[4 + q] = __expf(glast - gb[q]); }
#pragma unroll
            for (int dt = 0; dt < 4; ++dt) { const bf16_t* kp = KnT + (size_t)(32 * dt + r) * 64 + 32 * mp + 16 * s + 4 * h;
                const u32x2 p0 = *(const u32x2*)kp, p1 = *(const u32x2*)(kp + 8);
                u32x4 w; w.x = pk2(bflo(p0.x) * sc[0], bfhi(p0.x) * sc[1]); w.y = pk2(bflo(p0.y) * sc[2], bfhi(p0.y) * sc[3]); w.z = pk2(bflo(p1.x) * sc[4], bfhi(p1.x) * sc[5]); w.w = pk2(bflo(p1.y) * sc[6], bfhi(p1.y) * sc[7]);
                *(u32x4*)(img + 32768 + ((dt * 2 + mp) * 2 + s) * 1024 + lane * 16) = w; } }
}
DI void b1_gmlp(const Ctx& c, int l, int unit) {
    int lane = c.lane; asm volatile("" : "+v"(lane));
    const int r = lane & 31, h = lane >> 5;
    const int hb = unit & 3, cc = (unit >> 2) & 15, b = unit >> 6, tokc0 = b * SEQ + cc * 128;
    const bf16_t* A = WSP(bf16_t, WS_VBT) + (size_t)unit * 128 * 128;
    const bf16_t* B = WSP(bf16_t, WS_WM) + (size_t)(l * 4 + hb) * 128 * 128;
    const bf16_t* P = WSP(bf16_t, WS_P); bf16_t* AM = WSP(bf16_t, WS_AMIX);
#pragma unroll
    for (int nt = 0; nt < 4; ++nt) {
        f32x16 acc[4];
#pragma unroll
        for (int mt = 0; mt < 4; ++mt) acc[mt] = zero16();
#pragma unroll
        for (int ks = 0; ks < 2 * (nt + 1); ++ks) { const bf16x8 bf = *(const bf16x8*)(B + (size_t)(32 * nt + r) * 128 + 16 * ks + 8 * h);
#pragma unroll
            for (int mt = 0; mt < 4; ++mt) { const bf16x8 af = *(const bf16x8*)(A + (size_t)(32 * mt + r) * 128 + 16 * ks + 8 * h); acc[mt] = MFMA32(af, bf, acc[mt]); } }
        const int tok = tokc0 + 32 * nt + r; const float bsi = c.b_s[(l * 4 + hb) * 128 + 32 * nt + r];
#pragma unroll
        for (int mt = 0; mt < 4; ++mt)
#pragma unroll
            for (int g4 = 0; g4 < 4; ++g4) { const int dch0 = 32 * mt + 8 * g4 + 4 * h;
                const u32x2 u4 = *(const u32x2*)(P + (size_t)tok * NP + 2048 + hb * 128 + dch0);
                u32x2 w; w.x = pk2(bflo(u4.x) * (acc[mt][4 * g4] + bsi), bfhi(u4.x) * (acc[mt][4 * g4 + 1] + bsi)); w.y = pk2(bflo(u4.y) * (acc[mt][4 * g4 + 2] + bsi), bfhi(u4.y) * (acc[mt][4 * g4 + 3] + bsi));
                *(u32x2*)(AM + (size_t)tok * DM + 512 + hb * 128 + dch0) = w; }
    }
}
DI void phase_b1(const Ctx& c, int l, LAS unsigned char* lds) {
    LAS unsigned char* wl = lds + c.wave * 16384; LAS float* sg = (LAS float*)(lds + 131072 + c.wave * 512); LAS float* sb = sg + 64;
    for (int t = c.gw; t < 1024 + 512; t += c.ngw) {
        if (t < 1024) { if (SUB(0)) b1_prep(c, l, t, wl, sg, sb); } else { if (SUB(1)) b1_gmlp(c, l, t - 1024); }
    }
}

constexpr int OB_STRIDE = 136;
constexpr int LDS_OBUF = 2 * IMG_BYTES, OBUF_BYTES = 64 * OB_STRIDE * 2;
static_assert(LDS_OBUF + 2 * OBUF_BYTES <= LDS_BYTES, "scan LDS");
DI void scan_post(const Ctx& c, int l, int b, int hh, int n, const LAS bf16_t* ob, int lid, const u32x4 (&gt4)[4]) {
    const int i = lid >> 2, q = lid & 3, tok = b * SEQ + n * 64 + i;
    u32x4 ov[4]; float ss = 0.f;
#pragma unroll
    for (int x = 0; x < 4; ++x) { ov[x] = *(const LAS u32x4*)(ob + i * OB_STRIDE + 32 * q + 8 * x);
#pragma unroll
        for (int e = 0; e < 4; ++e) { const float a = bflo(ov[x][e]), bq = bfhi(ov[x][e]); ss += a * a + bq * bq; } }
    ss += __shfl_xor(ss, 1); ss += __shfl_xor(ss, 2);
    const float rs = rsqrtf(ss * (1.0f / 128.0f) + EPS);
    bf16_t* op = WSP(bf16_t, WS_AMIX) + (size_t)tok * DM + hh * 128 + 32 * q;
    const float* og = c.o_norm_g + l * 128 + 32 * q;
#pragma unroll
    for (int x = 0; x < 4; ++x) { const u32x4 gt = gt4[x]; u32x4 w;
#pragma unroll
        for (int e = 0; e < 4; ++e) { const float o0 = bflo(ov[x][e]) * rs * og[8 * x + 2 * e] * silu_f(bflo(gt[e])), o1 = bfhi(ov[x][e]) * rs * og[8 * x + 2 * e + 1] * silu_f(bfhi(gt[e])); w[e] = pk2(o0, o1); }
        *(u32x4*)(op + 8 * x) = w; }
}
DI void scan_block(const Ctx& c, int l, int bh, LAS unsigned char* lds) {
    const int wave = c.wave, b = bh >> 2, hh = bh & 3;
    const unsigned char* img0 = c.ws + WS_IMG + (size_t)bh * 32 * IMG_BYTES;
    if (wave >= 4) { if (SUB2(0)) {
        int lane = c.lane; asm volatile("" : "+v"(lane));
        const int lw = wave - 4, lid = lw * 64 + lane;
        u32x4 regs[14]; u32x4 gt[4];
        const bf16_t* gbase = WSP(bf16_t, WS_P) + (size_t)(b * SEQ + (lid >> 2)) * NP + 1536 + hh * 128 + 32 * (lid & 3);
#pragma unroll
        for (int i = 0; i < 14; ++i) { const int ch = lw + 4 * i; if (i < 13 || lw < 2) regs[i] = *(const u32x4*)(img0 + ch * 1024 + lane * 16); }
#pragma unroll
        for (int i = 0; i < 14; ++i) { const int ch = lw + 4 * i; if (i < 13 || lw < 2) *(LAS u32x4*)(lds + ch * 1024 + lane * 16) = regs[i]; }
#pragma unroll
        for (int i = 0; i < 14; ++i) { const int ch = lw + 4 * i; if (i < 13 || lw < 2) regs[i] = *(const u32x4*)(img0 + (size_t)IMG_BYTES + ch * 1024 + lane * 16); }
        __syncthreads();
        for (int n = 0; n < 32; ++n) {
            if (n + 1 < 32) {
#pragma unroll
                for (int i = 0; i < 14; ++i) { const int ch = lw + 4 * i; if (i < 13 || lw < 2) *(LAS u32x4*)(lds + ((n + 1) & 1) * IMG_BYTES + ch * 1024 + lane * 16) = regs[i]; } }
            if (n + 2 < 32) {
#pragma unroll
                for (int i = 0; i < 14; ++i) { const int ch = lw + 4 * i; if (i < 13 || lw < 2) regs[i] = *(const u32x4*)(img0 + (size_t)(n + 2) * IMG_BYTES + ch * 1024 + lane * 16); } }
            if (n >= 1) scan_post(c, l, b, hh, n - 1, (const LAS bf16_t*)(lds + LDS_OBUF + ((n - 1) & 1) * OBUF_BYTES), lid, gt);
#pragma unroll
            for (int x = 0; x < 4; ++x) gt[x] = *(const u32x4*)(gbase + (size_t)n * 64 * NP + 8 * x);
            __syncthreads();
        }
        scan_post(c, l, b, hh, 31, (const LAS bf16_t*)(lds + LDS_OBUF + (31 & 1) * OBUF_BYTES), lid, gt);
    } } else if (SUB2(1)) {
        int lane = c.lane; asm volatile("" : "+v"(lane));
        const int ws = wave, r = lane & 31, h = lane >> 5;
        f32x16 S[4];
#pragma unroll
        for (int dt = 0; dt < 4; ++dt) S[dt] = zero16();
        const float* uimg0 = WSP(float, WS_UIMG) + (size_t)bh * 32 * 8192 + (size_t)ws * 2 * 4 * 256 + lane * 4;
        const float* egp = WSP(float, WS_EG) + bh * 32;
        f32x16 un[2];
#pragma unroll
        for (int mt = 0; mt < 2; ++mt)
#pragma unroll
            for (int g4 = 0; g4 < 4; ++g4) { const f32x4 v = *(const f32x4*)(uimg0 + (mt * 4 + g4) * 256); un[mt][4 * g4] = v.x; un[mt][4 * g4 + 1] = v.y; un[mt][4 * g4 + 2] = v.z; un[mt][4 * g4 + 3] = v.w; }
        float eg_n = egp[0];
        __syncthreads();
        for (int n = 0; n < 32; ++n) {
            const LAS unsigned char* buf = lds + (n & 1) * IMG_BYTES + lane * 16;
            f32x16 av[2], ao[2]; av[0] = un[0]; av[1] = un[1]; ao[0] = zero16(); ao[1] = zero16();
            const float eg = eg_n;
            if (n + 1 < 32) { const float* up = uimg0 + (size_t)(n + 1) * 8192;
#pragma unroll
                for (int mt = 0; mt < 2; ++mt)
#pragma unroll
                    for (int g4 = 0; g4 < 4; ++g4) { const f32x4 v = *(const f32x4*)(up + (mt * 4 + g4) * 256); un[mt][4 * g4] = v.x; un[mt][4 * g4 + 1] = v.y; un[mt][4 * g4 + 2] = v.z; un[mt][4 * g4 + 3] = v.w; }
                eg_n = egp[n + 1]; }
#pragma unroll
            for (int pass = 0; pass < 2; ++pass) {
                const LAS unsigned char* fb = buf + pass * 16384;
                bf16x8 fg[2][2];
#pragma unroll
                for (int mt = 0; mt < 2; ++mt) fg[0][mt] = *(const LAS bf16x8*)(fb + (mt * 8) * 1024);
#pragma unroll
                for (int gI = 0; gI < 8; ++gI) { const int dt = gI >> 1, s = gI & 1;
                    if (gI + 1 < 8) {
#pragma unroll
                        for (int mt = 0; mt < 2; ++mt) fg[(gI + 1) & 1][mt] = *(const LAS bf16x8*)(fb + (mt * 8 + gI + 1) * 1024); }
                    asm volatile("" ::: "memory");
                    const bf16x8 sb = as_bf(pack8(S[dt], s));
                    if (pass == 0) { av[0] = MFMA32(fg[gI & 1][0], sb, av[0]); av[1] = MFMA32(fg[gI & 1][1], sb, av[1]); }
                    else { ao[0] = MFMA32(fg[gI & 1][0], sb, ao[0]); ao[1] = MFMA32(fg[gI & 1][1], sb, ao[1]); } }
            }
            bf16x8 vb[2][2];
#pragma unroll
            for (int mp = 0; mp < 2; ++mp)
#pragma unroll
                for (int s = 0; s < 2; ++s) vb[mp][s] = as_bf(pack8(av[mp], s));
            {
                bf16x8 qf[6];
#pragma unroll
                for (int f = 0; f < 6; ++f) qf[f] = *(const LAS bf16x8*)(buf + 49152 + f * 1024);
                asm volatile("" ::: "memory");
#pragma unroll
                for (int s = 0; s < 2; ++s) { ao[0] = MFMA32(qf[s], vb[0][s], ao[0]); ao[1] = MFMA32(qf[2 + s], vb[0][s], ao[1]); ao[1] = MFMA32(qf[4 + s], vb[1][s], ao[1]); }
            }
            LAS bf16_t* ob = (LAS bf16_t*)(lds + LDS_OBUF + (n & 1) * OBUF_BYTES);
#pragma unroll
            for (int mt = 0; mt < 2; ++mt)
#pragma unroll
                for (int reg = 0; reg < 16; ++reg) ob[(32 * mt + crow(reg, h)) * OB_STRIDE + 32 * ws + r] = f2bf(ao[mt][reg]);
            bf16x8 kf[2][4];
#pragma unroll
            for (int f = 0; f < 4; ++f) kf[0][f] = *(const LAS bf16x8*)(buf + 32768 + f * 1024);
#pragma unroll
            for (int dt = 0; dt < 4; ++dt) {
                if (dt + 1 < 4) {
#pragma unroll
                    for (int f = 0; f < 4; ++f) kf[(dt + 1) & 1][f] = *(const LAS bf16x8*)(buf + 32768 + ((dt + 1) * 4 + f) * 1024); }
                asm volatile("" ::: "memory");
                S[dt] = S[dt] * eg;
#pragma unroll
                for (int mp = 0; mp < 2; ++mp)
#pragma unroll
                    for (int s = 0; s < 2; ++s) S[dt] = MFMA32(kf[dt & 1][mp * 2 + s], vb[mp][s], S[dt]); }
            __syncthreads();
        }
        const char* od = (const char*)(c.out + O_DP + (size_t)(l * 32 + bh) * 128 * 128);
        unsigned voff = (unsigned)((4 * h) * 128 + 32 * ws + r) * 4u;
        asm volatile("" : "+v"(voff));
#pragma unroll
        for (int dt = 0; dt < 4; ++dt)
#pragma unroll
            for (int reg = 0; reg < 16; ++reg) *(float*)(od + (32 * dt + (reg & 3) + 8 * (reg >> 2)) * 512 + voff) = S[dt][reg];
    }
}
DI void sample_recurrent(const Ctx& c, int l, int unit) {
    const int lane = c.lane, bs = unit >> 2, hh = unit & 3, e2 = 2 * lane;
    const float* S0 = c.state_delta + (size_t)((l * SBATCH + bs) * 4 + hh) * 128 * 128 + e2;
    float* S1 = c.out + O_DS + (size_t)((l * SBATCH + bs) * 4 + hh) * 128 * 128 + e2;
    const float* q = WSP(float, WS_QS) + bs * 512 + hh * 128; const float* k = WSP(float, WS_KS) + bs * 512 + hh * 128; const float* v = WSP(float, WS_VS) + bs * 512 + hh * 128;
    const float eg = __expf(WSP(float, WS_GS)[bs * 4 + hh]), beta = WSP(float, WS_BS)[bs * 4 + hh];
    f32x2 kv = {0.f, 0.f};
#pragma unroll 32
    for (int d = 0; d < 128; ++d) { const f32x2 s = *(const f32x2*)(S0 + d * 128); kv += s * k[d]; }
    const f32x2 v2 = *(const f32x2*)(v + e2);
    const f32x2 delta = (v2 - kv * eg) * beta;
    f32x2 oo = {0.f, 0.f};
#pragma unroll 32
    for (int d = 0; d < 128; ++d) { const f32x2 s = *(const f32x2*)(S0 + d * 128); const f32x2 sn = s * eg + delta * k[d]; oo += sn * q[d]; *(f32x2*)(S1 + d * 128) = sn; }
    const float ss = wave_sum(oo.x * oo.x + oo.y * oo.y); const float rs = rsqrtf(ss * (1.0f / 128.0f) + EPS);
    const float* ps = WSP(float, WS_PS) + (size_t)bs * NPS + 1536 + hh * 128 + e2; float* am = WSP(float, WS_AMIXS) + (size_t)bs * DM + hh * 128 + e2;
    const float* og = c.o_norm_g + l * 128 + e2;
    am[0] = oo.x * rs * og[0] * silu_f(ps[0]); am[1] = oo.y * rs * og[1] * silu_f(ps[1]);
}
DI void phase_scan(const Ctx& c, int l, LAS unsigned char* lds) {
    if (blockIdx.x < 32) { if (SUB(0)) scan_block(c, l, blockIdx.x, lds); return; }
    const int w0 = (blockIdx.x - 32) * 8 + c.wave, nw = (gridDim.x - 32) * 8;
    for (int u = w0; u < SBATCH * 4; u += nw) { if (SUB(1)) sample_recurrent(c, l, u); }
}

DI void phase_final(const Ctx& c) {
    for (int m = c.gw; m < MP + SBATCH; m += c.ngw) {
        const float* src = m < MP ? WSP(float, WS_XBUF) + (size_t)m * DM : WSP(float, WS_XS) + (size_t)(m - MP) * DM;
        float* dst = m < MP ? c.out + O_YP + (size_t)m * DM : c.out + O_YS + (size_t)(m - MP) * DM;
        const f32x4* xr = (const f32x4*)src + c.lane; const f32x4* gr = (const f32x4*)c.norm_f_g + c.lane; f32x4 v[4]; float s = 0.f;
#pragma unroll
        for (int j = 0; j < 4; ++j) { v[j] = xr[64 * j];
            if (m >= MP) { const f32x4* pp = (const f32x4*)(WSP(float, WS_XP) + (size_t)(m - MP) * DM) + c.lane + 64 * j;
#pragma unroll
                for (int q = 0; q < 4; ++q) v[j] += pp[(size_t)q * SBATCH * DM / 4]; }
            s += (v[j].x * v[j].x + v[j].y * v[j].y) + (v[j].z * v[j].z + v[j].w * v[j].w); }
        const float rs = rsqrtf(wave_sum(s) * (1.0f / DM) + EPS);
#pragma unroll
        for (int j = 0; j < 4; ++j) ((f32x4*)dst + c.lane)[64 * j] = v[j] * rs * gr[64 * j];
    }
}

#define XB_TMO      128
#define XB_XCNT(j)  (256  + 64 * (j))
#define XB_XSUB(j)  (1280 + 64 * (j))
#define XB_XGEN(j)  (2304 + 64 * (j))
#define XB_TOP      3328
#define XB_TOPGEN   3392
#define XCD_BAR_WORDS 3456
#define XB_SPIN_CAP (1u << 18)

__device__ __forceinline__ unsigned xb_ld(unsigned* p)              { return __hip_atomic_load(p, __ATOMIC_RELAXED, __HIP_MEMORY_SCOPE_AGENT); }
__device__ __forceinline__ unsigned xb_add(unsigned* p, unsigned v) { return __hip_atomic_fetch_add(p, v, __ATOMIC_RELAXED, __HIP_MEMORY_SCOPE_AGENT); }
__device__ __forceinline__ unsigned xb_xcc_id() { return (unsigned)__builtin_amdgcn_s_getreg((3 << 11) | 20) & 0xFu; }
#define XB_SPIN(cond, bar) do { unsigned _sp = 0; while (cond) { __builtin_amdgcn_s_sleep(1); \
    if ((++_sp & 255u) == 0u) { if (xb_ld(&(bar)[XB_TMO])) break; if (_sp > XB_SPIN_CAP) { atomicAdd(&(bar)[XB_TMO], 1u); break; } } } } while (0)

struct XcdBarrier {
    unsigned* bar; unsigned x;
    volatile LAS unsigned* st;
};

__device__ __forceinline__ XcdBarrier xcd_barrier_post(unsigned* bar, volatile LAS unsigned* st) {
    XcdBarrier b; b.bar = bar; b.x = xb_xcc_id(); b.st = st;
    if (threadIdx.x == 0) (void)xb_add(&bar[XB_XCNT(b.x)], 1u);
    return b;
}
__device__ __forceinline__ void xcd_barrier_complete(unsigned* bar, unsigned x, unsigned& nloc, unsigned& nx) {
    const unsigned G = gridDim.x * gridDim.y * gridDim.z;
    unsigned sum, cnt, mine, sp = 0u;
    for (;;) {
        sum = 0u; cnt = 0u; mine = 0u;
#pragma unroll
        for (unsigned j = 0; j < 16; ++j) { const unsigned c = xb_ld(&bar[XB_XCNT(j)]); sum += c; cnt += (c > 0u) ? 1u : 0u; mine = (j == x) ? c : mine; }
        if (sum == G) break;
        __builtin_amdgcn_s_sleep(1);
        if ((++sp & 255u) == 0u) { if (xb_ld(&bar[XB_TMO])) break; if (sp > XB_SPIN_CAP) { atomicAdd(&bar[XB_TMO], 1u); break; } }
    }
    nloc = mine > 0u ? mine : 1u; nx = cnt > 0u ? cnt : 1u;
}

__device__ __forceinline__ void xcd_barrier(const XcdBarrier& b) {
    asm volatile("s_waitcnt vmcnt(0)" ::: "memory");
    __syncthreads();
    if (threadIdx.x == 0) {
        unsigned* bar = b.bar;
        __builtin_amdgcn_s_waitcnt(0);
        unsigned nloc = b.st[0], nx = b.st[1];
        if (nloc == 0u) { xcd_barrier_complete(bar, b.x, nloc, nx); b.st[0] = nloc; b.st[1] = nx; }
        const unsigned old = xb_add(&bar[XB_XSUB(b.x)], 1u);
        const unsigned gen = old / nloc;
        if (old + 1u == (gen + 1u) * nloc) {
            __builtin_amdgcn_fence(__ATOMIC_RELEASE, "agent");
            asm volatile("s_waitcnt vmcnt(0)" ::: "memory");
            const unsigned og = xb_add(&bar[XB_TOP], 1u);
            const unsigned tg = og / nx;
            if (og + 1u == (tg + 1u) * nx) xb_add(&bar[XB_TOPGEN], 1u);
            else XB_SPIN(xb_ld(&bar[XB_TOPGEN]) == tg, bar);
            __builtin_amdgcn_fence(__ATOMIC_ACQUIRE, "agent");
            xb_add(&bar[XB_XGEN(b.x)], 1u);
            asm volatile("s_waitcnt vmcnt(0)" ::: "memory");
        } else {
            XB_SPIN(xb_ld(&bar[XB_XGEN(b.x)]) == gen, bar);
            __builtin_amdgcn_fence(__ATOMIC_ACQUIRE, "agent");
            asm volatile("s_waitcnt vmcnt(0)" ::: "memory");
        }
    }
    __syncthreads();
}
#ifndef ONLY
#define ONLY -1
#endif
#ifndef REPMASK
#define REPMASK 0
#endif
#define EN(x) (ONLY < 0 || ONLY == (x))
__global__ void __launch_bounds__(512, 2) hymba_fwd(Args args) {
    extern __shared__ __attribute__((aligned(16))) unsigned char lds_raw[];
    LAS unsigned char* lds = (LAS unsigned char*)lds_raw;
    cg::grid_group grid = cg::this_grid();
    Ctx c;
    c.x_prompt = args.in[0]; c.x_sample = args.in[1]; c.state_delta = args.in[2]; c.state_conv = args.in[3]; c.norm_mix_g = args.in[4]; c.w_in = args.in[5]; c.conv_w = args.in[6];
    c.A_log = args.in[7]; c.dt_bias = args.in[8]; c.o_norm_g = args.in[9]; c.v_norm_g = args.in[10]; c.w_s = args.in[11]; c.b_s = args.in[12]; c.w_o = args.in[13]; c.norm_ffn_g = args.in[14];
    c.w_up = args.in[15]; c.w_down = args.in[16]; c.norm_f_g = args.in[17]; c.out = args.out; c.ws = args.ws;
    c.lane = threadIdx.x & 63; c.wave = __builtin_amdgcn_readfirstlane(threadIdx.x >> 6); c.gw = blockIdx.x * 8 + c.wave; c.ngw = gridDim.x * 8;
    const int G = gridDim.x;
    volatile LAS unsigned* bst = (volatile LAS unsigned*)(lds + LDS_BYTES - 16);
    if (threadIdx.x < 2) bst[threadIdx.x] = 0u;
    __syncthreads();
    XcdBarrier xbar = xcd_barrier_post((unsigned*)args.ws, bst);
    grid.sync();
    for (int step = 2 * args.ph_lo; step < 2 * args.ph_hi; ++step) {
        const int ph = step >> 1;
        const int ptype = ph == 0 ? 0 : (ph == 29 ? 8 : 1 + (ph - 1) % 7);
        if ((step & 1) && !((REPMASK >> ptype) & 1)) continue;
        { int tl = threadIdx.x; asm volatile("" : "+v"(tl)); c.lane = tl & 63; }
        if (step & 1) __syncthreads();
        if (ph == 0) { if (EN(0)) phase_prologue(c, lds); }
        else if (ph == 29) { if (EN(8)) phase_final(c); }
        else {
            const int l = (ph - 1) / 7, s = (ph - 1) % 7;
            float* ssq = WSP(float, WS_SSQ);
            if (s == 0) { if (EN(1)) { sgemm1(c, l);
                pg8::Gemm g{WSP(bf16_t, WS_XB16), WSP(bf16_t, WS_WIN) + (size_t)l * NP * DM, MP, NP, DM}; pg8::StaticOrder S; S.init(MP, NP, G, blockIdx.x);
                pg8::EpiScaleBf16 E{WSP(bf16_t, WS_P), NP, ssq + (size_t)(2 * l) * MP * 16, 0, WSP(float, WS_VSS)}; pg8::gemm_phase(lds, g, S, E); } }
            else if (s == 1) { if (EN(2)) phase_b0(c, l, lds); }
            else if (s == 2) { if (EN(3)) phase_b1(c, l, lds); }
            else if (s == 3) { if (EN(4)) phase_scan(c, l, lds); }
            else if (s == 4) { if (EN(5)) { sgemm2(c, l);
                pg8::Gemm g{WSP(bf16_t, WS_AMIX), WSP(bf16_t, WS_WO) + (size_t)l * DM * DM, MP, DM, DM}; pg8::StaticOrder S; S.init(MP, DM, G, blockIdx.x);
                pg8::EpiResid E{l == 0 ? c.x_prompt : WSP(float, WS_XBUF), WSP(float, WS_XBUF), WSP(bf16_t, WS_XB16), ssq + (size_t)(2 * l + 1) * MP * 16}; pg8::gemm_phase(lds, g, S, E); } }
            else if (s == 5) { if (EN(6)) { sgemm3(c, l);
                pg8::Gemm g{WSP(bf16_t, WS_XB16), WSP(bf16_t, WS_WUP) + (size_t)l * FF * DM, MP, FF, DM}; pg8::StaticOrder S; S.init(MP, FF, G, blockIdx.x);
                pg8::EpiScaleBf16 E{WSP(bf16_t, WS_UNION), FF, ssq + (size_t)(2 * l + 1) * MP * 16, 1, nullptr}; pg8::gemm_phase(lds, g, S, E); } }
            else { if (EN(7)) { sgemm4(c, l);
                pg8::Gemm g{WSP(bf16_t, WS_UNION), WSP(bf16_t, WS_WDN) + (size_t)l * DM * FF, MP, DM, FF}; pg8::StaticOrder S; S.init(MP, DM, G, blockIdx.x);
                pg8::EpiResid E{WSP(float, WS_XBUF), WSP(float, WS_XBUF), WSP(bf16_t, WS_XB16), ssq + (size_t)(2 * l + 2) * MP * 16}; pg8::gemm_phase(lds, g, S, E); } }
        }
        if (!(step & 1) && ((REPMASK >> ptype) & 1)) continue;
        if ((REPMASK >> 9) & 1) { if (ph + 1 < args.ph_hi) xcd_barrier(xbar); }
        if (ph + 1 < args.ph_hi) {
            xcd_barrier(xbar);
        }
    }
}

extern "C" void kernel_launch(void* const* d_in, const int* in_sizes, int n_in, void* d_out, int out_size, void* d_ws, size_t ws_size, hipStream_t stream) {
    static int grid = 0;
    if (grid == 0) {
        int dev = 0, cus = 0, per_cu = 0;
        (void)hipGetDevice(&dev); (void)hipDeviceGetAttribute(&cus, hipDeviceAttributeMultiprocessorCount, dev);
        if (hipFuncSetAttribute((const void*)hymba_fwd, hipFuncAttributeMaxDynamicSharedMemorySize, LDS_BYTES) != hipSuccess) fprintf(stderr, "kernel_launch: hipFuncSetAttribute failed\n");
        if (hipOccupancyMaxActiveBlocksPerMultiprocessor(&per_cu, (const void*)hymba_fwd, 512, LDS_BYTES) != hipSuccess || per_cu < 1) { fprintf(stderr, "kernel_launch: occupancy query says %d\n", per_cu); per_cu = 1; }
        (void)hipGetLastError();
        grid = cus * 1;
        if (ws_size < WS_END) fprintf(stderr, "kernel_launch: workspace too small: %zu < %zu\n", ws_size, (size_t)WS_END);
    }
    (void)hipMemsetAsync(d_ws, 0, 65536, stream);
    Args a{};
    for (int i = 0; i < 18; ++i) a.in[i] = (const float*)d_in[i];
    a.out = (float*)d_out; a.ws = (unsigned char*)d_ws; a.ph_lo = 0; a.ph_hi = 30;
    void* kargs[] = {&a};
    hipError_t e = hipLaunchCooperativeKernel((const void*)hymba_fwd, dim3(grid), dim3(512), kargs, LDS_BYTES, stream);
    if (e != hipSuccess) fprintf(stderr, "kernel_launch: cooperative launch failed: %s (grid %d)\n", hipGetErrorString(e), grid);
}
```

```cpp
#include <hip/hip_runtime.h>
#include <hip/hip_cooperative_groups.h>
#include <cstdio>
namespace cg = cooperative_groups;

#define LAS __attribute__((address_space(3)))
#define DI __device__ __forceinline__
typedef unsigned short bf16_t;
typedef short bf16x8 __attribute__((ext_vector_type(8)));
typedef float f32x4 __attribute__((ext_vector_type(4)));
typedef float f32x2 __attribute__((ext_vector_type(2)));
typedef float f32x16 __attribute__((ext_vector_type(16)));
typedef unsigned u32x4 __attribute__((ext_vector_type(4)));
typedef unsigned u32x2 __attribute__((ext_vector_type(2)));
typedef __bf16 bf2_t __attribute__((ext_vector_type(2)));

#ifndef SUBSEL
#define SUBSEL -1
#endif
#define SUB(x) (SUBSEL < 0 || SUBSEL == (x))
#ifndef SUBSEL2
#define SUBSEL2 -1
#endif
#define SUB2(x) (SUBSEL2 < 0 || SUBSEL2 == (x))
constexpr int DM = 1024, NBATCH = 8, SEQ = 2048, MP = NBATCH * SEQ, DEPTH = 4, SBATCH = 128;
constexpr int NH = 4, QKV = 1536, NP = 3072, PROJ = 3080, FF = 4096, NPS = 3088;
constexpr float EPS = 1e-6f;
constexpr int IMG_BYTES = 55296;
constexpr int LDS_BYTES = 147456;
constexpr size_t O_YP = 0, O_YS = 16777216, O_DP = 16908288, O_CP = 19005440, O_DS = 19152896, O_CS = 52707328, O_VS = 55066624;
constexpr size_t WS_WIN = 65536;
constexpr size_t WS_WAB = WS_WIN + (size_t)DEPTH * NP * DM * 2;
constexpr size_t WS_WO = WS_WAB + (size_t)DEPTH * 16 * DM * 2;
constexpr size_t WS_WUP = WS_WO + (size_t)DEPTH * DM * DM * 2;
constexpr size_t WS_WDN = WS_WUP + (size_t)DEPTH * FF * DM * 2;
constexpr size_t WS_WM = WS_WDN + (size_t)DEPTH * FF * DM * 2;
constexpr size_t WS_XBUF = WS_WM + (size_t)DEPTH * 4 * 128 * 128 * 2;
constexpr size_t WS_XB16 = WS_XBUF + (size_t)MP * DM * 4;
constexpr size_t WS_SSQ = WS_XB16 + (size_t)MP * DM * 2;
constexpr size_t WS_UNION = WS_SSQ + (size_t)9 * MP * 16 * 4;
constexpr size_t WS_P = WS_UNION;
constexpr size_t WS_QN = WS_P + (size_t)MP * NP * 2;
constexpr size_t WS_KN = WS_QN + (size_t)MP * 512 * 2;
constexpr size_t WS_KNT = WS_UNION + (size_t)MP * FF * 2;
constexpr size_t WS_VT = WS_KNT + (size_t)MP * 512 * 2;
constexpr size_t WS_VBT = WS_VT + (size_t)MP * 512 * 2;
constexpr size_t WS_G = WS_VBT + (size_t)MP * 512 * 2;
constexpr size_t WS_BETA = WS_G + (size_t)MP * 4 * 4;
constexpr size_t WS_EG = WS_BETA + (size_t)MP * 4 * 4;
constexpr size_t WS_IMG = WS_EG + 4096;
constexpr size_t WS_UIMG = WS_IMG + (size_t)1024 * IMG_BYTES;
constexpr size_t WS_AMIX = WS_UIMG + (size_t)1024 * 32768;
constexpr size_t WS_XS = WS_AMIX + (size_t)MP * DM * 2;
constexpr size_t WS_PS = WS_XS + (size_t)SBATCH * DM * 4;
constexpr size_t WS_QS = WS_PS + (size_t)SBATCH * NPS * 4;
constexpr size_t WS_KS = WS_QS + (size_t)SBATCH * 512 * 4;
constexpr size_t WS_VS = WS_KS + (size_t)SBATCH * 512 * 4;
constexpr size_t WS_GS = WS_VS + (size_t)SBATCH * 512 * 4;
constexpr size_t WS_BS = WS_GS + (size_t)SBATCH * 4 * 4;
constexpr size_t WS_AMIXS = WS_BS + (size_t)SBATCH * 4 * 4;
constexpr size_t WS_HS = WS_AMIXS + (size_t)SBATCH * DM * 4;
constexpr size_t WS_XP = WS_HS + (size_t)SBATCH * FF * 4;
constexpr size_t WS_VSS = WS_XP + (size_t)4 * SBATCH * DM * 4;
constexpr size_t WS_END = WS_VSS + (size_t)MP * 8 * 4;
static_assert(WS_QN + 2 * (size_t)MP * 512 * 2 == WS_KNT, "union");
static_assert(WS_END <= (size_t)536870912, "workspace");

DI unsigned pk2(float lo, float hi) { f32x2 v = {lo, hi}; return __builtin_bit_cast(unsigned, __builtin_convertvector(v, bf2_t)); }
DI float bflo(unsigned w) { return __uint_as_float(w << 16); }
DI float bfhi(unsigned w) { return __uint_as_float(w & 0xffff0000u); }
DI float bf2f(bf16_t b) { return __uint_as_float(((unsigned)b) << 16); }
DI bf16_t f2bf(float f) { return (bf16_t)(pk2(f, 0.f) & 0xffffu); }
DI float wave_sum(float v) {
#pragma unroll
    for (int o = 1; o < 64; o <<= 1) v += __shfl_xor(v, o);
    return v;
}
DI float silu_f(float x) { return x * __builtin_amdgcn_rcpf(1.f + __expf(-x)); }
DI float sigmoid_f(float x) { return __builtin_amdgcn_rcpf(1.f + __expf(-x)); }
DI float softplus_f(float x) { return fmaxf(x, 0.f) + log1pf(__expf(-fabsf(x))); }
DI u32x4 pack8(const f32x16& x, int s) {
    u32x4 p; p.x = pk2(x[8 * s], x[8 * s + 1]); p.y = pk2(x[8 * s + 2], x[8 * s + 3]); p.z = pk2(x[8 * s + 4], x[8 * s + 5]); p.w = pk2(x[8 * s + 6], x[8 * s + 7]); return p;
}
DI float ssq_sum(const float* p) {
    const f32x4 a = *(const f32x4*)p, b = *(const f32x4*)(p + 4), c2 = *(const f32x4*)(p + 8), d2 = *(const f32x4*)(p + 12);
    return ((a.x + a.y) + (a.z + a.w)) + ((b.x + b.y) + (b.z + b.w)) + ((c2.x + c2.y) + (c2.z + c2.w)) + ((d2.x + d2.y) + (d2.z + d2.w));
}
DI int crow(int reg, int h) { return (reg & 3) + 8 * (reg >> 2) + 4 * h; }
#define MFMA32(a, b, c) __builtin_amdgcn_mfma_f32_32x32x16_bf16((a), (b), (c), 0, 0, 0)
#define MFMA16(a, b, c) __builtin_amdgcn_mfma_f32_16x16x32_bf16((a), (b), (c), 0, 0, 0)
DI bf16x8 as_bf(u32x4 v) { return __builtin_bit_cast(bf16x8, v); }
DI f32x16 zero16() { f32x16 z;
#pragma unroll
    for (int i = 0; i < 16; ++i) z[i] = 0.f; return z; }

namespace pg8 {
constexpr int BM = 256, BK = 64, HALF = 128, HTB = HALF * BK * 2, STAGE_BYTES = 8 * HTB, NXCD = 8, WGM = 8;
DI int lds_byte(int r, int c) { const int st = (r >> 4) * 2 + (c >> 5), rr = r & 15, cc = c & 31, ob = rr * 64 + cc * 2; return st * 1024 + (ob ^ (((ob >> 9) & 1) << 5)); }
DI void stage_rc(int b, int& R, int& C) { const int st = b / 1024, sb = b % 1024, swz = sb ^ (((sb >> 9) & 1) << 5); R = (st >> 1) * 16 + swz / 64; C = (st & 1) * 32 + (swz % 64) / 2; }
DI int perm32(int rho) { const int n = rho >> 4, i = rho & 15; return 8 * (i >> 2) + 4 * n + (i & 3); }
struct Unit { int pm, pn; };
struct Gemm { const bf16_t* A; const bf16_t* Bt; int M, N, K; };
struct StaticOrder {
    int nM, nN, nwg, G, c;
    DI void init(int M, int N, int G_, int c_) { nM = M / BM; nN = N / BM; nwg = nM * nN; G = G_; c = c_; }
    DI bool next(int i, Unit& u) const {
        const long L = (long)i * G + c; if (L >= nwg) return false;
        int wgid = (int)L; { const int q = nwg / NXCD, r = nwg % NXCD, xcd = wgid % NXCD, off = wgid / NXCD; wgid = (xcd < r ? xcd * (q + 1) : r * (q + 1) + (xcd - r) * q) + off; }
        const int nig = WGM * nN, gid = wgid / nig, fm = gid * WGM, gsz = (nM - fm) < WGM ? (nM - fm) : WGM;
        u.pm = fm + ((wgid % nig) % gsz); u.pn = (wgid % nig) / gsz; return true;
    }
};
template <class Epi>
DI void gemm_phase(LAS unsigned char* lds, const Gemm g, const StaticOrder& S, const Epi& E) {
    int tid = threadIdx.x; asm volatile("" : "+v"(tid));
    const int wid = __builtin_amdgcn_readfirstlane(tid >> 6), lane = tid & 63, wr = wid >> 2, wc = wid & 3, fr = lane & 15, fq = lane >> 4;
    const int K = g.K, nt = K / BK;
    unsigned voffA[2], voffB[2];
#pragma unroll
    for (int i = 0; i < 2; ++i) { int R, C; stage_rc(tid * 16 + i * 8192, R, C); const int Rb = (R & ~31) + perm32(R & 31);
        voffA[i] = (unsigned)(R * K + C) * 2u; voffB[i] = (unsigned)(Rb * K + C) * 2u; }
    const size_t kstep = (size_t)(BK * 2);
    const size_t hstep = (size_t)HALF * K * 2;
    const size_t tstep = 2 * hstep;
    const unsigned ldsw = (unsigned)wid * 1024u;
    const int aoff = lds_byte(wr * 64 + fr, fq * 8), boff = lds_byte(wc * 32 + fr, fq * 8);
#define PG8_SA(b, h) (((b) * 2 + (h)) * HTB)
#define PG8_SB(b, h) ((4 + (b) * 2 + (h)) * HTB)
#define PG8_STAGE(bufoff, gbase, voff) do { _Pragma("unroll") for (int _i = 0; _i < 2; ++_i) \
        __builtin_amdgcn_global_load_lds((const unsigned*)((const char*)(gbase) + (voff)[_i]), (LAS unsigned*)(lds + (bufoff) + ldsw + _i * 8192), 16, 0, 0); } while (0)
#define PG8_LDA(dst, b, h) do { _Pragma("unroll") for (int m = 0; m < 4; ++m) _Pragma("unroll") for (int k = 0; k < 2; ++k) dst[m][k] = *(const LAS bf16x8*)(lds + PG8_SA(b, h) + aoff + m * 2048 + k * 1024); } while (0)
#define PG8_LDB(dst, b, h) do { _Pragma("unroll") for (int n = 0; n < 2; ++n) _Pragma("unroll") for (int k = 0; k < 2; ++k) dst[n][k] = *(const LAS bf16x8*)(lds + PG8_SB(b, h) + boff + n * 2048 + k * 1024); } while (0)
#define PG8_MMA(ai, bj, At, Bt) do { __builtin_amdgcn_s_setprio(1); _Pragma("unroll") for (int m = 0; m < 4; ++m) _Pragma("unroll") for (int n = 0; n < 2; ++n) _Pragma("unroll") for (int k = 0; k < 2; ++k) \
        acc[ai][bj][m][n] = __builtin_amdgcn_mfma_f32_16x16x32_bf16(Bt[n][k], At[m][k], acc[ai][bj][m][n], 0, 0, 0); __builtin_amdgcn_s_setprio(0); } while (0)
#define PG8_WAIT_V(n) asm volatile("s_waitcnt vmcnt(" #n ")" ::: "memory")
#define PG8_WAIT_L(n) asm volatile("s_waitcnt lgkmcnt(" #n ")" ::: "memory")
#define PG8_BAR __builtin_amdgcn_s_barrier()
#define PG8_SCHED __builtin_amdgcn_sched_barrier(0)
    Unit cur, nxt; int ui = 0;
    if (!S.next(0, cur)) return;
    f32x4 acc[2][2][4][2];
#pragma unroll
    for (int a = 0; a < 2; ++a)
#pragma unroll
        for (int b = 0; b < 2; ++b)
#pragma unroll
            for (int m = 0; m < 4; ++m)
#pragma unroll
                for (int n = 0; n < 2; ++n) acc[a][b][m][n] = (f32x4){0.f, 0.f, 0.f, 0.f};
    bf16x8 At[4][2], B0[2][2], B1[2][2];
    const char* cA = (const char*)g.A + (size_t)cur.pm * tstep; const char* cB = (const char*)g.Bt + (size_t)cur.pn * tstep;
    PG8_STAGE(PG8_SB(0, 0), cB, voffB); PG8_STAGE(PG8_SA(0, 0), cA, voffA); PG8_STAGE(PG8_SB(0, 1), cB + hstep, voffB); PG8_STAGE(PG8_SA(0, 1), cA + hstep, voffA);
    if (wr == 1) PG8_BAR;
    PG8_WAIT_V(4); PG8_BAR;
    PG8_STAGE(PG8_SB(1, 0), cB + kstep, voffB); PG8_STAGE(PG8_SA(1, 0), cA + kstep, voffA); PG8_STAGE(PG8_SB(1, 1), cB + hstep + kstep, voffB);
    PG8_WAIT_V(6); PG8_BAR;
    for (;;) {
        const bool has_next = S.next(ui + 1, nxt);
        const char* nA = has_next ? (const char*)g.A + (size_t)nxt.pm * tstep : cA; const char* nB = has_next ? (const char*)g.Bt + (size_t)nxt.pn * tstep : cB;
        for (int t = 0; t < nt; t += 2) {
            const bool last = (t == nt - 2);
            const char* a1 = cA + (size_t)(t + 1) * kstep;
            const char* a2 = last ? nA : cA + (size_t)(t + 2) * kstep; const char* b2 = last ? nB : cB + (size_t)(t + 2) * kstep;
            const char* a3 = a2 + kstep; const char* b3 = b2 + kstep;
            PG8_LDB(B0, 0, 0); PG8_SCHED; PG8_LDA(At, 0, 0); PG8_STAGE(PG8_SA(1, 1), a1 + hstep, voffA);
            PG8_WAIT_L(8); PG8_BAR; PG8_WAIT_L(0); PG8_MMA(0, 0, At, B0); PG8_BAR; PG8_SCHED;
            PG8_LDB(B1, 0, 1); PG8_STAGE(PG8_SB(0, 0), b2, voffB);
            PG8_BAR; PG8_WAIT_L(0); PG8_MMA(0, 1, At, B1); PG8_BAR;
            PG8_LDA(At, 0, 1); PG8_STAGE(PG8_SA(0, 0), a2, voffA);
            PG8_BAR; PG8_WAIT_L(0); PG8_MMA(1, 0, At, B0); PG8_BAR; PG8_SCHED;
            PG8_STAGE(PG8_SB(0, 1), b2 + hstep, voffB);
            PG8_WAIT_V(6); PG8_BAR; PG8_MMA(1, 1, At, B1); PG8_BAR;
            PG8_LDB(B0, 1, 0); PG8_SCHED; PG8_LDA(At, 1, 0); PG8_STAGE(PG8_SA(0, 1), a2 + hstep, voffA);
            PG8_WAIT_L(8); PG8_BAR; PG8_WAIT_L(0); PG8_MMA(0, 0, At, B0); PG8_BAR; PG8_SCHED;
            PG8_LDB(B1, 1, 1); PG8_STAGE(PG8_SB(1, 0), b3, voffB);
            PG8_BAR; PG8_WAIT_L(0); PG8_MMA(0, 1, At, B1); PG8_BAR;
            PG8_LDA(At, 1, 1); PG8_STAGE(PG8_SA(1, 0), a3, voffA);
            PG8_BAR; PG8_WAIT_L(0); PG8_MMA(1, 0, At, B0); PG8_BAR; PG8_SCHED;
            PG8_STAGE(PG8_SB(1, 1), b3 + hstep, voffB);
            PG8_WAIT_V(6); PG8_BAR; PG8_MMA(1, 1, At, B1); PG8_BAR;
        }
        E(acc, cur, wr, wc, fr, fq);
        if (!has_next) break;
#pragma unroll
        for (int a = 0; a < 2; ++a)
#pragma unroll
            for (int b = 0; b < 2; ++b)
#pragma unroll
                for (int m = 0; m < 4; ++m)
#pragma unroll
                    for (int n = 0; n < 2; ++n) acc[a][b][m][n] = (f32x4){0.f, 0.f, 0.f, 0.f};
        cur = nxt; cA = nA; cB = nB; ++ui;
    }
    PG8_WAIT_V(0);
    if (wr == 0) PG8_BAR;
    PG8_BAR;
#undef PG8_SA
#undef PG8_SB
#undef PG8_STAGE
#undef PG8_LDA
#undef PG8_LDB
#undef PG8_MMA
#undef PG8_WAIT_V
#undef PG8_WAIT_L
#undef PG8_BAR
#undef PG8_SCHED
}
struct EpiScaleBf16 {
    bf16_t* O; int ldc; const float* ssq; int act; float* vss;
    DI void operator()(const f32x4 (&acc)[2][2][4][2], const Unit& u, int wr, int wc, int fr, int fq) const {
        const int row0 = u.pm * BM + wr * 64 + fr, col0 = u.pn * BM + wc * 32 + 8 * fq;
#pragma unroll
        for (int ai = 0; ai < 2; ++ai)
#pragma unroll
            for (int m = 0; m < 4; ++m) { const int row = row0 + ai * HALF + m * 16; const float rs = rsqrtf(ssq_sum(ssq + (size_t)row * 16) * (1.0f / DM) + EPS);
                bf16_t* rowp = O + (size_t)row * ldc + col0; float vs = 0.f;
#pragma unroll
                for (int bj = 0; bj < 2; ++bj) { f32x4 v0 = acc[ai][bj][m][0] * rs, v1 = acc[ai][bj][m][1] * rs;
                    if (act) {
#pragma unroll
                        for (int j = 0; j < 4; ++j) { const float a = fmaxf(v0[j], 0.f), b = fmaxf(v1[j], 0.f); v0[j] = a * a; v1[j] = b * b; } }
                    u32x4 w; w.x = pk2(v0[0], v0[1]); w.y = pk2(v0[2], v0[3]); w.z = pk2(v1[0], v1[1]); w.w = pk2(v1[2], v1[3]);
                    *(u32x4*)(rowp + bj * HALF) = w;
                    vs += (v0[0] * v0[0] + v0[1] * v0[1]) + (v0[2] * v0[2] + v0[3] * v0[3]) + (v1[0] * v1[0] + v1[1] * v1[1]) + (v1[2] * v1[2] + v1[3] * v1[3]); }
                if (vss != nullptr && u.pn >= 10) { vs += __shfl_xor(vs, 16); vs += __shfl_xor(vs, 32); if (fq == 0) vss[(size_t)row * 8 + (u.pn - 10) * 4 + wc] = vs; } }
    }
};
struct EpiResid {
    const float* base; float* out; bf16_t* xb; float* ssq;
    DI void operator()(const f32x4 (&acc)[2][2][4][2], const Unit& u, int wr, int wc, int fr, int fq) const {
        const int row0 = u.pm * BM + wr * 64 + fr, col0 = u.pn * BM + wc * 32 + 8 * fq;
#pragma unroll
        for (int ai = 0; ai < 2; ++ai)
#pragma unroll
            for (int m = 0; m < 4; ++m) { const int row = row0 + ai * HALF + m * 16; const size_t off = (size_t)row * DM + col0; float ss = 0.f;
#pragma unroll
                for (int bj = 0; bj < 2; ++bj) {
                    const f32x4 b0 = *(const f32x4*)(base + off + bj * HALF), b1 = *(const f32x4*)(base + off + bj * HALF + 4);
                    const f32x4 o0 = b0 + acc[ai][bj][m][0], o1 = b1 + acc[ai][bj][m][1];
                    *(f32x4*)(out + off + bj * HALF) = o0; *(f32x4*)(out + off + bj * HALF + 4) = o1;
                    u32x4 w; w.x = pk2(o0[0], o0[1]); w.y = pk2(o0[2], o0[3]); w.z = pk2(o1[0], o1[1]); w.w = pk2(o1[2], o1[3]);
                    *(u32x4*)(xb + off + bj * HALF) = w;
                    ss += (o0[0] * o0[0] + o0[1] * o0[1]) + (o0[2] * o0[2] + o0[3] * o0[3]) + (o1[0] * o1[0] + o1[1] * o1[1]) + (o1[2] * o1[2] + o1[3] * o1[3]); }
                ss += __shfl_xor(ss, 16); ss += __shfl_xor(ss, 32);
                if (fq == 0) ssq[(size_t)row * 16 + u.pn * 4 + wc] = ss;
                asm volatile("" ::: "memory"); }
    }
};
}

struct Args { const float* in[18]; float* out; unsigned char* ws; int ph_lo, ph_hi; };
struct Ctx {
    const float *x_prompt, *x_sample, *state_delta, *state_conv, *norm_mix_g, *w_in, *conv_w, *A_log, *dt_bias, *o_norm_g, *v_norm_g, *w_s, *b_s, *w_o, *norm_ffn_g, *w_up, *w_down, *norm_f_g;
    float* out; unsigned char* ws;
    int lane, wave, gw, ngw;
};
#define WSP(T, off) ((T*)(c.ws + (off)))

DI void transpose_item(const float* W, int K, int N, const float* kscale, bf16_t* WT, bf16_t* WAB, int mode, int item, int nblk, LAS float* scr, int lane) {
    const int kb = item / nblk, nb = item % nblk, k0 = 64 * kb, n0 = 32 * nb;
    const int nl = lane & 31, nsrc = n0 + nl;
#pragma unroll 8
    for (int i = 0; i < 32; ++i) { const int kk = 2 * i + (lane >> 5);
        float v = 0.f; if (nsrc < N) { v = W[(size_t)(k0 + kk) * N + nsrc]; if (kscale) v *= kscale[k0 + kk]; }
        scr[kk * 33 + nl] = v; }
    asm volatile("s_waitcnt lgkmcnt(0)" ::: "memory");
    const int cch = lane & 7;
#pragma unroll
    for (int j = 0; j < 4; ++j) { const int n = (lane >> 3) + 8 * j, ns = n0 + n; const LAS float* s = scr + (8 * cch) * 33 + n;
        u32x4 o; o.x = pk2(s[0 * 33], s[1 * 33]); o.y = pk2(s[2 * 33], s[3 * 33]); o.z = pk2(s[4 * 33], s[5 * 33]); o.w = pk2(s[6 * 33], s[7 * 33]);
        if (ns < N) {
            bf16_t* rowp;
            if (mode == 0) rowp = WT + (size_t)ns * K;
            else rowp = ns < 2048 ? WT + (size_t)ns * K : (ns < 2056 ? WAB + (size_t)(ns - 2048) * K : WT + (size_t)(ns - 8) * K);
            *(u32x4*)(rowp + k0 + 8 * cch) = o; } }
    asm volatile("s_waitcnt lgkmcnt(0)" ::: "memory");
}
DI void phase_prologue(const Ctx& c, LAS unsigned char* lds) {
    LAS float* scr = (LAS float*)(lds + c.wave * 16384);
    constexpr int I_IN = 16 * 97, I_O = 16 * 32, I_UP = 16 * 128, I_DN = 64 * 32, I_L = I_IN + I_O + I_UP + I_DN;
    for (int it = c.gw; it < DEPTH * I_L; it += c.ngw) {
        const int l = it / I_L; int r = it % I_L;
        if (r < I_IN) { transpose_item(c.w_in + (size_t)l * DM * PROJ, DM, PROJ, c.norm_mix_g + l * DM, WSP(bf16_t, WS_WIN) + (size_t)l * NP * DM, WSP(bf16_t, WS_WAB) + (size_t)l * 16 * DM, 1, r, 97, scr, c.lane); continue; } r -= I_IN;
        if (r < I_O) { transpose_item(c.w_o + (size_t)l * DM * DM, DM, DM, nullptr, WSP(bf16_t, WS_WO) + (size_t)l * DM * DM, nullptr, 0, r, 32, scr, c.lane); continue; } r -= I_O;
        if (r < I_UP) { transpose_item(c.w_up + (size_t)l * DM * FF, DM, FF, c.norm_ffn_g + l * DM, WSP(bf16_t, WS_WUP) + (size_t)l * FF * DM, nullptr, 0, r, 128, scr, c.lane); continue; } r -= I_UP;
        transpose_item(c.w_down + (size_t)l * FF * DM, FF, DM, nullptr, WSP(bf16_t, WS_WDN) + (size_t)l * DM * FF, nullptr, 0, r, 32, scr, c.lane);
    }
    float* ssq = WSP(float, WS_SSQ);
    for (int m = c.gw; m < MP; m += c.ngw) {
        const f32x4* xr = (const f32x4*)(c.x_prompt + (size_t)m * DM) + c.lane; u32x2* o8 = (u32x2*)(WSP(bf16_t, WS_XB16) + (size_t)m * DM) + c.lane; float s = 0.f;
#pragma unroll
        for (int j = 0; j < 4; ++j) { const f32x4 v = xr[64 * j]; s += (v.x * v.x + v.y * v.y) + (v.z * v.z + v.w * v.w); u32x2 w; w.x = pk2(v.x, v.y); w.y = pk2(v.z, v.w); o8[64 * j] = w; }
        s = wave_sum(s); if (c.lane < 16) ssq[(size_t)m * 16 + c.lane] = c.lane == 0 ? s : 0.f;
    }
    const int gt = c.gw * 64 + c.lane, ngt = c.ngw * 64;
    float* xs = WSP(float, WS_XS);
    for (int i = gt; i < SBATCH * DM; i += ngt) xs[i] = c.x_sample[i];
    bf16_t* wab = WSP(bf16_t, WS_WAB);
    for (int i = gt; i < DEPTH * 8 * DM; i += ngt) { const int l = i / (8 * DM), r = i % (8 * DM); wab[(size_t)l * 16 * DM + 8 * DM + r] = 0; }
    unsigned* wm = WSP(unsigned, WS_WM);
    for (int i = gt; i < DEPTH * 4 * 128 * 64; i += ngt) { const int e = 2 * i, ii = (e >> 7) & 127, jj = e & 127;
        const float a = ii >= jj ? c.w_s[e] : 0.f, b = ii >= jj + 1 ? c.w_s[e + 1] : 0.f; wm[i] = pk2(a, b); }
}

template <int NT, bool NORM, int EPI>
DI void sgemm_block(const Ctx& c, const float* A, int lda, int K, const bf16_t* Bt, int ncg, float* out, int ldo, LAS unsigned char* lds, const bf16_t* Bab) {
    int lane = c.lane; asm volatile("" : "+v"(lane));
    const int wave = c.wave, fr = lane & 15, fq = lane >> 4;
    LAS f32x4* red = (LAS f32x4*)lds;
    LAS float* ssr = (LAS float*)(lds + 8 * NT * 64 * 16);
    const int kw = K / 8, k0 = wave * kw;
    for (int u = blockIdx.x; u < 8 * ncg; u += gridDim.x) {
        const int rt = u & 7, cg = u >> 3;
        const bool abg = (Bab != nullptr) && (cg == ncg - 1);
        const bf16_t* bp = (abg ? Bab : Bt + (size_t)cg * NT * 16 * K) + (size_t)fr * K + k0 + 8 * fq;
        const float* ap = A + (size_t)(rt * 16 + fr) * lda + k0 + 8 * fq;
        f32x4 acc[NT]; float ss = 0.f;
#pragma unroll
        for (int nt = 0; nt < NT; ++nt) acc[nt] = (f32x4){0.f, 0.f, 0.f, 0.f};
#pragma unroll 4
        for (int k = 0; k < kw; k += 32) {
            const f32x4 a0 = *(const f32x4*)(ap + k), a1 = *(const f32x4*)(ap + k + 4);
            if (NORM) ss += (a0.x * a0.x + a0.y * a0.y) + (a0.z * a0.z + a0.w * a0.w) + (a1.x * a1.x + a1.y * a1.y) + (a1.z * a1.z + a1.w * a1.w);
            u32x4 a; a.x = pk2(a0.x, a0.y); a.y = pk2(a0.z, a0.w); a.z = pk2(a1.x, a1.y); a.w = pk2(a1.z, a1.w);
#pragma unroll
            for (int nt = 0; nt < NT; ++nt) if (nt == 0 || !abg) { const bf16x8 bf = *(const bf16x8*)(bp + (size_t)nt * 16 * K + k); acc[nt] = MFMA16(as_bf(a), bf, acc[nt]); }
        }
        if (NORM) { ss += __shfl_xor(ss, 16); ss += __shfl_xor(ss, 32); if (fq == 0) ssr[wave * 16 + fr] = ss; }
#pragma unroll
        for (int nt = 0; nt < NT; ++nt) red[(wave * NT + nt) * 64 + lane] = acc[nt];
        __syncthreads();
        if (wave < NT && (wave == 0 || !abg)) {
            f32x4 t = red[wave * 64 + lane];
#pragma unroll
            for (int w = 1; w < 8; ++w) t += red[(w * NT + wave) * 64 + lane];
            const int col = (cg * NT + wave) * 16 + fr;
#pragma unroll
            for (int j = 0; j < 4; ++j) { const int rl = 4 * fq + j; float rs = 1.f;
                if (NORM) { float sq = 0.f;
#pragma unroll
                    for (int w = 0; w < 8; ++w) sq += ssr[w * 16 + rl];
                    rs = rsqrtf(sq * (1.0f / DM) + EPS); }
                float* o = out + (size_t)(rt * 16 + rl) * ldo + col;
                if (EPI == 0) *o = t[j] * rs; else if (EPI == 1) *o += t[j]; else { const float v = fmaxf(t[j] * rs, 0.f); *o = v * v; } }
        }
        __syncthreads();
    }
}
DI void sgemm1(const Ctx& c, int l, LAS unsigned char* lds) {
    sgemm_block<4, true, 0>(c, WSP(float, WS_XS), DM, DM, WSP(bf16_t, WS_WIN) + (size_t)l * NP * DM, 49, WSP(float, WS_PS), NPS, lds, WSP(bf16_t, WS_WAB) + (size_t)l * 16 * DM);
}
DI void sgemm2(const Ctx& c, int l, LAS unsigned char* lds) {
    sgemm_block<2, false, 1>(c, WSP(float, WS_AMIXS), DM, DM, WSP(bf16_t, WS_WO) + (size_t)l * DM * DM, 32, WSP(float, WS_XS), DM, lds, nullptr);
}
DI void sgemm3(const Ctx& c, int l, LAS unsigned char* lds) {
    sgemm_block<4, true, 2>(c, WSP(float, WS_XS), DM, DM, WSP(bf16_t, WS_WUP) + (size_t)l * FF * DM, 64, WSP(float, WS_HS), FF, lds, nullptr);
}
DI void sgemm4(const Ctx& c, int l, LAS unsigned char* lds) {
    sgemm_block<2, false, 1>(c, WSP(float, WS_HS), FF, FF, WSP(bf16_t, WS_WDN) + (size_t)l * DM * FF, 32, WSP(float, WS_XS), DM, lds, nullptr);
}

DI void b0_task_ab(const Ctx& c, int l, int b, int n) {
    const int fr = c.lane & 15, fq = c.lane >> 4, tok0 = b * SEQ + n * 64;
    const bf16_t* ap = WSP(bf16_t, WS_XB16) + (size_t)(tok0 + fr) * DM + 8 * fq;
    const bf16_t* bp = WSP(bf16_t, WS_WAB) + (size_t)l * 16 * DM + (size_t)fr * DM + 8 * fq;
    f32x4 acc[4];
#pragma unroll
    for (int mt = 0; mt < 4; ++mt) acc[mt] = (f32x4){0.f, 0.f, 0.f, 0.f};
#pragma unroll 4
    for (int k = 0; k < DM; k += 32) {
        const bf16x8 bf = *(const bf16x8*)(bp + k);
#pragma unroll
        for (int mt = 0; mt < 4; ++mt) { const bf16x8 a = *(const bf16x8*)(ap + (size_t)mt * 16 * DM + k); acc[mt] = MFMA16(a, bf, acc[mt]); }
    }
    const float* ssq = WSP(float, WS_SSQ) + (size_t)(2 * l) * MP * 16;
    float* gb = WSP(float, WS_G); float* bb = WSP(float, WS_BETA);
    if (fr < 8) { const int hh = fr & 3; const float al = -__expf(c.A_log[l * 4 + hh]), dtb = c.dt_bias[l * 4 + hh];
#pragma unroll
        for (int mt = 0; mt < 4; ++mt)
#pragma unroll
            for (int j = 0; j < 4; ++j) { const int tok = tok0 + 16 * mt + 4 * fq + j; const float v = acc[mt][j] * rsqrtf(ssq_sum(ssq + (size_t)tok * 16) * (1.0f / DM) + EPS);
                if (fr < 4) gb[tok * 4 + hh] = al * softplus_f(v + dtb); else bb[tok * 4 + hh] = sigmoid_f(v); } }
}
constexpr int B0_STRIDE = 272, B0_WAVE_LDS = 18432;
DI void b0_task_conv(const Ctx& c, int l, int b, int n, int s, int hh, LAS unsigned char* wl) {
    int lane = c.lane; asm volatile("" : "+v"(lane));
    const int tok0 = b * SEQ + n * 64, cb = s * 512 + hh * 128, piece = lane & 15;
    const bf16_t* P = WSP(bf16_t, WS_P) + (size_t)tok0 * NP + cb + piece * 8;
#pragma unroll
    for (int k = 0; k < 17; ++k) { const int row = 4 * k + (lane >> 4);
        if (row < 67) { u32x4 v = (u32x4){0u, 0u, 0u, 0u}; if (n > 0 || row >= 3) v = *(const u32x4*)(P + (long)(row - 3) * NP);
            *(LAS u32x4*)(wl + row * B0_STRIDE + piece * 16) = v; } }
    const float* cw = c.conv_w + (size_t)l * 4 * QKV + cb;
    float wv[4][2];
#pragma unroll
    for (int j = 0; j < 4; ++j) { wv[j][0] = cw[j * QKV + lane]; wv[j][1] = cw[j * QKV + 64 + lane]; }
    float* ocp = c.out + O_CP + ((size_t)(l * NBATCH + b) * 3) * QKV + cb;
    float ss = 0.f;
#pragma unroll
    for (int hf = 0; hf < 2; ++hf)
#pragma unroll 2
    for (int i8 = 0; i8 < 8; ++i8) { const int i = hf * 8 + i8;
        u32x4 rws[4];
#pragma unroll
        for (int j = 0; j < 4; ++j) rws[j] = *(const LAS u32x4*)(wl + (lane + j) * B0_STRIDE + i * 16);
        float y[8];
#pragma unroll
        for (int e = 0; e < 8; ++e) { const int ch = 8 * i + e; float a = 0.f;
#pragma unroll
            for (int j = 0; j < 4; ++j) { const float wsel = wv[j][hf]; const float w = __builtin_bit_cast(float, __builtin_amdgcn_readlane(__builtin_bit_cast(int, wsel), ch & 63));
                const unsigned pw = rws[j][e >> 1]; a += ((e & 1) ? bfhi(pw) : bflo(pw)) * w; }
            y[e] = silu_f(a); ss += y[e] * y[e]; }
        if (n == 31 && lane >= 61) {
#pragma unroll
            for (int e = 0; e < 8; ++e) { const unsigned pw = rws[3][e >> 1]; ocp[(size_t)(lane - 61) * QKV + 8 * i + e] = (e & 1) ? bfhi(pw) : bflo(pw); } }
        u32x4 w; w.x = pk2(y[0], y[1]); w.y = pk2(y[2], y[3]); w.z = pk2(y[4], y[5]); w.w = pk2(y[6], y[7]);
        *(LAS u32x4*)(wl + (lane + 3) * B0_STRIDE + i * 16) = w;
    }
    const float sc = s == 0 ? rsqrtf(ss + EPS) * 0.08838834764831845f : (s == 1 ? rsqrtf(ss + EPS) : 1.0f);
    const size_t unit = (size_t)((b * 4 + hh) * 32 + n);
    bf16_t* ot = (s == 1 ? WSP(bf16_t, WS_KNT) : WSP(bf16_t, WS_VT)) + unit * 128 * 64 + lane;
#pragma unroll 2
    for (int i = 0; i < 16; ++i) { const u32x4 v = *(const LAS u32x4*)(wl + (lane + 3) * B0_STRIDE + i * 16); u32x4 w;
#pragma unroll
        for (int e = 0; e < 4; ++e) w[e] = pk2(bflo(v[e]) * sc, bfhi(v[e]) * sc);
        if (s < 2) *(LAS u32x4*)(wl + (lane + 3) * B0_STRIDE + i * 16) = w;
        if (s >= 1) {
#pragma unroll
            for (int e = 0; e < 8; ++e) ot[(8 * i + e) * 64] = (bf16_t)((e & 1) ? (w[e >> 1] >> 16) : (w[e >> 1] & 0xffffu)); } }
    if (s < 2) { bf16_t* o = (s == 0 ? WSP(bf16_t, WS_QN) : WSP(bf16_t, WS_KN)) + (size_t)tok0 * 512 + hh * 128 + piece * 8;
#pragma unroll
        for (int k = 0; k < 16; ++k) { const int row = 4 * k + (lane >> 4); *(u32x4*)(o + (size_t)row * 512) = *(const LAS u32x4*)(wl + (row + 3) * B0_STRIDE + piece * 16); } }
}
DI void b0_task_vb(const Ctx& c, int l, int b, int n, int hb, LAS unsigned char* wl) {
    int lane = c.lane; asm volatile("" : "+v"(lane));
    const int tok0 = b * SEQ + n * 64, piece = lane & 15;
    const bf16_t* P = WSP(bf16_t, WS_P) + (size_t)tok0 * NP + 2560 + hb * 128 + piece * 8;
#pragma unroll
    for (int k = 0; k < 16; ++k) { const int row = 4 * k + (lane >> 4); *(LAS u32x4*)(wl + row * B0_STRIDE + piece * 16) = *(const u32x4*)(P + (size_t)row * NP); }
    const float* vp = WSP(float, WS_VSS) + (size_t)(tok0 + lane) * 8; const f32x4 p0 = *(const f32x4*)vp, p1 = *(const f32x4*)(vp + 4);
    const float rs = rsqrtf((((p0.x + p0.y) + (p0.z + p0.w)) + ((p1.x + p1.y) + (p1.z + p1.w))) * (1.0f / 512.0f) + EPS);
    const float* vg = c.v_norm_g + l * 512 + hb * 128;
    bf16_t* vbt = WSP(bf16_t, WS_VBT) + ((size_t)((b * 16 + (n >> 1)) * 4 + hb) * 128) * 128 + (n & 1) * 64 + lane;
#pragma unroll 2
    for (int i = 0; i < 16; ++i) { const u32x4 v = *(const LAS u32x4*)(wl + lane * B0_STRIDE + i * 16);
#pragma unroll
        for (int e = 0; e < 8; ++e) { const float pv = (e & 1) ? bfhi(v[e >> 1]) : bflo(v[e >> 1]); vbt[(size_t)(8 * i + e) * 128] = f2bf(pv * rs * vg[8 * i + e]); } }
}
DI void b0_task_sample(const Ctx& c, int l, int bs) {
    const float* ps = WSP(float, WS_PS) + (size_t)bs * NPS;
    if (c.lane < 4) { const int hh = c.lane;
        WSP(float, WS_GS)[bs * 4 + hh] = -__expf(c.A_log[l * 4 + hh]) * softplus_f(ps[3072 + hh] + c.dt_bias[l * 4 + hh]);
        WSP(float, WS_BS)[bs * 4 + hh] = sigmoid_f(ps[3076 + hh]); }
    const float* sc = c.state_conv + (size_t)(l * SBATCH + bs) * 3 * QKV;
    const float* cw = c.conv_w + (size_t)l * 4 * QKV;
    float* ocs = c.out + O_CS + (size_t)(l * SBATCH + bs) * 3 * QKV;
    float* qkvs = WSP(float, WS_QS) + bs * 512;
#pragma unroll 1
    for (int sh = 0; sh < 12; ++sh) {
        float y[2];
#pragma unroll
        for (int t = 0; t < 2; ++t) { const int ch = sh * 128 + t * 64 + c.lane; const float s0 = sc[ch], s1 = sc[QKV + ch], s2 = sc[2 * QKV + ch], cur = ps[ch];
            ocs[ch] = s1; ocs[QKV + ch] = s2; ocs[2 * QKV + ch] = cur;
            y[t] = silu_f(s0 * cw[ch] + s1 * cw[QKV + ch] + s2 * cw[2 * QKV + ch] + cur * cw[3 * QKV + ch]); }
        float scale = 1.0f;
        if (sh < 8) { const float ssum = wave_sum(y[0] * y[0] + y[1] * y[1]); scale = rsqrtf(ssum + EPS) * (sh < 4 ? 0.08838834764831845f : 1.0f); }
        float* o = qkvs + (size_t)(sh >> 2) * SBATCH * 512 + (sh & 3) * 128;
        o[c.lane] = y[0] * scale; o[64 + c.lane] = y[1] * scale;
    }
    float pv[8]; float ss = 0.f;
#pragma unroll
    for (int i = 0; i < 8; ++i) { pv[i] = ps[2560 + c.lane + 64 * i]; ss += pv[i] * pv[i]; }
    ss = wave_sum(ss); const float rs = rsqrtf(ss * (1.0f / 512.0f) + EPS);
    float* am = WSP(float, WS_AMIXS) + (size_t)bs * DM; float* ovs = c.out + O_VS + (size_t)(l * SBATCH + bs) * 512;
#pragma unroll
    for (int i = 0; i < 8; ++i) { const int ch = c.lane + 64 * i, hb = ch >> 7; const float vb = pv[i] * rs * c.v_norm_g[l * 512 + ch];
        ovs[ch] = vb; am[512 + ch] = ps[2048 + ch] * (c.w_s[(size_t)(l * 4 + hb) * 128 * 128] * vb + c.b_s[(l * 4 + hb) * 128]); }
}
DI void phase_b0(const Ctx& c, int l, LAS unsigned char* lds) {
    constexpr int NPT = 256 * 17;
    LAS unsigned char* wl = lds + c.wave * B0_WAVE_LDS;
    for (int t = c.gw; t < NPT + SBATCH; t += c.ngw) {
        if (t >= NPT) { if (SUB(0)) b0_task_sample(c, l, t - NPT); continue; }
        const int chunk = t / 17, k = t % 17, b = chunk >> 5, n = chunk & 31;
        if (k == 0) { if (SUB(1)) b0_task_ab(c, l, b, n); }
        else if (k >= 13) { if (SUB(2)) b0_task_vb(c, l, b, n, k - 13, wl); }
        else { if (SUB(3)) b0_task_conv(c, l, b, n, (k - 1) >> 2, (k - 1) & 3, wl); }
    }
}

DI void b1_prep(const Ctx& c, int l, int unit, LAS unsigned char* wl, LAS float* sg, LAS float* sb) {
    int lane = c.lane; asm volatile("" : "+v"(lane));
    const int r = lane & 31, h = lane >> 5;
    const int n = unit & 31, bh = unit >> 5, hh = bh & 3, b = bh >> 2, tok0 = b * SEQ + n * 64;
    const float bt = WSP(float, WS_BETA)[(tok0 + lane) * 4 + hh];
    float gc = WSP(float, WS_G)[(tok0 + lane) * 4 + hh];
#pragma unroll
    for (int o = 1; o < 64; o <<= 1) { const float t = __shfl_up(gc, o); if (lane >= o) gc += t; }
    sg[lane] = gc; sb[lane] = bt;
    const float glast = __shfl(gc, 63);
    if (lane == 0) WSP(float, WS_EG)[unit] = __expf(glast);
    unsigned char* img = c.ws + WS_IMG + (size_t)unit * IMG_BYTES;
    const bf16_t* Kn = WSP(bf16_t, WS_KN) + (size_t)tok0 * 512 + hh * 128;
    const bf16_t* Qn = WSP(bf16_t, WS_QN) + (size_t)tok0 * 512 + hh * 128;
    const bf16_t* KnT = WSP(bf16_t, WS_KNT) + (size_t)unit * 128 * 64;
    const bf16_t* VT = WSP(bf16_t, WS_VT) + (size_t)unit * 128 * 64;
    LAS float* L = (LAS float*)wl;
    {
        bf16x8 Kf[2][8];
#pragma unroll
        for (int t = 0; t < 2; ++t)
#pragma unroll
            for (int ks = 0; ks < 8; ++ks) Kf[t][ks] = *(const bf16x8*)(Kn + (size_t)(32 * t + r) * 512 + 16 * ks + 8 * h);
#pragma unroll
        for (int tt = 0; tt < 3; ++tt) { const int mt = tt == 0 ? 0 : 1, nt = tt == 2 ? 1 : 0;
            f32x16 acc = zero16();
#pragma unroll
            for (int ks = 0; ks < 8; ++ks) acc = MFMA32(Kf[mt][ks], Kf[nt][ks], acc);
            const int j = 32 * nt + r; const float gj = sg[j];
#pragma unroll
            for (int g4 = 0; g4 < 4; ++g4) { const f32x4 gi4 = *(const LAS f32x4*)(sg + 32 * mt + 8 * g4 + 4 * h), bi4 = *(const LAS f32x4*)(sb + 32 * mt + 8 * g4 + 4 * h);
#pragma unroll
                for (int q = 0; q < 4; ++q) { const int i = 32 * mt + 8 * g4 + 4 * h + q; const float arg = i > j ? gi4[q] - gj : 0.f;
                    L[i * 64 + j] = i > j ? acc[4 * g4 + q] * bi4[q] * __expf(arg) : 0.f; } } }
#pragma unroll
        for (int mt = 0; mt < 2; ++mt) {
            bf16x8 Qf[8];
#pragma unroll
            for (int ks = 0; ks < 8; ++ks) Qf[ks] = *(const bf16x8*)(Qn + (size_t)(32 * mt + r) * 512 + 16 * ks + 8 * h);
            const int i = 32 * mt + r; const float gi = sg[i];
#pragma unroll
            for (int mp = 0; mp <= mt; ++mp) {
                f32x16 acc = zero16();
#pragma unroll
                for (int ks = 0; ks < 8; ++ks) acc = MFMA32(Kf[mp][ks], Qf[ks], acc);
#pragma unroll
                for (int g4 = 0; g4 < 4; ++g4) { const f32x4 gj4 = *(const LAS f32x4*)(sg + 32 * mp + 8 * g4 + 4 * h);
#pragma unroll
                    for (int q = 0; q < 4; ++q) { const int j = 32 * mp + 8 * g4 + 4 * h + q; const float arg = i >= j ? gi - gj4[q] : 0.f;
                        acc[4 * g4 + q] = i >= j ? acc[4 * g4 + q] * __expf(arg) : 0.f; } }
                const int fb = (mt == 0 ? 0 : 1 + mp) * 2;
#pragma unroll
                for (int s = 0; s < 2; ++s) *(u32x4*)(img + 49152 + (fb + s) * 1024 + lane * 16) = pack8(acc, s);
            }
        }
    }
    float Tr[64];
    {
        f32x4 lb[2][16];
#pragma unroll
        for (int i = 0; i < 64; ++i) {
            if (i + 1 < 64) {
#pragma unroll
                for (int j4 = 0; j4 < (i + 1 + 3) / 4; ++j4) lb[(i + 1) & 1][j4] = *(const LAS f32x4*)(L + (i + 1) * 64 + 4 * j4); }
            asm volatile("" ::: "memory");
            float a0 = lane == i ? 1.f : 0.f, a1 = 0.f;
#pragma unroll
            for (int j4 = 0; j4 < (i + 3) / 4; ++j4) {
#pragma unroll
                for (int q = 0; q < 4; ++q) { const int j = 4 * j4 + q; if (j < i) { if (q & 1) a1 -= lb[i & 1][j4][q] * Tr[j]; else a0 -= lb[i & 1][j4][q] * Tr[j]; } } }
            Tr[i] = a0 + a1;
        }
    }
    LAS bf16_t* T1 = (LAS bf16_t*)wl;
    asm volatile("" ::: "memory");
    {
        const float sc1 = bt * __expf(gc);
#pragma unroll
        for (int i = 0; i < 64; ++i) T1[i * 72 + lane] = f2bf(Tr[i] * sc1);
        bf16x8 Tf[2][4];
#pragma unroll
        for (int mt = 0; mt < 2; ++mt)
#pragma unroll
            for (int ks = 0; ks < 4; ++ks) Tf[mt][ks] = *(const LAS bf16x8*)(T1 + (32 * mt + r) * 72 + 16 * ks + 8 * h);
#pragma unroll
        for (int dt = 0; dt < 4; ++dt) {
            bf16x8 Kt[4];
#pragma unroll
            for (int ks = 0; ks < 4; ++ks) Kt[ks] = *(const bf16x8*)(KnT + (size_t)(32 * dt + r) * 64 + 16 * ks + 8 * h);
#pragma unroll
            for (int mt = 0; mt < 2; ++mt) { f32x16 acc = zero16();
#pragma unroll
                for (int ks = 0; ks < 2 * (mt + 1); ++ks) acc = MFMA32(Kt[ks], Tf[mt][ks], acc);
                acc = -acc;
#pragma unroll
                for (int s = 0; s < 2; ++s) *(u32x4*)(img + ((mt * 4 + dt) * 2 + s) * 1024 + lane * 16) = pack8(acc, s); }
        }
    }
    asm volatile("" ::: "memory");
    {
#pragma unroll
        for (int i = 0; i < 64; ++i) T1[i * 72 + lane] = f2bf(Tr[i] * bt);
        bf16x8 Tf[2][4];
#pragma unroll
        for (int mt = 0; mt < 2; ++mt)
#pragma unroll
            for (int ks = 0; ks < 4; ++ks) Tf[mt][ks] = *(const LAS bf16x8*)(T1 + (32 * mt + r) * 72 + 16 * ks + 8 * h);
        float* uimg = WSP(float, WS_UIMG) + (size_t)unit * 8192;
#pragma unroll
        for (int et = 0; et < 4; ++et) {
            bf16x8 Vt[4];
#pragma unroll
            for (int ks = 0; ks < 4; ++ks) Vt[ks] = *(const bf16x8*)(VT + (size_t)(32 * et + r) * 64 + 16 * ks + 8 * h);
#pragma unroll
            for (int mt = 0; mt < 2; ++mt) { f32x16 acc = zero16();
#pragma unroll
                for (int ks = 0; ks < 2 * (mt + 1); ++ks) acc = MFMA32(Tf[mt][ks], Vt[ks], acc);
#pragma unroll
                for (int g4 = 0; g4 < 4; ++g4) *(f32x4*)(uimg + ((et * 2 + mt) * 4 + g4) * 256 + lane * 4) = (f32x4){acc[4 * g4], acc[4 * g4 + 1], acc[4 * g4 + 2], acc[4 * g4 + 3]}; }
        }
    }
    asm volatile("" ::: "memory");
#pragma unroll
    for (int mt = 0; mt < 2; ++mt) { const float ei = __expf(sg[32 * mt + r]);
#pragma unroll
        for (int dt = 0; dt < 4; ++dt)
#pragma unroll
            for (int s = 0; s < 2; ++s) { const bf16_t* qp = Qn + (size_t)(32 * mt + r) * 512 + 32 * dt + 16 * s + 4 * h;
                const u32x2 p0 = *(const u32x2*)qp, p1 = *(const u32x2*)(qp + 8);
                u32x4 w; w.x = pk2(bflo(p0.x) * ei, bfhi(p0.x) * ei); w.y = pk2(bflo(p0.y) * ei, bfhi(p0.y) * ei); w.z = pk2(bflo(p1.x) * ei, bfhi(p1.x) * ei); w.w = pk2(bflo(p1.y) * ei, bfhi(p1.y) * ei);
                *(u32x4*)(img + 16384 + ((mt * 4 + dt) * 2 + s) * 1024 + lane * 16) = w; } }
#pragma unroll
    for (int mp = 0; mp < 2; ++mp)
#pragma unroll
        for (int s = 0; s < 2; ++s) { const f32x4 ga = *(const LAS f32x4*)(sg + 32 * mp + 16 * s + 4 * h), gb = *(const LAS f32x4*)(sg + 32 * mp + 16 * s + 8 + 4 * h);
            float sc[8];
#pragma unroll
            for (int q = 0; q < 4; ++q) { sc[q] = __expf(glast - ga[q]); sc[4 + q] = __expf(glast - gb[q]); }
#pragma unroll
            for (int dt = 0; dt < 4; ++dt) { const bf16_t* kp = KnT + (size_t)(32 * dt + r) * 64 + 32 * mp + 16 * s + 4 * h;
                const u32x2 p0 = *(const u32x2*)kp, p1 = *(const u32x2*)(kp + 8);
                u32x4 w; w.x = pk2(bflo(p0.x) * sc[0], bfhi(p0.x) * sc[1]); w.y = pk2(bflo(p0.y) * sc[2], bfhi(p0.y) * sc[3]); w.z = pk2(bflo(p1.x) * sc[4], bfhi(p1.x) * sc[5]); w.w = pk2(bflo(p1.y) * sc[6], bfhi(p1.y) * sc[7]);
                *(u32x4*)(img + 32768 + ((dt * 2 + mp) * 2 + s) * 1024 + lane * 16) = w; } }
}
DI void b1_gmlp(const Ctx& c, int l, int unit) {
    int lane = c.lane; asm volatile("" : "+v"(lane));
    const int r = lane & 31, h = lane >> 5;
    const int hb = unit & 3, cc = (unit >> 2) & 15, b = unit >> 6, tokc0 = b * SEQ + cc * 128;
    const bf16_t* A = WSP(bf16_t, WS_VBT) + (size_t)unit * 128 * 128;
    const bf16_t* B = WSP(bf16_t, WS_WM) + (size_t)(l * 4 + hb) * 128 * 128;
    const bf16_t* P = WSP(bf16_t, WS_P); bf16_t* AM = WSP(bf16_t, WS_AMIX);
#pragma unroll
    for (int nt = 0; nt < 4; ++nt) {
        f32x16 acc[4];
#pragma unroll
        for (int mt = 0; mt < 4; ++mt) acc[mt] = zero16();
#pragma unroll
        for (int ks = 0; ks < 2 * (nt + 1); ++ks) { const bf16x8 bf = *(const bf16x8*)(B + (size_t)(32 * nt + r) * 128 + 16 * ks + 8 * h);
#pragma unroll
            for (int mt = 0; mt < 4; ++mt) { const bf16x8 af = *(const bf16x8*)(A + (size_t)(32 * mt + r) * 128 + 16 * ks + 8 * h); acc[mt] = MFMA32(af, bf, acc[mt]); } }
        const int tok = tokc0 + 32 * nt + r; const float bsi = c.b_s[(l * 4 + hb) * 128 + 32 * nt + r];
#pragma unroll
        for (int mt = 0; mt < 4; ++mt)
#pragma unroll
            for (int g4 = 0; g4 < 4; ++g4) { const int dch0 = 32 * mt + 8 * g4 + 4 * h;
                const u32x2 u4 = *(const u32x2*)(P + (size_t)tok * NP + 2048 + hb * 128 + dch0);
                u32x2 w; w.x = pk2(bflo(u4.x) * (acc[mt][4 * g4] + bsi), bfhi(u4.x) * (acc[mt][4 * g4 + 1] + bsi)); w.y = pk2(bflo(u4.y) * (acc[mt][4 * g4 + 2] + bsi), bfhi(u4.y) * (acc[mt][4 * g4 + 3] + bsi));
                *(u32x2*)(AM + (size_t)tok * DM + 512 + hb * 128 + dch0) = w; }
    }
}
DI void phase_b1(const Ctx& c, int l, LAS unsigned char* lds) {
    LAS unsigned char* wl = lds + c.wave * 16384; LAS float* sg = (LAS float*)(lds + 131072 + c.wave * 512); LAS float* sb = sg + 64;
    for (int t = c.gw; t < 1024 + 512; t += c.ngw) {
        if (t < 1024) { if (SUB(0)) b1_prep(c, l, t, wl, sg, sb); } else { if (SUB(1)) b1_gmlp(c, l, t - 1024); }
    }
}

constexpr int OB_STRIDE = 136;
constexpr int LDS_OBUF = 2 * IMG_BYTES, OBUF_BYTES = 64 * OB_STRIDE * 2;
static_assert(LDS_OBUF + 2 * OBUF_BYTES <= LDS_BYTES, "scan LDS");
DI void scan_post(const Ctx& c, int l, int b, int hh, int n, const LAS bf16_t* ob, int lid, const u32x4 (&gt4)[4]) {
    const int i = lid >> 2, q = lid & 3, tok = b * SEQ + n * 64 + i;
    u32x4 ov[4]; float ss = 0.f;
#pragma unroll
    for (int x = 0; x < 4; ++x) { ov[x] = *(const LAS u32x4*)(ob + i * OB_STRIDE + 32 * q + 8 * x);
#pragma unroll
        for (int e = 0; e < 4; ++e) { const float a = bflo(ov[x][e]), bq = bfhi(ov[x][e]); ss += a * a + bq * bq; } }
    ss += __shfl_xor(ss, 1); ss += __shfl_xor(ss, 2);
    const float rs = rsqrtf(ss * (1.0f / 128.0f) + EPS);
    bf16_t* op = WSP(bf16_t, WS_AMIX) + (size_t)tok * DM + hh * 128 + 32 * q;
    const float* og = c.o_norm_g + l * 128 + 32 * q;
#pragma unroll
    for (int x = 0; x < 4; ++x) { const u32x4 gt = gt4[x]; u32x4 w;
#pragma unroll
        for (int e = 0; e < 4; ++e) { const float o0 = bflo(ov[x][e]) * rs * og[8 * x + 2 * e] * silu_f(bflo(gt[e])), o1 = bfhi(ov[x][e]) * rs * og[8 * x + 2 * e + 1] * silu_f(bfhi(gt[e])); w[e] = pk2(o0, o1); }
        *(u32x4*)(op + 8 * x) = w; }
}
DI void scan_block(const Ctx& c, int l, int bh, LAS unsigned char* lds) {
    const int wave = c.wave, b = bh >> 2, hh = bh & 3;
    const unsigned char* img0 = c.ws + WS_IMG + (size_t)bh * 32 * IMG_BYTES;
    if (wave >= 4) { if (SUB2(0)) {
        int lane = c.lane; asm volatile("" : "+v"(lane));
        const int lw = wave - 4, lid = lw * 64 + lane;
        u32x4 regs[14]; u32x4 gtc[4], gtn[4];
        const bf16_t* gbase = WSP(bf16_t, WS_P) + (size_t)(b * SEQ + (lid >> 2)) * NP + 1536 + hh * 128 + 32 * (lid & 3);
#define LD_IMG(nn) do { _Pragma("unroll") for (int i = 0; i < 14; ++i) { const int ch = (lw + 4 * i) < 53 ? (lw + 4 * i) : 53; regs[i] = *(const u32x4*)(img0 + (size_t)(nn) * IMG_BYTES + ch * 1024 + lane * 16); } } while (0)
#define ST_IMG(bb) do { _Pragma("unroll") for (int i = 0; i < 14; ++i) { const int ch = (lw + 4 * i) < 53 ? (lw + 4 * i) : 53; *(LAS u32x4*)(lds + (bb) * IMG_BYTES + ch * 1024 + lane * 16) = regs[i]; } } while (0)
        LD_IMG(0); ST_IMG(0);
#pragma unroll
        for (int x = 0; x < 4; ++x) { gtn[x] = *(const u32x4*)(gbase + 8 * x); gtc[x] = gtn[x]; }
        LD_IMG(1);
        __syncthreads();
        for (int n = 0; n < 32; ++n) {
            if (n + 1 < 32) ST_IMG((n + 1) & 1);
            if (n >= 1) scan_post(c, l, b, hh, n - 1, (const LAS bf16_t*)(lds + LDS_OBUF + ((n - 1) & 1) * OBUF_BYTES), lid, gtc);
#pragma unroll
            for (int x = 0; x < 4; ++x) gtc[x] = gtn[x];
            if (n + 1 < 32) {
#pragma unroll
                for (int x = 0; x < 4; ++x) gtn[x] = *(const u32x4*)(gbase + (size_t)(n + 1) * 64 * NP + 8 * x); }
            if (n + 2 < 32) LD_IMG(n + 2);
            __syncthreads();
        }
        scan_post(c, l, b, hh, 31, (const LAS bf16_t*)(lds + LDS_OBUF + (31 & 1) * OBUF_BYTES), lid, gtc);
#undef LD_IMG
#undef ST_IMG
    } } else if (SUB2(1)) {
        int lane = c.lane; asm volatile("" : "+v"(lane));
        const int ws = wave, r = lane & 31, h = lane >> 5;
        f32x16 S[4];
#pragma unroll
        for (int dt = 0; dt < 4; ++dt) S[dt] = zero16();
        const float* uimg0 = WSP(float, WS_UIMG) + (size_t)bh * 32 * 8192 + (size_t)ws * 2 * 4 * 256 + lane * 4;
        const float* egp = WSP(float, WS_EG) + bh * 32;
        f32x16 un[2];
#pragma unroll
        for (int mt = 0; mt < 2; ++mt)
#pragma unroll
            for (int g4 = 0; g4 < 4; ++g4) { const f32x4 v = *(const f32x4*)(uimg0 + (mt * 4 + g4) * 256); un[mt][4 * g4] = v.x; un[mt][4 * g4 + 1] = v.y; un[mt][4 * g4 + 2] = v.z; un[mt][4 * g4 + 3] = v.w; }
        float eg_n = egp[0];
        __syncthreads();
        for (int n = 0; n < 32; ++n) {
            const LAS unsigned char* buf = lds + (n & 1) * IMG_BYTES + lane * 16;
            f32x16 av[2], ao[2]; av[0] = un[0]; av[1] = un[1]; ao[0] = zero16(); ao[1] = zero16();
            const float eg = eg_n;
            if (n + 1 < 32) { const float* up = uimg0 + (size_t)(n + 1) * 8192;
#pragma unroll
                for (int mt = 0; mt < 2; ++mt)
#pragma unroll
                    for (int g4 = 0; g4 < 4; ++g4) { const f32x4 v = *(const f32x4*)(up + (mt * 4 + g4) * 256); un[mt][4 * g4] = v.x; un[mt][4 * g4 + 1] = v.y; un[mt][4 * g4 + 2] = v.z; un[mt][4 * g4 + 3] = v.w; }
                eg_n = egp[n + 1]; }
#pragma unroll
            for (int pass = 0; pass < 2; ++pass) {
                const LAS unsigned char* fb = buf + pass * 16384;
                bf16x8 fg[2][2];
#pragma unroll
                for (int mt = 0; mt < 2; ++mt) fg[0][mt] = *(const LAS bf16x8*)(fb + (mt * 8) * 1024);
#pragma unroll
                for (int gI = 0; gI < 8; ++gI) { const int dt = gI >> 1, s = gI & 1;
                    if (gI + 1 < 8) {
#pragma unroll
                        for (int mt = 0; mt < 2; ++mt) fg[(gI + 1) & 1][mt] = *(const LAS bf16x8*)(fb + (mt * 8 + gI + 1) * 1024); }
                    asm volatile("" ::: "memory");
                    const bf16x8 sb = as_bf(pack8(S[dt], s));
                    if (pass == 0) { av[0] = MFMA32(fg[gI & 1][0], sb, av[0]); av[1] = MFMA32(fg[gI & 1][1], sb, av[1]); }
                    else { ao[0] = MFMA32(fg[gI & 1][0], sb, ao[0]); ao[1] = MFMA32(fg[gI & 1][1], sb, ao[1]); } }
            }
            bf16x8 vb[2][2];
#pragma unroll
            for (int mp = 0; mp < 2; ++mp)
#pragma unroll
                for (int s = 0; s < 2; ++s) vb[mp][s] = as_bf(pack8(av[mp], s));
            {
                bf16x8 qf[6];
#pragma unroll
                for (int f = 0; f < 6; ++f) qf[f] = *(const LAS bf16x8*)(buf + 49152 + f * 1024);
                asm volatile("" ::: "memory");
#pragma unroll
                for (int s = 0; s < 2; ++s) { ao[0] = MFMA32(qf[s], vb[0][s], ao[0]); ao[1] = MFMA32(qf[2 + s], vb[0][s], ao[1]); ao[1] = MFMA32(qf[4 + s], vb[1][s], ao[1]); }
            }
            LAS bf16_t* ob = (LAS bf16_t*)(lds + LDS_OBUF + (n & 1) * OBUF_BYTES);
#pragma unroll
            for (int mt = 0; mt < 2; ++mt)
#pragma unroll
                for (int reg = 0; reg < 16; ++reg) ob[(32 * mt + crow(reg, h)) * OB_STRIDE + 32 * ws + r] = f2bf(ao[mt][reg]);
            bf16x8 kf[2][4];
#pragma unroll
            for (int f = 0; f < 4; ++f) kf[0][f] = *(const LAS bf16x8*)(buf + 32768 + f * 1024);
#pragma unroll
            for (int dt = 0; dt < 4; ++dt) {
                if (dt + 1 < 4) {
#pragma unroll
                    for (int f = 0; f < 4; ++f) kf[(dt + 1) & 1][f] = *(const LAS bf16x8*)(buf + 32768 + ((dt + 1) * 4 + f) * 1024); }
                asm volatile("" ::: "memory");
                S[dt] = S[dt] * eg;
#pragma unroll
                for (int mp = 0; mp < 2; ++mp)
#pragma unroll
                    for (int s = 0; s < 2; ++s) S[dt] = MFMA32(kf[dt & 1][mp * 2 + s], vb[mp][s], S[dt]); }
            __syncthreads();
        }
        const char* od = (const char*)(c.out + O_DP + (size_t)(l * 32 + bh) * 128 * 128);
        unsigned voff = (unsigned)((4 * h) * 128 + 32 * ws + r) * 4u;
        asm volatile("" : "+v"(voff));
#pragma unroll
        for (int dt = 0; dt < 4; ++dt)
#pragma unroll
            for (int reg = 0; reg < 16; ++reg) *(float*)(od + (32 * dt + (reg & 3) + 8 * (reg >> 2)) * 512 + voff) = S[dt][reg];
    }
}
DI void sample_recurrent(const Ctx& c, int l, int unit) {
    const int lane = c.lane, bs = unit >> 2, hh = unit & 3, e2 = 2 * lane;
    const float* S0 = c.state_delta + (size_t)((l * SBATCH + bs) * 4 + hh) * 128 * 128 + e2;
    float* S1 = c.out + O_DS + (size_t)((l * SBATCH + bs) * 4 + hh) * 128 * 128 + e2;
    const float* q = WSP(float, WS_QS) + bs * 512 + hh * 128; const float* k = WSP(float, WS_KS) + bs * 512 + hh * 128; const float* v = WSP(float, WS_VS) + bs * 512 + hh * 128;
    const float eg = __expf(WSP(float, WS_GS)[bs * 4 + hh]), beta = WSP(float, WS_BS)[bs * 4 + hh];
    f32x2 kv = {0.f, 0.f};
#pragma unroll 32
    for (int d = 0; d < 128; ++d) { const f32x2 s = *(const f32x2*)(S0 + d * 128); kv += s * k[d]; }
    const f32x2 v2 = *(const f32x2*)(v + e2);
    const f32x2 delta = (v2 - kv * eg) * beta;
    f32x2 oo = {0.f, 0.f};
#pragma unroll 32
    for (int d = 0; d < 128; ++d) { const f32x2 s = *(const f32x2*)(S0 + d * 128); const f32x2 sn = s * eg + delta * k[d]; oo += sn * q[d]; *(f32x2*)(S1 + d * 128) = sn; }
    const float ss = wave_sum(oo.x * oo.x + oo.y * oo.y); const float rs = rsqrtf(ss * (1.0f / 128.0f) + EPS);
    const float* ps = WSP(float, WS_PS) + (size_t)bs * NPS + 1536 + hh * 128 + e2; float* am = WSP(float, WS_AMIXS) + (size_t)bs * DM + hh * 128 + e2;
    const float* og = c.o_norm_g + l * 128 + e2;
    am[0] = oo.x * rs * og[0] * silu_f(ps[0]); am[1] = oo.y * rs * og[1] * silu_f(ps[1]);
}
DI void phase_scan(const Ctx& c, int l, LAS unsigned char* lds) {
    if (blockIdx.x < 32) { if (SUB(0)) scan_block(c, l, blockIdx.x, lds); return; }
    const int w0 = (blockIdx.x - 32) * 8 + c.wave, nw = (gridDim.x - 32) * 8;
    for (int u = w0; u < SBATCH * 4; u += nw) { if (SUB(1)) sample_recurrent(c, l, u); }
}

DI void phase_final(const Ctx& c) {
    for (int m = c.gw; m < MP + SBATCH; m += c.ngw) {
        const float* src = m < MP ? WSP(float, WS_XBUF) + (size_t)m * DM : WSP(float, WS_XS) + (size_t)(m - MP) * DM;
        float* dst = m < MP ? c.out + O_YP + (size_t)m * DM : c.out + O_YS + (size_t)(m - MP) * DM;
        const f32x4* xr = (const f32x4*)src + c.lane; const f32x4* gr = (const f32x4*)c.norm_f_g + c.lane; f32x4 v[4]; float s = 0.f;
#pragma unroll
        for (int j = 0; j < 4; ++j) { v[j] = xr[64 * j];
            s += (v[j].x * v[j].x + v[j].y * v[j].y) + (v[j].z * v[j].z + v[j].w * v[j].w); }
        const float rs = rsqrtf(wave_sum(s) * (1.0f / DM) + EPS);
#pragma unroll
        for (int j = 0; j < 4; ++j) ((f32x4*)dst + c.lane)[64 * j] = v[j] * rs * gr[64 * j];
    }
}

#define XB_TMO      128
#define XB_XCNT(j)  (256  + 64 * (j))
#define XB_XSUB(j)  (1280 + 64 * (j))
#define XB_XGEN(j)  (2304 + 64 * (j))
#define XB_TOP      3328
#define XB_TOPGEN   3392
#define XCD_BAR_WORDS 3456
#define XB_SPIN_CAP (1u << 18)

__device__ __forceinline__ unsigned xb_ld(unsigned* p)              { return __hip_atomic_load(p, __ATOMIC_RELAXED, __HIP_MEMORY_SCOPE_AGENT); }
__device__ __forceinline__ unsigned xb_add(unsigned* p, unsigned v) { return __hip_atomic_fetch_add(p, v, __ATOMIC_RELAXED, __HIP_MEMORY_SCOPE_AGENT); }
__device__ __forceinline__ unsigned xb_xcc_id() { return (unsigned)__builtin_amdgcn_s_getreg((3 << 11) | 20) & 0xFu; }
#define XB_SPIN(cond, bar) do { unsigned _sp = 0; while (cond) { __builtin_amdgcn_s_sleep(1); \
    if ((++_sp & 255u) == 0u) { if (xb_ld(&(bar)[XB_TMO])) break; if (_sp > XB_SPIN_CAP) { atomicAdd(&(bar)[XB_TMO], 1u); break; } } } } while (0)

struct XcdBarrier {
    unsigned* bar; unsigned x;
    volatile LAS unsigned* st;
};

__device__ __forceinline__ XcdBarrier xcd_barrier_post(unsigned* bar, volatile LAS unsigned* st) {
    XcdBarrier b; b.bar = bar; b.x = xb_xcc_id(); b.st = st;
    if (threadIdx.x == 0) (void)xb_add(&bar[XB_XCNT(b.x)], 1u);
    return b;
}
__device__ __forceinline__ void xcd_barrier_complete(unsigned* bar, unsigned x, unsigned& nloc, unsigned& nx) {
    const unsigned G = gridDim.x * gridDim.y * gridDim.z;
    unsigned sum, cnt, mine, sp = 0u;
    for (;;) {
        sum = 0u; cnt = 0u; mine = 0u;
#pragma unroll
        for (unsigned j = 0; j < 16; ++j) { const unsigned c = xb_ld(&bar[XB_XCNT(j)]); sum += c; cnt += (c > 0u) ? 1u : 0u; mine = (j == x) ? c : mine; }
        if (sum == G) break;
        __builtin_amdgcn_s_sleep(1);
        if ((++sp & 255u) == 0u) { if (xb_ld(&bar[XB_TMO])) break; if (sp > XB_SPIN_CAP) { atomicAdd(&bar[XB_TMO], 1u); break; } }
    }
    nloc = mine > 0u ? mine : 1u; nx = cnt > 0u ? cnt : 1u;
}

__device__ __forceinline__ void xcd_barrier(const XcdBarrier& b) {
    asm volatile("s_waitcnt vmcnt(0)" ::: "memory");
    __syncthreads();
    if (threadIdx.x == 0) {
        unsigned* bar = b.bar;
        __builtin_amdgcn_s_waitcnt(0);
        unsigned nloc = b.st[0], nx = b.st[1];
        if (nloc == 0u) { xcd_barrier_complete(bar, b.x, nloc, nx); b.st[0] = nloc; b.st[1] = nx; }
        const unsigned old = xb_add(&bar[XB_XSUB(b.x)], 1u);
        const unsigned gen = old / nloc;
        if (old + 1u == (gen + 1u) * nloc) {
            __builtin_amdgcn_fence(__ATOMIC_RELEASE, "agent");
            asm volatile("s_waitcnt vmcnt(0)" ::: "memory");
            const unsigned og = xb_add(&bar[XB_TOP], 1u);
            const unsigned tg = og / nx;
            if (og + 1u == (tg + 1u) * nx) xb_add(&bar[XB_TOPGEN], 1u);
            else XB_SPIN(xb_ld(&bar[XB_TOPGEN]) == tg, bar);
            __builtin_amdgcn_fence(__ATOMIC_ACQUIRE, "agent");
            xb_add(&bar[XB_XGEN(b.x)], 1u);
            asm volatile("s_waitcnt vmcnt(0)" ::: "memory");
        } else {
            XB_SPIN(xb_ld(&bar[XB_XGEN(b.x)]) == gen, bar);
            __builtin_amdgcn_fence(__ATOMIC_ACQUIRE, "agent");
            asm volatile("s_waitcnt vmcnt(0)" ::: "memory");
        }
    }
    __syncthreads();
}
#ifndef ONLY
#define ONLY -1
#endif
#ifndef REPMASK
#define REPMASK 0
#endif
#define EN(x) (ONLY < 0 || ONLY == (x))
__global__ void __launch_bounds__(512, 2) hymba_fwd(Args args) {
    extern __shared__ __attribute__((aligned(16))) unsigned char lds_raw[];
    LAS unsigned char* lds = (LAS unsigned char*)lds_raw;
    cg::grid_group grid = cg::this_grid();
    Ctx c;
    c.x_prompt = args.in[0]; c.x_sample = args.in[1]; c.state_delta = args.in[2]; c.state_conv = args.in[3]; c.norm_mix_g = args.in[4]; c.w_in = args.in[5]; c.conv_w = args.in[6];
    c.A_log = args.in[7]; c.dt_bias = args.in[8]; c.o_norm_g = args.in[9]; c.v_norm_g = args.in[10]; c.w_s = args.in[11]; c.b_s = args.in[12]; c.w_o = args.in[13]; c.norm_ffn_g = args.in[14];
    c.w_up = args.in[15]; c.w_down = args.in[16]; c.norm_f_g = args.in[17]; c.out = args.out; c.ws = args.ws;
    c.lane = threadIdx.x & 63; c.wave = __builtin_amdgcn_readfirstlane(threadIdx.x >> 6); c.gw = blockIdx.x * 8 + c.wave; c.ngw = gridDim.x * 8;
    const int G = gridDim.x;
    volatile LAS unsigned* bst = (volatile LAS unsigned*)(lds + LDS_BYTES - 16);
    if (threadIdx.x < 2) bst[threadIdx.x] = 0u;
    __syncthreads();
    XcdBarrier xbar = xcd_barrier_post((unsigned*)args.ws, bst);
    grid.sync();
    for (int step = 2 * args.ph_lo; step < 2 * args.ph_hi; ++step) {
        const int ph = step >> 1;
        const int ptype = ph == 0 ? 0 : (ph == 29 ? 8 : 1 + (ph - 1) % 7);
        if ((step & 1) && !((REPMASK >> ptype) & 1)) continue;
        { int tl = threadIdx.x; asm volatile("" : "+v"(tl)); c.lane = tl & 63; }
        if (step & 1) __syncthreads();
        if (ph == 0) { if (EN(0)) phase_prologue(c, lds); }
        else if (ph == 29) { if (EN(8)) phase_final(c); }
        else {
            const int l = (ph - 1) / 7, s = (ph - 1) % 7;
            float* ssq = WSP(float, WS_SSQ);
            if (s == 0) { if (EN(1)) { sgemm1(c, l, lds); if ((REPMASK >> 10) & 1) sgemm1(c, l, lds);
                pg8::Gemm g{WSP(bf16_t, WS_XB16), WSP(bf16_t, WS_WIN) + (size_t)l * NP * DM, MP, NP, DM}; pg8::StaticOrder S; S.init(MP, NP, G, blockIdx.x);
                pg8::EpiScaleBf16 E{WSP(bf16_t, WS_P), NP, ssq + (size_t)(2 * l) * MP * 16, 0, WSP(float, WS_VSS)}; pg8::gemm_phase(lds, g, S, E); } }
            else if (s == 1) { if (EN(2)) phase_b0(c, l, lds); }
            else if (s == 2) { if (EN(3)) phase_b1(c, l, lds); }
            else if (s == 3) { if (EN(4)) phase_scan(c, l, lds); if ((REPMASK >> 12) & 1) { __syncthreads(); if (blockIdx.x < 32) scan_block(c, l, blockIdx.x, lds); } }
            else if (s == 4) { if (EN(5)) { if (!(step & 1)) sgemm2(c, l, lds);
                pg8::Gemm g{WSP(bf16_t, WS_AMIX), WSP(bf16_t, WS_WO) + (size_t)l * DM * DM, MP, DM, DM}; pg8::StaticOrder S; S.init(MP, DM, G, blockIdx.x);
                pg8::EpiResid E{l == 0 ? c.x_prompt : WSP(float, WS_XBUF), (step & 1) ? WSP(float, WS_IMG) : WSP(float, WS_XBUF), (step & 1) ? WSP(bf16_t, WS_KNT) : WSP(bf16_t, WS_XB16), (step & 1) ? WSP(float, WS_VBT) : ssq + (size_t)(2 * l + 1) * MP * 16}; pg8::gemm_phase(lds, g, S, E); } }
            else if (s == 5) { if (EN(6)) { sgemm3(c, l, lds); if ((REPMASK >> 11) & 1) sgemm3(c, l, lds);
                pg8::Gemm g{WSP(bf16_t, WS_XB16), WSP(bf16_t, WS_WUP) + (size_t)l * FF * DM, MP, FF, DM}; pg8::StaticOrder S; S.init(MP, FF, G, blockIdx.x);
                pg8::EpiScaleBf16 E{WSP(bf16_t, WS_UNION), FF, ssq + (size_t)(2 * l + 1) * MP * 16, 1, nullptr}; pg8::gemm_phase(lds, g, S, E); } }
            else { if (EN(7)) { if (!(step & 1)) sgemm4(c, l, lds);
                pg8::Gemm g{WSP(bf16_t, WS_UNION), WSP(bf16_t, WS_WDN) + (size_t)l * DM * FF, MP, DM, FF}; pg8::StaticOrder S; S.init(MP, DM, G, blockIdx.x);
                pg8::EpiResid E{WSP(float, WS_XBUF), (step & 1) ? WSP(float, WS_IMG) : WSP(float, WS_XBUF), (step & 1) ? WSP(bf16_t, WS_KNT) : WSP(bf16_t, WS_XB16), (step & 1) ? WSP(float, WS_VBT) : ssq + (size_t)(2 * l + 2) * MP * 16}; pg8::gemm_phase(lds, g, S, E); } }
        }
        if (!(step & 1) && ((REPMASK >> ptype) & 1)) continue;
        if ((REPMASK >> 9) & 1) { if (ph + 1 < args.ph_hi) xcd_barrier(xbar); }
        if (ph + 1 < args.ph_hi) {
            xcd_barrier(xbar);
        }
    }
}

extern "C" void kernel_launch(void* const* d_in, const int* in_sizes, int n_in, void* d_out, int out_size, void* d_ws, size_t ws_size, hipStream_t stream) {
    static int grid = 0;
    if (grid == 0) {
        int dev = 0, cus = 0, per_cu = 0;
        (void)hipGetDevice(&dev); (void)hipDeviceGetAttribute(&cus, hipDeviceAttributeMultiprocessorCount, dev);
        if (hipFuncSetAttribute((const void*)hymba_fwd, hipFuncAttributeMaxDynamicSharedMemorySize, LDS_BYTES) != hipSuccess) fprintf(stderr, "kernel_launch: hipFuncSetAttribute failed\n");
        if (hipOccupancyMaxActiveBlocksPerMultiprocessor(&per_cu, (const void*)hymba_fwd, 512, LDS_BYTES) != hipSuccess || per_cu < 1) { fprintf(stderr, "kernel_launch: occupancy query says %d\n", per_cu); per_cu = 1; }
        (void)hipGetLastError();
        grid = cus * 1;
        if (ws_size < WS_END) fprintf(stderr, "kernel_launch: workspace too small: %zu < %zu\n", ws_size, (size_t)WS_END);
    }
    (void)hipMemsetAsync(d_ws, 0, 65536, stream);
    Args a{};
    for (int i = 0; i < 18; ++i) a.in[i] = (const float*)d_in[i];
    a.out = (float*)d_out; a.ws = (unsigned char*)d_ws; a.ph_lo = 0; a.ph_hi = 30;
    void* kargs[] = {&a};
    hipError_t e = hipLaunchCooperativeKernel((const void*)hymba_fwd, dim3(grid), dim3(512), kargs, LDS_BYTES, stream);
    if (e != hipSuccess) fprintf(stderr, "kernel_launch: cooperative launch failed: %s (grid %d)\n", hipGetErrorString(e), grid);
}
```

```cpp
#include <hip/hip_runtime.h>
#include <hip/hip_cooperative_groups.h>
#include <cstdio>
namespace cg = cooperative_groups;

#define LAS __attribute__((address_space(3)))
#define DI __device__ __forceinline__
typedef unsigned short bf16_t;
typedef short bf16x8 __attribute__((ext_vector_type(8)));
typedef float f32x4 __attribute__((ext_vector_type(4)));
typedef float f32x2 __attribute__((ext_vector_type(2)));
typedef float f32x16 __attribute__((ext_vector_type(16)));
typedef unsigned u32x4 __attribute__((ext_vector_type(4)));
typedef unsigned u32x2 __attribute__((ext_vector_type(2)));
typedef __bf16 bf2_t __attribute__((ext_vector_type(2)));

#ifndef SUBSEL
#define SUBSEL -1
#endif
#define SUB(x) (SUBSEL < 0 || SUBSEL == (x))
#ifndef SUBSEL2
#define SUBSEL2 -1
#endif
#define SUB2(x) (SUBSEL2 < 0 || SUBSEL2 == (x))
constexpr int DM = 1024, NBATCH = 8, SEQ = 2048, MP = NBATCH * SEQ, DEPTH = 4, SBATCH = 128;
constexpr int NH = 4, QKV = 1536, NP = 3072, PROJ = 3080, FF = 4096, NPS = 3088;
constexpr float EPS = 1e-6f;
constexpr int IMG_BYTES = 55296;
constexpr int LDS_BYTES = 150528;
constexpr size_t O_YP = 0, O_YS = 16777216, O_DP = 16908288, O_CP = 19005440, O_DS = 19152896, O_CS = 52707328, O_VS = 55066624;
constexpr size_t WS_WIN = 65536;
constexpr size_t WS_WAB = WS_WIN + (size_t)DEPTH * NP * DM * 2;
constexpr size_t WS_WO = WS_WAB + (size_t)DEPTH * 16 * DM * 2;
constexpr size_t WS_WUP = WS_WO + (size_t)DEPTH * DM * DM * 2;
constexpr size_t WS_WDN = WS_WUP + (size_t)DEPTH * FF * DM * 2;
constexpr size_t WS_WM = WS_WDN + (size_t)DEPTH * FF * DM * 2;
constexpr size_t WS_XBUF = WS_WM + (size_t)DEPTH * 4 * 128 * 128 * 2;
constexpr size_t WS_XB16 = WS_XBUF + (size_t)MP * DM * 4;
constexpr size_t WS_SSQ = WS_XB16 + (size_t)MP * DM * 2;
constexpr size_t WS_UNION = WS_SSQ + (size_t)9 * MP * 16 * 4;
constexpr size_t WS_P = WS_UNION;
constexpr size_t WS_QN = WS_P + (size_t)MP * NP * 2;
constexpr size_t WS_KN = WS_QN + (size_t)MP * 512 * 2;
constexpr size_t WS_KNT = WS_UNION + (size_t)MP * FF * 2;
constexpr size_t WS_VT = WS_KNT + (size_t)MP * 512 * 2;
constexpr size_t WS_VBT = WS_VT + (size_t)MP * 512 * 2;
constexpr size_t WS_G = WS_VBT + (size_t)MP * 512 * 2;
constexpr size_t WS_BETA = WS_G + (size_t)MP * 4 * 4;
constexpr size_t WS_EG = WS_BETA + (size_t)MP * 4 * 4;
constexpr size_t WS_IMG = WS_EG + 4096;
constexpr size_t WS_UIMG = WS_IMG + (size_t)1024 * IMG_BYTES;
constexpr size_t WS_AMIX = WS_UIMG + (size_t)1024 * 32768;
constexpr size_t WS_XS = WS_AMIX + (size_t)MP * DM * 2;
constexpr size_t WS_PS = WS_XS + (size_t)SBATCH * DM * 4;
constexpr size_t WS_QS = WS_PS + (size_t)SBATCH * NPS * 4;
constexpr size_t WS_KS = WS_QS + (size_t)SBATCH * 512 * 4;
constexpr size_t WS_VS = WS_KS + (size_t)SBATCH * 512 * 4;
constexpr size_t WS_GS = WS_VS + (size_t)SBATCH * 512 * 4;
constexpr size_t WS_BS = WS_GS + (size_t)SBATCH * 4 * 4;
constexpr size_t WS_AMIXS = WS_BS + (size_t)SBATCH * 4 * 4;
constexpr size_t WS_HS = WS_AMIXS + (size_t)SBATCH * DM * 4;
constexpr size_t WS_XP = WS_HS + (size_t)SBATCH * FF * 4;
constexpr size_t WS_VSS = WS_XP + (size_t)4 * SBATCH * DM * 4;
constexpr size_t WS_END = WS_VSS + (size_t)MP * 8 * 4;
static_assert(WS_QN + 2 * (size_t)MP * 512 * 2 == WS_KNT, "union");
static_assert(WS_END <= (size_t)536870912, "workspace");

DI unsigned pk2(float lo, float hi) { f32x2 v = {lo, hi}; return __builtin_bit_cast(unsigned, __builtin_convertvector(v, bf2_t)); }
DI float bflo(unsigned w) { return __uint_as_float(w << 16); }
DI float bfhi(unsigned w) { return __uint_as_float(w & 0xffff0000u); }
DI float bf2f(bf16_t b) { return __uint_as_float(((unsigned)b) << 16); }
DI bf16_t f2bf(float f) { return (bf16_t)(pk2(f, 0.f) & 0xffffu); }
DI float xlane(float v, int srclane) { return __builtin_bit_cast(float, __builtin_amdgcn_ds_bpermute(srclane << 2, __builtin_bit_cast(int, v))); }
DI float wave_sum(float v, int lane) {
#pragma unroll
    for (int o = 1; o < 64; o <<= 1) v += xlane(v, lane ^ o);
    return v;
}
DI float silu_f(float x) { return x * __builtin_amdgcn_rcpf(1.f + __expf(-x)); }
DI float sigmoid_f(float x) { return __builtin_amdgcn_rcpf(1.f + __expf(-x)); }
DI float softplus_f(float x) { const float e = __expf(-fabsf(x)); const float l = e < 0.01f ? e * (1.f - e * (0.5f - 0.33333334f * e)) : __logf(1.f + e); return fmaxf(x, 0.f) + l; }
DI u32x4 pack8(const f32x16& x, int s) {
    u32x4 p; p.x = pk2(x[8 * s], x[8 * s + 1]); p.y = pk2(x[8 * s + 2], x[8 * s + 3]); p.z = pk2(x[8 * s + 4], x[8 * s + 5]); p.w = pk2(x[8 * s + 6], x[8 * s + 7]); return p;
}
DI float ssq_sum(const float* p) {
    const f32x4 a = *(const f32x4*)p, b = *(const f32x4*)(p + 4), c2 = *(const f32x4*)(p + 8), d2 = *(const f32x4*)(p + 12);
    return ((a.x + a.y) + (a.z + a.w)) + ((b.x + b.y) + (b.z + b.w)) + ((c2.x + c2.y) + (c2.z + c2.w)) + ((d2.x + d2.y) + (d2.z + d2.w));
}
DI int crow(int reg, int h) { return (reg & 3) + 8 * (reg >> 2) + 4 * h; }
#define MFMA32(a, b, c) __builtin_amdgcn_mfma_f32_32x32x16_bf16((a), (b), (c), 0, 0, 0)
#define MFMA16(a, b, c) __builtin_amdgcn_mfma_f32_16x16x32_bf16((a), (b), (c), 0, 0, 0)
DI bf16x8 as_bf(u32x4 v) { return __builtin_bit_cast(bf16x8, v); }
DI f32x16 zero16() { f32x16 z;
#pragma unroll
    for (int i = 0; i < 16; ++i) z[i] = 0.f; return z; }

namespace pg8 {
constexpr int BM = 256, BK = 64, HALF = 128, HTB = HALF * BK * 2, STAGE_BYTES = 8 * HTB, NXCD = 8, WGM = 8;
DI int lds_byte(int r, int c) { const int st = (r >> 4) * 2 + (c >> 5), rr = r & 15, cc = c & 31, ob = rr * 64 + cc * 2; return st * 1024 + (ob ^ (((ob >> 9) & 1) << 5)); }
DI void stage_rc(int b, int& R, int& C) { const int st = b / 1024, sb = b % 1024, swz = sb ^ (((sb >> 9) & 1) << 5); R = (st >> 1) * 16 + swz / 64; C = (st & 1) * 32 + (swz % 64) / 2; }
DI int perm32(int rho) { const int n = rho >> 4, i = rho & 15; return 8 * (i >> 2) + 4 * n + (i & 3); }
struct Unit { int pm, pn; };
struct Gemm { const bf16_t* A; const bf16_t* Bt; int M, N, K; };
struct StaticOrder {
    int nM, nN, nwg, G, c;
    DI void init(int M, int N, int G_, int c_) { nM = M / BM; nN = N / BM; nwg = nM * nN; G = G_; c = c_; }
    DI bool next(int i, Unit& u) const {
        const long L = (long)i * G + c; if (L >= nwg) return false;
        int wgid = (int)L; { const int q = nwg / NXCD, r = nwg % NXCD, xcd = wgid % NXCD, off = wgid / NXCD; wgid = (xcd < r ? xcd * (q + 1) : r * (q + 1) + (xcd - r) * q) + off; }
        const int nig = WGM * nN, gid = wgid / nig, fm = gid * WGM, gsz = (nM - fm) < WGM ? (nM - fm) : WGM;
        u.pm = fm + ((wgid % nig) % gsz); u.pn = (wgid % nig) / gsz; return true;
    }
};
template <class Epi>
DI void gemm_phase(LAS unsigned char* lds, const Gemm g, const StaticOrder& S, const Epi& E) {
    int tid = threadIdx.x; asm volatile("" : "+v"(tid));
    const int wid = __builtin_amdgcn_readfirstlane(tid >> 6), lane = tid & 63, wr = wid >> 2, wc = wid & 3, fr = lane & 15, fq = lane >> 4;
    const int K = g.K, nt = K / BK;
    unsigned voffA[2], voffB[2];
#pragma unroll
    for (int i = 0; i < 2; ++i) { int R, C; stage_rc(tid * 16 + i * 8192, R, C); const int Rb = (R & ~31) + perm32(R & 31);
        voffA[i] = (unsigned)(R * K + C) * 2u; voffB[i] = (unsigned)(Rb * K + C) * 2u; }
    const size_t kstep = (size_t)(BK * 2);
    const size_t hstep = (size_t)HALF * K * 2;
    const size_t tstep = 2 * hstep;
    const unsigned ldsw = (unsigned)wid * 1024u;
    const int aoff = lds_byte(wr * 64 + fr, fq * 8), boff = lds_byte(wc * 32 + fr, fq * 8);
#define PG8_SA(b, h) (((b) * 2 + (h)) * HTB)
#define PG8_SB(b, h) ((4 + (b) * 2 + (h)) * HTB)
#define PG8_STAGE(bufoff, gbase, voff) do { _Pragma("unroll") for (int _i = 0; _i < 2; ++_i) \
        __builtin_amdgcn_global_load_lds((const unsigned*)((const char*)(gbase) + (voff)[_i]), (LAS unsigned*)(lds + (bufoff) + ldsw + _i * 8192), 16, 0, 0); } while (0)
#define PG8_LDA(dst, b, h) do { _Pragma("unroll") for (int m = 0; m < 4; ++m) _Pragma("unroll") for (int k = 0; k < 2; ++k) dst[m][k] = *(const LAS bf16x8*)(lds + PG8_SA(b, h) + aoff + m * 2048 + k * 1024); } while (0)
#define PG8_LDB(dst, b, h) do { _Pragma("unroll") for (int n = 0; n < 2; ++n) _Pragma("unroll") for (int k = 0; k < 2; ++k) dst[n][k] = *(const LAS bf16x8*)(lds + PG8_SB(b, h) + boff + n * 2048 + k * 1024); } while (0)
#define PG8_MMA(ai, bj, At, Bt) do { __builtin_amdgcn_s_setprio(1); _Pragma("unroll") for (int m = 0; m < 4; ++m) _Pragma("unroll") for (int n = 0; n < 2; ++n) _Pragma("unroll") for (int k = 0; k < 2; ++k) \
        acc[ai][bj][m][n] = __builtin_amdgcn_mfma_f32_16x16x32_bf16(Bt[n][k], At[m][k], acc[ai][bj][m][n], 0, 0, 0); __builtin_amdgcn_s_setprio(0); } while (0)
#define PG8_WAIT_V(n) asm volatile("s_waitcnt vmcnt(" #n ")" ::: "memory")
#define PG8_WAIT_L(n) asm volatile("s_waitcnt lgkmcnt(" #n ")" ::: "memory")
#define PG8_BAR __builtin_amdgcn_s_barrier()
#define PG8_SCHED __builtin_amdgcn_sched_barrier(0)
    Unit cur, nxt; int ui = 0;
    if (!S.next(0, cur)) return;
    f32x4 acc[2][2][4][2];
#pragma unroll
    for (int a = 0; a < 2; ++a)
#pragma unroll
        for (int b = 0; b < 2; ++b)
#pragma unroll
            for (int m = 0; m < 4; ++m)
#pragma unroll
                for (int n = 0; n < 2; ++n) acc[a][b][m][n] = (f32x4){0.f, 0.f, 0.f, 0.f};
    bf16x8 At[4][2], B0[2][2], B1[2][2];
    const char* cA = (const char*)g.A + (size_t)cur.pm * tstep; const char* cB = (const char*)g.Bt + (size_t)cur.pn * tstep;
    PG8_STAGE(PG8_SB(0, 0), cB, voffB); PG8_STAGE(PG8_SA(0, 0), cA, voffA); PG8_STAGE(PG8_SB(0, 1), cB + hstep, voffB); PG8_STAGE(PG8_SA(0, 1), cA + hstep, voffA);
    if (wr == 1) PG8_BAR;
    PG8_WAIT_V(4); PG8_BAR;
    PG8_STAGE(PG8_SB(1, 0), cB + kstep, voffB); PG8_STAGE(PG8_SA(1, 0), cA + kstep, voffA); PG8_STAGE(PG8_SB(1, 1), cB + hstep + kstep, voffB);
    PG8_WAIT_V(6); PG8_BAR;
    for (;;) {
        const bool has_next = S.next(ui + 1, nxt);
        const char* nA = has_next ? (const char*)g.A + (size_t)nxt.pm * tstep : cA; const char* nB = has_next ? (const char*)g.Bt + (size_t)nxt.pn * tstep : cB;
        for (int t = 0; t < nt; t += 2) {
            const bool last = (t == nt - 2);
            const char* a1 = cA + (size_t)(t + 1) * kstep;
            const char* a2 = last ? nA : cA + (size_t)(t + 2) * kstep; const char* b2 = last ? nB : cB + (size_t)(t + 2) * kstep;
            const char* a3 = a2 + kstep; const char* b3 = b2 + kstep;
            PG8_LDB(B0, 0, 0); PG8_SCHED; PG8_LDA(At, 0, 0); PG8_STAGE(PG8_SA(1, 1), a1 + hstep, voffA);
            PG8_WAIT_L(8); PG8_BAR; PG8_WAIT_L(0); PG8_MMA(0, 0, At, B0); PG8_BAR; PG8_SCHED;
            PG8_LDB(B1, 0, 1); PG8_STAGE(PG8_SB(0, 0), b2, voffB);
            PG8_BAR; PG8_WAIT_L(0); PG8_MMA(0, 1, At, B1); PG8_BAR;
            PG8_LDA(At, 0, 1); PG8_STAGE(PG8_SA(0, 0), a2, voffA);
            PG8_BAR; PG8_WAIT_L(0); PG8_MMA(1, 0, At, B0); PG8_BAR; PG8_SCHED;
            PG8_STAGE(PG8_SB(0, 1), b2 + hstep, voffB);
            PG8_WAIT_V(6); PG8_BAR; PG8_MMA(1, 1, At, B1); PG8_BAR;
            PG8_LDB(B0, 1, 0); PG8_SCHED; PG8_LDA(At, 1, 0); PG8_STAGE(PG8_SA(0, 1), a2 + hstep, voffA);
            PG8_WAIT_L(8); PG8_BAR; PG8_WAIT_L(0); PG8_MMA(0, 0, At, B0); PG8_BAR; PG8_SCHED;
            PG8_LDB(B1, 1, 1); PG8_STAGE(PG8_SB(1, 0), b3, voffB);
            PG8_BAR; PG8_WAIT_L(0); PG8_MMA(0, 1, At, B1); PG8_BAR;
            PG8_LDA(At, 1, 1); PG8_STAGE(PG8_SA(1, 0), a3, voffA);
            PG8_BAR; PG8_WAIT_L(0); PG8_MMA(1, 0, At, B0); PG8_BAR; PG8_SCHED;
            PG8_STAGE(PG8_SB(1, 1), b3 + hstep, voffB);
            PG8_WAIT_V(6); PG8_BAR; PG8_MMA(1, 1, At, B1); PG8_BAR;
        }
        E(acc, cur, wr, wc, fr, fq);
        if (!has_next) break;
#pragma unroll
        for (int a = 0; a < 2; ++a)
#pragma unroll
            for (int b = 0; b < 2; ++b)
#pragma unroll
                for (int m = 0; m < 4; ++m)
#pragma unroll
                    for (int n = 0; n < 2; ++n) acc[a][b][m][n] = (f32x4){0.f, 0.f, 0.f, 0.f};
        cur = nxt; cA = nA; cB = nB; ++ui;
    }
    PG8_WAIT_V(0);
    if (wr == 0) PG8_BAR;
    PG8_BAR;
#undef PG8_SA
#undef PG8_SB
#undef PG8_STAGE
#undef PG8_LDA
#undef PG8_LDB
#undef PG8_MMA
#undef PG8_WAIT_V
#undef PG8_WAIT_L
#undef PG8_BAR
#undef PG8_SCHED
}
struct EpiScaleBf16 {
    bf16_t* O; int ldc; const float* ssq; int act; float* vss; const float* og;
    DI void operator()(const f32x4 (&acc)[2][2][4][2], const Unit& u, int wr, int wc, int fr, int fq) const {
        const int row0 = u.pm * BM + wr * 64 + fr, col0 = u.pn * BM + wc * 32 + 8 * fq;
#pragma unroll
        for (int ai = 0; ai < 2; ++ai)
#pragma unroll
            for (int m = 0; m < 4; ++m) { const int row = row0 + ai * HALF + m * 16; const float rs = rsqrtf(ssq_sum(ssq + (size_t)row * 16) * (1.0f / DM) + EPS);
                bf16_t* rowp = O + (size_t)row * ldc + col0; float vs = 0.f;
#pragma unroll
                for (int bj = 0; bj < 2; ++bj) { f32x4 v0 = acc[ai][bj][m][0] * rs, v1 = acc[ai][bj][m][1] * rs;
                    if (act) {
#pragma unroll
                        for (int j = 0; j < 4; ++j) { const float a = fmaxf(v0[j], 0.f), b = fmaxf(v1[j], 0.f); v0[j] = a * a; v1[j] = b * b; } }
                    if (og != nullptr && (u.pn == 6 || u.pn == 7)) { const float* gp = og + ((col0 + bj * HALF) & 127); const f32x4 g0 = *(const f32x4*)gp, g1 = *(const f32x4*)(gp + 4);
#pragma unroll
                        for (int j = 0; j < 4; ++j) { v0[j] = silu_f(v0[j]) * g0[j]; v1[j] = silu_f(v1[j]) * g1[j]; } }
                    u32x4 w; w.x = pk2(v0[0], v0[1]); w.y = pk2(v0[2], v0[3]); w.z = pk2(v1[0], v1[1]); w.w = pk2(v1[2], v1[3]);
                    *(u32x4*)(rowp + bj * HALF) = w;
                    vs += (v0[0] * v0[0] + v0[1] * v0[1]) + (v0[2] * v0[2] + v0[3] * v0[3]) + (v1[0] * v1[0] + v1[1] * v1[1]) + (v1[2] * v1[2] + v1[3] * v1[3]); }
                if (vss != nullptr && u.pn >= 10) { { const int ln = fq * 16 + fr; vs += xlane(vs, ln ^ 16); vs += xlane(vs, ln ^ 32); } if (fq == 0) vss[(size_t)row * 8 + (u.pn - 10) * 4 + wc] = vs; } }
    }
};
struct EpiResid {
    const float* base; float* out; bf16_t* xb; float* ssq;
    DI void operator()(const f32x4 (&acc)[2][2][4][2], const Unit& u, int wr, int wc, int fr, int fq) const {
        const int row0 = u.pm * BM + wr * 64 + fr, col0 = u.pn * BM + wc * 32 + 8 * fq;
#pragma unroll
        for (int ai = 0; ai < 2; ++ai)
#pragma unroll
            for (int m = 0; m < 4; ++m) { const int row = row0 + ai * HALF + m * 16; const size_t off = (size_t)row * DM + col0; float ss = 0.f;
#pragma unroll
                for (int bj = 0; bj < 2; ++bj) {
                    const f32x4 b0 = *(const f32x4*)(base + off + bj * HALF), b1 = *(const f32x4*)(base + off + bj * HALF + 4);
                    const f32x4 o0 = b0 + acc[ai][bj][m][0], o1 = b1 + acc[ai][bj][m][1];
                    *(f32x4*)(out + off + bj * HALF) = o0; *(f32x4*)(out + off + bj * HALF + 4) = o1;
                    u32x4 w; w.x = pk2(o0[0], o0[1]); w.y = pk2(o0[2], o0[3]); w.z = pk2(o1[0], o1[1]); w.w = pk2(o1[2], o1[3]);
                    *(u32x4*)(xb + off + bj * HALF) = w;
                    ss += (o0[0] * o0[0] + o0[1] * o0[1]) + (o0[2] * o0[2] + o0[3] * o0[3]) + (o1[0] * o1[0] + o1[1] * o1[1]) + (o1[2] * o1[2] + o1[3] * o1[3]); }
                { const int ln = fq * 16 + fr; ss += xlane(ss, ln ^ 16); ss += xlane(ss, ln ^ 32); }
                if (fq == 0) ssq[(size_t)row * 16 + u.pn * 4 + wc] = ss;
                asm volatile("" ::: "memory"); }
    }
};
}

struct Args { const float* in[18]; float* out; unsigned char* ws; int ph_lo, ph_hi; };
struct Ctx {
    const float *x_prompt, *x_sample, *state_delta, *state_conv, *norm_mix_g, *w_in, *conv_w, *A_log, *dt_bias, *o_norm_g, *v_norm_g, *w_s, *b_s, *w_o, *norm_ffn_g, *w_up, *w_down, *norm_f_g;
    float* out; unsigned char* ws;
    int lane, wave, gw, ngw;
};
#define WSP(T, off) ((T*)(c.ws + (off)))

DI void transpose_item(const float* W, int K, int N, const float* kscale, bf16_t* WT, bf16_t* WAB, int mode, int item, int nblk, LAS float* scr, int lane) {
    const int kb = item / nblk, nb = item % nblk, k0 = 64 * kb, n0 = 64 * nb;
    const int c4 = lane & 15, rsub = lane >> 4;
    const bool cval = n0 + 4 * c4 + 3 < N;
#pragma unroll 4
    for (int kk = 0; kk < 64; kk += 4) { const int row = kk + rsub;
        f32x4 v = (f32x4){0.f, 0.f, 0.f, 0.f}; if (cval) { v = *(const f32x4*)(W + (size_t)(k0 + row) * N + n0 + 4 * c4); if (kscale) v = v * kscale[k0 + row]; }
        LAS float* p = scr + row * 65 + 4 * c4; p[0] = v.x; p[1] = v.y; p[2] = v.z; p[3] = v.w; }
    asm volatile("s_waitcnt lgkmcnt(0)" ::: "memory");
    const int kc = lane & 7;
#pragma unroll
    for (int it = 0; it < 8; ++it) { const int n = 8 * it + (lane >> 3), ns = n0 + n; const LAS float* s = scr + (8 * kc) * 65 + n;
        u32x4 o; o.x = pk2(s[0 * 65], s[1 * 65]); o.y = pk2(s[2 * 65], s[3 * 65]); o.z = pk2(s[4 * 65], s[5 * 65]); o.w = pk2(s[6 * 65], s[7 * 65]);
        if (ns < N) {
            bf16_t* rowp;
            if (mode == 0) rowp = WT + (size_t)ns * K;
            else rowp = ns < 2048 ? WT + (size_t)ns * K : (ns < 2056 ? WAB + (size_t)(ns - 2048) * K : WT + (size_t)(ns - 8) * K);
            *(u32x4*)(rowp + k0 + 8 * kc) = o; } }
    asm volatile("s_waitcnt lgkmcnt(0)" ::: "memory");
}
DI void phase_prologue(const Ctx& c, LAS unsigned char* lds) {
    LAS float* scr = (LAS float*)(lds + c.wave * 18432);
    constexpr int I_IN = 16 * 49, I_O = 16 * 16, I_UP = 16 * 64, I_DN = 64 * 16, I_L = I_IN + I_O + I_UP + I_DN;
    for (int it = c.gw; it < DEPTH * I_L; it += c.ngw) {
        const int l = it / I_L; int r = it % I_L;
        if (r < I_IN) { transpose_item(c.w_in + (size_t)l * DM * PROJ, DM, PROJ, c.norm_mix_g + l * DM, WSP(bf16_t, WS_WIN) + (size_t)l * NP * DM, WSP(bf16_t, WS_WAB) + (size_t)l * 16 * DM, 1, r, 49, scr, c.lane); continue; } r -= I_IN;
        if (r < I_O) { transpose_item(c.w_o + (size_t)l * DM * DM, DM, DM, nullptr, WSP(bf16_t, WS_WO) + (size_t)l * DM * DM, nullptr, 0, r, 16, scr, c.lane); continue; } r -= I_O;
        if (r < I_UP) { transpose_item(c.w_up + (size_t)l * DM * FF, DM, FF, c.norm_ffn_g + l * DM, WSP(bf16_t, WS_WUP) + (size_t)l * FF * DM, nullptr, 0, r, 64, scr, c.lane); continue; } r -= I_UP;
        transpose_item(c.w_down + (size_t)l * FF * DM, FF, DM, nullptr, WSP(bf16_t, WS_WDN) + (size_t)l * DM * FF, nullptr, 0, r, 16, scr, c.lane);
    }
    float* ssq = WSP(float, WS_SSQ);
    for (int m = c.gw; m < MP; m += c.ngw) {
        const f32x4* xr = (const f32x4*)(c.x_prompt + (size_t)m * DM) + c.lane; u32x2* o8 = (u32x2*)(WSP(bf16_t, WS_XB16) + (size_t)m * DM) + c.lane; float s = 0.f;
#pragma unroll
        for (int j = 0; j < 4; ++j) { const f32x4 v = xr[64 * j]; s += (v.x * v.x + v.y * v.y) + (v.z * v.z + v.w * v.w); u32x2 w; w.x = pk2(v.x, v.y); w.y = pk2(v.z, v.w); o8[64 * j] = w; }
        s = wave_sum(s, c.lane); if (c.lane < 16) ssq[(size_t)m * 16 + c.lane] = c.lane == 0 ? s : 0.f;
    }
    const int gt = c.gw * 64 + c.lane, ngt = c.ngw * 64;
    float* xs = WSP(float, WS_XS);
    for (int i = gt; i < SBATCH * DM; i += ngt) xs[i] = c.x_sample[i];
    bf16_t* wab = WSP(bf16_t, WS_WAB);
    for (int i = gt; i < DEPTH * 8 * DM; i += ngt) { const int l = i / (8 * DM), r = i % (8 * DM); wab[(size_t)l * 16 * DM + 8 * DM + r] = 0; }
    unsigned* wm = WSP(unsigned, WS_WM);
    for (int i = gt; i < DEPTH * 4 * 128 * 64; i += ngt) { const int e = 2 * i, ii = (e >> 7) & 127, jj = e & 127;
        const float a = ii >= jj ? c.w_s[e] : 0.f, b = ii >= jj + 1 ? c.w_s[e + 1] : 0.f; wm[i] = pk2(a, b); }
}

template <int NT, bool NORM, int EPI>
DI void sgemm_block(const Ctx& c, const float* A, int lda, int K, const bf16_t* Bt, int ncg, float* out, int ldo, LAS unsigned char* lds, const bf16_t* Bab) {
    int lane = c.lane; asm volatile("" : "+v"(lane));
    const int wave = c.wave, fr = lane & 15, fq = lane >> 4;
    LAS f32x4* red = (LAS f32x4*)lds;
    LAS float* ssr = (LAS float*)(lds + 8 * NT * 64 * 16);
    const int kw = K / 8, k0 = wave * kw;
    for (int u = blockIdx.x; u < 8 * ncg; u += gridDim.x) {
        const int rt = u & 7, cg = u >> 3;
        const bool abg = (Bab != nullptr) && (cg == ncg - 1);
        const bf16_t* bp = (abg ? Bab : Bt + (size_t)cg * NT * 16 * K) + (size_t)fr * K + k0 + 8 * fq;
        const float* ap = A + (size_t)(rt * 16 + fr) * lda + k0 + 8 * fq;
        f32x4 acc[NT]; float ss = 0.f;
#pragma unroll
        for (int nt = 0; nt < NT; ++nt) acc[nt] = (f32x4){0.f, 0.f, 0.f, 0.f};
#pragma unroll 4
        for (int k = 0; k < kw; k += 32) {
            const f32x4 a0 = *(const f32x4*)(ap + k), a1 = *(const f32x4*)(ap + k + 4);
            if (NORM) ss += (a0.x * a0.x + a0.y * a0.y) + (a0.z * a0.z + a0.w * a0.w) + (a1.x * a1.x + a1.y * a1.y) + (a1.z * a1.z + a1.w * a1.w);
            u32x4 a; a.x = pk2(a0.x, a0.y); a.y = pk2(a0.z, a0.w); a.z = pk2(a1.x, a1.y); a.w = pk2(a1.z, a1.w);
#pragma unroll
            for (int nt = 0; nt < NT; ++nt) if (nt == 0 || !abg) { const bf16x8 bf = *(const bf16x8*)(bp + (size_t)nt * 16 * K + k); acc[nt] = MFMA16(as_bf(a), bf, acc[nt]); }
        }
        if (NORM) { ss += xlane(ss, lane ^ 16); ss += xlane(ss, lane ^ 32); if (fq == 0) ssr[wave * 16 + fr] = ss; }
#pragma unroll
        for (int nt = 0; nt < NT; ++nt) red[(wave * NT + nt) * 64 + lane] = acc[nt];
        __syncthreads();
        if (wave < NT && (wave == 0 || !abg)) {
            f32x4 t = red[wave * 64 + lane];
#pragma unroll
            for (int w = 1; w < 8; ++w) t += red[(w * NT + wave) * 64 + lane];
            const int col = (cg * NT + wave) * 16 + fr;
#pragma unroll
            for (int j = 0; j < 4; ++j) { const int rl = 4 * fq + j; float rs = 1.f;
                if (NORM) { float sq = 0.f;
#pragma unroll
                    for (int w = 0; w < 8; ++w) sq += ssr[w * 16 + rl];
                    rs = rsqrtf(sq * (1.0f / DM) + EPS); }
                float* o = out + (size_t)(rt * 16 + rl) * ldo + col;
                if (EPI == 0) *o = t[j] * rs; else if (EPI == 1) *o += t[j]; else { const float v = fmaxf(t[j] * rs, 0.f); *o = v * v; } }
        }
        __syncthreads();
    }
}
DI void sgemm1(const Ctx& c, int l, LAS unsigned char* lds) {
    sgemm_block<4, true, 0>(c, WSP(float, WS_XS), DM, DM, WSP(bf16_t, WS_WIN) + (size_t)l * NP * DM, 49, WSP(float, WS_PS), NPS, lds, WSP(bf16_t, WS_WAB) + (size_t)l * 16 * DM);
}
DI void sgemm2(const Ctx& c, int l, LAS unsigned char* lds) {
    sgemm_block<2, false, 1>(c, WSP(float, WS_AMIXS), DM, DM, WSP(bf16_t, WS_WO) + (size_t)l * DM * DM, 32, WSP(float, WS_XS), DM, lds, nullptr);
}
DI void sgemm3(const Ctx& c, int l, LAS unsigned char* lds) {
    sgemm_block<4, true, 2>(c, WSP(float, WS_XS), DM, DM, WSP(bf16_t, WS_WUP) + (size_t)l * FF * DM, 64, WSP(float, WS_HS), FF, lds, nullptr);
}
DI void sgemm4(const Ctx& c, int l, LAS unsigned char* lds) {
    sgemm_block<2, false, 1>(c, WSP(float, WS_HS), FF, FF, WSP(bf16_t, WS_WDN) + (size_t)l * DM * FF, 32, WSP(float, WS_XS), DM, lds, nullptr);
}

DI void b0_task_ab(const Ctx& c, int l, int b, int n) {
    const int fr = c.lane & 15, fq = c.lane >> 4, tok0 = b * SEQ + n * 64;
    const bf16_t* ap = WSP(bf16_t, WS_XB16) + (size_t)(tok0 + fr) * DM + 8 * fq;
    const bf16_t* bp = WSP(bf16_t, WS_WAB) + (size_t)l * 16 * DM + (size_t)fr * DM + 8 * fq;
    f32x4 acc[4];
#pragma unroll
    for (int mt = 0; mt < 4; ++mt) acc[mt] = (f32x4){0.f, 0.f, 0.f, 0.f};
#pragma unroll 4
    for (int k = 0; k < DM; k += 32) {
        const bf16x8 bf = *(const bf16x8*)(bp + k);
#pragma unroll
        for (int mt = 0; mt < 4; ++mt) { const bf16x8 a = *(const bf16x8*)(ap + (size_t)mt * 16 * DM + k); acc[mt] = MFMA16(a, bf, acc[mt]); }
    }
    const float* ssq = WSP(float, WS_SSQ) + (size_t)(2 * l) * MP * 16;
    float* gb = WSP(float, WS_G); float* bb = WSP(float, WS_BETA);
    if (fr < 8) { const int hh = fr & 3; const float al = -__expf(c.A_log[l * 4 + hh]), dtb = c.dt_bias[l * 4 + hh];
#pragma unroll
        for (int mt = 0; mt < 4; ++mt)
#pragma unroll
            for (int j = 0; j < 4; ++j) { const int tok = tok0 + 16 * mt + 4 * fq + j; const float v = acc[mt][j] * rsqrtf(ssq_sum(ssq + (size_t)tok * 16) * (1.0f / DM) + EPS);
                if (fr < 4) gb[tok * 4 + hh] = al * softplus_f(v + dtb); else bb[tok * 4 + hh] = sigmoid_f(v); } }
}
constexpr int B0_STRIDE = 272, B0_WAVE_LDS = 18432;
DI void b0_task_conv(const Ctx& c, int l, int b, int n, int s, int hh, LAS unsigned char* wl) {
    int lane = c.lane; asm volatile("" : "+v"(lane));
    const int tok0 = b * SEQ + n * 64, cb = s * 512 + hh * 128, piece = lane & 15;
    const bf16_t* P = WSP(bf16_t, WS_P) + (size_t)tok0 * NP + cb + piece * 8;
#pragma unroll
    for (int k = 0; k < 17; ++k) { const int row = 4 * k + (lane >> 4);
        if (row < 67) { u32x4 v = (u32x4){0u, 0u, 0u, 0u}; if (n > 0 || row >= 3) v = *(const u32x4*)(P + (long)(row - 3) * NP);
            *(LAS u32x4*)(wl + row * B0_STRIDE + piece * 16) = v; } }
    const float* cw = c.conv_w + (size_t)l * 4 * QKV + cb;
    float wv[4][2];
#pragma unroll
    for (int j = 0; j < 4; ++j) { wv[j][0] = cw[j * QKV + lane]; wv[j][1] = cw[j * QKV + 64 + lane]; }
    if (n == 31) {
        float* ocp = c.out + O_CP + ((size_t)(l * NBATCH + b) * 3) * QKV + cb;
#pragma unroll
        for (int t = 0; t < 6; ++t) { const int idx = lane + 64 * t, row = idx >> 7, ch = idx & 127; ocp[(size_t)row * QKV + ch] = bf2f(*(const LAS bf16_t*)(wl + (64 + row) * B0_STRIDE + ch * 2)); } }
    float ss = 0.f;
#pragma unroll
    for (int hf = 0; hf < 2; ++hf)
#pragma unroll 2
    for (int i8 = 0; i8 < 8; ++i8) { const int i = hf * 8 + i8;
        u32x4 rws[4];
#pragma unroll
        for (int j = 0; j < 4; ++j) rws[j] = *(const LAS u32x4*)(wl + (lane + j) * B0_STRIDE + i * 16);
        float y[8];
#pragma unroll
        for (int e = 0; e < 8; ++e) { const int ch = 8 * i + e; float a = 0.f;
#pragma unroll
            for (int j = 0; j < 4; ++j) { const float wsel = wv[j][hf]; const float w = __builtin_bit_cast(float, __builtin_amdgcn_readlane(__builtin_bit_cast(int, wsel), ch & 63));
                const unsigned pw = rws[j][e >> 1]; a += ((e & 1) ? bfhi(pw) : bflo(pw)) * w; }
            y[e] = silu_f(a); ss += y[e] * y[e]; }
        u32x4 w; w.x = pk2(y[0], y[1]); w.y = pk2(y[2], y[3]); w.z = pk2(y[4], y[5]); w.w = pk2(y[6], y[7]);
        *(LAS u32x4*)(wl + (lane + 3) * B0_STRIDE + i * 16) = w;
    }
    const float sc = s == 0 ? rsqrtf(ss + EPS) * 0.08838834764831845f : (s == 1 ? rsqrtf(ss + EPS) : 1.0f);
    const size_t unit = (size_t)((b * 4 + hh) * 32 + n);
    bf16_t* ot = (s == 1 ? WSP(bf16_t, WS_KNT) : WSP(bf16_t, WS_VT)) + unit * 128 * 64 + lane;
#pragma unroll 2
    for (int i = 0; i < 16; ++i) { const u32x4 v = *(const LAS u32x4*)(wl + (lane + 3) * B0_STRIDE + i * 16); u32x4 w;
#pragma unroll
        for (int e = 0; e < 4; ++e) w[e] = pk2(bflo(v[e]) * sc, bfhi(v[e]) * sc);
        if (s < 2) *(LAS u32x4*)(wl + (lane + 3) * B0_STRIDE + i * 16) = w;
        if (s >= 1) {
#pragma unroll
            for (int e = 0; e < 8; ++e) ot[(8 * i + e) * 64] = (bf16_t)((e & 1) ? (w[e >> 1] >> 16) : (w[e >> 1] & 0xffffu)); } }
    if (s < 2) { bf16_t* o = (s == 0 ? WSP(bf16_t, WS_QN) : WSP(bf16_t, WS_KN)) + (size_t)tok0 * 512 + hh * 128 + piece * 8;
#pragma unroll
        for (int k = 0; k < 16; ++k) { const int row = 4 * k + (lane >> 4); *(u32x4*)(o + (size_t)row * 512) = *(const LAS u32x4*)(wl + (row + 3) * B0_STRIDE + piece * 16); } }
}
DI void b0_task_vb(const Ctx& c, int l, int b, int n, int hb, LAS unsigned char* wl) {
    int lane = c.lane; asm volatile("" : "+v"(lane));
    const int tok0 = b * SEQ + n * 64, piece = lane & 15;
    const bf16_t* P = WSP(bf16_t, WS_P) + (size_t)tok0 * NP + 2560 + hb * 128 + piece * 8;
#pragma unroll
    for (int k = 0; k < 16; ++k) { const int row = 4 * k + (lane >> 4); *(LAS u32x4*)(wl + row * B0_STRIDE + piece * 16) = *(const u32x4*)(P + (size_t)row * NP); }
    const float* vp = WSP(float, WS_VSS) + (size_t)(tok0 + lane) * 8; const f32x4 p0 = *(const f32x4*)vp, p1 = *(const f32x4*)(vp + 4);
    const float rs = rsqrtf((((p0.x + p0.y) + (p0.z + p0.w)) + ((p1.x + p1.y) + (p1.z + p1.w))) * (1.0f / 512.0f) + EPS);
    const float* vg = c.v_norm_g + l * 512 + hb * 128;
    bf16_t* vbt = WSP(bf16_t, WS_VBT) + ((size_t)((b * 16 + (n >> 1)) * 4 + hb) * 128) * 128 + (n & 1) * 64 + lane;
#pragma unroll 2
    for (int i = 0; i < 16; ++i) { const u32x4 v = *(const LAS u32x4*)(wl + lane * B0_STRIDE + i * 16);
#pragma unroll
        for (int e = 0; e < 8; ++e) { const float pv = (e & 1) ? bfhi(v[e >> 1]) : bflo(v[e >> 1]); vbt[(size_t)(8 * i + e) * 128] = f2bf(pv * rs * vg[8 * i + e]); } }
}
DI void b0_task_sample(const Ctx& c, int l, int bs) {
    const float* ps = WSP(float, WS_PS) + (size_t)bs * NPS;
    if (c.lane < 4) { const int hh = c.lane;
        WSP(float, WS_GS)[bs * 4 + hh] = -__expf(c.A_log[l * 4 + hh]) * softplus_f(ps[3072 + hh] + c.dt_bias[l * 4 + hh]);
        WSP(float, WS_BS)[bs * 4 + hh] = sigmoid_f(ps[3076 + hh]); }
    const float* sc = c.state_conv + (size_t)(l * SBATCH + bs) * 3 * QKV;
    const float* cw = c.conv_w + (size_t)l * 4 * QKV;
    float* ocs = c.out + O_CS + (size_t)(l * SBATCH + bs) * 3 * QKV;
    float* qkvs = WSP(float, WS_QS) + bs * 512;
#pragma unroll 1
    for (int sh = 0; sh < 12; ++sh) {
        float y[2];
#pragma unroll
        for (int t = 0; t < 2; ++t) { const int ch = sh * 128 + t * 64 + c.lane; const float s0 = sc[ch], s1 = sc[QKV + ch], s2 = sc[2 * QKV + ch], cur = ps[ch];
            ocs[ch] = s1; ocs[QKV + ch] = s2; ocs[2 * QKV + ch] = cur;
            y[t] = silu_f(s0 * cw[ch] + s1 * cw[QKV + ch] + s2 * cw[2 * QKV + ch] + cur * cw[3 * QKV + ch]); }
        float scale = 1.0f;
        if (sh < 8) { const float ssum = wave_sum(y[0] * y[0] + y[1] * y[1], c.lane); scale = rsqrtf(ssum + EPS) * (sh < 4 ? 0.08838834764831845f : 1.0f); }
        float* o = qkvs + (size_t)(sh >> 2) * SBATCH * 512 + (sh & 3) * 128;
        o[c.lane] = y[0] * scale; o[64 + c.lane] = y[1] * scale;
    }
    float pv[8]; float ss = 0.f;
#pragma unroll
    for (int i = 0; i < 8; ++i) { pv[i] = ps[2560 + c.lane + 64 * i]; ss += pv[i] * pv[i]; }
    ss = wave_sum(ss, c.lane); const float rs = rsqrtf(ss * (1.0f / 512.0f) + EPS);
    float* am = WSP(float, WS_AMIXS) + (size_t)bs * DM; float* ovs = c.out + O_VS + (size_t)(l * SBATCH + bs) * 512;
#pragma unroll
    for (int i = 0; i < 8; ++i) { const int ch = c.lane + 64 * i, hb = ch >> 7; const float vb = pv[i] * rs * c.v_norm_g[l * 512 + ch];
        ovs[ch] = vb; am[512 + ch] = ps[2048 + ch] * (c.w_s[(size_t)(l * 4 + hb) * 128 * 128] * vb + c.b_s[(l * 4 + hb) * 128]); }
}
DI void phase_b0(const Ctx& c, int l, LAS unsigned char* lds) {
    constexpr int NPT = 256 * 17;
    LAS unsigned char* wl = lds + c.wave * B0_WAVE_LDS;
    for (int t = c.gw; t < NPT + SBATCH; t += c.ngw) {
        if (t >= NPT) { if (SUB(0)) b0_task_sample(c, l, t - NPT); continue; }
        const int chunk = t / 17, k = t % 17, b = chunk >> 5, n = chunk & 31;
        if (k == 0) { if (SUB(1)) b0_task_ab(c, l, b, n); }
        else if (k >= 13) { if (SUB(2)) b0_task_vb(c, l, b, n, k - 13, wl); }
        else { if (SUB(3)) b0_task_conv(c, l, b, n, (k - 1) >> 2, (k - 1) & 3, wl); }
    }
}

DI void b1_prep(const Ctx& c, int l, int unit, LAS unsigned char* wl, LAS float* sg, LAS float* sb) {
    int lane = c.lane; asm volatile("" : "+v"(lane));
    const int r = lane & 31, h = lane >> 5;
    const int n = unit & 31, bh = unit >> 5, hh = bh & 3, b = bh >> 2, tok0 = b * SEQ + n * 64;
    const float bt = WSP(float, WS_BETA)[(tok0 + lane) * 4 + hh];
    float gc = WSP(float, WS_G)[(tok0 + lane) * 4 + hh];
#pragma unroll
    for (int o = 1; o < 64; o <<= 1) { const float t = xlane(gc, lane - o); if (lane >= o) gc += t; }
    sg[lane] = gc; sb[lane] = bt;
    const float glast = __builtin_bit_cast(float, __builtin_amdgcn_readlane(__builtin_bit_cast(int, gc), 63));
    if (lane == 0) WSP(float, WS_EG)[unit] = __expf(glast);
    unsigned char* img = c.ws + WS_IMG + (size_t)unit * IMG_BYTES;
    const bf16_t* Kn = WSP(bf16_t, WS_KN) + (size_t)tok0 * 512 + hh * 128;
    const bf16_t* Qn = WSP(bf16_t, WS_QN) + (size_t)tok0 * 512 + hh * 128;
    const bf16_t* KnT = WSP(bf16_t, WS_KNT) + (size_t)unit * 128 * 64;
    const bf16_t* VT = WSP(bf16_t, WS_VT) + (size_t)unit * 128 * 64;
    LAS float* L = (LAS float*)wl;
    {
        bf16x8 Kf[2][8];
#pragma unroll
        for (int t = 0; t < 2; ++t)
#pragma unroll
            for (int ks = 0; ks < 8; ++ks) Kf[t][ks] = *(const bf16x8*)(Kn + (size_t)(32 * t + r) * 512 + 16 * ks + 8 * h);
#pragma unroll
        for (int tt = 0; tt < 3; ++tt) { const int mt = tt == 0 ? 0 : 1, nt = tt == 2 ? 1 : 0;
            f32x16 acc = zero16();
#pragma unroll
            for (int ks = 0; ks < 8; ++ks) acc = MFMA32(Kf[mt][ks], Kf[nt][ks], acc);
            const int j = 32 * nt + r; const float gj = sg[j];
#pragma unroll
            for (int g4 = 0; g4 < 4; ++g4) { const f32x4 gi4 = *(const LAS f32x4*)(sg + 32 * mt + 8 * g4 + 4 * h), bi4 = *(const LAS f32x4*)(sb + 32 * mt + 8 * g4 + 4 * h);
#pragma unroll
                for (int q = 0; q < 4; ++q) { const int i = 32 * mt + 8 * g4 + 4 * h + q; const float arg = i > j ? gi4[q] - gj : 0.f;
                    L[i * 64 + j] = i > j ? acc[4 * g4 + q] * bi4[q] * __expf(arg) : 0.f; } } }
#pragma unroll
        for (int mt = 0; mt < 2; ++mt) {
            bf16x8 Qf[8];
#pragma unroll
            for (int ks = 0; ks < 8; ++ks) Qf[ks] = *(const bf16x8*)(Qn + (size_t)(32 * mt + r) * 512 + 16 * ks + 8 * h);
            const int i = 32 * mt + r; const float gi = sg[i];
#pragma unroll
            for (int mp = 0; mp <= mt; ++mp) {
                f32x16 acc = zero16();
#pragma unroll
                for (int ks = 0; ks < 8; ++ks) acc = MFMA32(Kf[mp][ks], Qf[ks], acc);
#pragma unroll
                for (int g4 = 0; g4 < 4; ++g4) { const f32x4 gj4 = *(const LAS f32x4*)(sg + 32 * mp + 8 * g4 + 4 * h);
#pragma unroll
                    for (int q = 0; q < 4; ++q) { const int j = 32 * mp + 8 * g4 + 4 * h + q; const float arg = i >= j ? gi - gj4[q] : 0.f;
                        acc[4 * g4 + q] = i >= j ? acc[4 * g4 + q] * __expf(arg) : 0.f; } }
                const int fb = (mt == 0 ? 0 : 1 + mp) * 2;
#pragma unroll
                for (int s = 0; s < 2; ++s) *(u32x4*)(img + 49152 + (fb + s) * 1024 + lane * 16) = pack8(acc, s);
            }
        }
    }
    float Tr[64];
    {
        f32x4 lb[2][16];
#pragma unroll
        for (int i = 0; i < 64; ++i) {
            if (i + 1 < 64) {
#pragma unroll
                for (int j4 = 0; j4 < (i + 1 + 3) / 4; ++j4) lb[(i + 1) & 1][j4] = *(const LAS f32x4*)(L + (i + 1) * 64 + 4 * j4); }
            asm volatile("" ::: "memory");
            float a0 = lane == i ? 1.f : 0.f, a1 = 0.f;
#pragma unroll
            for (int j4 = 0; j4 < (i + 3) / 4; ++j4) {
#pragma unroll
                for (int q = 0; q < 4; ++q) { const int j = 4 * j4 + q; if (j < i) { if (q & 1) a1 -= lb[i & 1][j4][q] * Tr[j]; else a0 -= lb[i & 1][j4][q] * Tr[j]; } } }
            Tr[i] = a0 + a1;
        }
    }
    LAS bf16_t* T1 = (LAS bf16_t*)wl;
    asm volatile("" ::: "memory");
    {
        const float sc1 = bt * __expf(gc);
#pragma unroll
        for (int i = 0; i < 64; ++i) T1[i * 72 + lane] = f2bf(Tr[i] * sc1);
        bf16x8 Tf[2][4];
#pragma unroll
        for (int mt = 0; mt < 2; ++mt)
#pragma unroll
            for (int ks = 0; ks < 4; ++ks) Tf[mt][ks] = *(const LAS bf16x8*)(T1 + (32 * mt + r) * 72 + 16 * ks + 8 * h);
#pragma unroll
        for (int dt = 0; dt < 4; ++dt) {
            bf16x8 Kt[4];
#pragma unroll
            for (int ks = 0; ks < 4; ++ks) Kt[ks] = *(const bf16x8*)(KnT + (size_t)(32 * dt + r) * 64 + 16 * ks + 8 * h);
#pragma unroll
            for (int mt = 0; mt < 2; ++mt) { f32x16 acc = zero16();
#pragma unroll
                for (int ks = 0; ks < 2 * (mt + 1); ++ks) acc = MFMA32(Kt[ks], Tf[mt][ks], acc);
                acc = -acc;
#pragma unroll
                for (int s = 0; s < 2; ++s) *(u32x4*)(img + ((mt * 4 + dt) * 2 + s) * 1024 + lane * 16) = pack8(acc, s); }
        }
    }
    asm volatile("" ::: "memory");
    {
#pragma unroll
        for (int i = 0; i < 64; ++i) T1[i * 72 + lane] = f2bf(Tr[i] * bt);
        bf16x8 Tf[2][4];
#pragma unroll
        for (int mt = 0; mt < 2; ++mt)
#pragma unroll
            for (int ks = 0; ks < 4; ++ks) Tf[mt][ks] = *(const LAS bf16x8*)(T1 + (32 * mt + r) * 72 + 16 * ks + 8 * h);
        bf16_t* uimg = WSP(bf16_t, WS_UIMG) + (size_t)unit * 8192;
#pragma unroll
        for (int et = 0; et < 4; ++et) {
            bf16x8 Vt[4];
#pragma unroll
            for (int ks = 0; ks < 4; ++ks) Vt[ks] = *(const bf16x8*)(VT + (size_t)(32 * et + r) * 64 + 16 * ks + 8 * h);
#pragma unroll
            for (int mt = 0; mt < 2; ++mt) { f32x16 acc = zero16();
#pragma unroll
                for (int ks = 0; ks < 2 * (mt + 1); ++ks) acc = MFMA32(Tf[mt][ks], Vt[ks], acc);
#pragma unroll
                for (int g4 = 0; g4 < 4; ++g4) { u32x2 w; w.x = pk2(acc[4 * g4], acc[4 * g4 + 1]); w.y = pk2(acc[4 * g4 + 2], acc[4 * g4 + 3]); *(u32x2*)(uimg + ((et * 2 + mt) * 4 + g4) * 256 + lane * 4) = w; } }
        }
    }
    asm volatile("" ::: "memory");
#pragma unroll
    for (int mt = 0; mt < 2; ++mt) { const float ei = __expf(sg[32 * mt + r]);
#pragma unroll
        for (int dt = 0; dt < 4; ++dt)
#pragma unroll
            for (int s = 0; s < 2; ++s) { const bf16_t* qp = Qn + (size_t)(32 * mt + r) * 512 + 32 * dt + 16 * s + 4 * h;
                const u32x2 p0 = *(const u32x2*)qp, p1 = *(const u32x2*)(qp + 8);
                u32x4 w; w.x = pk2(bflo(p0.x) * ei, bfhi(p0.x) * ei); w.y = pk2(bflo(p0.y) * ei, bfhi(p0.y) * ei); w.z = pk2(bflo(p1.x) * ei, bfhi(p1.x) * ei); w.w = pk2(bflo(p1.y) * ei, bfhi(p1.y) * ei);
                *(u32x4*)(img + 16384 + ((mt * 4 + dt) * 2 + s) * 1024 + lane * 16) = w; } }
#pragma unroll
    for (int mp = 0; mp < 2; ++mp)
#pragma unroll
        for (int s = 0; s < 2; ++s) { const f32x4 ga = *(const LAS f32x4*)(sg + 32 * mp + 16 * s + 4 * h), gb = *(const LAS f32x4*)(sg + 32 * mp + 16 * s + 8 + 4 * h);
            float sc[8];
#pragma unroll
            for (int q = 0; q < 4; ++q) { sc[q] = __expf(glast - ga[q]); sc[4 + q] = __expf(glast - gb[q]); }
#pragma unroll
            for (int dt = 0; dt < 4; ++dt) { const bf16_t* kp = KnT + (size_t)(32 * dt + r) * 64 + 32 * mp + 16 * s + 4 * h;
                const u32x2 p0 = *(const u32x2*)kp, p1 = *(const u32x2*)(kp + 8);
                u32x4 w; w.x = pk2(bflo(p0.x) * sc[0], bfhi(p0.x) * sc[1]); w.y = pk2(bflo(p0.y) * sc[2], bfhi(p0.y) * sc[3]); w.z = pk2(bflo(p1.x) * sc[4], bfhi(p1.x) * sc[5]); w.w = pk2(bflo(p1.y) * sc[6], bfhi(p1.y) * sc[7]);
                *(u32x4*)(img + 32768 + ((dt * 2 + mp) * 2 + s) * 1024 + lane * 16) = w; } }
}
DI void b1_gmlp(const Ctx& c, int l, int unit) {
    int lane = c.lane; asm volatile("" : "+v"(lane));
    const int r = lane & 31, h = lane >> 5;
    const int hb = unit & 3, cc = (unit >> 2) & 15, b = unit >> 6, tokc0 = b * SEQ + cc * 128;
    const bf16_t* A = WSP(bf16_t, WS_VBT) + (size_t)unit * 128 * 128;
    const bf16_t* B = WSP(bf16_t, WS_WM) + (size_t)(l * 4 + hb) * 128 * 128;
    const bf16_t* P = WSP(bf16_t, WS_P); bf16_t* AM = WSP(bf16_t, WS_AMIX);
#pragma unroll
    for (int nt = 0; nt < 4; ++nt) {
        f32x16 acc[4];
#pragma unroll
        for (int mt = 0; mt < 4; ++mt) acc[mt] = zero16();
#pragma unroll
        for (int ks = 0; ks < 2 * (nt + 1); ++ks) { const bf16x8 bf = *(const bf16x8*)(B + (size_t)(32 * nt + r) * 128 + 16 * ks + 8 * h);
#pragma unroll
            for (int mt = 0; mt < 4; ++mt) { const bf16x8 af = *(const bf16x8*)(A + (size_t)(32 * mt + r) * 128 + 16 * ks + 8 * h); acc[mt] = MFMA32(af, bf, acc[mt]); } }
        const int tok = tokc0 + 32 * nt + r; const float bsi = c.b_s[(l * 4 + hb) * 128 + 32 * nt + r];
#pragma unroll
        for (int mt = 0; mt < 4; ++mt)
#pragma unroll
            for (int g4 = 0; g4 < 4; ++g4) { const int dch0 = 32 * mt + 8 * g4 + 4 * h;
                const u32x2 u4 = *(const u32x2*)(P + (size_t)tok * NP + 2048 + hb * 128 + dch0);
                u32x2 w; w.x = pk2(bflo(u4.x) * (acc[mt][4 * g4] + bsi), bfhi(u4.x) * (acc[mt][4 * g4 + 1] + bsi)); w.y = pk2(bflo(u4.y) * (acc[mt][4 * g4 + 2] + bsi), bfhi(u4.y) * (acc[mt][4 * g4 + 3] + bsi));
                *(u32x2*)(AM + (size_t)tok * DM + 512 + hb * 128 + dch0) = w; }
    }
}
DI void phase_b1(const Ctx& c, int l, LAS unsigned char* lds) {
    LAS unsigned char* wl = lds + c.wave * 16384; LAS float* sg = (LAS float*)(lds + 131072 + c.wave * 512); LAS float* sb = sg + 64;
    for (int t = c.gw; t < 1024 + 512; t += c.ngw) {
        if (t < 1024) { if (SUB(0)) b1_prep(c, l, t, wl, sg, sb); } else { if (SUB(1)) b1_gmlp(c, l, t - 1024); }
    }
}

constexpr int OB_STRIDE = 136;
constexpr int IMG_LDS = 57344;
constexpr int LDS_OBUF = 2 * IMG_LDS, OBUF_BYTES = 64 * OB_STRIDE * 2;
static_assert(LDS_OBUF + 2 * OBUF_BYTES <= LDS_BYTES, "scan LDS");
DI void scan_post(const Ctx& c, int l, int b, int hh, int n, const LAS bf16_t* ob, int lid, const u32x4 (&gt4)[4]) {
    const int i = lid >> 2, q = lid & 3, tok = b * SEQ + n * 64 + i;
    u32x4 ov[4]; float ss = 0.f;
#pragma unroll
    for (int x = 0; x < 4; ++x) { ov[x] = *(const LAS u32x4*)(ob + i * OB_STRIDE + 32 * q + 8 * x);
#pragma unroll
        for (int e = 0; e < 4; ++e) { const float a = bflo(ov[x][e]), bq = bfhi(ov[x][e]); ss += a * a + bq * bq; } }
    ss += xlane(ss, (lid & 63) ^ 1); ss += xlane(ss, (lid & 63) ^ 2);
    const float rs = rsqrtf(ss * (1.0f / 128.0f) + EPS);
    bf16_t* op = WSP(bf16_t, WS_AMIX) + (size_t)tok * DM + hh * 128 + 32 * q;
#pragma unroll
    for (int x = 0; x < 4; ++x) { u32x4 w;
#pragma unroll
        for (int e = 0; e < 4; ++e) w[e] = pk2(bflo(ov[x][e]) * rs * bflo(gt4[x][e]), bfhi(ov[x][e]) * rs * bfhi(gt4[x][e]));
        *(u32x4*)(op + 8 * x) = w; }
}
DI void scan_loader_step(const Ctx& c, int l, int b, int hh, int n, LAS unsigned char* lds, const unsigned char* img0, const bf16_t* gbase, int lw, int lane, int lid, u32x4 (&regs)[14], u32x4 (&gt)[4]) {
    u32x4 gcur[4];
#pragma unroll
    for (int x = 0; x < 4; ++x) gcur[x] = gt[x];
#pragma unroll
    for (int x = 0; x < 4; ++x) gt[x] = *(const u32x4*)(gbase + (size_t)n * 64 * NP + 8 * x);
    const unsigned voff = (unsigned)(lw * 14336 + lane * 16);
    if (n + 1 < 32) { LAS unsigned char* dst = lds + ((n + 1) & 1) * IMG_LDS + voff;
#pragma unroll
        for (int i = 0; i < 14; ++i) *(LAS u32x4*)(dst + i * 1024) = regs[i]; }
    if (n + 3 < 32) { const unsigned char* src = img0 + (size_t)(n + 3) * IMG_BYTES;
#pragma unroll
        for (int i = 0; i < 14; ++i) regs[i] = *(const u32x4*)(src + voff + i * 1024); }
    if (n >= 1) scan_post(c, l, b, hh, n - 1, (const LAS bf16_t*)(lds + LDS_OBUF + ((n - 1) & 1) * OBUF_BYTES), lid, gcur);
    __syncthreads();
}
DI void scan_consumer_step(int n, LAS unsigned char* lds, f32x16 (&S)[4], u32x2 (&ucur)[8], float& egc, const bf16_t* uimg0, const float* egp, int lane, int ws, int r, int h) {
    const LAS unsigned char* buf = lds + (n & 1) * IMG_LDS + lane * 16;
    f32x16 av[2], ao[2]; ao[0] = zero16(); ao[1] = zero16();
#pragma unroll
    for (int mt = 0; mt < 2; ++mt)
#pragma unroll
        for (int g4 = 0; g4 < 4; ++g4) { const u32x2 w = ucur[mt * 4 + g4]; av[mt][4 * g4] = bflo(w.x); av[mt][4 * g4 + 1] = bfhi(w.x); av[mt][4 * g4 + 2] = bflo(w.y); av[mt][4 * g4 + 3] = bfhi(w.y); }
    const float eg = egc;
    if (n + 2 < 32) { const bf16_t* up = uimg0 + (size_t)(n + 2) * 8192;
#pragma unroll
        for (int x = 0; x < 8; ++x) ucur[x] = *(const u32x2*)(up + x * 256);
        egc = egp[n + 2]; }
    {
        bf16x8 fg[2][4];
#pragma unroll
        for (int mt = 0; mt < 2; ++mt) { fg[0][mt] = *(const LAS bf16x8*)(buf + (mt * 8) * 1024); fg[0][2 + mt] = *(const LAS bf16x8*)(buf + 16384 + (mt * 8) * 1024); }
#pragma unroll
        for (int gI = 0; gI < 8; ++gI) { const int dt = gI >> 1, s = gI & 1;
            if (gI + 1 < 8) {
#pragma unroll
                for (int mt = 0; mt < 2; ++mt) { fg[(gI + 1) & 1][mt] = *(const LAS bf16x8*)(buf + (mt * 8 + gI + 1) * 1024); fg[(gI + 1) & 1][2 + mt] = *(const LAS bf16x8*)(buf + 16384 + (mt * 8 + gI + 1) * 1024); } }
            asm volatile("" ::: "memory");
            const bf16x8 sb = as_bf(pack8(S[dt], s));
            av[0] = MFMA32(fg[gI & 1][0], sb, av[0]); av[1] = MFMA32(fg[gI & 1][1], sb, av[1]);
            ao[0] = MFMA32(sb, fg[gI & 1][2], ao[0]); ao[1] = MFMA32(sb, fg[gI & 1][3], ao[1]); }
    }
    bf16x8 vb[2][2];
#pragma unroll
    for (int mp = 0; mp < 2; ++mp)
#pragma unroll
        for (int s = 0; s < 2; ++s) vb[mp][s] = as_bf(pack8(av[mp], s));
    {
        bf16x8 qf[6];
#pragma unroll
        for (int f = 0; f < 6; ++f) qf[f] = *(const LAS bf16x8*)(buf + 49152 + f * 1024);
        asm volatile("" ::: "memory");
#pragma unroll
        for (int s = 0; s < 2; ++s) { ao[0] = MFMA32(vb[0][s], qf[s], ao[0]); ao[1] = MFMA32(vb[0][s], qf[2 + s], ao[1]); ao[1] = MFMA32(vb[1][s], qf[4 + s], ao[1]); }
    }
    LAS bf16_t* ob = (LAS bf16_t*)(lds + LDS_OBUF + (n & 1) * OBUF_BYTES);
#pragma unroll
    for (int mt = 0; mt < 2; ++mt)
#pragma unroll
        for (int g4 = 0; g4 < 4; ++g4) { u32x2 w; w.x = pk2(ao[mt][4 * g4], ao[mt][4 * g4 + 1]); w.y = pk2(ao[mt][4 * g4 + 2], ao[mt][4 * g4 + 3]);
            *(LAS u32x2*)(ob + (32 * mt + r) * OB_STRIDE + 32 * ws + 8 * g4 + 4 * h) = w; }
    bf16x8 kf[2][4];
#pragma unroll
    for (int f = 0; f < 4; ++f) kf[0][f] = *(const LAS bf16x8*)(buf + 32768 + f * 1024);
#pragma unroll
    for (int dt = 0; dt < 4; ++dt) {
        if (dt + 1 < 4) {
#pragma unroll
            for (int f = 0; f < 4; ++f) kf[(dt + 1) & 1][f] = *(const LAS bf16x8*)(buf + 32768 + ((dt + 1) * 4 + f) * 1024); }
        asm volatile("" ::: "memory");
        S[dt] = S[dt] * eg;
#pragma unroll
        for (int mp = 0; mp < 2; ++mp)
#pragma unroll
            for (int s = 0; s < 2; ++s) S[dt] = MFMA32(kf[dt & 1][mp * 2 + s], vb[mp][s], S[dt]); }
    __syncthreads();
}
DI void scan_block(const Ctx& c, int l, int bh, LAS unsigned char* lds) {
    const int wave = c.wave, b = bh >> 2, hh = bh & 3;
    const unsigned char* img0 = c.ws + WS_IMG + (size_t)bh * 32 * IMG_BYTES;
    if (wave >= 4) { if (SUB2(0)) {
        int lane = c.lane; asm volatile("" : "+v"(lane));
        const int lw = wave - 4, lid = lw * 64 + lane;
        u32x4 regs0[14], regs1[14], gt0[4];
        const bf16_t* gbase = WSP(bf16_t, WS_P) + (size_t)(b * SEQ + (lid >> 2)) * NP + 1536 + hh * 128 + 32 * (lid & 3);
        const unsigned voff0 = (unsigned)(lw * 14336 + lane * 16);
#pragma unroll
        for (int i = 0; i < 14; ++i) regs0[i] = *(const u32x4*)(img0 + voff0 + i * 1024);
#pragma unroll
        for (int i = 0; i < 14; ++i) *(LAS u32x4*)(lds + voff0 + i * 1024) = regs0[i];
#pragma unroll
        for (int i = 0; i < 14; ++i) { regs1[i] = *(const u32x4*)(img0 + (size_t)IMG_BYTES + voff0 + i * 1024); regs0[i] = *(const u32x4*)(img0 + (size_t)2 * IMG_BYTES + voff0 + i * 1024); }
#pragma unroll
        for (int x = 0; x < 4; ++x) gt0[x] = (u32x4){0u, 0u, 0u, 0u};
        __syncthreads();
        for (int n = 0; n < 32; n += 2) {
            scan_loader_step(c, l, b, hh, n, lds, img0, gbase, lw, lane, lid, regs1, gt0);
            scan_loader_step(c, l, b, hh, n + 1, lds, img0, gbase, lw, lane, lid, regs0, gt0);
        }
        scan_post(c, l, b, hh, 31, (const LAS bf16_t*)(lds + LDS_OBUF + (31 & 1) * OBUF_BYTES), lid, gt0);
    } } else if (SUB2(1)) {
        int lane = c.lane; asm volatile("" : "+v"(lane));
        const int ws = wave, r = lane & 31, h = lane >> 5;
        f32x16 S[4];
#pragma unroll
        for (int dt = 0; dt < 4; ++dt) S[dt] = zero16();
        const bf16_t* uimg0 = WSP(bf16_t, WS_UIMG) + (size_t)bh * 32 * 8192 + (size_t)ws * 2 * 4 * 256 + lane * 4;
        const float* egp = WSP(float, WS_EG) + bh * 32;
        u32x2 u0[8], u1[8];
#pragma unroll
        for (int x = 0; x < 8; ++x) { u0[x] = *(const u32x2*)(uimg0 + x * 256); u1[x] = *(const u32x2*)(uimg0 + 8192 + x * 256); }
        float eg0 = egp[0], eg1 = egp[1];
        __syncthreads();
        for (int n = 0; n < 32; n += 2) {
            scan_consumer_step(n, lds, S, u0, eg0, uimg0, egp, lane, ws, r, h);
            scan_consumer_step(n + 1, lds, S, u1, eg1, uimg0, egp, lane, ws, r, h);
        }
        const char* od = (const char*)(c.out + O_DP + (size_t)(l * 32 + bh) * 128 * 128);
        unsigned voff = (unsigned)((4 * h) * 128 + 32 * ws + r) * 4u;
        asm volatile("" : "+v"(voff));
#pragma unroll
        for (int dt = 0; dt < 4; ++dt)
#pragma unroll
            for (int reg = 0; reg < 16; ++reg) *(float*)(od + (32 * dt + (reg & 3) + 8 * (reg >> 2)) * 512 + voff) = S[dt][reg];
    }
}
DI float rdlane(float v, int l) { return __builtin_bit_cast(float, __builtin_amdgcn_readlane(__builtin_bit_cast(int, v), l)); }
DI void sample_recurrent(const Ctx& c, int l, int unit) {
    int lane = c.lane; asm volatile("" : "+v"(lane));
    const int bs = unit >> 2, hh = unit & 3, e2 = 2 * lane;
    const float* S0 = c.state_delta + (size_t)((l * SBATCH + bs) * 4 + hh) * 128 * 128 + e2;
    float* S1 = c.out + O_DS + (size_t)((l * SBATCH + bs) * 4 + hh) * 128 * 128 + e2;
    const float* q = WSP(float, WS_QS) + bs * 512 + hh * 128; const float* k = WSP(float, WS_KS) + bs * 512 + hh * 128; const float* v = WSP(float, WS_VS) + bs * 512 + hh * 128;
    const float eg = __expf(WSP(float, WS_GS)[bs * 4 + hh]), beta = WSP(float, WS_BS)[bs * 4 + hh];
    const float k0 = k[lane], k1 = k[64 + lane], q0 = q[lane], q1 = q[64 + lane];
    f32x2 kv = {0.f, 0.f};
#pragma unroll
    for (int d0 = 0; d0 < 128; d0 += 32) { f32x2 sv[32];
#pragma unroll
        for (int j = 0; j < 32; ++j) sv[j] = *(const f32x2*)(S0 + (d0 + j) * 128);
#pragma unroll
        for (int j = 0; j < 32; ++j) { const int dd = d0 + j; kv += sv[j] * rdlane(dd < 64 ? k0 : k1, dd & 63); } }
    const f32x2 v2 = *(const f32x2*)(v + e2);
    const f32x2 delta = (v2 - kv * eg) * beta;
    f32x2 oo = {0.f, 0.f};
#pragma unroll
    for (int d0 = 0; d0 < 128; d0 += 32) { f32x2 sv[32];
#pragma unroll
        for (int j = 0; j < 32; ++j) sv[j] = *(const f32x2*)(S0 + (d0 + j) * 128);
#pragma unroll
        for (int j = 0; j < 32; ++j) { const int dd = d0 + j; const f32x2 sn = sv[j] * eg + delta * rdlane(dd < 64 ? k0 : k1, dd & 63); oo += sn * rdlane(dd < 64 ? q0 : q1, dd & 63); *(f32x2*)(S1 + dd * 128) = sn; } }
    const float ss = wave_sum(oo.x * oo.x + oo.y * oo.y, lane); const float rs = rsqrtf(ss * (1.0f / 128.0f) + EPS);
    const float* ps = WSP(float, WS_PS) + (size_t)bs * NPS + 1536 + hh * 128 + e2; float* am = WSP(float, WS_AMIXS) + (size_t)bs * DM + hh * 128 + e2;
    const float* og = c.o_norm_g + l * 128 + e2;
    am[0] = oo.x * rs * og[0] * silu_f(ps[0]); am[1] = oo.y * rs * og[1] * silu_f(ps[1]);
}
DI void phase_scan(const Ctx& c, int l, LAS unsigned char* lds) {
    if (blockIdx.x < 32) { if (SUB(0)) scan_block(c, l, blockIdx.x, lds); return; }
    const int w0 = (blockIdx.x - 32) * 8 + c.wave, nw = (gridDim.x - 32) * 8;
    for (int u = w0; u < SBATCH * 4; u += nw) { if (SUB(1)) sample_recurrent(c, l, u); }
}

DI void phase_final(const Ctx& c) {
    for (int m = c.gw; m < MP + SBATCH; m += c.ngw) {
        const float* src = m < MP ? WSP(float, WS_XBUF) + (size_t)m * DM : WSP(float, WS_XS) + (size_t)(m - MP) * DM;
        float* dst = m < MP ? c.out + O_YP + (size_t)m * DM : c.out + O_YS + (size_t)(m - MP) * DM;
        const f32x4* xr = (const f32x4*)src + c.lane; const f32x4* gr = (const f32x4*)c.norm_f_g + c.lane; f32x4 v[4]; float s = 0.f;
#pragma unroll
        for (int j = 0; j < 4; ++j) { v[j] = xr[64 * j];
            s += (v[j].x * v[j].x + v[j].y * v[j].y) + (v[j].z * v[j].z + v[j].w * v[j].w); }
        const float rs = rsqrtf(wave_sum(s, c.lane) * (1.0f / DM) + EPS);
#pragma unroll
        for (int j = 0; j < 4; ++j) ((f32x4*)dst + c.lane)[64 * j] = v[j] * rs * gr[64 * j];
    }
}

#define XB_TMO      128
#define XB_XCNT(j)  (256  + 64 * (j))
#define XB_XSUB(j)  (1280 + 64 * (j))
#define XB_XGEN(j)  (2304 + 64 * (j))
#define XB_TOP      3328
#define XB_TOPGEN   3392
#define XCD_BAR_WORDS 3456
#define XB_SPIN_CAP (1u << 18)

__device__ __forceinline__ unsigned xb_ld(unsigned* p)              { return __hip_atomic_load(p, __ATOMIC_RELAXED, __HIP_MEMORY_SCOPE_AGENT); }
__device__ __forceinline__ unsigned xb_add(unsigned* p, unsigned v) { return __hip_atomic_fetch_add(p, v, __ATOMIC_RELAXED, __HIP_MEMORY_SCOPE_AGENT); }
__device__ __forceinline__ unsigned xb_xcc_id() { return (unsigned)__builtin_amdgcn_s_getreg((3 << 11) | 20) & 0xFu; }
#define XB_SPIN(cond, bar) do { unsigned _sp = 0; while (cond) { __builtin_amdgcn_s_sleep(8); \
    if ((++_sp & 255u) == 0u) { if (xb_ld(&(bar)[XB_TMO])) break; if (_sp > XB_SPIN_CAP) { atomicAdd(&(bar)[XB_TMO], 1u); break; } } } } while (0)

struct XcdBarrier {
    unsigned* bar; unsigned x;
    volatile LAS unsigned* st;
};

__device__ __forceinline__ XcdBarrier xcd_barrier_post(unsigned* bar, volatile LAS unsigned* st) {
    XcdBarrier b; b.bar = bar; b.x = xb_xcc_id(); b.st = st;
    if (threadIdx.x == 0) (void)xb_add(&bar[XB_XCNT(b.x)], 1u);
    return b;
}
__device__ __forceinline__ void xcd_barrier_complete(unsigned* bar, unsigned x, unsigned& nloc, unsigned& nx) {
    const unsigned G = gridDim.x * gridDim.y * gridDim.z;
    unsigned sum, cnt, mine, sp = 0u;
    for (;;) {
        sum = 0u; cnt = 0u; mine = 0u;
#pragma unroll
        for (unsigned j = 0; j < 16; ++j) { const unsigned c = xb_ld(&bar[XB_XCNT(j)]); sum += c; cnt += (c > 0u) ? 1u : 0u; mine = (j == x) ? c : mine; }
        if (sum == G) break;
        __builtin_amdgcn_s_sleep(1);
        if ((++sp & 255u) == 0u) { if (xb_ld(&bar[XB_TMO])) break; if (sp > XB_SPIN_CAP) { atomicAdd(&bar[XB_TMO], 1u); break; } }
    }
    nloc = mine > 0u ? mine : 1u; nx = cnt > 0u ? cnt : 1u;
}

__device__ __forceinline__ void xcd_barrier(const XcdBarrier& b) {
    asm volatile("s_waitcnt vmcnt(0)" ::: "memory");
    __syncthreads();
    if (threadIdx.x == 0) {
        unsigned* bar = b.bar;
        __builtin_amdgcn_s_waitcnt(0);
        unsigned nloc = b.st[0], nx = b.st[1];
        if (nloc == 0u) { xcd_barrier_complete(bar, b.x, nloc, nx); b.st[0] = nloc; b.st[1] = nx; }
        const unsigned old = xb_add(&bar[XB_XSUB(b.x)], 1u);
        const unsigned gen = old / nloc;
        if (old + 1u == (gen + 1u) * nloc) {
            __builtin_amdgcn_fence(__ATOMIC_RELEASE, "agent");
            asm volatile("s_waitcnt vmcnt(0)" ::: "memory");
            const unsigned og = xb_add(&bar[XB_TOP], 1u);
            const unsigned tg = og / nx;
            if (og + 1u == (tg + 1u) * nx) xb_add(&bar[XB_TOPGEN], 1u);
            else XB_SPIN(xb_ld(&bar[XB_TOPGEN]) == tg, bar);
            __builtin_amdgcn_fence(__ATOMIC_ACQUIRE, "agent");
            xb_add(&bar[XB_XGEN(b.x)], 1u);
            asm volatile("s_waitcnt vmcnt(0)" ::: "memory");
        } else {
            XB_SPIN(xb_ld(&bar[XB_XGEN(b.x)]) == gen, bar);
            __builtin_amdgcn_fence(__ATOMIC_ACQUIRE, "agent");
            asm volatile("s_waitcnt vmcnt(0)" ::: "memory");
        }
    }
    __syncthreads();
}
#ifndef ONLY
#define ONLY -1
#endif
#ifndef REPMASK
#define REPMASK 0
#endif
#define EN(x) (ONLY < 0 || ONLY == (x))
__global__ void __launch_bounds__(512, 2) hymba_fwd(Args args) {
    extern __shared__ __attribute__((aligned(16))) unsigned char lds_raw[];
    LAS unsigned char* lds = (LAS unsigned char*)lds_raw;
    cg::grid_group grid = cg::this_grid();
    Ctx c;
    c.x_prompt = args.in[0]; c.x_sample = args.in[1]; c.state_delta = args.in[2]; c.state_conv = args.in[3]; c.norm_mix_g = args.in[4]; c.w_in = args.in[5]; c.conv_w = args.in[6];
    c.A_log = args.in[7]; c.dt_bias = args.in[8]; c.o_norm_g = args.in[9]; c.v_norm_g = args.in[10]; c.w_s = args.in[11]; c.b_s = args.in[12]; c.w_o = args.in[13]; c.norm_ffn_g = args.in[14];
    c.w_up = args.in[15]; c.w_down = args.in[16]; c.norm_f_g = args.in[17]; c.out = args.out; c.ws = args.ws;
    c.lane = threadIdx.x & 63; c.wave = __builtin_amdgcn_readfirstlane(threadIdx.x >> 6); c.gw = blockIdx.x * 8 + c.wave; c.ngw = gridDim.x * 8;
    const int G = gridDim.x;
    volatile LAS unsigned* bst = (volatile LAS unsigned*)(lds + LDS_BYTES - 16);
    if (threadIdx.x < 2) bst[threadIdx.x] = 0u;
    __syncthreads();
    XcdBarrier xbar = xcd_barrier_post((unsigned*)args.ws, bst);
    grid.sync();
    for (int step = 2 * args.ph_lo; step < 2 * args.ph_hi; ++step) {
        const int ph = step >> 1;
        const int ptype = ph == 0 ? 0 : (ph == 29 ? 8 : 1 + (ph - 1) % 7);
        if ((step & 1) && !((REPMASK >> ptype) & 1)) continue;
        { int tl = threadIdx.x; asm volatile("" : "+v"(tl)); c.lane = tl & 63; unsigned char* wsp = args.ws; asm volatile("" : "+s"(wsp)); c.ws = wsp; float* op = args.out; asm volatile("" : "+s"(op)); c.out = op; }
        if (step & 1) __syncthreads();
        if (ph == 0) { if (EN(0)) phase_prologue(c, lds); }
        else if (ph == 29) { if (EN(8)) phase_final(c); }
        else {
            const int l = (ph - 1) / 7, s = (ph - 1) % 7;
            float* ssq = WSP(float, WS_SSQ);
            if (s == 0) { if (EN(1)) { sgemm1(c, l, lds); if ((REPMASK >> 10) & 1) sgemm1(c, l, lds);
                pg8::Gemm g{WSP(bf16_t, WS_XB16), WSP(bf16_t, WS_WIN) + (size_t)l * NP * DM, MP, NP, DM}; pg8::StaticOrder S; S.init(MP, NP, G, blockIdx.x);
                pg8::EpiScaleBf16 E{WSP(bf16_t, WS_P), NP, ssq + (size_t)(2 * l) * MP * 16, 0, WSP(float, WS_VSS), c.o_norm_g + l * 128}; pg8::gemm_phase(lds, g, S, E); } }
            else if (s == 1) { if (EN(2)) phase_b0(c, l, lds); }
            else if (s == 2) { if (EN(3)) phase_b1(c, l, lds); }
            else if (s == 3) { if (EN(4)) phase_scan(c, l, lds); if ((REPMASK >> 12) & 1) { __syncthreads(); if (blockIdx.x < 32) scan_block(c, l, blockIdx.x, lds); } if ((REPMASK >> 13) & 1) { if (blockIdx.x >= 32) { const int w0 = (blockIdx.x - 32) * 8 + c.wave, nw = (gridDim.x - 32) * 8; for (int u = w0; u < SBATCH * 4; u += nw) sample_recurrent(c, l, u); } } }
            else if (s == 4) { if (EN(5)) { if (!(step & 1)) sgemm2(c, l, lds);
                pg8::Gemm g{WSP(bf16_t, WS_AMIX), WSP(bf16_t, WS_WO) + (size_t)l * DM * DM, MP, DM, DM}; pg8::StaticOrder S; S.init(MP, DM, G, blockIdx.x);
                pg8::EpiResid E{l == 0 ? c.x_prompt : WSP(float, WS_XBUF), (step & 1) ? WSP(float, WS_IMG) : WSP(float, WS_XBUF), (step & 1) ? WSP(bf16_t, WS_KNT) : WSP(bf16_t, WS_XB16), (step & 1) ? WSP(float, WS_VBT) : ssq + (size_t)(2 * l + 1) * MP * 16}; pg8::gemm_phase(lds, g, S, E); } }
            else if (s == 5) { if (EN(6)) { sgemm3(c, l, lds); if ((REPMASK >> 11) & 1) sgemm3(c, l, lds);
                pg8::Gemm g{WSP(bf16_t, WS_XB16), WSP(bf16_t, WS_WUP) + (size_t)l * FF * DM, MP, FF, DM}; pg8::StaticOrder S; S.init(MP, FF, G, blockIdx.x);
                pg8::EpiScaleBf16 E{WSP(bf16_t, WS_UNION), FF, ssq + (size_t)(2 * l + 1) * MP * 16, 1, nullptr, nullptr}; pg8::gemm_phase(lds, g, S, E); } }
            else { if (EN(7)) { if (!(step & 1)) sgemm4(c, l, lds);
                pg8::Gemm g{WSP(bf16_t, WS_UNION), WSP(bf16_t, WS_WDN) + (size_t)l * DM * FF, MP, DM, FF}; pg8::StaticOrder S; S.init(MP, DM, G, blockIdx.x);
                pg8::EpiResid E{WSP(float, WS_XBUF), (step & 1) ? WSP(float, WS_IMG) : WSP(float, WS_XBUF), (step & 1) ? WSP(bf16_t, WS_KNT) : WSP(bf16_t, WS_XB16), (step & 1) ? WSP(float, WS_VBT) : ssq + (size_t)(2 * l + 2) * MP * 16}; pg8::gemm_phase(lds, g, S, E); } }
        }
        if (!(step & 1) && ((REPMASK >> ptype) & 1)) continue;
        if ((REPMASK >> 9) & 1) { if (ph + 1 < args.ph_hi) xcd_barrier(xbar); }
        if (ph + 1 < args.ph_hi) {
            xcd_barrier(xbar);
        }
    }
}

extern "C" void kernel_launch(void* const* d_in, const int* in_sizes, int n_in, void* d_out, int out_size, void* d_ws, size_t ws_size, hipStream_t stream) {
    static int grid = 0;
    if (grid == 0) {
        int dev = 0, cus = 0, per_cu = 0;
        (void)hipGetDevice(&dev); (void)hipDeviceGetAttribute(&cus, hipDeviceAttributeMultiprocessorCount, dev);
        if (hipFuncSetAttribute((const void*)hymba_fwd, hipFuncAttributeMaxDynamicSharedMemorySize, LDS_BYTES) != hipSuccess) fprintf(stderr, "kernel_launch: hipFuncSetAttribute failed\n");
        if (hipOccupancyMaxActiveBlocksPerMultiprocessor(&per_cu, (const void*)hymba_fwd, 512, LDS_BYTES) != hipSuccess || per_cu < 1) { fprintf(stderr, "kernel_launch: occupancy query says %d\n", per_cu); per_cu = 1; }
        (void)hipGetLastError();
        grid = cus * 1;
        if (ws_size < WS_END) fprintf(stderr, "kernel_launch: workspace too small: %zu < %zu\n", ws_size, (size_t)WS_END);
    }
    (void)hipMemsetAsync(d_ws, 0, 65536, stream);
    Args a{};
    for (int i = 0; i < 18; ++i) a.in[i] = (const float*)d_in[i];
    a.out = (float*)d_out; a.ws = (unsigned char*)d_ws; a.ph_lo = 0; a.ph_hi = 30;
    void* kargs[] = {&a};
    hipError_t e = hipLaunchCooperativeKernel((const void*)hymba_fwd, dim3(grid), dim3(512), kargs, LDS_BYTES, stream);
    if (e != hipSuccess) fprintf(stderr, "kernel_launch: cooperative launch failed: %s (grid %d)\n", hipGetErrorString(e), grid);
}
```

```cpp
#include <hip/hip_runtime.h>
#include <hip/hip_cooperative_groups.h>
#include <cstdio>
namespace cg = cooperative_groups;

#define LAS __attribute__((address_space(3)))
#define DI __device__ __forceinline__
typedef unsigned short bf16_t;
typedef short bf16x8 __attribute__((ext_vector_type(8)));
typedef float f32x4 __attribute__((ext_vector_type(4)));
typedef float f32x2 __attribute__((ext_vector_type(2)));
typedef float f32x16 __attribute__((ext_vector_type(16)));
typedef unsigned u32x4 __attribute__((ext_vector_type(4)));
typedef unsigned u32x2 __attribute__((ext_vector_type(2)));
typedef __bf16 bf2_t __attribute__((ext_vector_type(2)));
typedef unsigned u32x8 __attribute__((ext_vector_type(8)));

#ifndef SUBSEL
#define SUBSEL -1
#endif
#define SUB(x) (SUBSEL < 0 || SUBSEL == (x))
#ifndef SUBSEL2
#define SUBSEL2 -1
#endif
#define SUB2(x) (SUBSEL2 < 0 || SUBSEL2 == (x))
constexpr int DM = 1024, NBATCH = 8, SEQ = 2048, MP = NBATCH * SEQ, DEPTH = 4, SBATCH = 128;
constexpr int NH = 4, QKV = 1536, NP = 3072, PROJ = 3080, FF = 4096, NPS = 3088;
constexpr float EPS = 1e-6f;
constexpr int IMG_BYTES = 55296;
constexpr int LDS_BYTES = 150528;
constexpr size_t O_YP = 0, O_YS = 16777216, O_DP = 16908288, O_CP = 19005440, O_DS = 19152896, O_CS = 52707328, O_VS = 55066624;
constexpr size_t WS_WIN = 65536;
constexpr size_t WS_WAB = WS_WIN + (size_t)DEPTH * NP * DM * 2;
constexpr size_t WS_WO = WS_WAB + (size_t)DEPTH * 16 * DM * 2;
constexpr size_t WS_WUP = WS_WO + (size_t)DEPTH * DM * DM * 2;
constexpr size_t WS_WDN = WS_WUP + (size_t)DEPTH * FF * DM * 2;
constexpr size_t WS_WM = WS_WDN + (size_t)DEPTH * FF * DM * 2;
constexpr size_t WS_XBUF = WS_WM + (size_t)DEPTH * 4 * 128 * 128 * 2;
constexpr size_t WS_XB16 = WS_XBUF + (size_t)MP * DM * 4;
constexpr size_t WS_SSQ = WS_XB16 + (size_t)MP * DM * 2;
constexpr size_t WS_UNION = WS_SSQ + (size_t)9 * MP * 16 * 4;
constexpr size_t WS_P = WS_UNION;
constexpr size_t WS_QN = WS_P + (size_t)MP * NP * 2;
constexpr size_t WS_KN = WS_QN + (size_t)MP * 512 * 2;
constexpr size_t WS_KNT = WS_UNION + (size_t)MP * FF * 2;
constexpr size_t WS_VT = WS_KNT + (size_t)MP * 512 * 2;
constexpr size_t WS_VBT = WS_VT + (size_t)MP * 512 * 2;
constexpr size_t WS_G = WS_VBT + (size_t)MP * 512 * 2;
constexpr size_t WS_BETA = WS_G + (size_t)MP * 4 * 4;
constexpr size_t WS_EG = WS_BETA + (size_t)MP * 4 * 4;
constexpr size_t WS_IMG = WS_EG + 4096;
constexpr size_t WS_UIMG = WS_IMG + (size_t)1024 * IMG_BYTES;
constexpr size_t WS_AMIX = WS_UIMG + (size_t)1024 * 32768;
constexpr size_t WS_XS = WS_AMIX + (size_t)MP * DM * 2;
constexpr size_t WS_PS = WS_XS + (size_t)SBATCH * DM * 4;
constexpr size_t WS_QS = WS_PS + (size_t)SBATCH * NPS * 4;
constexpr size_t WS_KS = WS_QS + (size_t)SBATCH * 512 * 4;
constexpr size_t WS_VS = WS_KS + (size_t)SBATCH * 512 * 4;
constexpr size_t WS_GS = WS_VS + (size_t)SBATCH * 512 * 4;
constexpr size_t WS_BS = WS_GS + (size_t)SBATCH * 4 * 4;
constexpr size_t WS_AMIXS = WS_BS + (size_t)SBATCH * 4 * 4;
constexpr size_t WS_HS = WS_AMIXS + (size_t)SBATCH * DM * 4;
constexpr size_t WS_XP = WS_HS + (size_t)SBATCH * FF * 4;
constexpr size_t WS_VSS = WS_XP + (size_t)4 * SBATCH * DM * 4;
constexpr size_t WS_CWP = WS_VSS + (size_t)MP * 8 * 4;
constexpr size_t WS_END = WS_CWP + (size_t)DEPTH * 4 * QKV * 4;
static_assert(WS_QN + 2 * (size_t)MP * 512 * 2 == WS_KNT, "union");
static_assert(WS_END <= (size_t)536870912, "workspace");

DI unsigned pk2(float lo, float hi) { f32x2 v = {lo, hi}; return __builtin_bit_cast(unsigned, __builtin_convertvector(v, bf2_t)); }
DI float bflo(unsigned w) { return __uint_as_float(w << 16); }
DI float bfhi(unsigned w) { return __uint_as_float(w & 0xffff0000u); }
DI float bf2f(bf16_t b) { return __uint_as_float(((unsigned)b) << 16); }
DI bf16_t f2bf(float f) { return (bf16_t)(pk2(f, 0.f) & 0xffffu); }
DI float xlane(float v, int srclane) { return __builtin_bit_cast(float, __builtin_amdgcn_ds_bpermute(srclane << 2, __builtin_bit_cast(int, v))); }
DI float wave_sum(float v, int lane) {
#pragma unroll
    for (int o = 1; o < 64; o <<= 1) v += xlane(v, lane ^ o);
    return v;
}
DI float silu_f(float x) { return x * __builtin_amdgcn_rcpf(1.f + __expf(-x)); }
DI float sigmoid_f(float x) { return __builtin_amdgcn_rcpf(1.f + __expf(-x)); }
DI float softplus_f(float x) { const float e = __expf(-fabsf(x)); const float l = e < 0.01f ? e * (1.f - e * (0.5f - 0.33333334f * e)) : __logf(1.f + e); return fmaxf(x, 0.f) + l; }
DI u32x4 pack8(const f32x16& x, int s) {
    u32x4 p; p.x = pk2(x[8 * s], x[8 * s + 1]); p.y = pk2(x[8 * s + 2], x[8 * s + 3]); p.z = pk2(x[8 * s + 4], x[8 * s + 5]); p.w = pk2(x[8 * s + 6], x[8 * s + 7]); return p;
}
DI float ssq_sum(const float* p) {
    const f32x4 a = *(const f32x4*)p, b = *(const f32x4*)(p + 4), c2 = *(const f32x4*)(p + 8), d2 = *(const f32x4*)(p + 12);
    return ((a.x + a.y) + (a.z + a.w)) + ((b.x + b.y) + (b.z + b.w)) + ((c2.x + c2.y) + (c2.z + c2.w)) + ((d2.x + d2.y) + (d2.z + d2.w));
}
DI int crow(int reg, int h) { return (reg & 3) + 8 * (reg >> 2) + 4 * h; }
#define MFMA32(a, b, c) __builtin_amdgcn_mfma_f32_32x32x16_bf16((a), (b), (c), 0, 0, 0)
#define MFMA16(a, b, c) __builtin_amdgcn_mfma_f32_16x16x32_bf16((a), (b), (c), 0, 0, 0)
DI bf16x8 as_bf(u32x4 v) { return __builtin_bit_cast(bf16x8, v); }
DI f32x16 zero16() { f32x16 z;
#pragma unroll
    for (int i = 0; i < 16; ++i) z[i] = 0.f; return z; }

namespace pg8 {
constexpr int BM = 256, BK = 64, HALF = 128, HTB = HALF * BK * 2, STAGE_BYTES = 8 * HTB, NXCD = 8, WGM = 8;
DI int lds_byte(int r, int c) { const int st = (r >> 4) * 2 + (c >> 5), rr = r & 15, cc = c & 31, ob = rr * 64 + cc * 2; return st * 1024 + (ob ^ (((ob >> 9) & 1) << 5)); }
DI void stage_rc(int b, int& R, int& C) { const int st = b / 1024, sb = b % 1024, swz = sb ^ (((sb >> 9) & 1) << 5); R = (st >> 1) * 16 + swz / 64; C = (st & 1) * 32 + (swz % 64) / 2; }
DI int perm32(int rho) { const int n = rho >> 4, i = rho & 15; return 8 * (i >> 2) + 4 * n + (i & 3); }
struct Unit { int pm, pn; };
struct Gemm { const bf16_t* A; const bf16_t* Bt; int M, N, K; };
struct StaticOrder {
    int nM, nN, nwg, G, c;
    DI void init(int M, int N, int G_, int c_) { nM = M / BM; nN = N / BM; nwg = nM * nN; G = G_; c = c_; }
    DI bool next(int i, Unit& u) const {
        const long L = (long)i * G + c; if (L >= nwg) return false;
        int wgid = (int)L; { const int q = nwg / NXCD, r = nwg % NXCD, xcd = wgid % NXCD, off = wgid / NXCD; wgid = (xcd < r ? xcd * (q + 1) : r * (q + 1) + (xcd - r) * q) + off; }
        const int nig = WGM * nN, gid = wgid / nig, fm = gid * WGM, gsz = (nM - fm) < WGM ? (nM - fm) : WGM;
        u.pm = fm + ((wgid % nig) % gsz); u.pn = (wgid % nig) / gsz; return true;
    }
};
template <class Epi>
DI void gemm_phase(LAS unsigned char* lds, const Gemm g, const StaticOrder& S, const Epi& E) {
    int tid = threadIdx.x; asm volatile("" : "+v"(tid));
    const int wid = __builtin_amdgcn_readfirstlane(tid >> 6), lane = tid & 63, wr = wid >> 2, wc = wid & 3, fr = lane & 15, fq = lane >> 4;
    const int K = g.K, nt = K / BK;
    unsigned voffA[2], voffB[2];
#pragma unroll
    for (int i = 0; i < 2; ++i) { int R, C; stage_rc(tid * 16 + i * 8192, R, C); const int Rb = (R & ~31) + perm32(R & 31);
        voffA[i] = (unsigned)(R * K + C) * 2u; voffB[i] = (unsigned)(Rb * K + C) * 2u; }
    const size_t kstep = (size_t)(BK * 2);
    const size_t hstep = (size_t)HALF * K * 2;
    const size_t tstep = 2 * hstep;
    const unsigned ldsw = (unsigned)wid * 1024u;
    const int aoff = lds_byte(wr * 64 + fr, fq * 8), boff = lds_byte(wc * 32 + fr, fq * 8);
#define PG8_SA(b, h) (((b) * 2 + (h)) * HTB)
#define PG8_SB(b, h) ((4 + (b) * 2 + (h)) * HTB)
#define PG8_STAGE(bufoff, gbase, voff) do { _Pragma("unroll") for (int _i = 0; _i < 2; ++_i) \
        __builtin_amdgcn_global_load_lds((const unsigned*)((const char*)(gbase) + (voff)[_i]), (LAS unsigned*)(lds + (bufoff) + ldsw + _i * 8192), 16, 0, 0); } while (0)
#define PG8_LDA(dst, b, h) do { _Pragma("unroll") for (int m = 0; m < 4; ++m) _Pragma("unroll") for (int k = 0; k < 2; ++k) dst[m][k] = *(const LAS bf16x8*)(lds + PG8_SA(b, h) + aoff + m * 2048 + k * 1024); } while (0)
#define PG8_LDB(dst, b, h) do { _Pragma("unroll") for (int n = 0; n < 2; ++n) _Pragma("unroll") for (int k = 0; k < 2; ++k) dst[n][k] = *(const LAS bf16x8*)(lds + PG8_SB(b, h) + boff + n * 2048 + k * 1024); } while (0)
#define PG8_MMA(ai, bj, At, Bt) do { __builtin_amdgcn_s_setprio(1); _Pragma("unroll") for (int m = 0; m < 4; ++m) _Pragma("unroll") for (int n = 0; n < 2; ++n) _Pragma("unroll") for (int k = 0; k < 2; ++k) \
        acc[ai][bj][m][n] = __builtin_amdgcn_mfma_f32_16x16x32_bf16(Bt[n][k], At[m][k], acc[ai][bj][m][n], 0, 0, 0); __builtin_amdgcn_s_setprio(0); } while (0)
#define PG8_WAIT_V(n) asm volatile("s_waitcnt vmcnt(" #n ")" ::: "memory")
#define PG8_WAIT_L(n) asm volatile("s_waitcnt lgkmcnt(" #n ")" ::: "memory")
#define PG8_BAR __builtin_amdgcn_s_barrier()
#define PG8_SCHED __builtin_amdgcn_sched_barrier(0)
    Unit cur, nxt; int ui = 0;
    if (!S.next(0, cur)) return;
    f32x4 acc[2][2][4][2];
#pragma unroll
    for (int a = 0; a < 2; ++a)
#pragma unroll
        for (int b = 0; b < 2; ++b)
#pragma unroll
            for (int m = 0; m < 4; ++m)
#pragma unroll
                for (int n = 0; n < 2; ++n) acc[a][b][m][n] = (f32x4){0.f, 0.f, 0.f, 0.f};
    bf16x8 At[4][2], B0[2][2], B1[2][2];
    const char* cA = (const char*)g.A + (size_t)cur.pm * tstep; const char* cB = (const char*)g.Bt + (size_t)cur.pn * tstep;
    PG8_STAGE(PG8_SB(0, 0), cB, voffB); PG8_STAGE(PG8_SA(0, 0), cA, voffA); PG8_STAGE(PG8_SB(0, 1), cB + hstep, voffB); PG8_STAGE(PG8_SA(0, 1), cA + hstep, voffA);
    if (wr == 1) PG8_BAR;
    PG8_WAIT_V(4); PG8_BAR;
    PG8_STAGE(PG8_SB(1, 0), cB + kstep, voffB); PG8_STAGE(PG8_SA(1, 0), cA + kstep, voffA); PG8_STAGE(PG8_SB(1, 1), cB + hstep + kstep, voffB);
    PG8_WAIT_V(6); PG8_BAR;
    for (;;) {
        const bool has_next = S.next(ui + 1, nxt);
        const char* nA = has_next ? (const char*)g.A + (size_t)nxt.pm * tstep : cA; const char* nB = has_next ? (const char*)g.Bt + (size_t)nxt.pn * tstep : cB;
        for (int t = 0; t < nt; t += 2) {
            const bool last = (t == nt - 2);
            const char* a1 = cA + (size_t)(t + 1) * kstep;
            const char* a2 = last ? nA : cA + (size_t)(t + 2) * kstep; const char* b2 = last ? nB : cB + (size_t)(t + 2) * kstep;
            const char* a3 = a2 + kstep; const char* b3 = b2 + kstep;
            PG8_LDB(B0, 0, 0); PG8_SCHED; PG8_LDA(At, 0, 0); PG8_STAGE(PG8_SA(1, 1), a1 + hstep, voffA);
            PG8_WAIT_L(8); PG8_BAR; PG8_WAIT_L(0); PG8_MMA(0, 0, At, B0); PG8_BAR; PG8_SCHED;
            PG8_LDB(B1, 0, 1); PG8_STAGE(PG8_SB(0, 0), b2, voffB);
            PG8_BAR; PG8_WAIT_L(0); PG8_MMA(0, 1, At, B1); PG8_BAR;
            PG8_LDA(At, 0, 1); PG8_STAGE(PG8_SA(0, 0), a2, voffA);
            PG8_BAR; PG8_WAIT_L(0); PG8_MMA(1, 0, At, B0); PG8_BAR; PG8_SCHED;
            PG8_STAGE(PG8_SB(0, 1), b2 + hstep, voffB);
            PG8_WAIT_V(6); PG8_BAR; PG8_MMA(1, 1, At, B1); PG8_BAR;
            PG8_LDB(B0, 1, 0); PG8_SCHED; PG8_LDA(At, 1, 0); PG8_STAGE(PG8_SA(0, 1), a2 + hstep, voffA);
            PG8_WAIT_L(8); PG8_BAR; PG8_WAIT_L(0); PG8_MMA(0, 0, At, B0); PG8_BAR; PG8_SCHED;
            PG8_LDB(B1, 1, 1); PG8_STAGE(PG8_SB(1, 0), b3, voffB);
            PG8_BAR; PG8_WAIT_L(0); PG8_MMA(0, 1, At, B1); PG8_BAR;
            PG8_LDA(At, 1, 1); PG8_STAGE(PG8_SA(1, 0), a3, voffA);
            PG8_BAR; PG8_WAIT_L(0); PG8_MMA(1, 0, At, B0); PG8_BAR; PG8_SCHED;
            PG8_STAGE(PG8_SB(1, 1), b3 + hstep, voffB);
            PG8_WAIT_V(6); PG8_BAR; PG8_MMA(1, 1, At, B1); PG8_BAR;
        }
        E(acc, cur, wr, wc, fr, fq);
        if (!has_next) break;
#pragma unroll
        for (int a = 0; a < 2; ++a)
#pragma unroll
            for (int b = 0; b < 2; ++b)
#pragma unroll
                for (int m = 0; m < 4; ++m)
#pragma unroll
                    for (int n = 0; n < 2; ++n) acc[a][b][m][n] = (f32x4){0.f, 0.f, 0.f, 0.f};
        cur = nxt; cA = nA; cB = nB; ++ui;
    }
    PG8_WAIT_V(0);
    if (wr == 0) PG8_BAR;
    PG8_BAR;
#undef PG8_SA
#undef PG8_SB
#undef PG8_STAGE
#undef PG8_LDA
#undef PG8_LDB
#undef PG8_MMA
#undef PG8_WAIT_V
#undef PG8_WAIT_L
#undef PG8_BAR
#undef PG8_SCHED
}
struct EpiScaleBf16 {
    bf16_t* O; int ldc; const float* ssq; int act; float* vss; const float* og;
    DI void operator()(const f32x4 (&acc)[2][2][4][2], const Unit& u, int wr, int wc, int fr, int fq) const {
        const int row0 = u.pm * BM + wr * 64 + fr, col0 = u.pn * BM + wc * 32 + 8 * fq;
#pragma unroll
        for (int ai = 0; ai < 2; ++ai)
#pragma unroll
            for (int m = 0; m < 4; ++m) { const int row = row0 + ai * HALF + m * 16; const float rs = rsqrtf(ssq_sum(ssq + (size_t)row * 16) * (1.0f / DM) + EPS);
                bf16_t* rowp = O + (size_t)row * ldc + col0; float vs = 0.f;
#pragma unroll
                for (int bj = 0; bj < 2; ++bj) { f32x4 v0 = acc[ai][bj][m][0] * rs, v1 = acc[ai][bj][m][1] * rs;
                    if (act) {
#pragma unroll
                        for (int j = 0; j < 4; ++j) { const float a = fmaxf(v0[j], 0.f), b = fmaxf(v1[j], 0.f); v0[j] = a * a; v1[j] = b * b; } }
                    if (og != nullptr && (u.pn == 6 || u.pn == 7)) { const float* gp = og + ((col0 + bj * HALF) & 127); const f32x4 g0 = *(const f32x4*)gp, g1 = *(const f32x4*)(gp + 4);
#pragma unroll
                        for (int j = 0; j < 4; ++j) { v0[j] = silu_f(v0[j]) * g0[j]; v1[j] = silu_f(v1[j]) * g1[j]; } }
                    u32x4 w; w.x = pk2(v0[0], v0[1]); w.y = pk2(v0[2], v0[3]); w.z = pk2(v1[0], v1[1]); w.w = pk2(v1[2], v1[3]);
                    *(u32x4*)(rowp + bj * HALF) = w;
                    vs += (v0[0] * v0[0] + v0[1] * v0[1]) + (v0[2] * v0[2] + v0[3] * v0[3]) + (v1[0] * v1[0] + v1[1] * v1[1]) + (v1[2] * v1[2] + v1[3] * v1[3]); }
                if (vss != nullptr && u.pn >= 10) { { const int ln = fq * 16 + fr; vs += xlane(vs, ln ^ 16); vs += xlane(vs, ln ^ 32); } if (fq == 0) vss[(size_t)row * 8 + (u.pn - 10) * 4 + wc] = vs; } }
    }
};
struct EpiResid {
    bf16_t* xb; float* ssq;
    DI void operator()(const f32x4 (&acc)[2][2][4][2], const Unit& u, int wr, int wc, int fr, int fq) const {
        const int row0 = u.pm * BM + wr * 64 + fr, col0 = u.pn * BM + wc * 32 + 8 * fq;
#pragma unroll
        for (int ai = 0; ai < 2; ++ai)
#pragma unroll
            for (int m = 0; m < 4; ++m) { const int row = row0 + ai * HALF + m * 16; const size_t off = (size_t)row * DM + col0; float ss = 0.f;
#pragma unroll
                for (int bj = 0; bj < 2; ++bj) {
                    const u32x4 b = *(const u32x4*)(xb + off + bj * HALF);
                    const f32x4 o0 = (f32x4){bflo(b.x), bfhi(b.x), bflo(b.y), bfhi(b.y)} + acc[ai][bj][m][0], o1 = (f32x4){bflo(b.z), bfhi(b.z), bflo(b.w), bfhi(b.w)} + acc[ai][bj][m][1];
                    u32x4 w; w.x = pk2(o0[0], o0[1]); w.y = pk2(o0[2], o0[3]); w.z = pk2(o1[0], o1[1]); w.w = pk2(o1[2], o1[3]);
                    *(u32x4*)(xb + off + bj * HALF) = w;
                    ss += (o0[0] * o0[0] + o0[1] * o0[1]) + (o0[2] * o0[2] + o0[3] * o0[3]) + (o1[0] * o1[0] + o1[1] * o1[1]) + (o1[2] * o1[2] + o1[3] * o1[3]); }
                { const int ln = fq * 16 + fr; ss += xlane(ss, ln ^ 16); ss += xlane(ss, ln ^ 32); }
                if (fq == 0) ssq[(size_t)row * 16 + u.pn * 4 + wc] = ss;
                asm volatile("" ::: "memory"); }
    }
};
}

struct Args { const float* in[18]; float* out; unsigned char* ws; int ph_lo, ph_hi; };
struct Ctx {
    const float *x_prompt, *x_sample, *state_delta, *state_conv, *norm_mix_g, *w_in, *conv_w, *A_log, *dt_bias, *o_norm_g, *v_norm_g, *w_s, *b_s, *w_o, *norm_ffn_g, *w_up, *w_down, *norm_f_g;
    float* out; unsigned char* ws;
    int lane, wave, gw, ngw, bx, nb;
};
#define WSP(T, off) ((T*)(c.ws + (off)))

DI void transpose_item(const float* W, int K, int N, const float* kscale, bf16_t* WT, bf16_t* WAB, int mode, int item, int nblk, LAS float* scr, int lane) {
    const int kb = item / nblk, nb = item % nblk, k0 = 64 * kb, n0 = 64 * nb;
    const int c4 = lane & 15, rsub = lane >> 4;
    const bool cval = n0 + 4 * c4 + 3 < N;
#pragma unroll 4
    for (int kk = 0; kk < 64; kk += 4) { const int row = kk + rsub;
        f32x4 v = (f32x4){0.f, 0.f, 0.f, 0.f}; if (cval) { v = *(const f32x4*)(W + (size_t)(k0 + row) * N + n0 + 4 * c4); if (kscale) v = v * kscale[k0 + row]; }
        LAS float* p = scr + row * 65 + 4 * c4; p[0] = v.x; p[1] = v.y; p[2] = v.z; p[3] = v.w; }
    asm volatile("s_waitcnt lgkmcnt(0)" ::: "memory");
    const int kc = lane & 7;
#pragma unroll
    for (int it = 0; it < 8; ++it) { const int n = 8 * it + (lane >> 3), ns = n0 + n; const LAS float* s = scr + (8 * kc) * 65 + n;
        u32x4 o; o.x = pk2(s[0 * 65], s[1 * 65]); o.y = pk2(s[2 * 65], s[3 * 65]); o.z = pk2(s[4 * 65], s[5 * 65]); o.w = pk2(s[6 * 65], s[7 * 65]);
        if (ns < N) {
            bf16_t* rowp;
            if (mode == 0) rowp = WT + (size_t)ns * K;
            else rowp = ns < 2048 ? WT + (size_t)ns * K : (ns < 2056 ? WAB + (size_t)(ns - 2048) * K : WT + (size_t)(ns - 8) * K);
            *(u32x4*)(rowp + k0 + 8 * kc) = o; } }
    asm volatile("s_waitcnt lgkmcnt(0)" ::: "memory");
}
DI void phase_prologue(const Ctx& c, LAS unsigned char* lds) {
    LAS float* scr = (LAS float*)(lds + c.wave * 18432);
    constexpr int I_IN = 16 * 49, I_O = 16 * 16, I_UP = 16 * 64, I_DN = 64 * 16, I_L = I_IN + I_O + I_UP + I_DN;
    for (int it = c.gw; it < DEPTH * I_L; it += c.ngw) {
        const int l = it / I_L; int r = it % I_L;
        if (r < I_IN) { transpose_item(c.w_in + (size_t)l * DM * PROJ, DM, PROJ, c.norm_mix_g + l * DM, WSP(bf16_t, WS_WIN) + (size_t)l * NP * DM, WSP(bf16_t, WS_WAB) + (size_t)l * 16 * DM, 1, r, 49, scr, c.lane); continue; } r -= I_IN;
        if (r < I_O) { transpose_item(c.w_o + (size_t)l * DM * DM, DM, DM, nullptr, WSP(bf16_t, WS_WO) + (size_t)l * DM * DM, nullptr, 0, r, 16, scr, c.lane); continue; } r -= I_O;
        if (r < I_UP) { transpose_item(c.w_up + (size_t)l * DM * FF, DM, FF, c.norm_ffn_g + l * DM, WSP(bf16_t, WS_WUP) + (size_t)l * FF * DM, nullptr, 0, r, 64, scr, c.lane); continue; } r -= I_UP;
        transpose_item(c.w_down + (size_t)l * FF * DM, FF, DM, nullptr, WSP(bf16_t, WS_WDN) + (size_t)l * DM * FF, nullptr, 0, r, 16, scr, c.lane);
    }
    float* ssq = WSP(float, WS_SSQ);
    for (int m = c.gw; m < MP; m += c.ngw) {
        const f32x4* xr = (const f32x4*)(c.x_prompt + (size_t)m * DM) + c.lane; u32x2* o8 = (u32x2*)(WSP(bf16_t, WS_XB16) + (size_t)m * DM) + c.lane; float s = 0.f;
#pragma unroll
        for (int j = 0; j < 4; ++j) { const f32x4 v = xr[64 * j]; s += (v.x * v.x + v.y * v.y) + (v.z * v.z + v.w * v.w); u32x2 w; w.x = pk2(v.x, v.y); w.y = pk2(v.z, v.w); o8[64 * j] = w; }
        s = wave_sum(s, c.lane); if (c.lane < 16) ssq[(size_t)m * 16 + c.lane] = c.lane == 0 ? s : 0.f;
    }
    const int gt = c.gw * 64 + c.lane, ngt = c.ngw * 64;
    float* xs = WSP(float, WS_XS);
    for (int i = gt; i < SBATCH * DM; i += ngt) xs[i] = c.x_sample[i];
    bf16_t* wab = WSP(bf16_t, WS_WAB);
    for (int i = gt; i < DEPTH * 8 * DM; i += ngt) { const int l = i / (8 * DM), r = i % (8 * DM); wab[(size_t)l * 16 * DM + 8 * DM + r] = 0; }
    unsigned* wm = WSP(unsigned, WS_WM);
    for (int i = gt; i < DEPTH * 4 * 128 * 64; i += ngt) { const int e = 2 * i, ii = (e >> 7) & 127, jj = e & 127;
        const float a = ii >= jj ? c.w_s[e] : 0.f, b = ii >= jj + 1 ? c.w_s[e + 1] : 0.f; wm[i] = pk2(a, b); }
}

template <int NT, bool NORM, int EPI>
DI void sgemm_block(const Ctx& c, const float* A, int lda, int K, const bf16_t* Bt, int ncg, float* out, int ldo, LAS unsigned char* lds, const bf16_t* Bab) {
    int lane = c.lane; asm volatile("" : "+v"(lane));
    const int wave = c.wave, fr = lane & 15, fq = lane >> 4;
    LAS f32x4* red = (LAS f32x4*)lds;
    LAS float* ssr = (LAS float*)(lds + 8 * NT * 64 * 16);
    const int kw = K / 8, k0 = wave * kw;
    for (int u = c.bx; u < 8 * ncg; u += c.nb) {
        const int rt = u & 7, cg = u >> 3;
        const bool abg = (Bab != nullptr) && (cg == ncg - 1);
        const bf16_t* bp = (abg ? Bab : Bt + (size_t)cg * NT * 16 * K) + (size_t)fr * K + k0 + 8 * fq;
        const float* ap = A + (size_t)(rt * 16 + fr) * lda + k0 + 8 * fq;
        f32x4 acc[NT]; float ss = 0.f;
#pragma unroll
        for (int nt = 0; nt < NT; ++nt) acc[nt] = (f32x4){0.f, 0.f, 0.f, 0.f};
#pragma unroll 4
        for (int k = 0; k < kw; k += 32) {
            const f32x4 a0 = *(const f32x4*)(ap + k), a1 = *(const f32x4*)(ap + k + 4);
            if (NORM) ss += (a0.x * a0.x + a0.y * a0.y) + (a0.z * a0.z + a0.w * a0.w) + (a1.x * a1.x + a1.y * a1.y) + (a1.z * a1.z + a1.w * a1.w);
            u32x4 a; a.x = pk2(a0.x, a0.y); a.y = pk2(a0.z, a0.w); a.z = pk2(a1.x, a1.y); a.w = pk2(a1.z, a1.w);
#pragma unroll
            for (int nt = 0; nt < NT; ++nt) if (nt == 0 || !abg) { const bf16x8 bf = *(const bf16x8*)(bp + (size_t)nt * 16 * K + k); acc[nt] = MFMA16(as_bf(a), bf, acc[nt]); }
        }
        if (NORM) { ss += xlane(ss, lane ^ 16); ss += xlane(ss, lane ^ 32); if (fq == 0) ssr[wave * 16 + fr] = ss; }
#pragma unroll
        for (int nt = 0; nt < NT; ++nt) red[(wave * NT + nt) * 64 + lane] = acc[nt];
        __syncthreads();
        if (wave < NT && (wave == 0 || !abg)) {
            f32x4 t = red[wave * 64 + lane];
#pragma unroll
            for (int w = 1; w < 8; ++w) t += red[(w * NT + wave) * 64 + lane];
            const int col = (cg * NT + wave) * 16 + fr;
#pragma unroll
            for (int j = 0; j < 4; ++j) { const int rl = 4 * fq + j; float rs = 1.f;
                if (NORM) { float sq = 0.f;
#pragma unroll
                    for (int w = 0; w < 8; ++w) sq += ssr[w * 16 + rl];
                    rs = rsqrtf(sq * (1.0f / DM) + EPS); }
                float* o = out + (size_t)(rt * 16 + rl) * ldo + col;
                if (EPI == 0) *o = t[j] * rs; else if (EPI == 1) *o += t[j]; else { const float v = fmaxf(t[j] * rs, 0.f); *o = v * v; } }
        }
        __syncthreads();
    }
}
DI void sgemm1(const Ctx& c, int l, LAS unsigned char* lds) {
    sgemm_block<4, true, 0>(c, WSP(float, WS_XS), DM, DM, WSP(bf16_t, WS_WIN) + (size_t)l * NP * DM, 49, WSP(float, WS_PS), NPS, lds, WSP(bf16_t, WS_WAB) + (size_t)l * 16 * DM);
}
DI void sgemm2(const Ctx& c, int l, LAS unsigned char* lds) {
    sgemm_block<2, false, 1>(c, WSP(float, WS_AMIXS), DM, DM, WSP(bf16_t, WS_WO) + (size_t)l * DM * DM, 32, WSP(float, WS_XS), DM, lds, nullptr);
}
DI void sgemm3(const Ctx& c, int l, LAS unsigned char* lds) {
    sgemm_block<4, true, 2>(c, WSP(float, WS_XS), DM, DM, WSP(bf16_t, WS_WUP) + (size_t)l * FF * DM, 64, WSP(float, WS_HS), FF, lds, nullptr);
}
DI void sgemm4(const Ctx& c, int l, LAS unsigned char* lds) {
    sgemm_block<2, false, 1>(c, WSP(float, WS_HS), FF, FF, WSP(bf16_t, WS_WDN) + (size_t)l * DM * FF, 32, WSP(float, WS_XS), DM, lds, nullptr);
}

DI void b0_block_ab(const Ctx& c, int l, int chunk, LAS unsigned char* lds) {
    int lane = c.lane; asm volatile("" : "+v"(lane));
    const int wave = c.wave, fr = lane & 15, fq = lane >> 4, tok0 = chunk * 64, k0 = wave * 128;
    const bf16_t* ap = WSP(bf16_t, WS_XB16) + (size_t)(tok0 + fr) * DM + k0 + 8 * fq;
    const bf16_t* bp = WSP(bf16_t, WS_WAB) + (size_t)l * 16 * DM + (size_t)fr * DM + k0 + 8 * fq;
    f32x4 acc[4];
#pragma unroll
    for (int mt = 0; mt < 4; ++mt) acc[mt] = (f32x4){0.f, 0.f, 0.f, 0.f};
#pragma unroll
    for (int k = 0; k < 128; k += 32) {
        const bf16x8 bf = *(const bf16x8*)(bp + k);
#pragma unroll
        for (int mt = 0; mt < 4; ++mt) { const bf16x8 a = *(const bf16x8*)(ap + (size_t)mt * 16 * DM + k); acc[mt] = MFMA16(a, bf, acc[mt]); }
    }
    LAS f32x4* red = (LAS f32x4*)lds;
#pragma unroll
    for (int mt = 0; mt < 4; ++mt) red[(wave * 4 + mt) * 64 + lane] = acc[mt];
    __syncthreads();
    if (wave < 4 && fr < 8) { const int mt = wave;
        f32x4 t = red[mt * 64 + lane];
#pragma unroll
        for (int w = 1; w < 8; ++w) t += red[(w * 4 + mt) * 64 + lane];
        const float* ssq = WSP(float, WS_SSQ) + (size_t)(2 * l) * MP * 16;
        float* gb = WSP(float, WS_G); float* bb = WSP(float, WS_BETA);
        const int hh = fr & 3; const float al = -__expf(c.A_log[l * 4 + hh]), dtb = c.dt_bias[l * 4 + hh];
#pragma unroll
        for (int j = 0; j < 4; ++j) { const int tok = tok0 + 16 * mt + 4 * fq + j; const float v = t[j] * rsqrtf(ssq_sum(ssq + (size_t)tok * 16) * (1.0f / DM) + EPS);
            if (fr < 4) gb[tok * 4 + hh] = al * softplus_f(v + dtb); else bb[tok * 4 + hh] = sigmoid_f(v); } }
    __syncthreads();
}
DI float dot2bf(unsigned a, unsigned b, float c) { float r; asm("v_dot2c_f32_bf16 %0, %1, %2" : "=v"(r) : "s"(b), "v"(a), "0"(c)); return r; }
constexpr int B0_STRIDE = 272, B0_WAVE_LDS = 18432;
DI void b0_task_conv(const Ctx& c, int l, int b, int n, int s, int hh, LAS unsigned char* wl) {
    int lane = c.lane; asm volatile("" : "+v"(lane));
    const int tok0 = b * SEQ + n * 64, cb = s * 512 + hh * 128, piece = lane & 15;
    const bf16_t* P = WSP(bf16_t, WS_P) + (size_t)tok0 * NP + cb + piece * 8;
#pragma unroll
    for (int k = 0; k < 17; ++k) { const int row = 4 * k + (lane >> 4);
        if (row < 67) { u32x4 v = (u32x4){0u, 0u, 0u, 0u}; if (n > 0 || row >= 3) v = *(const u32x4*)(P + (long)(row - 3) * NP);
            *(LAS u32x4*)(wl + row * B0_STRIDE + piece * 16) = v; } }
    const unsigned* cwl = (const unsigned*)(c.conv_w + (size_t)l * 4 * QKV + cb);
    if (n == 31) {
        float* ocp = c.out + O_CP + ((size_t)(l * NBATCH + b) * 3) * QKV + cb;
#pragma unroll
        for (int t = 0; t < 6; ++t) { const int idx = lane + 64 * t, row = idx >> 7, ch = idx & 127; ocp[(size_t)row * QKV + ch] = bf2f(*(const LAS bf16_t*)(wl + (64 + row) * B0_STRIDE + ch * 2)); } }
    float ss = 0.f;
#pragma unroll 1
    for (int i = 0; i < 16; ++i) {
        u32x4 rws[4];
#pragma unroll
        for (int j = 0; j < 4; ++j) rws[j] = *(const LAS u32x4*)(wl + (lane + j) * B0_STRIDE + i * 16);
        u32x8 w0, w1, w2, w3; const unsigned* wp = cwl + 8 * i;
        asm volatile("s_load_dwordx8 %0, %4, 0x0\n\ts_load_dwordx8 %1, %4, 0x1800\n\ts_load_dwordx8 %2, %4, 0x3000\n\ts_load_dwordx8 %3, %4, 0x4800\n\ts_waitcnt lgkmcnt(0)"
                     : "=&s"(w0), "=&s"(w1), "=&s"(w2), "=&s"(w3) : "s"(wp) : "memory");
        float y[8];
#pragma unroll
        for (int e = 0; e < 8; ++e) { float a = 0.f;
            a = dot2bf(rws[0][e >> 1], (e & 1) ? ((w0[e] + 0x8000u) & 0xffff0000u) : ((w0[e] + 0x8000u) >> 16), a);
            a = dot2bf(rws[1][e >> 1], (e & 1) ? ((w1[e] + 0x8000u) & 0xffff0000u) : ((w1[e] + 0x8000u) >> 16), a);
            a = dot2bf(rws[2][e >> 1], (e & 1) ? ((w2[e] + 0x8000u) & 0xffff0000u) : ((w2[e] + 0x8000u) >> 16), a);
            a = dot2bf(rws[3][e >> 1], (e & 1) ? ((w3[e] + 0x8000u) & 0xffff0000u) : ((w3[e] + 0x8000u) >> 16), a);
            y[e] = silu_f(a); ss += y[e] * y[e]; }
        u32x4 w; w.x = pk2(y[0], y[1]); w.y = pk2(y[2], y[3]); w.z = pk2(y[4], y[5]); w.w = pk2(y[6], y[7]);
        *(LAS u32x4*)(wl + (lane + 3) * B0_STRIDE + i * 16) = w;
    }
    const float sc = s == 0 ? rsqrtf(ss + EPS) * 0.08838834764831845f : (s == 1 ? rsqrtf(ss + EPS) : 1.0f);
    const size_t unit = (size_t)((b * 4 + hh) * 32 + n);
    bf16_t* ot = (s == 1 ? WSP(bf16_t, WS_KNT) : WSP(bf16_t, WS_VT)) + unit * 128 * 64 + lane;
#pragma unroll 2
    for (int i = 0; i < 16; ++i) { const u32x4 v = *(const LAS u32x4*)(wl + (lane + 3) * B0_STRIDE + i * 16); u32x4 w;
#pragma unroll
        for (int e = 0; e < 4; ++e) w[e] = pk2(bflo(v[e]) * sc, bfhi(v[e]) * sc);
        if (s < 2) *(LAS u32x4*)(wl + (lane + 3) * B0_STRIDE + i * 16) = w;
        if (s >= 1) {
#pragma unroll
            for (int e = 0; e < 8; ++e) ot[(8 * i + e) * 64] = (bf16_t)((e & 1) ? (w[e >> 1] >> 16) : (w[e >> 1] & 0xffffu)); } }
    if (s < 2) { bf16_t* o = (s == 0 ? WSP(bf16_t, WS_QN) : WSP(bf16_t, WS_KN)) + (size_t)tok0 * 512 + hh * 128 + piece * 8;
#pragma unroll
        for (int k = 0; k < 16; ++k) { const int row = 4 * k + (lane >> 4); *(u32x4*)(o + (size_t)row * 512) = *(const LAS u32x4*)(wl + (row + 3) * B0_STRIDE + piece * 16); } }
}
DI void b0_task_vb(const Ctx& c, int l, int b, int n, int hb, LAS unsigned char* wl) {
    int lane = c.lane; asm volatile("" : "+v"(lane));
    const int tok0 = b * SEQ + n * 64, piece = lane & 15;
    const bf16_t* P = WSP(bf16_t, WS_P) + (size_t)tok0 * NP + 2560 + hb * 128 + piece * 8;
#pragma unroll
    for (int k = 0; k < 16; ++k) { const int row = 4 * k + (lane >> 4); *(LAS u32x4*)(wl + row * B0_STRIDE + piece * 16) = *(const u32x4*)(P + (size_t)row * NP); }
    const float* vp = WSP(float, WS_VSS) + (size_t)(tok0 + lane) * 8; const f32x4 p0 = *(const f32x4*)vp, p1 = *(const f32x4*)(vp + 4);
    const float rs = rsqrtf((((p0.x + p0.y) + (p0.z + p0.w)) + ((p1.x + p1.y) + (p1.z + p1.w))) * (1.0f / 512.0f) + EPS);
    const float* vg = c.v_norm_g + l * 512 + hb * 128;
    bf16_t* vbt = WSP(bf16_t, WS_VBT) + ((size_t)((b * 16 + (n >> 1)) * 4 + hb) * 128) * 128 + (n & 1) * 64 + lane;
#pragma unroll 2
    for (int i = 0; i < 16; ++i) { const u32x4 v = *(const LAS u32x4*)(wl + lane * B0_STRIDE + i * 16);
#pragma unroll
        for (int e = 0; e < 8; ++e) { const float pv = (e & 1) ? bfhi(v[e >> 1]) : bflo(v[e >> 1]); vbt[(size_t)(8 * i + e) * 128] = f2bf(pv * rs * vg[8 * i + e]); } }
}
DI void b0_task_sample(const Ctx& c, int l, int bs) {
    const float* ps = WSP(float, WS_PS) + (size_t)bs * NPS;
    if (c.lane < 4) { const int hh = c.lane;
        WSP(float, WS_GS)[bs * 4 + hh] = -__expf(c.A_log[l * 4 + hh]) * softplus_f(ps[3072 + hh] + c.dt_bias[l * 4 + hh]);
        WSP(float, WS_BS)[bs * 4 + hh] = sigmoid_f(ps[3076 + hh]); }
    const float* sc = c.state_conv + (size_t)(l * SBATCH + bs) * 3 * QKV;
    const float* cw = c.conv_w + (size_t)l * 4 * QKV;
    float* ocs = c.out + O_CS + (size_t)(l * SBATCH + bs) * 3 * QKV;
    float* qkvs = WSP(float, WS_QS) + bs * 512;
#pragma unroll 1
    for (int sh = 0; sh < 12; ++sh) {
        float y[2];
#pragma unroll
        for (int t = 0; t < 2; ++t) { const int ch = sh * 128 + t * 64 + c.lane; const float s0 = sc[ch], s1 = sc[QKV + ch], s2 = sc[2 * QKV + ch], cur = ps[ch];
            ocs[ch] = s1; ocs[QKV + ch] = s2; ocs[2 * QKV + ch] = cur;
            y[t] = silu_f(s0 * cw[ch] + s1 * cw[QKV + ch] + s2 * cw[2 * QKV + ch] + cur * cw[3 * QKV + ch]); }
        float scale = 1.0f;
        if (sh < 8) { const float ssum = wave_sum(y[0] * y[0] + y[1] * y[1], c.lane); scale = rsqrtf(ssum + EPS) * (sh < 4 ? 0.08838834764831845f : 1.0f); }
        float* o = qkvs + (size_t)(sh >> 2) * SBATCH * 512 + (sh & 3) * 128;
        o[c.lane] = y[0] * scale; o[64 + c.lane] = y[1] * scale;
    }
    float pv[8]; float ss = 0.f;
#pragma unroll
    for (int i = 0; i < 8; ++i) { pv[i] = ps[2560 + c.lane + 64 * i]; ss += pv[i] * pv[i]; }
    ss = wave_sum(ss, c.lane); const float rs = rsqrtf(ss * (1.0f / 512.0f) + EPS);
    float* am = WSP(float, WS_AMIXS) + (size_t)bs * DM; float* ovs = c.out + O_VS + (size_t)(l * SBATCH + bs) * 512;
#pragma unroll
    for (int i = 0; i < 8; ++i) { const int ch = c.lane + 64 * i, hb = ch >> 7; const float vb = pv[i] * rs * c.v_norm_g[l * 512 + ch];
        ovs[ch] = vb; am[512 + ch] = ps[2048 + ch] * (c.w_s[(size_t)(l * 4 + hb) * 128 * 128] * vb + c.b_s[(l * 4 + hb) * 128]); }
}
DI void phase_b0(const Ctx& c, int l, LAS unsigned char* lds) {
    for (int ch = c.bx; ch < 256; ch += c.nb) b0_block_ab(c, l, ch, lds);
    constexpr int NPT = 256 * 16;
    LAS unsigned char* wl = lds + c.wave * B0_WAVE_LDS;
    for (int t = c.gw; t < NPT + SBATCH; t += c.ngw) {
        if (t >= NPT) { if (SUB(0)) b0_task_sample(c, l, t - NPT); continue; }
        const int chunk = t >> 4, k = t & 15, b = chunk >> 5, n = chunk & 31;
        if (k >= 12) { if (SUB(2)) b0_task_vb(c, l, b, n, k - 12, wl); }
        else { if (SUB(3)) b0_task_conv(c, l, b, n, k >> 2, k & 3, wl); }
    }
}

DI void b1_prep(const Ctx& c, int l, int unit, LAS unsigned char* wl, LAS float* sg, LAS float* sb) {
    int lane = c.lane; asm volatile("" : "+v"(lane));
    const int r = lane & 31, h = lane >> 5;
    const int n = unit & 31, bh = unit >> 5, hh = bh & 3, b = bh >> 2, tok0 = b * SEQ + n * 64;
    const float bt = WSP(float, WS_BETA)[(tok0 + lane) * 4 + hh];
    float gc = WSP(float, WS_G)[(tok0 + lane) * 4 + hh];
#pragma unroll
    for (int o = 1; o < 64; o <<= 1) { const float t = xlane(gc, lane - o); if (lane >= o) gc += t; }
    sg[lane] = gc; sb[lane] = bt;
    const float glast = __builtin_bit_cast(float, __builtin_amdgcn_readlane(__builtin_bit_cast(int, gc), 63));
    if (lane == 0) WSP(float, WS_EG)[unit] = __expf(glast);
    unsigned char* img = c.ws + WS_IMG + (size_t)unit * IMG_BYTES;
    const bf16_t* Kn = WSP(bf16_t, WS_KN) + (size_t)tok0 * 512 + hh * 128;
    const bf16_t* Qn = WSP(bf16_t, WS_QN) + (size_t)tok0 * 512 + hh * 128;
    const bf16_t* KnT = WSP(bf16_t, WS_KNT) + (size_t)unit * 128 * 64;
    const bf16_t* VT = WSP(bf16_t, WS_VT) + (size_t)unit * 128 * 64;
    LAS float* L = (LAS float*)wl;
    {
        bf16x8 Kf[2][8];
#pragma unroll
        for (int t = 0; t < 2; ++t)
#pragma unroll
            for (int ks = 0; ks < 8; ++ks) Kf[t][ks] = *(const bf16x8*)(Kn + (size_t)(32 * t + r) * 512 + 16 * ks + 8 * h);
#pragma unroll
        for (int tt = 0; tt < 3; ++tt) { const int mt = tt == 0 ? 0 : 1, nt = tt == 2 ? 1 : 0;
            f32x16 acc = zero16();
#pragma unroll
            for (int ks = 0; ks < 8; ++ks) acc = MFMA32(Kf[mt][ks], Kf[nt][ks], acc);
            const int j = 32 * nt + r; const float gj = sg[j];
#pragma unroll
            for (int g4 = 0; g4 < 4; ++g4) { const f32x4 gi4 = *(const LAS f32x4*)(sg + 32 * mt + 8 * g4 + 4 * h), bi4 = *(const LAS f32x4*)(sb + 32 * mt + 8 * g4 + 4 * h);
#pragma unroll
                for (int q = 0; q < 4; ++q) { const int i = 32 * mt + 8 * g4 + 4 * h + q; const float arg = i > j ? gi4[q] - gj : 0.f;
                    L[i * 64 + j] = i > j ? acc[4 * g4 + q] * bi4[q] * __expf(arg) : 0.f; } } }
#pragma unroll
        for (int mt = 0; mt < 2; ++mt) {
            bf16x8 Qf[8];
#pragma unroll
            for (int ks = 0; ks < 8; ++ks) Qf[ks] = *(const bf16x8*)(Qn + (size_t)(32 * mt + r) * 512 + 16 * ks + 8 * h);
            const int i = 32 * mt + r; const float gi = sg[i];
#pragma unroll
            for (int mp = 0; mp <= mt; ++mp) {
                f32x16 acc = zero16();
#pragma unroll
                for (int ks = 0; ks < 8; ++ks) acc = MFMA32(Kf[mp][ks], Qf[ks], acc);
#pragma unroll
                for (int g4 = 0; g4 < 4; ++g4) { const f32x4 gj4 = *(const LAS f32x4*)(sg + 32 * mp + 8 * g4 + 4 * h);
#pragma unroll
                    for (int q = 0; q < 4; ++q) { const int j = 32 * mp + 8 * g4 + 4 * h + q; const float arg = i >= j ? gi - gj4[q] : 0.f;
                        acc[4 * g4 + q] = i >= j ? acc[4 * g4 + q] * __expf(arg) : 0.f; } }
                const int fb = (mt == 0 ? 0 : 1 + mp) * 2;
#pragma unroll
                for (int s = 0; s < 2; ++s) *(u32x4*)(img + 49152 + (fb + s) * 1024 + lane * 16) = pack8(acc, s);
            }
        }
    }
    float Tr[64];
    {
        f32x4 lb[2][16];
#pragma unroll
        for (int i = 0; i < 64; ++i) {
            if (i + 1 < 64) {
#pragma unroll
                for (int j4 = 0; j4 < (i + 1 + 3) / 4; ++j4) lb[(i + 1) & 1][j4] = *(const LAS f32x4*)(L + (i + 1) * 64 + 4 * j4); }
            asm volatile("" ::: "memory");
            float a0 = lane == i ? 1.f : 0.f, a1 = 0.f;
#pragma unroll
            for (int j4 = 0; j4 < (i + 3) / 4; ++j4) {
#pragma unroll
                for (int q = 0; q < 4; ++q) { const int j = 4 * j4 + q; if (j < i) { if (q & 1) a1 -= lb[i & 1][j4][q] * Tr[j]; else a0 -= lb[i & 1][j4][q] * Tr[j]; } } }
            Tr[i] = a0 + a1;
        }
    }
    LAS bf16_t* T1 = (LAS bf16_t*)wl;
    asm volatile("" ::: "memory");
    {
        const float sc1 = bt * __expf(gc);
#pragma unroll
        for (int i = 0; i < 64; ++i) T1[i * 72 + lane] = f2bf(Tr[i] * sc1);
        bf16x8 Tf[2][4];
#pragma unroll
        for (int mt = 0; mt < 2; ++mt)
#pragma unroll
            for (int ks = 0; ks < 4; ++ks) Tf[mt][ks] = *(const LAS bf16x8*)(T1 + (32 * mt + r) * 72 + 16 * ks + 8 * h);
#pragma unroll
        for (int dt = 0; dt < 4; ++dt) {
            bf16x8 Kt[4];
#pragma unroll
            for (int ks = 0; ks < 4; ++ks) Kt[ks] = *(const bf16x8*)(KnT + (size_t)(32 * dt + r) * 64 + 16 * ks + 8 * h);
#pragma unroll
            for (int mt = 0; mt < 2; ++mt) { f32x16 acc = zero16();
#pragma unroll
                for (int ks = 0; ks < 2 * (mt + 1); ++ks) acc = MFMA32(Kt[ks], Tf[mt][ks], acc);
                acc = -acc;
#pragma unroll
                for (int s = 0; s < 2; ++s) *(u32x4*)(img + ((mt * 4 + dt) * 2 + s) * 1024 + lane * 16) = pack8(acc, s); }
        }
    }
    asm volatile("" ::: "memory");
    {
#pragma unroll
        for (int i = 0; i < 64; ++i) T1[i * 72 + lane] = f2bf(Tr[i] * bt);
        bf16x8 Tf[2][4];
#pragma unroll
        for (int mt = 0; mt < 2; ++mt)
#pragma unroll
            for (int ks = 0; ks < 4; ++ks) Tf[mt][ks] = *(const LAS bf16x8*)(T1 + (32 * mt + r) * 72 + 16 * ks + 8 * h);
        bf16_t* uimg = WSP(bf16_t, WS_UIMG) + (size_t)unit * 8192;
#pragma unroll
        for (int et = 0; et < 4; ++et) {
            bf16x8 Vt[4];
#pragma unroll
            for (int ks = 0; ks < 4; ++ks) Vt[ks] = *(const bf16x8*)(VT + (size_t)(32 * et + r) * 64 + 16 * ks + 8 * h);
#pragma unroll
            for (int mt = 0; mt < 2; ++mt) { f32x16 acc = zero16();
#pragma unroll
                for (int ks = 0; ks < 2 * (mt + 1); ++ks) acc = MFMA32(Tf[mt][ks], Vt[ks], acc);
#pragma unroll
                for (int g4 = 0; g4 < 4; ++g4) { u32x2 w; w.x = pk2(acc[4 * g4], acc[4 * g4 + 1]); w.y = pk2(acc[4 * g4 + 2], acc[4 * g4 + 3]); *(u32x2*)(uimg + ((et * 2 + mt) * 4 + g4) * 256 + lane * 4) = w; } }
        }
    }
    asm volatile("" ::: "memory");
#pragma unroll
    for (int mt = 0; mt < 2; ++mt) { const float ei = __expf(sg[32 * mt + r]);
#pragma unroll
        for (int dt = 0; dt < 4; ++dt)
#pragma unroll
            for (int s = 0; s < 2; ++s) { const bf16_t* qp = Qn + (size_t)(32 * mt + r) * 512 + 32 * dt + 16 * s + 4 * h;
                const u32x2 p0 = *(const u32x2*)qp, p1 = *(const u32x2*)(qp + 8);
                u32x4 w; w.x = pk2(bflo(p0.x) * ei, bfhi(p0.x) * ei); w.y = pk2(bflo(p0.y) * ei, bfhi(p0.y) * ei); w.z = pk2(bflo(p1.x) * ei, bfhi(p1.x) * ei); w.w = pk2(bflo(p1.y) * ei, bfhi(p1.y) * ei);
                *(u32x4*)(img + 16384 + ((mt * 4 + dt) * 2 + s) * 1024 + lane * 16) = w; } }
#pragma unroll
    for (int mp = 0; mp < 2; ++mp)
#pragma unroll
        for (int s = 0; s < 2; ++s) { const f32x4 ga = *(const LAS f32x4*)(sg + 32 * mp + 16 * s + 4 * h), gb = *(const LAS f32x4*)(sg + 32 * mp + 16 * s + 8 + 4 * h);
            float sc[8];
#pragma unroll
            for (int q = 0; q < 4; ++q) { sc[q] = __expf(glast - ga[q]); sc[4 + q] = __expf(glast - gb[q]); }
#pragma unroll
            for (int dt = 0; dt < 4; ++dt) { const bf16_t* kp = KnT + (size_t)(32 * dt + r) * 64 + 32 * mp + 16 * s + 4 * h;
                const u32x2 p0 = *(const u32x2*)kp, p1 = *(const u32x2*)(kp + 8);
                u32x4 w; w.x = pk2(bflo(p0.x) * sc[0], bfhi(p0.x) * sc[1]); w.y = pk2(bflo(p0.y) * sc[2], bfhi(p0.y) * sc[3]); w.z = pk2(bflo(p1.x) * sc[4], bfhi(p1.x) * sc[5]); w.w = pk2(bflo(p1.y) * sc[6], bfhi(p1.y) * sc[7]);
                *(u32x4*)(img + 32768 + ((dt * 2 + mp) * 2 + s) * 1024 + lane * 16) = w; } }
}
DI void b1_gmlp(const Ctx& c, int l, int unit) {
    int lane = c.lane; asm volatile("" : "+v"(lane));
    const int r = lane & 31, h = lane >> 5;
    const int hb = unit & 3, cc = (unit >> 2) & 15, b = unit >> 6, tokc0 = b * SEQ + cc * 128;
    const bf16_t* A = WSP(bf16_t, WS_VBT) + (size_t)unit * 128 * 128;
    const bf16_t* B = WSP(bf16_t, WS_WM) + (size_t)(l * 4 + hb) * 128 * 128;
    const bf16_t* P = WSP(bf16_t, WS_P); bf16_t* AM = WSP(bf16_t, WS_AMIX);
#pragma unroll
    for (int nt = 0; nt < 4; ++nt) {
        f32x16 acc[4];
#pragma unroll
        for (int mt = 0; mt < 4; ++mt) acc[mt] = zero16();
#pragma unroll
        for (int ks = 0; ks < 2 * (nt + 1); ++ks) { const bf16x8 bf = *(const bf16x8*)(B + (size_t)(32 * nt + r) * 128 + 16 * ks + 8 * h);
#pragma unroll
            for (int mt = 0; mt < 4; ++mt) { const bf16x8 af = *(const bf16x8*)(A + (size_t)(32 * mt + r) * 128 + 16 * ks + 8 * h); acc[mt] = MFMA32(af, bf, acc[mt]); } }
        const int tok = tokc0 + 32 * nt + r; const float bsi = c.b_s[(l * 4 + hb) * 128 + 32 * nt + r];
#pragma unroll
        for (int mt = 0; mt < 4; ++mt)
#pragma unroll
            for (int g4 = 0; g4 < 4; ++g4) { const int dch0 = 32 * mt + 8 * g4 + 4 * h;
                const u32x2 u4 = *(const u32x2*)(P + (size_t)tok * NP + 2048 + hb * 128 + dch0);
                u32x2 w; w.x = pk2(bflo(u4.x) * (acc[mt][4 * g4] + bsi), bfhi(u4.x) * (acc[mt][4 * g4 + 1] + bsi)); w.y = pk2(bflo(u4.y) * (acc[mt][4 * g4 + 2] + bsi), bfhi(u4.y) * (acc[mt][4 * g4 + 3] + bsi));
                *(u32x2*)(AM + (size_t)tok * DM + 512 + hb * 128 + dch0) = w; }
    }
}
DI void phase_b1(const Ctx& c, int l, LAS unsigned char* lds) {
    LAS unsigned char* wl = lds + c.wave * 16384; LAS float* sg = (LAS float*)(lds + 131072 + c.wave * 512); LAS float* sb = sg + 64;
    for (int t = c.gw; t < 1024 + 512; t += c.ngw) {
        if (t < 1024) { if (SUB(0)) b1_prep(c, l, t, wl, sg, sb); } else { if (SUB(1)) b1_gmlp(c, l, t - 1024); }
    }
}

constexpr int OB_STRIDE = 136;
constexpr int IMG_LDS = 57344;
constexpr int LDS_OBUF = 2 * IMG_LDS, OBUF_BYTES = 64 * OB_STRIDE * 2;
static_assert(LDS_OBUF + 2 * OBUF_BYTES <= LDS_BYTES, "scan LDS");
DI void scan_post(const Ctx& c, int l, int b, int hh, int n, const LAS bf16_t* ob, int lid, const u32x4 (&gt4)[4]) {
    const int i = lid >> 2, q = lid & 3, tok = b * SEQ + n * 64 + i;
    u32x4 ov[4]; float ss = 0.f;
#pragma unroll
    for (int x = 0; x < 4; ++x) { ov[x] = *(const LAS u32x4*)(ob + i * OB_STRIDE + 32 * q + 8 * x);
#pragma unroll
        for (int e = 0; e < 4; ++e) { const float a = bflo(ov[x][e]), bq = bfhi(ov[x][e]); ss += a * a + bq * bq; } }
    ss += xlane(ss, (lid & 63) ^ 1); ss += xlane(ss, (lid & 63) ^ 2);
    const float rs = rsqrtf(ss * (1.0f / 128.0f) + EPS);
    bf16_t* op = WSP(bf16_t, WS_AMIX) + (size_t)tok * DM + hh * 128 + 32 * q;
#pragma unroll
    for (int x = 0; x < 4; ++x) { u32x4 w;
#pragma unroll
        for (int e = 0; e < 4; ++e) w[e] = pk2(bflo(ov[x][e]) * rs * bflo(gt4[x][e]), bfhi(ov[x][e]) * rs * bfhi(gt4[x][e]));
        *(u32x4*)(op + 8 * x) = w; }
}
DI void scan_loader_step(const Ctx& c, int l, int b, int hh, int n, LAS unsigned char* lds, const unsigned char* img0, const bf16_t* gbase, int lw, int lane, int lid, u32x4 (&regs)[14], u32x4 (&gt)[4]) {
    u32x4 gcur[4];
#pragma unroll
    for (int x = 0; x < 4; ++x) gcur[x] = gt[x];
#pragma unroll
    for (int x = 0; x < 4; ++x) gt[x] = *(const u32x4*)(gbase + (size_t)n * 64 * NP + 8 * x);
    const unsigned voff = (unsigned)(lw * 14336 + lane * 16);
    if (n + 1 < 32) { LAS unsigned char* dst = lds + ((n + 1) & 1) * IMG_LDS + voff;
#pragma unroll
        for (int i = 0; i < 14; ++i) *(LAS u32x4*)(dst + i * 1024) = regs[i]; }
    if (n + 3 < 32) { const unsigned char* src = img0 + (size_t)(n + 3) * IMG_BYTES;
#pragma unroll
        for (int i = 0; i < 14; ++i) regs[i] = *(const u32x4*)(src + voff + i * 1024); }
    if (n >= 1) scan_post(c, l, b, hh, n - 1, (const LAS bf16_t*)(lds + LDS_OBUF + ((n - 1) & 1) * OBUF_BYTES), lid, gcur);
    __syncthreads();
}
DI void scan_consumer_step(int n, LAS unsigned char* lds, f32x16 (&S)[4], u32x2 (&ucur)[8], float& egc, const bf16_t* uimg0, const float* egp, int lane, int ws, int r, int h) {
    const LAS unsigned char* buf = lds + (n & 1) * IMG_LDS + lane * 16;
    f32x16 av[2], ao[2]; ao[0] = zero16(); ao[1] = zero16();
#pragma unroll
    for (int mt = 0; mt < 2; ++mt)
#pragma unroll
        for (int g4 = 0; g4 < 4; ++g4) { const u32x2 w = ucur[mt * 4 + g4]; av[mt][4 * g4] = bflo(w.x); av[mt][4 * g4 + 1] = bfhi(w.x); av[mt][4 * g4 + 2] = bflo(w.y); av[mt][4 * g4 + 3] = bfhi(w.y); }
    const float eg = egc;
    if (n + 2 < 32) { const bf16_t* up = uimg0 + (size_t)(n + 2) * 8192;
#pragma unroll
        for (int x = 0; x < 8; ++x) ucur[x] = *(const u32x2*)(up + x * 256);
        egc = egp[n + 2]; }
    {
        bf16x8 fg[2][4];
#pragma unroll
        for (int mt = 0; mt < 2; ++mt) { fg[0][mt] = *(const LAS bf16x8*)(buf + (mt * 8) * 1024); fg[0][2 + mt] = *(const LAS bf16x8*)(buf + 16384 + (mt * 8) * 1024); }
#pragma unroll
        for (int gI = 0; gI < 8; ++gI) { const int dt = gI >> 1, s = gI & 1;
            if (gI + 1 < 8) {
#pragma unroll
                for (int mt = 0; mt < 2; ++mt) { fg[(gI + 1) & 1][mt] = *(const LAS bf16x8*)(buf + (mt * 8 + gI + 1) * 1024); fg[(gI + 1) & 1][2 + mt] = *(const LAS bf16x8*)(buf + 16384 + (mt * 8 + gI + 1) * 1024); } }
            asm volatile("" ::: "memory");
            const bf16x8 sb = as_bf(pack8(S[dt], s));
            av[0] = MFMA32(fg[gI & 1][0], sb, av[0]); av[1] = MFMA32(fg[gI & 1][1], sb, av[1]);
            ao[0] = MFMA32(sb, fg[gI & 1][2], ao[0]); ao[1] = MFMA32(sb, fg[gI & 1][3], ao[1]); }
    }
    bf16x8 vb[2][2];
#pragma unroll
    for (int mp = 0; mp < 2; ++mp)
#pragma unroll
        for (int s = 0; s < 2; ++s) vb[mp][s] = as_bf(pack8(av[mp], s));
    {
        bf16x8 qf[6];
#pragma unroll
        for (int f = 0; f < 6; ++f) qf[f] = *(const LAS bf16x8*)(buf + 49152 + f * 1024);
        asm volatile("" ::: "memory");
#pragma unroll
        for (int s = 0; s < 2; ++s) { ao[0] = MFMA32(vb[0][s], qf[s], ao[0]); ao[1] = MFMA32(vb[0][s], qf[2 + s], ao[1]); ao[1] = MFMA32(vb[1][s], qf[4 + s], ao[1]); }
    }
    LAS bf16_t* ob = (LAS bf16_t*)(lds + LDS_OBUF + (n & 1) * OBUF_BYTES);
#pragma unroll
    for (int mt = 0; mt < 2; ++mt)
#pragma unroll
        for (int g4 = 0; g4 < 4; ++g4) { u32x2 w; w.x = pk2(ao[mt][4 * g4], ao[mt][4 * g4 + 1]); w.y = pk2(ao[mt][4 * g4 + 2], ao[mt][4 * g4 + 3]);
            *(LAS u32x2*)(ob + (32 * mt + r) * OB_STRIDE + 32 * ws + 8 * g4 + 4 * h) = w; }
    bf16x8 kf[2][4];
#pragma unroll
    for (int f = 0; f < 4; ++f) kf[0][f] = *(const LAS bf16x8*)(buf + 32768 + f * 1024);
#pragma unroll
    for (int dt = 0; dt < 4; ++dt) {
        if (dt + 1 < 4) {
#pragma unroll
            for (int f = 0; f < 4; ++f) kf[(dt + 1) & 1][f] = *(const LAS bf16x8*)(buf + 32768 + ((dt + 1) * 4 + f) * 1024); }
        asm volatile("" ::: "memory");
        S[dt] = S[dt] * eg;
#pragma unroll
        for (int mp = 0; mp < 2; ++mp)
#pragma unroll
            for (int s = 0; s < 2; ++s) S[dt] = MFMA32(kf[dt & 1][mp * 2 + s], vb[mp][s], S[dt]); }
    __syncthreads();
}
DI void scan_block(const Ctx& c, int l, int bh, LAS unsigned char* lds) {
    const int wave = c.wave, b = bh >> 2, hh = bh & 3;
    const unsigned char* img0 = c.ws + WS_IMG + (size_t)bh * 32 * IMG_BYTES;
    if (wave >= 4) { if (SUB2(0)) {
        int lane = c.lane; asm volatile("" : "+v"(lane));
        const int lw = wave - 4, lid = lw * 64 + lane;
        u32x4 regs0[14], regs1[14], gt0[4];
        const bf16_t* gbase = WSP(bf16_t, WS_P) + (size_t)(b * SEQ + (lid >> 2)) * NP + 1536 + hh * 128 + 32 * (lid & 3);
        const unsigned voff0 = (unsigned)(lw * 14336 + lane * 16);
#pragma unroll
        for (int i = 0; i < 14; ++i) regs0[i] = *(const u32x4*)(img0 + voff0 + i * 1024);
#pragma unroll
        for (int i = 0; i < 14; ++i) *(LAS u32x4*)(lds + voff0 + i * 1024) = regs0[i];
#pragma unroll
        for (int i = 0; i < 14; ++i) { regs1[i] = *(const u32x4*)(img0 + (size_t)IMG_BYTES + voff0 + i * 1024); regs0[i] = *(const u32x4*)(img0 + (size_t)2 * IMG_BYTES + voff0 + i * 1024); }
#pragma unroll
        for (int x = 0; x < 4; ++x) gt0[x] = (u32x4){0u, 0u, 0u, 0u};
        __syncthreads();
        for (int n = 0; n < 32; n += 2) {
            scan_loader_step(c, l, b, hh, n, lds, img0, gbase, lw, lane, lid, regs1, gt0);
            scan_loader_step(c, l, b, hh, n + 1, lds, img0, gbase, lw, lane, lid, regs0, gt0);
        }
        scan_post(c, l, b, hh, 31, (const LAS bf16_t*)(lds + LDS_OBUF + (31 & 1) * OBUF_BYTES), lid, gt0);
    } } else if (SUB2(1)) {
        int lane = c.lane; asm volatile("" : "+v"(lane));
        const int ws = wave, r = lane & 31, h = lane >> 5;
        f32x16 S[4];
#pragma unroll
        for (int dt = 0; dt < 4; ++dt) S[dt] = zero16();
        const bf16_t* uimg0 = WSP(bf16_t, WS_UIMG) + (size_t)bh * 32 * 8192 + (size_t)ws * 2 * 4 * 256 + lane * 4;
        const float* egp = WSP(float, WS_EG) + bh * 32;
        u32x2 u0[8], u1[8];
#pragma unroll
        for (int x = 0; x < 8; ++x) { u0[x] = *(const u32x2*)(uimg0 + x * 256); u1[x] = *(const u32x2*)(uimg0 + 8192 + x * 256); }
        float eg0 = egp[0], eg1 = egp[1];
        __syncthreads();
        for (int n = 0; n < 32; n += 2) {
            scan_consumer_step(n, lds, S, u0, eg0, uimg0, egp, lane, ws, r, h);
            scan_consumer_step(n + 1, lds, S, u1, eg1, uimg0, egp, lane, ws, r, h);
        }
        const char* od = (const char*)(c.out + O_DP + (size_t)(l * 32 + bh) * 128 * 128);
        unsigned voff = (unsigned)((4 * h) * 128 + 32 * ws + r) * 4u;
        asm volatile("" : "+v"(voff));
#pragma unroll
        for (int dt = 0; dt < 4; ++dt)
#pragma unroll
            for (int reg = 0; reg < 16; ++reg) *(float*)(od + (32 * dt + (reg & 3) + 8 * (reg >> 2)) * 512 + voff) = S[dt][reg];
    }
}
DI float rdlane(float v, int l) { return __builtin_bit_cast(float, __builtin_amdgcn_readlane(__builtin_bit_cast(int, v), l)); }
DI void sample_recurrent(const Ctx& c, int l, int unit) {
    int lane = c.lane; asm volatile("" : "+v"(lane));
    const int bs = unit >> 2, hh = unit & 3, e2 = 2 * lane;
    const float* S0 = c.state_delta + (size_t)((l * SBATCH + bs) * 4 + hh) * 128 * 128 + e2;
    float* S1 = c.out + O_DS + (size_t)((l * SBATCH + bs) * 4 + hh) * 128 * 128 + e2;
    const float* q = WSP(float, WS_QS) + bs * 512 + hh * 128; const float* k = WSP(float, WS_KS) + bs * 512 + hh * 128; const float* v = WSP(float, WS_VS) + bs * 512 + hh * 128;
    const float eg = __expf(WSP(float, WS_GS)[bs * 4 + hh]), beta = WSP(float, WS_BS)[bs * 4 + hh];
    const float k0 = k[lane], k1 = k[64 + lane], q0 = q[lane], q1 = q[64 + lane];
    f32x2 kv = {0.f, 0.f};
#pragma unroll
    for (int d0 = 0; d0 < 128; d0 += 32) { f32x2 sv[32];
#pragma unroll
        for (int j = 0; j < 32; ++j) sv[j] = *(const f32x2*)(S0 + (d0 + j) * 128);
#pragma unroll
        for (int j = 0; j < 32; ++j) { const int dd = d0 + j; kv += sv[j] * rdlane(dd < 64 ? k0 : k1, dd & 63); } }
    const f32x2 v2 = *(const f32x2*)(v + e2);
    const f32x2 delta = (v2 - kv * eg) * beta;
    f32x2 oo = {0.f, 0.f};
#pragma unroll
    for (int d0 = 0; d0 < 128; d0 += 32) { f32x2 sv[32];
#pragma unroll
        for (int j = 0; j < 32; ++j) sv[j] = *(const f32x2*)(S0 + (d0 + j) * 128);
#pragma unroll
        for (int j = 0; j < 32; ++j) { const int dd = d0 + j; const f32x2 sn = sv[j] * eg + delta * rdlane(dd < 64 ? k0 : k1, dd & 63); oo += sn * rdlane(dd < 64 ? q0 : q1, dd & 63); *(f32x2*)(S1 + dd * 128) = sn; } }
    const float ss = wave_sum(oo.x * oo.x + oo.y * oo.y, lane); const float rs = rsqrtf(ss * (1.0f / 128.0f) + EPS);
    const float* ps = WSP(float, WS_PS) + (size_t)bs * NPS + 1536 + hh * 128 + e2; float* am = WSP(float, WS_AMIXS) + (size_t)bs * DM + hh * 128 + e2;
    const float* og = c.o_norm_g + l * 128 + e2;
    am[0] = oo.x * rs * og[0] * silu_f(ps[0]); am[1] = oo.y * rs * og[1] * silu_f(ps[1]);
}
DI void phase_scan(const Ctx& c, int l, LAS unsigned char* lds) {
    if (c.bx < 32) { if (SUB(0)) scan_block(c, l, c.bx, lds); return; }
    const int w0 = (c.bx - 32) * 8 + c.wave, nw = (c.nb - 32) * 8;
    for (int u = w0; u < SBATCH * 4; u += nw) { if (SUB(1)) sample_recurrent(c, l, u); }
}

DI void phase_final(const Ctx& c) {
    const f32x4* gr = (const f32x4*)c.norm_f_g + c.lane;
    for (int m = c.gw; m < MP + SBATCH; m += c.ngw) {
        f32x4 v[4]; float s = 0.f;
        if (m < MP) { const u32x2* xr = (const u32x2*)(WSP(bf16_t, WS_XB16) + (size_t)m * DM) + c.lane;
#pragma unroll
            for (int j = 0; j < 4; ++j) { const u32x2 w = xr[64 * j]; v[j] = (f32x4){bflo(w.x), bfhi(w.x), bflo(w.y), bfhi(w.y)}; } }
        else { const f32x4* xr = (const f32x4*)(WSP(float, WS_XS) + (size_t)(m - MP) * DM) + c.lane;
#pragma unroll
            for (int j = 0; j < 4; ++j) v[j] = xr[64 * j]; }
        float* dst = m < MP ? c.out + O_YP + (size_t)m * DM : c.out + O_YS + (size_t)(m - MP) * DM;
#pragma unroll
        for (int j = 0; j < 4; ++j) s += (v[j].x * v[j].x + v[j].y * v[j].y) + (v[j].z * v[j].z + v[j].w * v[j].w);
        const float rs = rsqrtf(wave_sum(s, c.lane) * (1.0f / DM) + EPS);
#pragma unroll
        for (int j = 0; j < 4; ++j) ((f32x4*)dst + c.lane)[64 * j] = v[j] * rs * gr[64 * j];
    }
}

#define XB_TMO      128
#define XB_XCNT(j)  (256  + 64 * (j))
#define XB_XSUB(j)  (1280 + 64 * (j))
#define XB_XGEN(j)  (2304 + 64 * (j))
#define XB_TOP      3328
#define XB_TOPGEN   3392
#define XCD_BAR_WORDS 3456
#define XB_SPIN_CAP (1u << 18)

__device__ __forceinline__ unsigned xb_ld(unsigned* p)              { return __hip_atomic_load(p, __ATOMIC_RELAXED, __HIP_MEMORY_SCOPE_AGENT); }
__device__ __forceinline__ unsigned xb_add(unsigned* p, unsigned v) { return __hip_atomic_fetch_add(p, v, __ATOMIC_RELAXED, __HIP_MEMORY_SCOPE_AGENT); }
__device__ __forceinline__ unsigned xb_xcc_id() { return (unsigned)__builtin_amdgcn_s_getreg((3 << 11) | 20) & 0xFu; }
#define XB_SPIN(cond, bar) do { unsigned _sp = 0; while (cond) { __builtin_amdgcn_s_sleep(8); \
    if ((++_sp & 255u) == 0u) { if (xb_ld(&(bar)[XB_TMO])) break; if (_sp > XB_SPIN_CAP) { atomicAdd(&(bar)[XB_TMO], 1u); break; } } } } while (0)

struct XcdBarrier {
    unsigned* bar; unsigned x;
    volatile LAS unsigned* st;
};

__device__ __forceinline__ XcdBarrier xcd_barrier_post(unsigned* bar, volatile LAS unsigned* st) {
    XcdBarrier b; b.bar = bar; b.x = xb_xcc_id(); b.st = st;
    if (threadIdx.x == 0) (void)xb_add(&bar[XB_XCNT(b.x)], 1u);
    return b;
}
__device__ __forceinline__ void xcd_barrier_complete(unsigned* bar, unsigned x, unsigned& nloc, unsigned& nx) {
    const unsigned G = gridDim.x * gridDim.y * gridDim.z;
    unsigned sum, cnt, mine, sp = 0u;
    for (;;) {
        sum = 0u; cnt = 0u; mine = 0u;
#pragma unroll
        for (unsigned j = 0; j < 16; ++j) { const unsigned c = xb_ld(&bar[XB_XCNT(j)]); sum += c; cnt += (c > 0u) ? 1u : 0u; mine = (j == x) ? c : mine; }
        if (sum == G) break;
        __builtin_amdgcn_s_sleep(1);
        if ((++sp & 255u) == 0u) { if (xb_ld(&bar[XB_TMO])) break; if (sp > XB_SPIN_CAP) { atomicAdd(&bar[XB_TMO], 1u); break; } }
    }
    nloc = mine > 0u ? mine : 1u; nx = cnt > 0u ? cnt : 1u;
}

__device__ __forceinline__ void xcd_barrier(const XcdBarrier& b) {
    asm volatile("s_waitcnt vmcnt(0)" ::: "memory");
    __syncthreads();
    if (threadIdx.x == 0) {
        unsigned* bar = b.bar;
        __builtin_amdgcn_s_waitcnt(0);
        unsigned nloc = b.st[0], nx = b.st[1];
        if (nloc == 0u) { xcd_barrier_complete(bar, b.x, nloc, nx); b.st[0] = nloc; b.st[1] = nx; }
        const unsigned old = xb_add(&bar[XB_XSUB(b.x)], 1u);
        const unsigned gen = old / nloc;
        if (old + 1u == (gen + 1u) * nloc) {
            __builtin_amdgcn_fence(__ATOMIC_RELEASE, "agent");
            asm volatile("s_waitcnt vmcnt(0)" ::: "memory");
            const unsigned og = xb_add(&bar[XB_TOP], 1u);
            const unsigned tg = og / nx;
            if (og + 1u == (tg + 1u) * nx) xb_add(&bar[XB_TOPGEN], 1u);
            else XB_SPIN(xb_ld(&bar[XB_TOPGEN]) == tg, bar);
            __builtin_amdgcn_fence(__ATOMIC_ACQUIRE, "agent");
            xb_add(&bar[XB_XGEN(b.x)], 1u);
            asm volatile("s_waitcnt vmcnt(0)" ::: "memory");
        } else {
            XB_SPIN(xb_ld(&bar[XB_XGEN(b.x)]) == gen, bar);
            __builtin_amdgcn_fence(__ATOMIC_ACQUIRE, "agent");
            asm volatile("s_waitcnt vmcnt(0)" ::: "memory");
        }
    }
    __syncthreads();
}
#ifndef ONLY
#define ONLY -1
#endif
#ifndef REPMASK
#define REPMASK 0
#endif
#define EN(x) (ONLY < 0 || ONLY == (x))
__global__ void __launch_bounds__(512, 2) hymba_fwd(Args args) {
    extern __shared__ __attribute__((aligned(16))) unsigned char lds_raw[];
    LAS unsigned char* lds = (LAS unsigned char*)lds_raw;
    cg::grid_group grid = cg::this_grid();
    Ctx c;
    c.x_prompt = args.in[0]; c.x_sample = args.in[1]; c.state_delta = args.in[2]; c.state_conv = args.in[3]; c.norm_mix_g = args.in[4]; c.w_in = args.in[5]; c.conv_w = args.in[6];
    c.A_log = args.in[7]; c.dt_bias = args.in[8]; c.o_norm_g = args.in[9]; c.v_norm_g = args.in[10]; c.w_s = args.in[11]; c.b_s = args.in[12]; c.w_o = args.in[13]; c.norm_ffn_g = args.in[14];
    c.w_up = args.in[15]; c.w_down = args.in[16]; c.norm_f_g = args.in[17]; c.out = args.out; c.ws = args.ws;
    c.lane = threadIdx.x & 63; c.wave = __builtin_amdgcn_readfirstlane(threadIdx.x >> 6); c.gw = blockIdx.x * 8 + c.wave; c.ngw = gridDim.x * 8; c.bx = blockIdx.x; c.nb = gridDim.x;
    volatile LAS unsigned* bst = (volatile LAS unsigned*)(lds + LDS_BYTES - 16);
    if (threadIdx.x < 2) bst[threadIdx.x] = 0u;
    __syncthreads();
    XcdBarrier xbar = xcd_barrier_post((unsigned*)args.ws, bst);
    grid.sync();
    for (int step = 2 * args.ph_lo; step < 2 * args.ph_hi; ++step) {
        const int ph = step >> 1;
        const int ptype = ph == 0 ? 0 : (ph == 29 ? 8 : 1 + (ph - 1) % 7);
        if ((step & 1) && !((REPMASK >> ptype) & 1)) continue;
        { int tl = threadIdx.x; asm volatile("" : "+v"(tl)); c.lane = tl & 63; int bxo = blockIdx.x, nbo = gridDim.x; asm volatile("" : "+s"(bxo), "+s"(nbo)); c.bx = bxo; c.nb = nbo; c.wave = __builtin_amdgcn_readfirstlane(tl >> 6); c.gw = bxo * 8 + c.wave; c.ngw = nbo * 8; unsigned char* wsp = args.ws; asm volatile("" : "+s"(wsp)); c.ws = wsp; float* op = args.out; asm volatile("" : "+s"(op)); c.out = op; }
        if (step & 1) __syncthreads();
        if (ph == 0) { if (EN(0)) phase_prologue(c, lds); }
        else if (ph == 29) { if (EN(8)) phase_final(c); }
        else {
            const int l = (ph - 1) / 7, s = (ph - 1) % 7;
            float* ssq = WSP(float, WS_SSQ);
            if (s == 0) { if (EN(1)) { sgemm1(c, l, lds); if ((REPMASK >> 10) & 1) sgemm1(c, l, lds);
                pg8::Gemm g{WSP(bf16_t, WS_XB16), WSP(bf16_t, WS_WIN) + (size_t)l * NP * DM, MP, NP, DM}; pg8::StaticOrder S; S.init(MP, NP, c.nb, c.bx);
                pg8::EpiScaleBf16 E{WSP(bf16_t, WS_P), NP, ssq + (size_t)(2 * l) * MP * 16, 0, WSP(float, WS_VSS), c.o_norm_g + l * 128}; pg8::gemm_phase(lds, g, S, E); } }
            else if (s == 1) { if (EN(2)) phase_b0(c, l, lds); }
            else if (s == 2) { if (EN(3)) phase_b1(c, l, lds); }
            else if (s == 3) { if (EN(4)) phase_scan(c, l, lds); if ((REPMASK >> 12) & 1) { __syncthreads(); if (c.bx < 32) scan_block(c, l, c.bx, lds); } if ((REPMASK >> 13) & 1) { if (c.bx >= 32) { const int w0 = (c.bx - 32) * 8 + c.wave, nw = (c.nb - 32) * 8; for (int u = w0; u < SBATCH * 4; u += nw) sample_recurrent(c, l, u); } } }
            else if (s == 4) { if (EN(5)) { if (!(step & 1)) sgemm2(c, l, lds);
                pg8::Gemm g{WSP(bf16_t, WS_AMIX), WSP(bf16_t, WS_WO) + (size_t)l * DM * DM, MP, DM, DM}; pg8::StaticOrder S; S.init(MP, DM, c.nb, c.bx);
                pg8::EpiResid E{WSP(bf16_t, WS_XB16), ssq + (size_t)(2 * l + 1) * MP * 16}; pg8::gemm_phase(lds, g, S, E); } }
            else if (s == 5) { if (EN(6)) { sgemm3(c, l, lds); if ((REPMASK >> 11) & 1) sgemm3(c, l, lds);
                pg8::Gemm g{WSP(bf16_t, WS_XB16), WSP(bf16_t, WS_WUP) + (size_t)l * FF * DM, MP, FF, DM}; pg8::StaticOrder S; S.init(MP, FF, c.nb, c.bx);
                pg8::EpiScaleBf16 E{WSP(bf16_t, WS_UNION), FF, ssq + (size_t)(2 * l + 1) * MP * 16, 1, nullptr, nullptr}; pg8::gemm_phase(lds, g, S, E); } }
            else { if (EN(7)) { if (!(step & 1)) sgemm4(c, l, lds);
                pg8::Gemm g{WSP(bf16_t, WS_UNION), WSP(bf16_t, WS_WDN) + (size_t)l * DM * FF, MP, DM, FF}; pg8::StaticOrder S; S.init(MP, DM, c.nb, c.bx);
                pg8::EpiResid E{WSP(bf16_t, WS_XB16), ssq + (size_t)(2 * l + 2) * MP * 16}; pg8::gemm_phase(lds, g, S, E); } }
        }
        if (!(step & 1) && ((REPMASK >> ptype) & 1)) continue;
        if ((REPMASK >> 9) & 1) { if (ph + 1 < args.ph_hi) xcd_barrier(xbar); }
        if (ph + 1 < args.ph_hi) {
            xcd_barrier(xbar);
        }
    }
}

extern "C" void kernel_launch(void* const* d_in, const int* in_sizes, int n_in, void* d_out, int out_size, void* d_ws, size_t ws_size, hipStream_t stream) {
    static int grid = 0;
    if (grid == 0) {
        int dev = 0, cus = 0, per_cu = 0;
        (void)hipGetDevice(&dev); (void)hipDeviceGetAttribute(&cus, hipDeviceAttributeMultiprocessorCount, dev);
        if (hipFuncSetAttribute((const void*)hymba_fwd, hipFuncAttributeMaxDynamicSharedMemorySize, LDS_BYTES) != hipSuccess) fprintf(stderr, "kernel_launch: hipFuncSetAttribute failed\n");
        if (hipOccupancyMaxActiveBlocksPerMultiprocessor(&per_cu, (const void*)hymba_fwd, 512, LDS_BYTES) != hipSuccess || per_cu < 1) { fprintf(stderr, "kernel_launch: occupancy query says %d\n", per_cu); per_cu = 1; }
        (void)hipGetLastError();
        grid = cus * 1;
        if (ws_size < WS_END) fprintf(stderr, "kernel_launch: workspace too small: %zu < %zu\n", ws_size, (size_t)WS_END);
    }
    (void)hipMemsetAsync(d_ws, 0, 65536, stream);
    Args a{};
    for (int i = 0; i < 18; ++i) a.in[i] = (const float*)d_in[i];
    a.out = (float*)d_out; a.ws = (unsigned char*)d_ws; a.ph_lo = 0; a.ph_hi = 30;
    void* kargs[] = {&a};
    hipError_t e = hipLaunchCooperativeKernel((const void*)hymba_fwd, dim3(grid), dim3(512), kargs, LDS_BYTES, stream);
    if (e != hipSuccess) fprintf(stderr, "kernel_launch: cooperative launch failed: %s (grid %d)\n", hipGetErrorString(e), grid);
}
```

```cpp
#include <hip/hip_runtime.h>
#include <hip/hip_cooperative_groups.h>
#include <cstdio>
namespace cg = cooperative_groups;

#define LAS __attribute__((address_space(3)))
#define DI __device__ __forceinline__
typedef unsigned short bf16_t;
typedef short bf16x8 __attribute__((ext_vector_type(8)));
typedef float f32x4 __attribute__((ext_vector_type(4)));
typedef float f32x2 __attribute__((ext_vector_type(2)));
typedef float f32x16 __attribute__((ext_vector_type(16)));
typedef unsigned u32x4 __attribute__((ext_vector_type(4)));
typedef unsigned u32x2 __attribute__((ext_vector_type(2)));
typedef __bf16 bf2_t __attribute__((ext_vector_type(2)));
typedef unsigned u32x8 __attribute__((ext_vector_type(8)));

#ifndef SUBSEL
#define SUBSEL -1
#endif
#define SUB(x) (SUBSEL < 0 || SUBSEL == (x))
#ifndef SUBSEL2
#define SUBSEL2 -1
#endif
#define SUB2(x) (SUBSEL2 < 0 || SUBSEL2 == (x))
constexpr int DM = 1024, NBATCH = 8, SEQ = 2048, MP = NBATCH * SEQ, DEPTH = 4, SBATCH = 128;
constexpr int NH = 4, QKV = 1536, NP = 3072, PROJ = 3080, FF = 4096, NPS = 3088;
constexpr float EPS = 1e-6f;
constexpr int IMG_BYTES = 55296;
constexpr int LDS_BYTES = 150528;
constexpr size_t O_YP = 0, O_YS = 16777216, O_DP = 16908288, O_CP = 19005440, O_DS = 19152896, O_CS = 52707328, O_VS = 55066624;
constexpr size_t WS_WIN = 65536;
constexpr size_t WS_WAB = WS_WIN + (size_t)DEPTH * NP * DM * 2;
constexpr size_t WS_WO = WS_WAB + (size_t)DEPTH * 16 * DM * 2;
constexpr size_t WS_WUP = WS_WO + (size_t)DEPTH * DM * DM * 2;
constexpr size_t WS_WDN = WS_WUP + (size_t)DEPTH * FF * DM * 2;
constexpr size_t WS_WM = WS_WDN + (size_t)DEPTH * FF * DM * 2;
constexpr size_t WS_XBUF = WS_WM + (size_t)DEPTH * 4 * 128 * 128 * 2;
constexpr size_t WS_XB16 = WS_XBUF + (size_t)MP * DM * 4;
constexpr size_t WS_SSQ = WS_XB16 + (size_t)MP * DM * 2;
constexpr size_t WS_UNION = WS_SSQ + (size_t)9 * MP * 16 * 4;
constexpr size_t WS_P = WS_UNION;
constexpr size_t WS_QN = WS_P + (size_t)MP * NP * 2;
constexpr size_t WS_KN = WS_QN + (size_t)MP * 512 * 2;
constexpr size_t WS_KNT = WS_UNION + (size_t)MP * FF * 2;
constexpr size_t WS_VT = WS_KNT + (size_t)MP * 512 * 2;
constexpr size_t WS_VBT = WS_VT + (size_t)MP * 512 * 2;
constexpr size_t WS_G = WS_VBT + (size_t)MP * 512 * 2;
constexpr size_t WS_BETA = WS_G + (size_t)MP * 4 * 4;
constexpr size_t WS_EG = WS_BETA + (size_t)MP * 4 * 4;
constexpr size_t WS_IMG = WS_EG + 4096;
constexpr size_t WS_UIMG = WS_IMG + (size_t)1024 * IMG_BYTES;
constexpr size_t WS_AMIX = WS_UIMG + (size_t)1024 * 32768;
constexpr size_t WS_XS = WS_AMIX + (size_t)MP * DM * 2;
constexpr size_t WS_PS = WS_XS + (size_t)SBATCH * DM * 4;
constexpr size_t WS_QS = WS_PS + (size_t)SBATCH * NPS * 4;
constexpr size_t WS_KS = WS_QS + (size_t)SBATCH * 512 * 4;
constexpr size_t WS_VS = WS_KS + (size_t)SBATCH * 512 * 4;
constexpr size_t WS_GS = WS_VS + (size_t)SBATCH * 512 * 4;
constexpr size_t WS_BS = WS_GS + (size_t)SBATCH * 4 * 4;
constexpr size_t WS_AMIXS = WS_BS + (size_t)SBATCH * 4 * 4;
constexpr size_t WS_HS = WS_AMIXS + (size_t)SBATCH * DM * 4;
constexpr size_t WS_XP = WS_HS + (size_t)SBATCH * FF * 4;
constexpr size_t WS_VSS = WS_XP + (size_t)4 * SBATCH * DM * 4;
constexpr size_t WS_CWP = WS_VSS + (size_t)MP * 8 * 4;
constexpr size_t WS_END = WS_CWP + (size_t)DEPTH * 4 * QKV * 4;
static_assert(WS_QN + 2 * (size_t)MP * 512 * 2 == WS_KNT, "union");
static_assert(WS_END <= (size_t)536870912, "workspace");

DI unsigned pk2(float lo, float hi) { f32x2 v = {lo, hi}; return __builtin_bit_cast(unsigned, __builtin_convertvector(v, bf2_t)); }
DI float bflo(unsigned w) { return __uint_as_float(w << 16); }
DI float bfhi(unsigned w) { return __uint_as_float(w & 0xffff0000u); }
DI float bf2f(bf16_t b) { return __uint_as_float(((unsigned)b) << 16); }
DI bf16_t f2bf(float f) { return (bf16_t)(pk2(f, 0.f) & 0xffffu); }
DI float xlane(float v, int srclane) { return __builtin_bit_cast(float, __builtin_amdgcn_ds_bpermute(srclane << 2, __builtin_bit_cast(int, v))); }
DI float wave_sum(float v, int lane) {
#pragma unroll
    for (int o = 1; o < 64; o <<= 1) v += xlane(v, lane ^ o);
    return v;
}
DI float silu_f(float x) { return x * __builtin_amdgcn_rcpf(1.f + __expf(-x)); }
DI float sigmoid_f(float x) { return __builtin_amdgcn_rcpf(1.f + __expf(-x)); }
DI float softplus_f(float x) { const float e = __expf(-fabsf(x)); const float l = e < 0.01f ? e * (1.f - e * (0.5f - 0.33333334f * e)) : __logf(1.f + e); return fmaxf(x, 0.f) + l; }
DI u32x4 pack8(const f32x16& x, int s) {
    u32x4 p; p.x = pk2(x[8 * s], x[8 * s + 1]); p.y = pk2(x[8 * s + 2], x[8 * s + 3]); p.z = pk2(x[8 * s + 4], x[8 * s + 5]); p.w = pk2(x[8 * s + 6], x[8 * s + 7]); return p;
}
DI float ssq_sum(const float* p) {
    const f32x4 a = *(const f32x4*)p, b = *(const f32x4*)(p + 4), c2 = *(const f32x4*)(p + 8), d2 = *(const f32x4*)(p + 12);
    return ((a.x + a.y) + (a.z + a.w)) + ((b.x + b.y) + (b.z + b.w)) + ((c2.x + c2.y) + (c2.z + c2.w)) + ((d2.x + d2.y) + (d2.z + d2.w));
}
DI int crow(int reg, int h) { return (reg & 3) + 8 * (reg >> 2) + 4 * h; }
#define MFMA32(a, b, c) __builtin_amdgcn_mfma_f32_32x32x16_bf16((a), (b), (c), 0, 0, 0)
#define MFMA16(a, b, c) __builtin_amdgcn_mfma_f32_16x16x32_bf16((a), (b), (c), 0, 0, 0)
DI bf16x8 as_bf(u32x4 v) { return __builtin_bit_cast(bf16x8, v); }
DI f32x16 zero16() { f32x16 z;
#pragma unroll
    for (int i = 0; i < 16; ++i) z[i] = 0.f; return z; }

namespace pg8 {
constexpr int BM = 256, BK = 64, HALF = 128, HTB = HALF * BK * 2, STAGE_BYTES = 8 * HTB, NXCD = 8, WGM = 8;
DI int lds_byte(int r, int c) { const int st = (r >> 4) * 2 + (c >> 5), rr = r & 15, cc = c & 31, ob = rr * 64 + cc * 2; return st * 1024 + (ob ^ (((ob >> 9) & 1) << 5)); }
DI void stage_rc(int b, int& R, int& C) { const int st = b / 1024, sb = b % 1024, swz = sb ^ (((sb >> 9) & 1) << 5); R = (st >> 1) * 16 + swz / 64; C = (st & 1) * 32 + (swz % 64) / 2; }
DI int perm32(int rho) { const int n = rho >> 4, i = rho & 15; return 8 * (i >> 2) + 4 * n + (i & 3); }
struct Unit { int pm, pn; };
struct Gemm { const bf16_t* A; const bf16_t* Bt; int M, N, K; };
struct StaticOrder {
    int nM, nN, nwg, G, c;
    DI void init(int M, int N, int G_, int c_) { nM = M / BM; nN = N / BM; nwg = nM * nN; G = G_; c = c_; }
    DI bool next(int i, Unit& u) const {
        const long L = (long)i * G + c; if (L >= nwg) return false;
        int wgid = (int)L; { const int q = nwg / NXCD, r = nwg % NXCD, xcd = wgid % NXCD, off = wgid / NXCD; wgid = (xcd < r ? xcd * (q + 1) : r * (q + 1) + (xcd - r) * q) + off; }
        const int nig = WGM * nN, gid = wgid / nig, fm = gid * WGM, gsz = (nM - fm) < WGM ? (nM - fm) : WGM;
        u.pm = fm + ((wgid % nig) % gsz); u.pn = (wgid % nig) / gsz; return true;
    }
};
template <class Epi>
DI void gemm_phase(LAS unsigned char* lds, const Gemm g, const StaticOrder& S, const Epi& E) {
    int tid = threadIdx.x; asm volatile("" : "+v"(tid));
    const int wid = __builtin_amdgcn_readfirstlane(tid >> 6), lane = tid & 63, wr = wid >> 2, wc = wid & 3, fr = lane & 15, fq = lane >> 4;
    const int K = g.K, nt = K / BK;
    unsigned voffA[2], voffB[2];
#pragma unroll
    for (int i = 0; i < 2; ++i) { int R, C; stage_rc(tid * 16 + i * 8192, R, C); const int Rb = (R & ~31) + perm32(R & 31);
        voffA[i] = (unsigned)(R * K + C) * 2u; voffB[i] = (unsigned)(Rb * K + C) * 2u; }
    const size_t kstep = (size_t)(BK * 2);
    const size_t hstep = (size_t)HALF * K * 2;
    const size_t tstep = 2 * hstep;
    const unsigned ldsw = (unsigned)wid * 1024u;
    const int aoff = lds_byte(wr * 64 + fr, fq * 8), boff = lds_byte(wc * 32 + fr, fq * 8);
#define PG8_SA(b, h) (((b) * 2 + (h)) * HTB)
#define PG8_SB(b, h) ((4 + (b) * 2 + (h)) * HTB)
#define PG8_STAGE(bufoff, gbase, voff) do { _Pragma("unroll") for (int _i = 0; _i < 2; ++_i) \
        __builtin_amdgcn_global_load_lds((const unsigned*)((const char*)(gbase) + (voff)[_i]), (LAS unsigned*)(lds + (bufoff) + ldsw + _i * 8192), 16, 0, 0); } while (0)
#define PG8_LDA(dst, b, h) do { _Pragma("unroll") for (int m = 0; m < 4; ++m) _Pragma("unroll") for (int k = 0; k < 2; ++k) dst[m][k] = *(const LAS bf16x8*)(lds + PG8_SA(b, h) + aoff + m * 2048 + k * 1024); } while (0)
#define PG8_LDB(dst, b, h) do { _Pragma("unroll") for (int n = 0; n < 2; ++n) _Pragma("unroll") for (int k = 0; k < 2; ++k) dst[n][k] = *(const LAS bf16x8*)(lds + PG8_SB(b, h) + boff + n * 2048 + k * 1024); } while (0)
#define PG8_MMA(ai, bj, At, Bt) do { __builtin_amdgcn_s_setprio(1); _Pragma("unroll") for (int m = 0; m < 4; ++m) _Pragma("unroll") for (int n = 0; n < 2; ++n) _Pragma("unroll") for (int k = 0; k < 2; ++k) \
        acc[ai][bj][m][n] = __builtin_amdgcn_mfma_f32_16x16x32_bf16(Bt[n][k], At[m][k], acc[ai][bj][m][n], 0, 0, 0); __builtin_amdgcn_s_setprio(0); } while (0)
#define PG8_WAIT_V(n) asm volatile("s_waitcnt vmcnt(" #n ")" ::: "memory")
#define PG8_WAIT_L(n) asm volatile("s_waitcnt lgkmcnt(" #n ")" ::: "memory")
#define PG8_BAR __builtin_amdgcn_s_barrier()
#define PG8_SCHED __builtin_amdgcn_sched_barrier(0)
    Unit cur, nxt; int ui = 0;
    if (!S.next(0, cur)) return;
    f32x4 acc[2][2][4][2];
#pragma unroll
    for (int a = 0; a < 2; ++a)
#pragma unroll
        for (int b = 0; b < 2; ++b)
#pragma unroll
            for (int m = 0; m < 4; ++m)
#pragma unroll
                for (int n = 0; n < 2; ++n) acc[a][b][m][n] = (f32x4){0.f, 0.f, 0.f, 0.f};
    bf16x8 At[4][2], B0[2][2], B1[2][2];
    const char* cA = (const char*)g.A + (size_t)cur.pm * tstep; const char* cB = (const char*)g.Bt + (size_t)cur.pn * tstep;
    PG8_STAGE(PG8_SB(0, 0), cB, voffB); PG8_STAGE(PG8_SA(0, 0), cA, voffA); PG8_STAGE(PG8_SB(0, 1), cB + hstep, voffB); PG8_STAGE(PG8_SA(0, 1), cA + hstep, voffA);
    if (wr == 1) PG8_BAR;
    PG8_WAIT_V(4); PG8_BAR;
    PG8_STAGE(PG8_SB(1, 0), cB + kstep, voffB); PG8_STAGE(PG8_SA(1, 0), cA + kstep, voffA); PG8_STAGE(PG8_SB(1, 1), cB + hstep + kstep, voffB);
    PG8_WAIT_V(6); PG8_BAR;
    for (;;) {
        const bool has_next = S.next(ui + 1, nxt);
        const char* nA = has_next ? (const char*)g.A + (size_t)nxt.pm * tstep : cA; const char* nB = has_next ? (const char*)g.Bt + (size_t)nxt.pn * tstep : cB;
        for (int t = 0; t < nt; t += 2) {
            const bool last = (t == nt - 2);
            const char* a1 = cA + (size_t)(t + 1) * kstep;
            const char* a2 = last ? nA : cA + (size_t)(t + 2) * kstep; const char* b2 = last ? nB : cB + (size_t)(t + 2) * kstep;
            const char* a3 = a2 + kstep; const char* b3 = b2 + kstep;
            PG8_LDB(B0, 0, 0); PG8_SCHED; PG8_LDA(At, 0, 0); PG8_STAGE(PG8_SA(1, 1), a1 + hstep, voffA);
            PG8_WAIT_L(8); PG8_BAR; PG8_WAIT_L(0); PG8_MMA(0, 0, At, B0); PG8_BAR; PG8_SCHED;
            PG8_LDB(B1, 0, 1); PG8_STAGE(PG8_SB(0, 0), b2, voffB);
            PG8_BAR; PG8_WAIT_L(0); PG8_MMA(0, 1, At, B1); PG8_BAR;
            PG8_LDA(At, 0, 1); PG8_STAGE(PG8_SA(0, 0), a2, voffA);
            PG8_BAR; PG8_WAIT_L(0); PG8_MMA(1, 0, At, B0); PG8_BAR; PG8_SCHED;
            PG8_STAGE(PG8_SB(0, 1), b2 + hstep, voffB);
            PG8_WAIT_V(6); PG8_BAR; PG8_MMA(1, 1, At, B1); PG8_BAR;
            PG8_LDB(B0, 1, 0); PG8_SCHED; PG8_LDA(At, 1, 0); PG8_STAGE(PG8_SA(0, 1), a2 + hstep, voffA);
            PG8_WAIT_L(8); PG8_BAR; PG8_WAIT_L(0); PG8_MMA(0, 0, At, B0); PG8_BAR; PG8_SCHED;
            PG8_LDB(B1, 1, 1); PG8_STAGE(PG8_SB(1, 0), b3, voffB);
            PG8_BAR; PG8_WAIT_L(0); PG8_MMA(0, 1, At, B1); PG8_BAR;
            PG8_LDA(At, 1, 1); PG8_STAGE(PG8_SA(1, 0), a3, voffA);
            PG8_BAR; PG8_WAIT_L(0); PG8_MMA(1, 0, At, B0); PG8_BAR; PG8_SCHED;
            PG8_STAGE(PG8_SB(1, 1), b3 + hstep, voffB);
            PG8_WAIT_V(6); PG8_BAR; PG8_MMA(1, 1, At, B1); PG8_BAR;
        }
        E(acc, cur, wr, wc, fr, fq);
        if (!has_next) break;
#pragma unroll
        for (int a = 0; a < 2; ++a)
#pragma unroll
            for (int b = 0; b < 2; ++b)
#pragma unroll
                for (int m = 0; m < 4; ++m)
#pragma unroll
                    for (int n = 0; n < 2; ++n) acc[a][b][m][n] = (f32x4){0.f, 0.f, 0.f, 0.f};
        cur = nxt; cA = nA; cB = nB; ++ui;
    }
    PG8_WAIT_V(0);
    if (wr == 0) PG8_BAR;
    PG8_BAR;
#undef PG8_SA
#undef PG8_SB
#undef PG8_STAGE
#undef PG8_LDA
#undef PG8_LDB
#undef PG8_MMA
#undef PG8_WAIT_V
#undef PG8_WAIT_L
#undef PG8_BAR
#undef PG8_SCHED
}
struct EpiScaleBf16 {
    bf16_t* O; int ldc; const float* ssq; int act; float* vss; const float* og;
    DI void operator()(const f32x4 (&acc)[2][2][4][2], const Unit& u, int wr, int wc, int fr, int fq) const {
        const int row0 = u.pm * BM + wr * 64 + fr, col0 = u.pn * BM + wc * 32 + 8 * fq;
#pragma unroll
        for (int ai = 0; ai < 2; ++ai)
#pragma unroll
            for (int m = 0; m < 4; ++m) { const int row = row0 + ai * HALF + m * 16;
                float rq; { const f32x4 p4 = *(const f32x4*)(ssq + (size_t)row * 16 + 4 * fq); rq = (p4.x + p4.y) + (p4.z + p4.w); const int ln = fq * 16 + fr; rq += xlane(rq, ln ^ 16); rq += xlane(rq, ln ^ 32); }
                const float rs = rsqrtf(rq * (1.0f / DM) + EPS);
                bf16_t* rowp = O + (size_t)row * ldc + col0; float vs = 0.f;
#pragma unroll
                for (int bj = 0; bj < 2; ++bj) { f32x4 v0 = acc[ai][bj][m][0] * rs, v1 = acc[ai][bj][m][1] * rs;
                    if (act) {
#pragma unroll
                        for (int j = 0; j < 4; ++j) { const float a = fmaxf(v0[j], 0.f), b = fmaxf(v1[j], 0.f); v0[j] = a * a; v1[j] = b * b; } }
                    if (og != nullptr && (u.pn == 6 || u.pn == 7)) { const float* gp = og + ((col0 + bj * HALF) & 127); const f32x4 g0 = *(const f32x4*)gp, g1 = *(const f32x4*)(gp + 4);
#pragma unroll
                        for (int j = 0; j < 4; ++j) { v0[j] = silu_f(v0[j]) * g0[j]; v1[j] = silu_f(v1[j]) * g1[j]; } }
                    u32x4 w; w.x = pk2(v0[0], v0[1]); w.y = pk2(v0[2], v0[3]); w.z = pk2(v1[0], v1[1]); w.w = pk2(v1[2], v1[3]);
                    *(u32x4*)(rowp + bj * HALF) = w;
                    vs += (v0[0] * v0[0] + v0[1] * v0[1]) + (v0[2] * v0[2] + v0[3] * v0[3]) + (v1[0] * v1[0] + v1[1] * v1[1]) + (v1[2] * v1[2] + v1[3] * v1[3]); }
                if (vss != nullptr && u.pn >= 10) { { const int ln = fq * 16 + fr; vs += xlane(vs, ln ^ 16); vs += xlane(vs, ln ^ 32); } if (fq == 0) vss[(size_t)row * 8 + (u.pn - 10) * 4 + wc] = vs; } }
    }
};
struct EpiResid {
    bf16_t* xb; float* ssq;
    DI void operator()(const f32x4 (&acc)[2][2][4][2], const Unit& u, int wr, int wc, int fr, int fq) const {
        const int row0 = u.pm * BM + wr * 64 + fr, col0 = u.pn * BM + wc * 32 + 8 * fq;
#pragma unroll
        for (int ai = 0; ai < 2; ++ai)
#pragma unroll
            for (int m = 0; m < 4; ++m) { const int row = row0 + ai * HALF + m * 16; const size_t off = (size_t)row * DM + col0; float ss = 0.f;
#pragma unroll
                for (int bj = 0; bj < 2; ++bj) {
                    const u32x4 b = *(const u32x4*)(xb + off + bj * HALF);
                    const f32x4 o0 = (f32x4){bflo(b.x), bfhi(b.x), bflo(b.y), bfhi(b.y)} + acc[ai][bj][m][0], o1 = (f32x4){bflo(b.z), bfhi(b.z), bflo(b.w), bfhi(b.w)} + acc[ai][bj][m][1];
                    u32x4 w; w.x = pk2(o0[0], o0[1]); w.y = pk2(o0[2], o0[3]); w.z = pk2(o1[0], o1[1]); w.w = pk2(o1[2], o1[3]);
                    *(u32x4*)(xb + off + bj * HALF) = w;
                    ss += (o0[0] * o0[0] + o0[1] * o0[1]) + (o0[2] * o0[2] + o0[3] * o0[3]) + (o1[0] * o1[0] + o1[1] * o1[1]) + (o1[2] * o1[2] + o1[3] * o1[3]); }
                { const int ln = fq * 16 + fr; ss += xlane(ss, ln ^ 16); ss += xlane(ss, ln ^ 32); }
                if (fq == 0) ssq[(size_t)row * 16 + u.pn * 4 + wc] = ss;
                asm volatile("" ::: "memory"); }
    }
};
}

struct Args { const float* in[18]; float* out; unsigned char* ws; int ph_lo, ph_hi; };
struct Ctx {
    const float *x_prompt, *x_sample, *state_delta, *state_conv, *norm_mix_g, *w_in, *conv_w, *A_log, *dt_bias, *o_norm_g, *v_norm_g, *w_s, *b_s, *w_o, *norm_ffn_g, *w_up, *w_down, *norm_f_g;
    float* out; unsigned char* ws;
    int lane, wave, gw, ngw, bx, nb;
};
#define WSP(T, off) ((T*)(c.ws + (off)))

DI void transpose_item(const float* W, int K, int N, const float* kscale, bf16_t* WT, bf16_t* WAB, int mode, int item, int nblk, LAS float* scr, int lane) {
    const int kb = item / nblk, nb = item % nblk, k0 = 64 * kb, n0 = 64 * nb;
    const int c4 = lane & 15, rsub = lane >> 4;
    const bool cval = n0 + 4 * c4 + 3 < N;
#pragma unroll 4
    for (int kk = 0; kk < 64; kk += 4) { const int row = kk + rsub;
        f32x4 v = (f32x4){0.f, 0.f, 0.f, 0.f}; if (cval) { v = *(const f32x4*)(W + (size_t)(k0 + row) * N + n0 + 4 * c4); if (kscale) v = v * kscale[k0 + row]; }
        LAS float* p = scr + row * 65 + 4 * c4; p[0] = v.x; p[1] = v.y; p[2] = v.z; p[3] = v.w; }
    asm volatile("s_waitcnt lgkmcnt(0)" ::: "memory");
    const int kc = lane & 7;
#pragma unroll
    for (int it = 0; it < 8; ++it) { const int n = 8 * it + (lane >> 3), ns = n0 + n; const LAS float* s = scr + (8 * kc) * 65 + n;
        u32x4 o; o.x = pk2(s[0 * 65], s[1 * 65]); o.y = pk2(s[2 * 65], s[3 * 65]); o.z = pk2(s[4 * 65], s[5 * 65]); o.w = pk2(s[6 * 65], s[7 * 65]);
        if (ns < N) {
            bf16_t* rowp;
            if (mode == 0) rowp = WT + (size_t)ns * K;
            else rowp = ns < 2048 ? WT + (size_t)ns * K : (ns < 2056 ? WAB + (size_t)(ns - 2048) * K : WT + (size_t)(ns - 8) * K);
            *(u32x4*)(rowp + k0 + 8 * kc) = o; } }
    asm volatile("s_waitcnt lgkmcnt(0)" ::: "memory");
}
DI void convert_layer_weights(const Ctx& c, int l, int w0, int nw, LAS unsigned char* lds) {
    LAS float* scr = (LAS float*)(lds + c.wave * 18432);
    constexpr int I_IN = 16 * 49, I_O = 16 * 16, I_UP = 16 * 64, I_DN = 64 * 16, I_L = I_IN + I_O + I_UP + I_DN;
    for (int it = w0; it < I_L; it += nw) {
        int r = it;
        if (r < I_IN) { transpose_item(c.w_in + (size_t)l * DM * PROJ, DM, PROJ, c.norm_mix_g + l * DM, WSP(bf16_t, WS_WIN) + (size_t)l * NP * DM, WSP(bf16_t, WS_WAB) + (size_t)l * 16 * DM, 1, r, 49, scr, c.lane); continue; } r -= I_IN;
        if (r < I_O) { transpose_item(c.w_o + (size_t)l * DM * DM, DM, DM, nullptr, WSP(bf16_t, WS_WO) + (size_t)l * DM * DM, nullptr, 0, r, 16, scr, c.lane); continue; } r -= I_O;
        if (r < I_UP) { transpose_item(c.w_up + (size_t)l * DM * FF, DM, FF, c.norm_ffn_g + l * DM, WSP(bf16_t, WS_WUP) + (size_t)l * FF * DM, nullptr, 0, r, 64, scr, c.lane); continue; } r -= I_UP;
        transpose_item(c.w_down + (size_t)l * FF * DM, FF, DM, nullptr, WSP(bf16_t, WS_WDN) + (size_t)l * DM * FF, nullptr, 0, r, 16, scr, c.lane);
    }
}
DI void phase_prologue(const Ctx& c, LAS unsigned char* lds) {
    convert_layer_weights(c, 0, c.gw, c.ngw, lds);
    float* ssq = WSP(float, WS_SSQ);
    for (int m = c.gw; m < MP; m += c.ngw) {
        const f32x4* xr = (const f32x4*)(c.x_prompt + (size_t)m * DM) + c.lane; u32x2* o8 = (u32x2*)(WSP(bf16_t, WS_XB16) + (size_t)m * DM) + c.lane; float s = 0.f;
#pragma unroll
        for (int j = 0; j < 4; ++j) { const f32x4 v = xr[64 * j]; s += (v.x * v.x + v.y * v.y) + (v.z * v.z + v.w * v.w); u32x2 w; w.x = pk2(v.x, v.y); w.y = pk2(v.z, v.w); o8[64 * j] = w; }
        s = wave_sum(s, c.lane); if (c.lane < 16) ssq[(size_t)m * 16 + c.lane] = c.lane == 0 ? s : 0.f;
    }
    const int gt = c.gw * 64 + c.lane, ngt = c.ngw * 64;
    float* xs = WSP(float, WS_XS);
    for (int i = gt; i < SBATCH * DM; i += ngt) xs[i] = c.x_sample[i];
    bf16_t* wab = WSP(bf16_t, WS_WAB);
    for (int i = gt; i < DEPTH * 8 * DM; i += ngt) { const int l = i / (8 * DM), r = i % (8 * DM); wab[(size_t)l * 16 * DM + 8 * DM + r] = 0; }
    unsigned* wm = WSP(unsigned, WS_WM);
    for (int i = gt; i < DEPTH * 4 * 128 * 64; i += ngt) { const int e = 2 * i, ii = (e >> 7) & 127, jj = e & 127;
        const float a = ii >= jj ? c.w_s[e] : 0.f, b = ii >= jj + 1 ? c.w_s[e + 1] : 0.f; wm[i] = pk2(a, b); }
}

template <int NT, bool NORM, int EPI>
DI void sgemm_block(const Ctx& c, const float* A, int lda, int K, const bf16_t* Bt, int ncg, float* out, int ldo, LAS unsigned char* lds, const bf16_t* Bab) {
    int lane = c.lane; asm volatile("" : "+v"(lane));
    const int wave = c.wave, fr = lane & 15, fq = lane >> 4;
    LAS f32x4* red = (LAS f32x4*)lds;
    LAS float* ssr = (LAS float*)(lds + 8 * NT * 64 * 16);
    const int kw = K / 8, k0 = wave * kw;
    for (int u = c.bx; u < 8 * ncg; u += c.nb) {
        const int rt = u & 7, cg = u >> 3;
        const bool abg = (Bab != nullptr) && (cg == ncg - 1);
        const bf16_t* bp = (abg ? Bab : Bt + (size_t)cg * NT * 16 * K) + (size_t)fr * K + k0 + 8 * fq;
        const float* ap = A + (size_t)(rt * 16 + fr) * lda + k0 + 8 * fq;
        f32x4 acc[NT]; float ss = 0.f;
#pragma unroll
        for (int nt = 0; nt < NT; ++nt) acc[nt] = (f32x4){0.f, 0.f, 0.f, 0.f};
#pragma unroll 4
        for (int k = 0; k < kw; k += 32) {
            const f32x4 a0 = *(const f32x4*)(ap + k), a1 = *(const f32x4*)(ap + k + 4);
            if (NORM) ss += (a0.x * a0.x + a0.y * a0.y) + (a0.z * a0.z + a0.w * a0.w) + (a1.x * a1.x + a1.y * a1.y) + (a1.z * a1.z + a1.w * a1.w);
            u32x4 a; a.x = pk2(a0.x, a0.y); a.y = pk2(a0.z, a0.w); a.z = pk2(a1.x, a1.y); a.w = pk2(a1.z, a1.w);
#pragma unroll
            for (int nt = 0; nt < NT; ++nt) if (nt == 0 || !abg) { const bf16x8 bf = *(const bf16x8*)(bp + (size_t)nt * 16 * K + k); acc[nt] = MFMA16(as_bf(a), bf, acc[nt]); }
        }
        if (NORM) { ss += xlane(ss, lane ^ 16); ss += xlane(ss, lane ^ 32); if (fq == 0) ssr[wave * 16 + fr] = ss; }
#pragma unroll
        for (int nt = 0; nt < NT; ++nt) red[(wave * NT + nt) * 64 + lane] = acc[nt];
        __syncthreads();
        if (wave < NT && (wave == 0 || !abg)) {
            f32x4 t = red[wave * 64 + lane];
#pragma unroll
            for (int w = 1; w < 8; ++w) t += red[(w * NT + wave) * 64 + lane];
            const int col = (cg * NT + wave) * 16 + fr;
#pragma unroll
            for (int j = 0; j < 4; ++j) { const int rl = 4 * fq + j; float rs = 1.f;
                if (NORM) { float sq = 0.f;
#pragma unroll
                    for (int w = 0; w < 8; ++w) sq += ssr[w * 16 + rl];
                    rs = rsqrtf(sq * (1.0f / DM) + EPS); }
                float* o = out + (size_t)(rt * 16 + rl) * ldo + col;
                if (EPI == 0) *o = t[j] * rs; else if (EPI == 1) *o += t[j]; else { const float v = fmaxf(t[j] * rs, 0.f); *o = v * v; } }
        }
        __syncthreads();
    }
}
DI void sgemm1(const Ctx& c, int l, LAS unsigned char* lds) {
    sgemm_block<4, true, 0>(c, WSP(float, WS_XS), DM, DM, WSP(bf16_t, WS_WIN) + (size_t)l * NP * DM, 49, WSP(float, WS_PS), NPS, lds, WSP(bf16_t, WS_WAB) + (size_t)l * 16 * DM);
}
DI void sgemm2(const Ctx& c, int l, LAS unsigned char* lds) {
    sgemm_block<2, false, 1>(c, WSP(float, WS_AMIXS), DM, DM, WSP(bf16_t, WS_WO) + (size_t)l * DM * DM, 32, WSP(float, WS_XS), DM, lds, nullptr);
}
DI void sgemm3(const Ctx& c, int l, LAS unsigned char* lds) {
    sgemm_block<4, true, 2>(c, WSP(float, WS_XS), DM, DM, WSP(bf16_t, WS_WUP) + (size_t)l * FF * DM, 64, WSP(float, WS_HS), FF, lds, nullptr);
}
DI void sgemm4(const Ctx& c, int l, LAS unsigned char* lds) {
    sgemm_block<2, false, 1>(c, WSP(float, WS_HS), FF, FF, WSP(bf16_t, WS_WDN) + (size_t)l * DM * FF, 32, WSP(float, WS_XS), DM, lds, nullptr);
}

DI void b0_block_ab(const Ctx& c, int l, int chunk, LAS unsigned char* lds) {
    int lane = c.lane; asm volatile("" : "+v"(lane));
    const int wave = c.wave, fr = lane & 15, fq = lane >> 4, tok0 = chunk * 64, k0 = wave * 128;
    const bf16_t* ap = WSP(bf16_t, WS_XB16) + (size_t)(tok0 + fr) * DM + k0 + 8 * fq;
    const bf16_t* bp = WSP(bf16_t, WS_WAB) + (size_t)l * 16 * DM + (size_t)fr * DM + k0 + 8 * fq;
    f32x4 acc[4];
#pragma unroll
    for (int mt = 0; mt < 4; ++mt) acc[mt] = (f32x4){0.f, 0.f, 0.f, 0.f};
#pragma unroll
    for (int k = 0; k < 128; k += 32) {
        const bf16x8 bf = *(const bf16x8*)(bp + k);
#pragma unroll
        for (int mt = 0; mt < 4; ++mt) { const bf16x8 a = *(const bf16x8*)(ap + (size_t)mt * 16 * DM + k); acc[mt] = MFMA16(a, bf, acc[mt]); }
    }
    LAS f32x4* red = (LAS f32x4*)lds;
#pragma unroll
    for (int mt = 0; mt < 4; ++mt) red[(wave * 4 + mt) * 64 + lane] = acc[mt];
    __syncthreads();
    if (wave < 4 && fr < 8) { const int mt = wave;
        f32x4 t = red[mt * 64 + lane];
#pragma unroll
        for (int w = 1; w < 8; ++w) t += red[(w * 4 + mt) * 64 + lane];
        const float* ssq = WSP(float, WS_SSQ) + (size_t)(2 * l) * MP * 16;
        float* gb = WSP(float, WS_G); float* bb = WSP(float, WS_BETA);
        const int hh = fr & 3; const float al = -__expf(c.A_log[l * 4 + hh]), dtb = c.dt_bias[l * 4 + hh];
#pragma unroll
        for (int j = 0; j < 4; ++j) { const int tok = tok0 + 16 * mt + 4 * fq + j; const float v = t[j] * rsqrtf(ssq_sum(ssq + (size_t)tok * 16) * (1.0f / DM) + EPS);
            if (fr < 4) gb[tok * 4 + hh] = al * softplus_f(v + dtb); else bb[tok * 4 + hh] = sigmoid_f(v); } }
    __syncthreads();
}
DI float dot2bf(unsigned a, unsigned b, float c) { float r; asm("v_dot2c_f32_bf16 %0, %1, %2" : "=v"(r) : "s"(b), "v"(a), "0"(c)); return r; }
constexpr int B0_STRIDE = 272, B0_WAVE_LDS = 18432;
DI void b0_task_conv(const Ctx& c, int l, int b, int n, int s, int hh, LAS unsigned char* wl) {
    int lane = c.lane; asm volatile("" : "+v"(lane));
    const int tok0 = b * SEQ + n * 64, cb = s * 512 + hh * 128, piece = lane & 15;
    const bf16_t* P = WSP(bf16_t, WS_P) + (size_t)tok0 * NP + cb + piece * 8;
#pragma unroll
    for (int k = 0; k < 17; ++k) { const int row = 4 * k + (lane >> 4);
        if (row < 67) { u32x4 v = (u32x4){0u, 0u, 0u, 0u}; if (n > 0 || row >= 3) v = *(const u32x4*)(P + (long)(row - 3) * NP);
            *(LAS u32x4*)(wl + row * B0_STRIDE + piece * 16) = v; } }
    const unsigned* cwl = (const unsigned*)(c.conv_w + (size_t)l * 4 * QKV + cb);
    if (n == 31) {
        float* ocp = c.out + O_CP + ((size_t)(l * NBATCH + b) * 3) * QKV + cb;
#pragma unroll
        for (int t = 0; t < 6; ++t) { const int idx = lane + 64 * t, row = idx >> 7, ch = idx & 127; ocp[(size_t)row * QKV + ch] = bf2f(*(const LAS bf16_t*)(wl + (64 + row) * B0_STRIDE + ch * 2)); } }
    float ss = 0.f;
#pragma unroll 1
    for (int i = 0; i < 16; ++i) {
        u32x4 rws[4];
#pragma unroll
        for (int j = 0; j < 4; ++j) rws[j] = *(const LAS u32x4*)(wl + (lane + j) * B0_STRIDE + i * 16);
        u32x8 w0, w1, w2, w3; const unsigned* wp = cwl + 8 * i;
        asm volatile("s_load_dwordx8 %0, %4, 0x0\n\ts_load_dwordx8 %1, %4, 0x1800\n\ts_load_dwordx8 %2, %4, 0x3000\n\ts_load_dwordx8 %3, %4, 0x4800\n\ts_waitcnt lgkmcnt(0)"
                     : "=&s"(w0), "=&s"(w1), "=&s"(w2), "=&s"(w3) : "s"(wp) : "memory");
        float y[8];
#pragma unroll
        for (int e = 0; e < 8; ++e) { float a = 0.f;
            a = dot2bf(rws[0][e >> 1], (e & 1) ? ((w0[e] + 0x8000u) & 0xffff0000u) : ((w0[e] + 0x8000u) >> 16), a);
            a = dot2bf(rws[1][e >> 1], (e & 1) ? ((w1[e] + 0x8000u) & 0xffff0000u) : ((w1[e] + 0x8000u) >> 16), a);
            a = dot2bf(rws[2][e >> 1], (e & 1) ? ((w2[e] + 0x8000u) & 0xffff0000u) : ((w2[e] + 0x8000u) >> 16), a);
            a = dot2bf(rws[3][e >> 1], (e & 1) ? ((w3[e] + 0x8000u) & 0xffff0000u) : ((w3[e] + 0x8000u) >> 16), a);
            y[e] = silu_f(a); ss += y[e] * y[e]; }
        u32x4 w; w.x = pk2(y[0], y[1]); w.y = pk2(y[2], y[3]); w.z = pk2(y[4], y[5]); w.w = pk2(y[6], y[7]);
        *(LAS u32x4*)(wl + (lane + 3) * B0_STRIDE + i * 16) = w;
    }
    const float sc = s == 0 ? rsqrtf(ss + EPS) * 0.08838834764831845f : (s == 1 ? rsqrtf(ss + EPS) : 1.0f);
    const size_t unit = (size_t)((b * 4 + hh) * 32 + n);
    bf16_t* ot = (s == 1 ? WSP(bf16_t, WS_KNT) : WSP(bf16_t, WS_VT)) + unit * 128 * 64 + lane;
#pragma unroll 2
    for (int i = 0; i < 16; ++i) { const u32x4 v = *(const LAS u32x4*)(wl + (lane + 3) * B0_STRIDE + i * 16); u32x4 w;
#pragma unroll
        for (int e = 0; e < 4; ++e) w[e] = pk2(bflo(v[e]) * sc, bfhi(v[e]) * sc);
        if (s < 2) *(LAS u32x4*)(wl + (lane + 3) * B0_STRIDE + i * 16) = w;
        if (s >= 1) {
#pragma unroll
            for (int e = 0; e < 8; ++e) ot[(8 * i + e) * 64] = (bf16_t)((e & 1) ? (w[e >> 1] >> 16) : (w[e >> 1] & 0xffffu)); } }
    if (s < 2) { bf16_t* o = (s == 0 ? WSP(bf16_t, WS_QN) : WSP(bf16_t, WS_KN)) + (size_t)tok0 * 512 + hh * 128 + piece * 8;
#pragma unroll
        for (int k = 0; k < 16; ++k) { const int row = 4 * k + (lane >> 4); *(u32x4*)(o + (size_t)row * 512) = *(const LAS u32x4*)(wl + (row + 3) * B0_STRIDE + piece * 16); } }
}
DI void b0_task_vb(const Ctx& c, int l, int b, int n, int hb, LAS unsigned char* wl) {
    int lane = c.lane; asm volatile("" : "+v"(lane));
    const int tok0 = b * SEQ + n * 64, piece = lane & 15;
    const bf16_t* P = WSP(bf16_t, WS_P) + (size_t)tok0 * NP + 2560 + hb * 128 + piece * 8;
#pragma unroll
    for (int k = 0; k < 16; ++k) { const int row = 4 * k + (lane >> 4); *(LAS u32x4*)(wl + row * B0_STRIDE + piece * 16) = *(const u32x4*)(P + (size_t)row * NP); }
    const float* vp = WSP(float, WS_VSS) + (size_t)(tok0 + lane) * 8; const f32x4 p0 = *(const f32x4*)vp, p1 = *(const f32x4*)(vp + 4);
    const float rs = rsqrtf((((p0.x + p0.y) + (p0.z + p0.w)) + ((p1.x + p1.y) + (p1.z + p1.w))) * (1.0f / 512.0f) + EPS);
    const float* vg = c.v_norm_g + l * 512 + hb * 128;
    bf16_t* vbt = WSP(bf16_t, WS_VBT) + ((size_t)((b * 16 + (n >> 1)) * 4 + hb) * 128) * 128 + (n & 1) * 64 + lane;
#pragma unroll 2
    for (int i = 0; i < 16; ++i) { const u32x4 v = *(const LAS u32x4*)(wl + lane * B0_STRIDE + i * 16);
#pragma unroll
        for (int e = 0; e < 8; ++e) { const float pv = (e & 1) ? bfhi(v[e >> 1]) : bflo(v[e >> 1]); vbt[(size_t)(8 * i + e) * 128] = f2bf(pv * rs * vg[8 * i + e]); } }
}
DI void b0_task_sample(const Ctx& c, int l, int bs) {
    const float* ps = WSP(float, WS_PS) + (size_t)bs * NPS;
    if (c.lane < 4) { const int hh = c.lane;
        WSP(float, WS_GS)[bs * 4 + hh] = -__expf(c.A_log[l * 4 + hh]) * softplus_f(ps[3072 + hh] + c.dt_bias[l * 4 + hh]);
        WSP(float, WS_BS)[bs * 4 + hh] = sigmoid_f(ps[3076 + hh]); }
    const float* sc = c.state_conv + (size_t)(l * SBATCH + bs) * 3 * QKV;
    const float* cw = c.conv_w + (size_t)l * 4 * QKV;
    float* ocs = c.out + O_CS + (size_t)(l * SBATCH + bs) * 3 * QKV;
    float* qkvs = WSP(float, WS_QS) + bs * 512;
#pragma unroll 1
    for (int sh = 0; sh < 12; ++sh) {
        float y[2];
#pragma unroll
        for (int t = 0; t < 2; ++t) { const int ch = sh * 128 + t * 64 + c.lane; const float s0 = sc[ch], s1 = sc[QKV + ch], s2 = sc[2 * QKV + ch], cur = ps[ch];
            ocs[ch] = s1; ocs[QKV + ch] = s2; ocs[2 * QKV + ch] = cur;
            y[t] = silu_f(s0 * cw[ch] + s1 * cw[QKV + ch] + s2 * cw[2 * QKV + ch] + cur * cw[3 * QKV + ch]); }
        float scale = 1.0f;
        if (sh < 8) { const float ssum = wave_sum(y[0] * y[0] + y[1] * y[1], c.lane); scale = rsqrtf(ssum + EPS) * (sh < 4 ? 0.08838834764831845f : 1.0f); }
        float* o = qkvs + (size_t)(sh >> 2) * SBATCH * 512 + (sh & 3) * 128;
        o[c.lane] = y[0] * scale; o[64 + c.lane] = y[1] * scale;
    }
    float pv[8]; float ss = 0.f;
#pragma unroll
    for (int i = 0; i < 8; ++i) { pv[i] = ps[2560 + c.lane + 64 * i]; ss += pv[i] * pv[i]; }
    ss = wave_sum(ss, c.lane); const float rs = rsqrtf(ss * (1.0f / 512.0f) + EPS);
    float* am = WSP(float, WS_AMIXS) + (size_t)bs * DM; float* ovs = c.out + O_VS + (size_t)(l * SBATCH + bs) * 512;
#pragma unroll
    for (int i = 0; i < 8; ++i) { const int ch = c.lane + 64 * i, hb = ch >> 7; const float vb = pv[i] * rs * c.v_norm_g[l * 512 + ch];
        ovs[ch] = vb; am[512 + ch] = ps[2048 + ch] * (c.w_s[(size_t)(l * 4 + hb) * 128 * 128] * vb + c.b_s[(l * 4 + hb) * 128]); }
}
DI void phase_b0(const Ctx& c, int l, LAS unsigned char* lds) {
    for (int ch = c.bx; ch < 256; ch += c.nb) b0_block_ab(c, l, ch, lds);
    constexpr int NPT = 256 * 12;
    LAS unsigned char* wl = lds + c.wave * B0_WAVE_LDS;
    for (int t = c.gw; t < NPT + SBATCH; t += c.ngw) {
        if (t >= NPT) { if (SUB(0)) b0_task_sample(c, l, t - NPT); continue; }
        const int chunk = t / 12, k = t % 12, b = chunk >> 5, n = chunk & 31;
        if (SUB(3)) b0_task_conv(c, l, b, n, k >> 2, k & 3, wl);
    }
}

DI void b1_prep(const Ctx& c, int l, int unit, LAS unsigned char* wl, LAS float* sg, LAS float* sb) {
    int lane = c.lane; asm volatile("" : "+v"(lane));
    const int r = lane & 31, h = lane >> 5;
    const int n = unit & 31, bh = unit >> 5, hh = bh & 3, b = bh >> 2, tok0 = b * SEQ + n * 64;
    const float bt = WSP(float, WS_BETA)[(tok0 + lane) * 4 + hh];
    float gc = WSP(float, WS_G)[(tok0 + lane) * 4 + hh];
#pragma unroll
    for (int o = 1; o < 64; o <<= 1) { const float t = xlane(gc, lane - o); if (lane >= o) gc += t; }
    sg[lane] = gc; sb[lane] = bt;
    const float glast = __builtin_bit_cast(float, __builtin_amdgcn_readlane(__builtin_bit_cast(int, gc), 63));
    if (lane == 0) WSP(float, WS_EG)[unit] = __expf(glast);
    unsigned char* img = c.ws + WS_IMG + (size_t)unit * IMG_BYTES;
    const bf16_t* Kn = WSP(bf16_t, WS_KN) + (size_t)tok0 * 512 + hh * 128;
    const bf16_t* Qn = WSP(bf16_t, WS_QN) + (size_t)tok0 * 512 + hh * 128;
    const bf16_t* KnT = WSP(bf16_t, WS_KNT) + (size_t)unit * 128 * 64;
    const bf16_t* VT = WSP(bf16_t, WS_VT) + (size_t)unit * 128 * 64;
    LAS float* L = (LAS float*)wl;
    {
        bf16x8 Kf[2][8];
#pragma unroll
        for (int t = 0; t < 2; ++t)
#pragma unroll
            for (int ks = 0; ks < 8; ++ks) Kf[t][ks] = *(const bf16x8*)(Kn + (size_t)(32 * t + r) * 512 + 16 * ks + 8 * h);
#pragma unroll
        for (int tt = 0; tt < 3; ++tt) { const int mt = tt == 0 ? 0 : 1, nt = tt == 2 ? 1 : 0;
            f32x16 acc = zero16();
#pragma unroll
            for (int ks = 0; ks < 8; ++ks) acc = MFMA32(Kf[mt][ks], Kf[nt][ks], acc);
            const int j = 32 * nt + r; const float gj = sg[j];
#pragma unroll
            for (int g4 = 0; g4 < 4; ++g4) { const f32x4 gi4 = *(const LAS f32x4*)(sg + 32 * mt + 8 * g4 + 4 * h), bi4 = *(const LAS f32x4*)(sb + 32 * mt + 8 * g4 + 4 * h);
#pragma unroll
                for (int q = 0; q < 4; ++q) { const int i = 32 * mt + 8 * g4 + 4 * h + q; const float arg = i > j ? gi4[q] - gj : 0.f;
                    L[i * 64 + j] = i > j ? acc[4 * g4 + q] * bi4[q] * __expf(arg) : 0.f; } } }
#pragma unroll
        for (int mt = 0; mt < 2; ++mt) {
            bf16x8 Qf[8];
#pragma unroll
            for (int ks = 0; ks < 8; ++ks) Qf[ks] = *(const bf16x8*)(Qn + (size_t)(32 * mt + r) * 512 + 16 * ks + 8 * h);
            const int i = 32 * mt + r; const float gi = sg[i];
#pragma unroll
            for (int mp = 0; mp <= mt; ++mp) {
                f32x16 acc = zero16();
#pragma unroll
                for (int ks = 0; ks < 8; ++ks) acc = MFMA32(Kf[mp][ks], Qf[ks], acc);
#pragma unroll
                for (int g4 = 0; g4 < 4; ++g4) { const f32x4 gj4 = *(const LAS f32x4*)(sg + 32 * mp + 8 * g4 + 4 * h);
#pragma unroll
                    for (int q = 0; q < 4; ++q) { const int j = 32 * mp + 8 * g4 + 4 * h + q; const float arg = i >= j ? gi - gj4[q] : 0.f;
                        acc[4 * g4 + q] = i >= j ? acc[4 * g4 + q] * __expf(arg) : 0.f; } }
                const int fb = (mt == 0 ? 0 : 1 + mp) * 2;
#pragma unroll
                for (int s = 0; s < 2; ++s) *(u32x4*)(img + 49152 + (fb + s) * 1024 + lane * 16) = pack8(acc, s);
            }
        }
    }
    float Tr[64];
    {
        f32x4 lb[2][16];
#pragma unroll
        for (int i = 0; i < 64; ++i) {
            if (i + 1 < 64) {
#pragma unroll
                for (int j4 = 0; j4 < (i + 1 + 3) / 4; ++j4) lb[(i + 1) & 1][j4] = *(const LAS f32x4*)(L + (i + 1) * 64 + 4 * j4); }
            asm volatile("" ::: "memory");
            float a0 = lane == i ? 1.f : 0.f, a1 = 0.f;
#pragma unroll
            for (int j4 = 0; j4 < (i + 3) / 4; ++j4) {
#pragma unroll
                for (int q = 0; q < 4; ++q) { const int j = 4 * j4 + q; if (j < i) { if (q & 1) a1 -= lb[i & 1][j4][q] * Tr[j]; else a0 -= lb[i & 1][j4][q] * Tr[j]; } } }
            Tr[i] = a0 + a1;
        }
    }
    LAS bf16_t* T1 = (LAS bf16_t*)wl;
    asm volatile("" ::: "memory");
    {
        const float sc1 = bt * __expf(gc);
#pragma unroll
        for (int i = 0; i < 64; ++i) T1[i * 72 + lane] = f2bf(Tr[i] * sc1);
        bf16x8 Tf[2][4];
#pragma unroll
        for (int mt = 0; mt < 2; ++mt)
#pragma unroll
            for (int ks = 0; ks < 4; ++ks) Tf[mt][ks] = *(const LAS bf16x8*)(T1 + (32 * mt + r) * 72 + 16 * ks + 8 * h);
#pragma unroll
        for (int dt = 0; dt < 4; ++dt) {
            bf16x8 Kt[4];
#pragma unroll
            for (int ks = 0; ks < 4; ++ks) Kt[ks] = *(const bf16x8*)(KnT + (size_t)(32 * dt + r) * 64 + 16 * ks + 8 * h);
#pragma unroll
            for (int mt = 0; mt < 2; ++mt) { f32x16 acc = zero16();
#pragma unroll
                for (int ks = 0; ks < 2 * (mt + 1); ++ks) acc = MFMA32(Kt[ks], Tf[mt][ks], acc);
                acc = -acc;
#pragma unroll
                for (int s = 0; s < 2; ++s) *(u32x4*)(img + ((mt * 4 + dt) * 2 + s) * 1024 + lane * 16) = pack8(acc, s); }
        }
    }
    asm volatile("" ::: "memory");
    {
#pragma unroll
        for (int i = 0; i < 64; ++i) T1[i * 72 + lane] = f2bf(Tr[i] * bt);
        bf16x8 Tf[2][4];
#pragma unroll
        for (int mt = 0; mt < 2; ++mt)
#pragma unroll
            for (int ks = 0; ks < 4; ++ks) Tf[mt][ks] = *(const LAS bf16x8*)(T1 + (32 * mt + r) * 72 + 16 * ks + 8 * h);
        bf16_t* uimg = WSP(bf16_t, WS_UIMG) + (size_t)unit * 8192;
#pragma unroll
        for (int et = 0; et < 4; ++et) {
            bf16x8 Vt[4];
#pragma unroll
            for (int ks = 0; ks < 4; ++ks) Vt[ks] = *(const bf16x8*)(VT + (size_t)(32 * et + r) * 64 + 16 * ks + 8 * h);
#pragma unroll
            for (int mt = 0; mt < 2; ++mt) { f32x16 acc = zero16();
#pragma unroll
                for (int ks = 0; ks < 2 * (mt + 1); ++ks) acc = MFMA32(Tf[mt][ks], Vt[ks], acc);
#pragma unroll
                for (int g4 = 0; g4 < 4; ++g4) { u32x2 w; w.x = pk2(acc[4 * g4], acc[4 * g4 + 1]); w.y = pk2(acc[4 * g4 + 2], acc[4 * g4 + 3]); *(u32x2*)(uimg + ((et * 2 + mt) * 4 + g4) * 256 + lane * 4) = w; } }
        }
    }
    asm volatile("" ::: "memory");
#pragma unroll
    for (int mt = 0; mt < 2; ++mt) { const float ei = __expf(sg[32 * mt + r]);
#pragma unroll
        for (int dt = 0; dt < 4; ++dt)
#pragma unroll
            for (int s = 0; s < 2; ++s) { const bf16_t* qp = Qn + (size_t)(32 * mt + r) * 512 + 32 * dt + 16 * s + 4 * h;
                const u32x2 p0 = *(const u32x2*)qp, p1 = *(const u32x2*)(qp + 8);
                u32x4 w; w.x = pk2(bflo(p0.x) * ei, bfhi(p0.x) * ei); w.y = pk2(bflo(p0.y) * ei, bfhi(p0.y) * ei); w.z = pk2(bflo(p1.x) * ei, bfhi(p1.x) * ei); w.w = pk2(bflo(p1.y) * ei, bfhi(p1.y) * ei);
                *(u32x4*)(img + 16384 + ((mt * 4 + dt) * 2 + s) * 1024 + lane * 16) = w; } }
#pragma unroll
    for (int mp = 0; mp < 2; ++mp)
#pragma unroll
        for (int s = 0; s < 2; ++s) { const f32x4 ga = *(const LAS f32x4*)(sg + 32 * mp + 16 * s + 4 * h), gb = *(const LAS f32x4*)(sg + 32 * mp + 16 * s + 8 + 4 * h);
            float sc[8];
#pragma unroll
            for (int q = 0; q < 4; ++q) { sc[q] = __expf(glast - ga[q]); sc[4 + q] = __expf(glast - gb[q]); }
#pragma unroll
            for (int dt = 0; dt < 4; ++dt) { const bf16_t* kp = KnT + (size_t)(32 * dt + r) * 64 + 32 * mp + 16 * s + 4 * h;
                const u32x2 p0 = *(const u32x2*)kp, p1 = *(const u32x2*)(kp + 8);
                u32x4 w; w.x = pk2(bflo(p0.x) * sc[0], bfhi(p0.x) * sc[1]); w.y = pk2(bflo(p0.y) * sc[2], bfhi(p0.y) * sc[3]); w.z = pk2(bflo(p1.x) * sc[4], bfhi(p1.x) * sc[5]); w.w = pk2(bflo(p1.y) * sc[6], bfhi(p1.y) * sc[7]);
                *(u32x4*)(img + 32768 + ((dt * 2 + mp) * 2 + s) * 1024 + lane * 16) = w; } }
}
DI void b1_gmlp(const Ctx& c, int l, int unit) {
    int lane = c.lane; asm volatile("" : "+v"(lane));
    const int r = lane & 31, h = lane >> 5;
    const int hb = unit & 3, cc = (unit >> 2) & 15, b = unit >> 6, tokc0 = b * SEQ + cc * 128;
    const bf16_t* A = WSP(bf16_t, WS_VBT) + (size_t)unit * 128 * 128;
    const bf16_t* B = WSP(bf16_t, WS_WM) + (size_t)(l * 4 + hb) * 128 * 128;
    const bf16_t* P = WSP(bf16_t, WS_P); bf16_t* AM = WSP(bf16_t, WS_AMIX);
#pragma unroll
    for (int nt = 0; nt < 4; ++nt) {
        f32x16 acc[4];
#pragma unroll
        for (int mt = 0; mt < 4; ++mt) acc[mt] = zero16();
#pragma unroll
        for (int ks = 0; ks < 2 * (nt + 1); ++ks) { const bf16x8 bf = *(const bf16x8*)(B + (size_t)(32 * nt + r) * 128 + 16 * ks + 8 * h);
#pragma unroll
            for (int mt = 0; mt < 4; ++mt) { const bf16x8 af = *(const bf16x8*)(A + (size_t)(32 * mt + r) * 128 + 16 * ks + 8 * h); acc[mt] = MFMA32(af, bf, acc[mt]); } }
        const int tok = tokc0 + 32 * nt + r; const float bsi = c.b_s[(l * 4 + hb) * 128 + 32 * nt + r];
#pragma unroll
        for (int mt = 0; mt < 4; ++mt)
#pragma unroll
            for (int g4 = 0; g4 < 4; ++g4) { const int dch0 = 32 * mt + 8 * g4 + 4 * h;
                const u32x2 u4 = *(const u32x2*)(P + (size_t)tok * NP + 2048 + hb * 128 + dch0);
                u32x2 w; w.x = pk2(bflo(u4.x) * (acc[mt][4 * g4] + bsi), bfhi(u4.x) * (acc[mt][4 * g4 + 1] + bsi)); w.y = pk2(bflo(u4.y) * (acc[mt][4 * g4 + 2] + bsi), bfhi(u4.y) * (acc[mt][4 * g4 + 3] + bsi));
                *(u32x2*)(AM + (size_t)tok * DM + 512 + hb * 128 + dch0) = w; }
    }
}
DI void phase_b1(const Ctx& c, int l, LAS unsigned char* lds) {
    LAS unsigned char* wl = lds + c.wave * 16384; LAS float* sg = (LAS float*)(lds + 131072 + c.wave * 512); LAS float* sb = sg + 64;
    for (int t = c.gw; t < 1024; t += c.ngw) {
        if (SUB(0)) b1_prep(c, l, t, wl, sg, sb);
    }
}


constexpr int OB_STRIDE = 136;
constexpr int IMG_LDS = 57344;
constexpr int LDS_OBUF = 2 * IMG_LDS, OBUF_BYTES = 64 * OB_STRIDE * 2;
static_assert(LDS_OBUF + 2 * OBUF_BYTES <= LDS_BYTES, "scan LDS");
DI void scan_post(const Ctx& c, int l, int b, int hh, int n, const LAS bf16_t* ob, int lid, const u32x4 (&gt4)[4]) {
    const int i = lid >> 2, q = lid & 3, tok = b * SEQ + n * 64 + i;
    u32x4 ov[4]; float ss = 0.f;
#pragma unroll
    for (int x = 0; x < 4; ++x) { ov[x] = *(const LAS u32x4*)(ob + i * OB_STRIDE + 32 * q + 8 * x);
#pragma unroll
        for (int e = 0; e < 4; ++e) { const float a = bflo(ov[x][e]), bq = bfhi(ov[x][e]); ss += a * a + bq * bq; } }
    ss += xlane(ss, (lid & 63) ^ 1); ss += xlane(ss, (lid & 63) ^ 2);
    const float rs = rsqrtf(ss * (1.0f / 128.0f) + EPS);
    bf16_t* op = WSP(bf16_t, WS_AMIX) + (size_t)tok * DM + hh * 128 + 32 * q;
#pragma unroll
    for (int x = 0; x < 4; ++x) { u32x4 w;
#pragma unroll
        for (int e = 0; e < 4; ++e) w[e] = pk2(bflo(ov[x][e]) * rs * bflo(gt4[x][e]), bfhi(ov[x][e]) * rs * bfhi(gt4[x][e]));
        *(u32x4*)(op + 8 * x) = w; }
}
DI void scan_loader_step(const Ctx& c, int l, int b, int hh, int n, LAS unsigned char* lds, const unsigned char* img0, const bf16_t* gbase, int lw, int lane, int lid, u32x4 (&regs)[14], u32x4 (&gt)[4]) {
    u32x4 gcur[4];
#pragma unroll
    for (int x = 0; x < 4; ++x) gcur[x] = gt[x];
#pragma unroll
    for (int x = 0; x < 4; ++x) gt[x] = *(const u32x4*)(gbase + (size_t)n * 64 * NP + 8 * x);
    const unsigned voff = (unsigned)(lw * 14336 + lane * 16);
    if (n + 1 < 32) { LAS unsigned char* dst = lds + ((n + 1) & 1) * IMG_LDS + voff;
#pragma unroll
        for (int i = 0; i < 14; ++i) *(LAS u32x4*)(dst + i * 1024) = regs[i]; }
    if (n + 3 < 32) { const unsigned char* src = img0 + (size_t)(n + 3) * IMG_BYTES;
#pragma unroll
        for (int i = 0; i < 14; ++i) regs[i] = *(const u32x4*)(src + voff + i * 1024); }
    if (n >= 1) scan_post(c, l, b, hh, n - 1, (const LAS bf16_t*)(lds + LDS_OBUF + ((n - 1) & 1) * OBUF_BYTES), lid, gcur);
    __syncthreads();
}
DI void scan_consumer_step(int n, LAS unsigned char* lds, f32x16 (&S)[4], u32x2 (&ucur)[8], float& egc, const bf16_t* uimg0, const float* egp, int lane, int ws, int r, int h) {
    const LAS unsigned char* buf = lds + (n & 1) * IMG_LDS + lane * 16;
    f32x16 av[2], ao[2]; ao[0] = zero16(); ao[1] = zero16();
#pragma unroll
    for (int mt = 0; mt < 2; ++mt)
#pragma unroll
        for (int g4 = 0; g4 < 4; ++g4) { const u32x2 w = ucur[mt * 4 + g4]; av[mt][4 * g4] = bflo(w.x); av[mt][4 * g4 + 1] = bfhi(w.x); av[mt][4 * g4 + 2] = bflo(w.y); av[mt][4 * g4 + 3] = bfhi(w.y); }
    const float eg = egc;
    if (n + 2 < 32) { const bf16_t* up = uimg0 + (size_t)(n + 2) * 8192;
#pragma unroll
        for (int x = 0; x < 8; ++x) ucur[x] = *(const u32x2*)(up + x * 256);
        egc = egp[n + 2]; }
    {
        bf16x8 fg[2][4];
#pragma unroll
        for (int mt = 0; mt < 2; ++mt) { fg[0][mt] = *(const LAS bf16x8*)(buf + (mt * 8) * 1024); fg[0][2 + mt] = *(const LAS bf16x8*)(buf + 16384 + (mt * 8) * 1024); }
#pragma unroll
        for (int gI = 0; gI < 8; ++gI) { const int dt = gI >> 1, s = gI & 1;
            if (gI + 1 < 8) {
#pragma unroll
                for (int mt = 0; mt < 2; ++mt) { fg[(gI + 1) & 1][mt] = *(const LAS bf16x8*)(buf + (mt * 8 + gI + 1) * 1024); fg[(gI + 1) & 1][2 + mt] = *(const LAS bf16x8*)(buf + 16384 + (mt * 8 + gI + 1) * 1024); } }
            asm volatile("" ::: "memory");
            const bf16x8 sb = as_bf(pack8(S[dt], s));
            av[0] = MFMA32(fg[gI & 1][0], sb, av[0]); av[1] = MFMA32(fg[gI & 1][1], sb, av[1]);
            ao[0] = MFMA32(sb, fg[gI & 1][2], ao[0]); ao[1] = MFMA32(sb, fg[gI & 1][3], ao[1]); }
    }
    bf16x8 vb[2][2];
#pragma unroll
    for (int mp = 0; mp < 2; ++mp)
#pragma unroll
        for (int s = 0; s < 2; ++s) vb[mp][s] = as_bf(pack8(av[mp], s));
    {
        bf16x8 qf[6];
#pragma unroll
        for (int f = 0; f < 6; ++f) qf[f] = *(const LAS bf16x8*)(buf + 49152 + f * 1024);
        asm volatile("" ::: "memory");
#pragma unroll
        for (int s = 0; s < 2; ++s) { ao[0] = MFMA32(vb[0][s], qf[s], ao[0]); ao[1] = MFMA32(vb[0][s], qf[2 + s], ao[1]); ao[1] = MFMA32(vb[1][s], qf[4 + s], ao[1]); }
    }
    LAS bf16_t* ob = (LAS bf16_t*)(lds + LDS_OBUF + (n & 1) * OBUF_BYTES);
#pragma unroll
    for (int mt = 0; mt < 2; ++mt)
#pragma unroll
        for (int g4 = 0; g4 < 4; ++g4) { u32x2 w; w.x = pk2(ao[mt][4 * g4], ao[mt][4 * g4 + 1]); w.y = pk2(ao[mt][4 * g4 + 2], ao[mt][4 * g4 + 3]);
            *(LAS u32x2*)(ob + (32 * mt + r) * OB_STRIDE + 32 * ws + 8 * g4 + 4 * h) = w; }
    bf16x8 kf[2][4];
#pragma unroll
    for (int f = 0; f < 4; ++f) kf[0][f] = *(const LAS bf16x8*)(buf + 32768 + f * 1024);
#pragma unroll
    for (int dt = 0; dt < 4; ++dt) {
        if (dt + 1 < 4) {
#pragma unroll
            for (int f = 0; f < 4; ++f) kf[(dt + 1) & 1][f] = *(const LAS bf16x8*)(buf + 32768 + ((dt + 1) * 4 + f) * 1024); }
        asm volatile("" ::: "memory");
        S[dt] = S[dt] * eg;
#pragma unroll
        for (int mp = 0; mp < 2; ++mp)
#pragma unroll
            for (int s = 0; s < 2; ++s) S[dt] = MFMA32(kf[dt & 1][mp * 2 + s], vb[mp][s], S[dt]); }
    __syncthreads();
}
DI void scan_block(const Ctx& c, int l, int bh, LAS unsigned char* lds) {
    const int wave = c.wave, b = bh >> 2, hh = bh & 3;
    const unsigned char* img0 = c.ws + WS_IMG + (size_t)bh * 32 * IMG_BYTES;
    if (wave >= 4) { if (SUB2(0)) {
        int lane = c.lane; asm volatile("" : "+v"(lane));
        const int lw = wave - 4, lid = lw * 64 + lane;
        u32x4 regs0[14], regs1[14], gt0[4];
        const bf16_t* gbase = WSP(bf16_t, WS_P) + (size_t)(b * SEQ + (lid >> 2)) * NP + 1536 + hh * 128 + 32 * (lid & 3);
        const unsigned voff0 = (unsigned)(lw * 14336 + lane * 16);
#pragma unroll
        for (int i = 0; i < 14; ++i) regs0[i] = *(const u32x4*)(img0 + voff0 + i * 1024);
#pragma unroll
        for (int i = 0; i < 14; ++i) *(LAS u32x4*)(lds + voff0 + i * 1024) = regs0[i];
#pragma unroll
        for (int i = 0; i < 14; ++i) { regs1[i] = *(const u32x4*)(img0 + (size_t)IMG_BYTES + voff0 + i * 1024); regs0[i] = *(const u32x4*)(img0 + (size_t)2 * IMG_BYTES + voff0 + i * 1024); }
#pragma unroll
        for (int x = 0; x < 4; ++x) gt0[x] = (u32x4){0u, 0u, 0u, 0u};
        __syncthreads();
        for (int n = 0; n < 32; n += 2) {
            scan_loader_step(c, l, b, hh, n, lds, img0, gbase, lw, lane, lid, regs1, gt0);
            scan_loader_step(c, l, b, hh, n + 1, lds, img0, gbase, lw, lane, lid, regs0, gt0);
        }
        scan_post(c, l, b, hh, 31, (const LAS bf16_t*)(lds + LDS_OBUF + (31 & 1) * OBUF_BYTES), lid, gt0);
    } } else if (SUB2(1)) {
        int lane = c.lane; asm volatile("" : "+v"(lane));
        const int ws = wave, r = lane & 31, h = lane >> 5;
        f32x16 S[4];
#pragma unroll
        for (int dt = 0; dt < 4; ++dt) S[dt] = zero16();
        const bf16_t* uimg0 = WSP(bf16_t, WS_UIMG) + (size_t)bh * 32 * 8192 + (size_t)ws * 2 * 4 * 256 + lane * 4;
        const float* egp = WSP(float, WS_EG) + bh * 32;
        u32x2 u0[8], u1[8];
#pragma unroll
        for (int x = 0; x < 8; ++x) { u0[x] = *(const u32x2*)(uimg0 + x * 256); u1[x] = *(const u32x2*)(uimg0 + 8192 + x * 256); }
        float eg0 = egp[0], eg1 = egp[1];
        __syncthreads();
        for (int n = 0; n < 32; n += 2) {
            scan_consumer_step(n, lds, S, u0, eg0, uimg0, egp, lane, ws, r, h);
            scan_consumer_step(n + 1, lds, S, u1, eg1, uimg0, egp, lane, ws, r, h);
        }
        const char* od = (const char*)(c.out + O_DP + (size_t)(l * 32 + bh) * 128 * 128);
        unsigned voff = (unsigned)((4 * h) * 128 + 32 * ws + r) * 4u;
        asm volatile("" : "+v"(voff));
#pragma unroll
        for (int dt = 0; dt < 4; ++dt)
#pragma unroll
            for (int reg = 0; reg < 16; ++reg) *(float*)(od + (32 * dt + (reg & 3) + 8 * (reg >> 2)) * 512 + voff) = S[dt][reg];
    }
}
DI float rdlane(float v, int l) { return __builtin_bit_cast(float, __builtin_amdgcn_readlane(__builtin_bit_cast(int, v), l)); }
DI void sample_recurrent(const Ctx& c, int l, int unit) {
    int lane = c.lane; asm volatile("" : "+v"(lane));
    const int bs = unit >> 2, hh = unit & 3, e2 = 2 * lane;
    const float* S0 = c.state_delta + (size_t)((l * SBATCH + bs) * 4 + hh) * 128 * 128 + e2;
    float* S1 = c.out + O_DS + (size_t)((l * SBATCH + bs) * 4 + hh) * 128 * 128 + e2;
    const float* q = WSP(float, WS_QS) + bs * 512 + hh * 128; const float* k = WSP(float, WS_KS) + bs * 512 + hh * 128; const float* v = WSP(float, WS_VS) + bs * 512 + hh * 128;
    const float eg = __expf(WSP(float, WS_GS)[bs * 4 + hh]), beta = WSP(float, WS_BS)[bs * 4 + hh];
    const float k0 = k[lane], k1 = k[64 + lane], q0 = q[lane], q1 = q[64 + lane];
    f32x2 kv = {0.f, 0.f};
#pragma unroll
    for (int d0 = 0; d0 < 128; d0 += 32) { f32x2 sv[32];
#pragma unroll
        for (int j = 0; j < 32; ++j) sv[j] = *(const f32x2*)(S0 + (d0 + j) * 128);
#pragma unroll
        for (int j = 0; j < 32; ++j) { const int dd = d0 + j; kv += sv[j] * rdlane(dd < 64 ? k0 : k1, dd & 63); } }
    const f32x2 v2 = *(const f32x2*)(v + e2);
    const f32x2 delta = (v2 - kv * eg) * beta;
    f32x2 oo = {0.f, 0.f};
#pragma unroll
    for (int d0 = 0; d0 < 128; d0 += 32) { f32x2 sv[32];
#pragma unroll
        for (int j = 0; j < 32; ++j) sv[j] = *(const f32x2*)(S0 + (d0 + j) * 128);
#pragma unroll
        for (int j = 0; j < 32; ++j) { const int dd = d0 + j; const f32x2 sn = sv[j] * eg + delta * rdlane(dd < 64 ? k0 : k1, dd & 63); oo += sn * rdlane(dd < 64 ? q0 : q1, dd & 63); *(f32x2*)(S1 + dd * 128) = sn; } }
    const float ss = wave_sum(oo.x * oo.x + oo.y * oo.y, lane); const float rs = rsqrtf(ss * (1.0f / 128.0f) + EPS);
    const float* ps = WSP(float, WS_PS) + (size_t)bs * NPS + 1536 + hh * 128 + e2; float* am = WSP(float, WS_AMIXS) + (size_t)bs * DM + hh * 128 + e2;
    const float* og = c.o_norm_g + l * 128 + e2;
    am[0] = oo.x * rs * og[0] * silu_f(ps[0]); am[1] = oo.y * rs * og[1] * silu_f(ps[1]);
}
DI void phase_scan(const Ctx& c, int l, LAS unsigned char* lds) {
    if (c.bx < 32) { if (SUB(0)) scan_block(c, l, c.bx, lds); return; }
    const int w0 = (c.bx - 32) * 8 + c.wave, nw = (c.nb - 32) * 8;
    LAS unsigned char* wl = lds + c.wave * B0_WAVE_LDS;
    for (int u = w0; u < SBATCH * 4 + 512; u += nw) {
        if (u < SBATCH * 4) { if (SUB(1)) sample_recurrent(c, l, u); continue; }
        const int g = u - SBATCH * 4, hb = g & 3, cc = (g >> 2) & 15, b = g >> 6;
        b0_task_vb(c, l, b, 2 * cc, hb, wl); b0_task_vb(c, l, b, 2 * cc + 1, hb, wl);
        asm volatile("s_waitcnt vmcnt(0)" ::: "memory");
        b1_gmlp(c, l, g);
    }
    if (l + 1 < DEPTH) convert_layer_weights(c, l + 1, w0, nw, lds);

}

DI void phase_final(const Ctx& c) {
    const f32x4* gr = (const f32x4*)c.norm_f_g + c.lane;
    for (int m = c.gw; m < MP + SBATCH; m += c.ngw) {
        f32x4 v[4]; float s = 0.f;
        if (m < MP) { const u32x2* xr = (const u32x2*)(WSP(bf16_t, WS_XB16) + (size_t)m * DM) + c.lane;
#pragma unroll
            for (int j = 0; j < 4; ++j) { const u32x2 w = xr[64 * j]; v[j] = (f32x4){bflo(w.x), bfhi(w.x), bflo(w.y), bfhi(w.y)}; } }
        else { const f32x4* xr = (const f32x4*)(WSP(float, WS_XS) + (size_t)(m - MP) * DM) + c.lane;
#pragma unroll
            for (int j = 0; j < 4; ++j) v[j] = xr[64 * j]; }
        float* dst = m < MP ? c.out + O_YP + (size_t)m * DM : c.out + O_YS + (size_t)(m - MP) * DM;
#pragma unroll
        for (int j = 0; j < 4; ++j) s += (v[j].x * v[j].x + v[j].y * v[j].y) + (v[j].z * v[j].z + v[j].w * v[j].w);
        const float rs = rsqrtf(wave_sum(s, c.lane) * (1.0f / DM) + EPS);
#pragma unroll
        for (int j = 0; j < 4; ++j) ((f32x4*)dst + c.lane)[64 * j] = v[j] * rs * gr[64 * j];
    }
}

#define XB_TMO      128
#define XB_XCNT(j)  (256  + 64 * (j))
#define XB_XSUB(j)  (1280 + 64 * (j))
#define XB_XGEN(j)  (2304 + 64 * (j))
#define XB_TOP      3328
#define XB_TOPGEN   3392
#define XCD_BAR_WORDS 3456
#define XB_SPIN_CAP (1u << 18)

__device__ __forceinline__ unsigned xb_ld(unsigned* p)              { return __hip_atomic_load(p, __ATOMIC_RELAXED, __HIP_MEMORY_SCOPE_AGENT); }
__device__ __forceinline__ unsigned xb_add(unsigned* p, unsigned v) { return __hip_atomic_fetch_add(p, v, __ATOMIC_RELAXED, __HIP_MEMORY_SCOPE_AGENT); }
__device__ __forceinline__ unsigned xb_xcc_id() { return (unsigned)__builtin_amdgcn_s_getreg((3 << 11) | 20) & 0xFu; }
#define XB_SPIN(cond, bar) do { unsigned _sp = 0; while (cond) { __builtin_amdgcn_s_sleep(8); \
    if ((++_sp & 255u) == 0u) { if (xb_ld(&(bar)[XB_TMO])) break; if (_sp > XB_SPIN_CAP) { atomicAdd(&(bar)[XB_TMO], 1u); break; } } } } while (0)

struct XcdBarrier {
    unsigned* bar; unsigned x;
    volatile LAS unsigned* st;
};

__device__ __forceinline__ XcdBarrier xcd_barrier_post(unsigned* bar, volatile LAS unsigned* st) {
    XcdBarrier b; b.bar = bar; b.x = xb_xcc_id(); b.st = st;
    if (threadIdx.x == 0) (void)xb_add(&bar[XB_XCNT(b.x)], 1u);
    return b;
}
__device__ __forceinline__ void xcd_barrier_complete(unsigned* bar, unsigned x, unsigned& nloc, unsigned& nx) {
    const unsigned G = gridDim.x * gridDim.y * gridDim.z;
    unsigned sum, cnt, mine, sp = 0u;
    for (;;) {
        sum = 0u; cnt = 0u; mine = 0u;
#pragma unroll
        for (unsigned j = 0; j < 16; ++j) { const unsigned c = xb_ld(&bar[XB_XCNT(j)]); sum += c; cnt += (c > 0u) ? 1u : 0u; mine = (j == x) ? c : mine; }
        if (sum == G) break;
        __builtin_amdgcn_s_sleep(1);
        if ((++sp & 255u) == 0u) { if (xb_ld(&bar[XB_TMO])) break; if (sp > XB_SPIN_CAP) { atomicAdd(&bar[XB_TMO], 1u); break; } }
    }
    nloc = mine > 0u ? mine : 1u; nx = cnt > 0u ? cnt : 1u;
}

__device__ __forceinline__ void xcd_barrier(const XcdBarrier& b) {
    asm volatile("s_waitcnt vmcnt(0)" ::: "memory");
    __syncthreads();
    if (threadIdx.x == 0) {
        unsigned* bar = b.bar;
        __builtin_amdgcn_s_waitcnt(0);
        unsigned nloc = b.st[0], nx = b.st[1];
        if (nloc == 0u) { xcd_barrier_complete(bar, b.x, nloc, nx); b.st[0] = nloc; b.st[1] = nx; }
        const unsigned old = xb_add(&bar[XB_XSUB(b.x)], 1u);
        const unsigned gen = old / nloc;
        if (old + 1u == (gen + 1u) * nloc) {
            __builtin_amdgcn_fence(__ATOMIC_RELEASE, "agent");
            asm volatile("s_waitcnt vmcnt(0)" ::: "memory");
            const unsigned og = xb_add(&bar[XB_TOP], 1u);
            const unsigned tg = og / nx;
            if (og + 1u == (tg + 1u) * nx) xb_add(&bar[XB_TOPGEN], 1u);
            else XB_SPIN(xb_ld(&bar[XB_TOPGEN]) == tg, bar);
            __builtin_amdgcn_fence(__ATOMIC_ACQUIRE, "agent");
            xb_add(&bar[XB_XGEN(b.x)], 1u);
            asm volatile("s_waitcnt vmcnt(0)" ::: "memory");
        } else {
            XB_SPIN(xb_ld(&bar[XB_XGEN(b.x)]) == gen, bar);
            __builtin_amdgcn_fence(__ATOMIC_ACQUIRE, "agent");
            asm volatile("s_waitcnt vmcnt(0)" ::: "memory");
        }
    }
    __syncthreads();
}
#ifndef ONLY
#define ONLY -1
#endif
#ifndef REPMASK
#define REPMASK 0
#endif
#define EN(x) (ONLY < 0 || ONLY == (x))
__global__ void __launch_bounds__(512, 2) hymba_fwd(Args args) {
    extern __shared__ __attribute__((aligned(16))) unsigned char lds_raw[];
    LAS unsigned char* lds = (LAS unsigned char*)lds_raw;
    cg::grid_group grid = cg::this_grid();
    Ctx c;
    c.x_prompt = args.in[0]; c.x_sample = args.in[1]; c.state_delta = args.in[2]; c.state_conv = args.in[3]; c.norm_mix_g = args.in[4]; c.w_in = args.in[5]; c.conv_w = args.in[6];
    c.A_log = args.in[7]; c.dt_bias = args.in[8]; c.o_norm_g = args.in[9]; c.v_norm_g = args.in[10]; c.w_s = args.in[11]; c.b_s = args.in[12]; c.w_o = args.in[13]; c.norm_ffn_g = args.in[14];
    c.w_up = args.in[15]; c.w_down = args.in[16]; c.norm_f_g = args.in[17]; c.out = args.out; c.ws = args.ws;
    c.lane = threadIdx.x & 63; c.wave = __builtin_amdgcn_readfirstlane(threadIdx.x >> 6); c.gw = blockIdx.x * 8 + c.wave; c.ngw = gridDim.x * 8; c.bx = blockIdx.x; c.nb = gridDim.x;
    volatile LAS unsigned* bst = (volatile LAS unsigned*)(lds + LDS_BYTES - 16);
    if (threadIdx.x < 2) bst[threadIdx.x] = 0u;
    __syncthreads();
    XcdBarrier xbar = xcd_barrier_post((unsigned*)args.ws, bst);
    grid.sync();
    for (int step = 2 * args.ph_lo; step < 2 * args.ph_hi; ++step) {
        const int ph = step >> 1;
        const int ptype = ph == 0 ? 0 : (ph == 29 ? 8 : 1 + (ph - 1) % 7);
        if ((step & 1) && !((REPMASK >> ptype) & 1)) continue;
        { int tl = threadIdx.x; asm volatile("" : "+v"(tl)); c.lane = tl & 63; int bxo = blockIdx.x, nbo = gridDim.x; asm volatile("" : "+s"(bxo), "+s"(nbo)); c.bx = bxo; c.nb = nbo; c.wave = __builtin_amdgcn_readfirstlane(tl >> 6); c.gw = bxo * 8 + c.wave; c.ngw = nbo * 8; unsigned char* wsp = args.ws; asm volatile("" : "+s"(wsp)); c.ws = wsp; float* op = args.out; asm volatile("" : "+s"(op)); c.out = op; }
        if (step & 1) __syncthreads();
        if (ph == 0) { if (EN(0)) phase_prologue(c, lds); }
        else if (ph == 29) { if (EN(8)) phase_final(c); }
        else {
            const int l = (ph - 1) / 7, s = (ph - 1) % 7;
            float* ssq = WSP(float, WS_SSQ);
            if (s == 0) { if (EN(1)) { sgemm1(c, l, lds); if ((REPMASK >> 10) & 1) sgemm1(c, l, lds);
                pg8::Gemm g{WSP(bf16_t, WS_XB16), WSP(bf16_t, WS_WIN) + (size_t)l * NP * DM, MP, NP, DM}; pg8::StaticOrder S; S.init(MP, NP, c.nb, c.bx);
                pg8::EpiScaleBf16 E{WSP(bf16_t, WS_P), NP, ssq + (size_t)(2 * l) * MP * 16, 0, WSP(float, WS_VSS), c.o_norm_g + l * 128}; pg8::gemm_phase(lds, g, S, E); } }
            else if (s == 1) { if (EN(2)) phase_b0(c, l, lds); }
            else if (s == 2) { if (EN(3)) phase_b1(c, l, lds); }
            else if (s == 3) { if (EN(4)) phase_scan(c, l, lds); if ((REPMASK >> 12) & 1) { __syncthreads(); if (c.bx < 32) scan_block(c, l, c.bx, lds); } if ((REPMASK >> 13) & 1) { if (c.bx >= 32) { const int w0 = (c.bx - 32) * 8 + c.wave, nw = (c.nb - 32) * 8; for (int u = w0; u < SBATCH * 4; u += nw) sample_recurrent(c, l, u); } } }
            else if (s == 4) { if (EN(5)) { if (!(step & 1)) sgemm2(c, l, lds);
                pg8::Gemm g{WSP(bf16_t, WS_AMIX), WSP(bf16_t, WS_WO) + (size_t)l * DM * DM, MP, DM, DM}; pg8::StaticOrder S; S.init(MP, DM, c.nb, c.bx);
                pg8::EpiResid E{WSP(bf16_t, WS_XB16), ssq + (size_t)(2 * l + 1) * MP * 16}; pg8::gemm_phase(lds, g, S, E); } }
            else if (s == 5) { if (EN(6)) { sgemm3(c, l, lds); if ((REPMASK >> 11) & 1) sgemm3(c, l, lds);
                pg8::Gemm g{WSP(bf16_t, WS_XB16), WSP(bf16_t, WS_WUP) + (size_t)l * FF * DM, MP, FF, DM}; pg8::StaticOrder S; S.init(MP, FF, c.nb, c.bx);
                pg8::EpiScaleBf16 E{WSP(bf16_t, WS_UNION), FF, ssq + (size_t)(2 * l + 1) * MP * 16, 1, nullptr, nullptr}; pg8::gemm_phase(lds, g, S, E); } }
            else { if (EN(7)) { if (!(step & 1)) sgemm4(c, l, lds);
                pg8::Gemm g{WSP(bf16_t, WS_UNION), WSP(bf16_t, WS_WDN) + (size_t)l * DM * FF, MP, DM, FF}; pg8::StaticOrder S; S.init(MP, DM, c.nb, c.bx);
                pg8::EpiResid E{WSP(bf16_t, WS_XB16), ssq + (size_t)(2 * l + 2) * MP * 16}; pg8::gemm_phase(lds, g, S, E); } }
        }
        if (!(step & 1) && ((REPMASK >> ptype) & 1)) continue;
        if ((REPMASK >> 9) & 1) { if (ph + 1 < args.ph_hi) xcd_barrier(xbar); }
        if (ph + 1 < args.ph_hi) {
            xcd_barrier(xbar);
        }
    }
}

extern "C" void kernel_launch(void* const* d_in, const int* in_sizes, int n_in, void* d_out, int out_size, void* d_ws, size_t ws_size, hipStream_t stream) {
    static int grid = 0;
    if (grid == 0) {
        int dev = 0, cus = 0, per_cu = 0;
        (void)hipGetDevice(&dev); (void)hipDeviceGetAttribute(&cus, hipDeviceAttributeMultiprocessorCount, dev);
        if (hipFuncSetAttribute((const void*)hymba_fwd, hipFuncAttributeMaxDynamicSharedMemorySize, LDS_BYTES) != hipSuccess) fprintf(stderr, "kernel_launch: hipFuncSetAttribute failed\n");
        if (hipOccupancyMaxActiveBlocksPerMultiprocessor(&per_cu, (const void*)hymba_fwd, 512, LDS_BYTES) != hipSuccess || per_cu < 1) { fprintf(stderr, "kernel_launch: occupancy query says %d\n", per_cu); per_cu = 1; }
        (void)hipGetLastError();
        grid = cus * 1;
        if (ws_size < WS_END) fprintf(stderr, "kernel_launch: workspace too small: %zu < %zu\n", ws_size, (size_t)WS_END);
    }
    (void)hipMemsetAsync(d_ws, 0, 65536, stream);
    Args a{};
    for (int i = 0; i < 18; ++i) a.in[i] = (const float*)d_in[i];
    a.out = (float*)d_out; a.ws = (unsigned char*)d_ws; a.ph_lo = 0; a.ph_hi = 30;
    void* kargs[] = {&a};
    hipError_t e = hipLaunchCooperativeKernel((const void*)hymba_fwd, dim3(grid), dim3(512), kargs, LDS_BYTES, stream);
    if (e != hipSuccess) fprintf(stderr, "kernel_launch: cooperative launch failed: %s (grid %d)\n", hipGetErrorString(e), grid);
}
```

```cpp
#include <hip/hip_runtime.h>
#include <hip/hip_cooperative_groups.h>
#include <cstdio>
namespace cg = cooperative_groups;

#define LAS __attribute__((address_space(3)))
#define DI __device__ __forceinline__
typedef unsigned short bf16_t;
typedef short bf16x8 __attribute__((ext_vector_type(8)));
typedef float f32x4 __attribute__((ext_vector_type(4)));
typedef float f32x2 __attribute__((ext_vector_type(2)));
typedef float f32x16 __attribute__((ext_vector_type(16)));
typedef unsigned u32x4 __attribute__((ext_vector_type(4)));
typedef unsigned u32x2 __attribute__((ext_vector_type(2)));
typedef __bf16 bf2_t __attribute__((ext_vector_type(2)));
typedef unsigned u32x8 __attribute__((ext_vector_type(8)));

#ifndef SUBSEL
#define SUBSEL -1
#endif
#define SUB(x) (SUBSEL < 0 || SUBSEL == (x))
#ifndef SUBSEL2
#define SUBSEL2 -1
#endif
#define SUB2(x) (SUBSEL2 < 0 || SUBSEL2 == (x))
constexpr int DM = 1024, NBATCH = 8, SEQ = 2048, MP = NBATCH * SEQ, DEPTH = 4, SBATCH = 128;
constexpr int NH = 4, QKV = 1536, NP = 3072, PROJ = 3080, FF = 4096, NPS = 3088;
constexpr float EPS = 1e-6f;
constexpr int IMG_BYTES = 55296;
constexpr int LDS_BYTES = 150528;
constexpr size_t O_YP = 0, O_YS = 16777216, O_DP = 16908288, O_CP = 19005440, O_DS = 19152896, O_CS = 52707328, O_VS = 55066624;
constexpr size_t WS_WIN = 65536;
constexpr size_t WS_WAB = WS_WIN + (size_t)DEPTH * NP * DM * 2;
constexpr size_t WS_WO = WS_WAB + (size_t)DEPTH * 16 * DM * 2;
constexpr size_t WS_WUP = WS_WO + (size_t)DEPTH * DM * DM * 2;
constexpr size_t WS_WDN = WS_WUP + (size_t)DEPTH * FF * DM * 2;
constexpr size_t WS_WM = WS_WDN + (size_t)DEPTH * FF * DM * 2;
constexpr size_t WS_XBUF = WS_WM + (size_t)DEPTH * 4 * 128 * 128 * 2;
constexpr size_t WS_XB16 = WS_XBUF + (size_t)MP * DM * 4;
constexpr size_t WS_SSQ = WS_XB16 + (size_t)MP * DM * 2;
constexpr size_t WS_UNION = WS_SSQ + (size_t)9 * MP * 16 * 4;
constexpr size_t WS_P = WS_UNION;
constexpr size_t WS_QN = WS_P + (size_t)MP * NP * 2;
constexpr size_t WS_KN = WS_QN + (size_t)MP * 512 * 2;
constexpr size_t WS_KNT = WS_UNION + (size_t)MP * FF * 2;
constexpr size_t WS_VT = WS_KNT + (size_t)MP * 512 * 2;
constexpr size_t WS_VBT = WS_VT + (size_t)MP * 512 * 2;
constexpr size_t WS_G = WS_VBT + (size_t)MP * 512 * 2;
constexpr size_t WS_BETA = WS_G + (size_t)MP * 4 * 4;
constexpr size_t WS_EG = WS_BETA + (size_t)MP * 4 * 4;
constexpr size_t WS_IMG = WS_EG + 4096;
constexpr size_t WS_UIMG = WS_IMG + (size_t)1024 * IMG_BYTES;
constexpr size_t WS_AMIX = WS_UIMG + (size_t)1024 * 32768;
constexpr size_t WS_XS = WS_AMIX + (size_t)MP * DM * 2;
constexpr size_t WS_PS = WS_XS + (size_t)SBATCH * DM * 4;
constexpr size_t WS_QS = WS_PS + (size_t)SBATCH * NPS * 4;
constexpr size_t WS_KS = WS_QS + (size_t)SBATCH * 512 * 4;
constexpr size_t WS_VS = WS_KS + (size_t)SBATCH * 512 * 4;
constexpr size_t WS_GS = WS_VS + (size_t)SBATCH * 512 * 4;
constexpr size_t WS_BS = WS_GS + (size_t)SBATCH * 4 * 4;
constexpr size_t WS_AMIXS = WS_BS + (size_t)SBATCH * 4 * 4;
constexpr size_t WS_HS = WS_AMIXS + (size_t)SBATCH * DM * 4;
constexpr size_t WS_XP = WS_HS + (size_t)SBATCH * FF * 4;
constexpr size_t WS_VSS = WS_XP + (size_t)4 * SBATCH * DM * 4;
constexpr size_t WS_CWP = WS_VSS + (size_t)MP * 8 * 4;
constexpr size_t WS_END = WS_CWP + (size_t)DEPTH * 4 * QKV * 4;
static_assert(WS_QN + 2 * (size_t)MP * 512 * 2 == WS_KNT, "union");
static_assert(WS_END <= (size_t)536870912, "workspace");

DI unsigned pk2(float lo, float hi) { f32x2 v = {lo, hi}; return __builtin_bit_cast(unsigned, __builtin_convertvector(v, bf2_t)); }
DI float bflo(unsigned w) { return __uint_as_float(w << 16); }
DI float bfhi(unsigned w) { return __uint_as_float(w & 0xffff0000u); }
DI float bf2f(bf16_t b) { return __uint_as_float(((unsigned)b) << 16); }
DI bf16_t f2bf(float f) { return (bf16_t)(pk2(f, 0.f) & 0xffffu); }
DI float xlane(float v, int srclane) { return __builtin_bit_cast(float, __builtin_amdgcn_ds_bpermute(srclane << 2, __builtin_bit_cast(int, v))); }
DI float wave_sum(float v, int lane) {
#pragma unroll
    for (int o = 1; o < 64; o <<= 1) v += xlane(v, lane ^ o);
    return v;
}
DI float silu_f(float x) { return x * __builtin_amdgcn_rcpf(1.f + __expf(-x)); }
DI float sigmoid_f(float x) { return __builtin_amdgcn_rcpf(1.f + __expf(-x)); }
DI float softplus_f(float x) { const float e = __expf(-fabsf(x)); const float l = e < 0.01f ? e * (1.f - e * (0.5f - 0.33333334f * e)) : __logf(1.f + e); return fmaxf(x, 0.f) + l; }
DI u32x4 pack8(const f32x16& x, int s) {
    u32x4 p; p.x = pk2(x[8 * s], x[8 * s + 1]); p.y = pk2(x[8 * s + 2], x[8 * s + 3]); p.z = pk2(x[8 * s + 4], x[8 * s + 5]); p.w = pk2(x[8 * s + 6], x[8 * s + 7]); return p;
}
DI float ssq_sum(const float* p) {
    const f32x4 a = *(const f32x4*)p, b = *(const f32x4*)(p + 4), c2 = *(const f32x4*)(p + 8), d2 = *(const f32x4*)(p + 12);
    return ((a.x + a.y) + (a.z + a.w)) + ((b.x + b.y) + (b.z + b.w)) + ((c2.x + c2.y) + (c2.z + c2.w)) + ((d2.x + d2.y) + (d2.z + d2.w));
}
DI int crow(int reg, int h) { return (reg & 3) + 8 * (reg >> 2) + 4 * h; }
#define MFMA32(a, b, c) __builtin_amdgcn_mfma_f32_32x32x16_bf16((a), (b), (c), 0, 0, 0)
#define MFMA16(a, b, c) __builtin_amdgcn_mfma_f32_16x16x32_bf16((a), (b), (c), 0, 0, 0)
DI bf16x8 as_bf(u32x4 v) { return __builtin_bit_cast(bf16x8, v); }
DI f32x16 zero16() { f32x16 z;
#pragma unroll
    for (int i = 0; i < 16; ++i) z[i] = 0.f; return z; }

namespace pg8 {
constexpr int BM = 256, BK = 64, HALF = 128, HTB = HALF * BK * 2, STAGE_BYTES = 8 * HTB, NXCD = 8, WGM = 8;
DI int lds_byte(int r, int c) { const int st = (r >> 4) * 2 + (c >> 5), rr = r & 15, cc = c & 31, ob = rr * 64 + cc * 2; return st * 1024 + (ob ^ (((ob >> 9) & 1) << 5)); }
DI void stage_rc(int b, int& R, int& C) { const int st = b / 1024, sb = b % 1024, swz = sb ^ (((sb >> 9) & 1) << 5); R = (st >> 1) * 16 + swz / 64; C = (st & 1) * 32 + (swz % 64) / 2; }
DI int perm32(int rho) { const int n = rho >> 4, i = rho & 15; return 8 * (i >> 2) + 4 * n + (i & 3); }
struct Unit { int pm, pn; };
struct Gemm { const bf16_t* A; const bf16_t* Bt; int M, N, K; };
struct StaticOrder {
    int nM, nN, nwg, G, c;
    DI void init(int M, int N, int G_, int c_) { nM = M / BM; nN = N / BM; nwg = nM * nN; G = G_; c = c_; }
    DI bool next(int i, Unit& u) const {
        const long L = (long)i * G + c; if (L >= nwg) return false;
        int wgid = (int)L; { const int q = nwg / NXCD, r = nwg % NXCD, xcd = wgid % NXCD, off = wgid / NXCD; wgid = (xcd < r ? xcd * (q + 1) : r * (q + 1) + (xcd - r) * q) + off; }
        const int nig = WGM * nN, gid = wgid / nig, fm = gid * WGM, gsz = (nM - fm) < WGM ? (nM - fm) : WGM;
        u.pm = fm + ((wgid % nig) % gsz); u.pn = (wgid % nig) / gsz; return true;
    }
};
template <class Epi>
DI void gemm_phase(LAS unsigned char* lds, const Gemm g, const StaticOrder& S, const Epi& E) {
    int tid = threadIdx.x; asm volatile("" : "+v"(tid));
    const int wid = __builtin_amdgcn_readfirstlane(tid >> 6), lane = tid & 63, wr = wid >> 2, wc = wid & 3, fr = lane & 15, fq = lane >> 4;
    const int K = g.K, nt = K / BK;
    unsigned voffA[2], voffB[2];
#pragma unroll
    for (int i = 0; i < 2; ++i) { int R, C; stage_rc(tid * 16 + i * 8192, R, C); const int Rb = (R & ~31) + perm32(R & 31);
        voffA[i] = (unsigned)(R * K + C) * 2u; voffB[i] = (unsigned)(Rb * K + C) * 2u; }
    const size_t kstep = (size_t)(BK * 2);
    const size_t hstep = (size_t)HALF * K * 2;
    const size_t tstep = 2 * hstep;
    const unsigned ldsw = (unsigned)wid * 1024u;
    const int aoff = lds_byte(wr * 64 + fr, fq * 8), boff = lds_byte(wc * 32 + fr, fq * 8);
#define PG8_SA(b, h) (((b) * 2 + (h)) * HTB)
#define PG8_SB(b, h) ((4 + (b) * 2 + (h)) * HTB)
#define PG8_STAGE(bufoff, gbase, voff) do { _Pragma("unroll") for (int _i = 0; _i < 2; ++_i) \
        __builtin_amdgcn_global_load_lds((const unsigned*)((const char*)(gbase) + (voff)[_i]), (LAS unsigned*)(lds + (bufoff) + ldsw + _i * 8192), 16, 0, 0); } while (0)
#define PG8_LDA(dst, b, h) do { _Pragma("unroll") for (int m = 0; m < 4; ++m) _Pragma("unroll") for (int k = 0; k < 2; ++k) dst[m][k] = *(const LAS bf16x8*)(lds + PG8_SA(b, h) + aoff + m * 2048 + k * 1024); } while (0)
#define PG8_LDB(dst, b, h) do { _Pragma("unroll") for (int n = 0; n < 2; ++n) _Pragma("unroll") for (int k = 0; k < 2; ++k) dst[n][k] = *(const LAS bf16x8*)(lds + PG8_SB(b, h) + boff + n * 2048 + k * 1024); } while (0)
#define PG8_MMA(ai, bj, At, Bt) do { __builtin_amdgcn_s_setprio(1); _Pragma("unroll") for (int m = 0; m < 4; ++m) _Pragma("unroll") for (int n = 0; n < 2; ++n) _Pragma("unroll") for (int k = 0; k < 2; ++k) \
        acc[ai][bj][m][n] = __builtin_amdgcn_mfma_f32_16x16x32_bf16(Bt[n][k], At[m][k], acc[ai][bj][m][n], 0, 0, 0); __builtin_amdgcn_s_setprio(0); } while (0)
#define PG8_WAIT_V(n) asm volatile("s_waitcnt vmcnt(" #n ")" ::: "memory")
#define PG8_WAIT_L(n) asm volatile("s_waitcnt lgkmcnt(" #n ")" ::: "memory")
#define PG8_BAR __builtin_amdgcn_s_barrier()
#define PG8_SCHED __builtin_amdgcn_sched_barrier(0)
    Unit cur, nxt; int ui = 0;
    if (!S.next(0, cur)) return;
    f32x4 acc[2][2][4][2];
#pragma unroll
    for (int a = 0; a < 2; ++a)
#pragma unroll
        for (int b = 0; b < 2; ++b)
#pragma unroll
            for (int m = 0; m < 4; ++m)
#pragma unroll
                for (int n = 0; n < 2; ++n) acc[a][b][m][n] = (f32x4){0.f, 0.f, 0.f, 0.f};
    bf16x8 At[4][2], B0[2][2], B1[2][2];
    const char* cA = (const char*)g.A + (size_t)cur.pm * tstep; const char* cB = (const char*)g.Bt + (size_t)cur.pn * tstep;
    PG8_STAGE(PG8_SB(0, 0), cB, voffB); PG8_STAGE(PG8_SA(0, 0), cA, voffA); PG8_STAGE(PG8_SB(0, 1), cB + hstep, voffB); PG8_STAGE(PG8_SA(0, 1), cA + hstep, voffA);
    if (wr == 1) PG8_BAR;
    PG8_WAIT_V(4); PG8_BAR;
    PG8_STAGE(PG8_SB(1, 0), cB + kstep, voffB); PG8_STAGE(PG8_SA(1, 0), cA + kstep, voffA); PG8_STAGE(PG8_SB(1, 1), cB + hstep + kstep, voffB);
    PG8_WAIT_V(6); PG8_BAR;
    for (;;) {
        const bool has_next = S.next(ui + 1, nxt);
        const char* nA = has_next ? (const char*)g.A + (size_t)nxt.pm * tstep : cA; const char* nB = has_next ? (const char*)g.Bt + (size_t)nxt.pn * tstep : cB;
        for (int t = 0; t < nt; t += 2) {
            const bool last = (t == nt - 2);
            const char* a1 = cA + (size_t)(t + 1) * kstep;
            const char* a2 = last ? nA : cA + (size_t)(t + 2) * kstep; const char* b2 = last ? nB : cB + (size_t)(t + 2) * kstep;
            const char* a3 = a2 + kstep; const char* b3 = b2 + kstep;
            PG8_LDB(B0, 0, 0); PG8_SCHED; PG8_LDA(At, 0, 0); PG8_STAGE(PG8_SA(1, 1), a1 + hstep, voffA);
            PG8_WAIT_L(8); PG8_BAR; PG8_WAIT_L(0); PG8_MMA(0, 0, At, B0); PG8_BAR; PG8_SCHED;
            PG8_LDB(B1, 0, 1); PG8_STAGE(PG8_SB(0, 0), b2, voffB);
            PG8_BAR; PG8_WAIT_L(0); PG8_MMA(0, 1, At, B1); PG8_BAR;
            PG8_LDA(At, 0, 1); PG8_STAGE(PG8_SA(0, 0), a2, voffA);
            PG8_BAR; PG8_WAIT_L(0); PG8_MMA(1, 0, At, B0); PG8_BAR; PG8_SCHED;
            PG8_STAGE(PG8_SB(0, 1), b2 + hstep, voffB);
            PG8_WAIT_V(6); PG8_BAR; PG8_MMA(1, 1, At, B1); PG8_BAR;
            PG8_LDB(B0, 1, 0); PG8_SCHED; PG8_LDA(At, 1, 0); PG8_STAGE(PG8_SA(0, 1), a2 + hstep, voffA);
            PG8_WAIT_L(8); PG8_BAR; PG8_WAIT_L(0); PG8_MMA(0, 0, At, B0); PG8_BAR; PG8_SCHED;
            PG8_LDB(B1, 1, 1); PG8_STAGE(PG8_SB(1, 0), b3, voffB);
            PG8_BAR; PG8_WAIT_L(0); PG8_MMA(0, 1, At, B1); PG8_BAR;
            PG8_LDA(At, 1, 1); PG8_STAGE(PG8_SA(1, 0), a3, voffA);
            PG8_BAR; PG8_WAIT_L(0); PG8_MMA(1, 0, At, B0); PG8_BAR; PG8_SCHED;
            PG8_STAGE(PG8_SB(1, 1), b3 + hstep, voffB);
            PG8_WAIT_V(6); PG8_BAR; PG8_MMA(1, 1, At, B1); PG8_BAR;
        }
        E(acc, cur, wr, wc, fr, fq);
        if (!has_next) break;
#pragma unroll
        for (int a = 0; a < 2; ++a)
#pragma unroll
            for (int b = 0; b < 2; ++b)
#pragma unroll
                for (int m = 0; m < 4; ++m)
#pragma unroll
                    for (int n = 0; n < 2; ++n) acc[a][b][m][n] = (f32x4){0.f, 0.f, 0.f, 0.f};
        cur = nxt; cA = nA; cB = nB; ++ui;
    }
    PG8_WAIT_V(0);
    if (wr == 0) PG8_BAR;
    PG8_BAR;
#undef PG8_SA
#undef PG8_SB
#undef PG8_STAGE
#undef PG8_LDA
#undef PG8_LDB
#undef PG8_MMA
#undef PG8_WAIT_V
#undef PG8_WAIT_L
#undef PG8_BAR
#undef PG8_SCHED
}
struct EpiScaleBf16 {
    bf16_t* O; int ldc; const float* ssq; int act; float* vss; const float* og;
    DI void operator()(const f32x4 (&acc)[2][2][4][2], const Unit& u, int wr, int wc, int fr, int fq) const {
        const int row0 = u.pm * BM + wr * 64 + fr, col0 = u.pn * BM + wc * 32 + 8 * fq;
#pragma unroll
        for (int ai = 0; ai < 2; ++ai)
#pragma unroll
            for (int m = 0; m < 4; ++m) { const int row = row0 + ai * HALF + m * 16;
                float rq; { const f32x4 p4 = *(const f32x4*)(ssq + (size_t)row * 16 + 4 * fq); rq = (p4.x + p4.y) + (p4.z + p4.w); const int ln = fq * 16 + fr; rq += xlane(rq, ln ^ 16); rq += xlane(rq, ln ^ 32); }
                const float rs = rsqrtf(rq * (1.0f / DM) + EPS);
                bf16_t* rowp = O + (size_t)row * ldc + col0; float vs = 0.f;
#pragma unroll
                for (int bj = 0; bj < 2; ++bj) { f32x4 v0 = acc[ai][bj][m][0] * rs, v1 = acc[ai][bj][m][1] * rs;
                    if (act) {
#pragma unroll
                        for (int j = 0; j < 4; ++j) { const float a = fmaxf(v0[j], 0.f), b = fmaxf(v1[j], 0.f); v0[j] = a * a; v1[j] = b * b; } }
                    if (og != nullptr && (u.pn == 6 || u.pn == 7)) { const float* gp = og + ((col0 + bj * HALF) & 127); const f32x4 g0 = *(const f32x4*)gp, g1 = *(const f32x4*)(gp + 4);
#pragma unroll
                        for (int j = 0; j < 4; ++j) { v0[j] = silu_f(v0[j]) * g0[j]; v1[j] = silu_f(v1[j]) * g1[j]; } }
                    u32x4 w; w.x = pk2(v0[0], v0[1]); w.y = pk2(v0[2], v0[3]); w.z = pk2(v1[0], v1[1]); w.w = pk2(v1[2], v1[3]);
                    *(u32x4*)(rowp + bj * HALF) = w;
                    vs += (v0[0] * v0[0] + v0[1] * v0[1]) + (v0[2] * v0[2] + v0[3] * v0[3]) + (v1[0] * v1[0] + v1[1] * v1[1]) + (v1[2] * v1[2] + v1[3] * v1[3]); }
                if (vss != nullptr && u.pn >= 10) { { const int ln = fq * 16 + fr; vs += xlane(vs, ln ^ 16); vs += xlane(vs, ln ^ 32); } if (fq == 0) vss[(size_t)row * 8 + (u.pn - 10) * 4 + wc] = vs; } }
    }
};
struct EpiResid {
    bf16_t* xb; float* ssq;
    DI void operator()(const f32x4 (&acc)[2][2][4][2], const Unit& u, int wr, int wc, int fr, int fq) const {
        const int row0 = u.pm * BM + wr * 64 + fr, col0 = u.pn * BM + wc * 32 + 8 * fq;
#pragma unroll
        for (int ai = 0; ai < 2; ++ai)
#pragma unroll
            for (int m = 0; m < 4; ++m) { const int row = row0 + ai * HALF + m * 16; const size_t off = (size_t)row * DM + col0; float ss = 0.f;
#pragma unroll
                for (int bj = 0; bj < 2; ++bj) {
                    const u32x4 b = *(const u32x4*)(xb + off + bj * HALF);
                    const f32x4 o0 = (f32x4){bflo(b.x), bfhi(b.x), bflo(b.y), bfhi(b.y)} + acc[ai][bj][m][0], o1 = (f32x4){bflo(b.z), bfhi(b.z), bflo(b.w), bfhi(b.w)} + acc[ai][bj][m][1];
                    u32x4 w; w.x = pk2(o0[0], o0[1]); w.y = pk2(o0[2], o0[3]); w.z = pk2(o1[0], o1[1]); w.w = pk2(o1[2], o1[3]);
                    *(u32x4*)(xb + off + bj * HALF) = w;
                    ss += (o0[0] * o0[0] + o0[1] * o0[1]) + (o0[2] * o0[2] + o0[3] * o0[3]) + (o1[0] * o1[0] + o1[1] * o1[1]) + (o1[2] * o1[2] + o1[3] * o1[3]); }
                { const int ln = fq * 16 + fr; ss += xlane(ss, ln ^ 16); ss += xlane(ss, ln ^ 32); }
                if (fq == 0) ssq[(size_t)row * 16 + u.pn * 4 + wc] = ss;
                asm volatile("" ::: "memory"); }
    }
};
}

struct Args { const float* in[18]; float* out; unsigned char* ws; int ph_lo, ph_hi; };
struct Ctx {
    const float *x_prompt, *x_sample, *state_delta, *state_conv, *norm_mix_g, *w_in, *conv_w, *A_log, *dt_bias, *o_norm_g, *v_norm_g, *w_s, *b_s, *w_o, *norm_ffn_g, *w_up, *w_down, *norm_f_g;
    float* out; unsigned char* ws;
    int lane, wave, gw, ngw, bx, nb;
};
#define WSP(T, off) ((T*)(c.ws + (off)))

DI void transpose_item(const float* W, int K, int N, const float* kscale, bf16_t* WT, bf16_t* WAB, int mode, int item, int nblk, LAS float* scr, int lane) {
    const int kb = item / nblk, nb = item % nblk, k0 = 64 * kb, n0 = 64 * nb;
    const int c4 = lane & 15, rsub = lane >> 4;
    const bool cval = n0 + 4 * c4 + 3 < N;
#pragma unroll 4
    for (int kk = 0; kk < 64; kk += 4) { const int row = kk + rsub;
        f32x4 v = (f32x4){0.f, 0.f, 0.f, 0.f}; if (cval) { v = *(const f32x4*)(W + (size_t)(k0 + row) * N + n0 + 4 * c4); if (kscale) v = v * kscale[k0 + row]; }
        LAS float* p = scr + row * 65 + 4 * c4; p[0] = v.x; p[1] = v.y; p[2] = v.z; p[3] = v.w; }
    asm volatile("s_waitcnt lgkmcnt(0)" ::: "memory");
    const int kc = lane & 7;
#pragma unroll
    for (int it = 0; it < 8; ++it) { const int n = 8 * it + (lane >> 3), ns = n0 + n; const LAS float* s = scr + (8 * kc) * 65 + n;
        u32x4 o; o.x = pk2(s[0 * 65], s[1 * 65]); o.y = pk2(s[2 * 65], s[3 * 65]); o.z = pk2(s[4 * 65], s[5 * 65]); o.w = pk2(s[6 * 65], s[7 * 65]);
        if (ns < N) {
            bf16_t* rowp;
            if (mode == 0) rowp = WT + (size_t)ns * K;
            else rowp = ns < 2048 ? WT + (size_t)ns * K : (ns < 2056 ? WAB + (size_t)(ns - 2048) * K : WT + (size_t)(ns - 8) * K);
            *(u32x4*)(rowp + k0 + 8 * kc) = o; } }
    asm volatile("s_waitcnt lgkmcnt(0)" ::: "memory");
}
DI void convert_layer_weights(const Ctx& c, int l, int w0, int nw, LAS unsigned char* lds) {
    LAS float* scr = (LAS float*)(lds + c.wave * 18432);
    constexpr int I_IN = 16 * 49, I_O = 16 * 16, I_UP = 16 * 64, I_DN = 64 * 16, I_L = I_IN + I_O + I_UP + I_DN;
    for (int it = w0; it < I_L; it += nw) {
        int r = it;
        if (r < I_IN) { transpose_item(c.w_in + (size_t)l * DM * PROJ, DM, PROJ, c.norm_mix_g + l * DM, WSP(bf16_t, WS_WIN) + (size_t)l * NP * DM, WSP(bf16_t, WS_WAB) + (size_t)l * 16 * DM, 1, r, 49, scr, c.lane); continue; } r -= I_IN;
        if (r < I_O) { transpose_item(c.w_o + (size_t)l * DM * DM, DM, DM, nullptr, WSP(bf16_t, WS_WO) + (size_t)l * DM * DM, nullptr, 0, r, 16, scr, c.lane); continue; } r -= I_O;
        if (r < I_UP) { transpose_item(c.w_up + (size_t)l * DM * FF, DM, FF, c.norm_ffn_g + l * DM, WSP(bf16_t, WS_WUP) + (size_t)l * FF * DM, nullptr, 0, r, 64, scr, c.lane); continue; } r -= I_UP;
        transpose_item(c.w_down + (size_t)l * FF * DM, FF, DM, nullptr, WSP(bf16_t, WS_WDN) + (size_t)l * DM * FF, nullptr, 0, r, 16, scr, c.lane);
    }
}
DI void phase_prologue(const Ctx& c, LAS unsigned char* lds) {
    convert_layer_weights(c, 0, c.gw, c.ngw, lds);
    float* ssq = WSP(float, WS_SSQ);
    for (int m = c.gw; m < MP; m += c.ngw) {
        const f32x4* xr = (const f32x4*)(c.x_prompt + (size_t)m * DM) + c.lane; u32x2* o8 = (u32x2*)(WSP(bf16_t, WS_XB16) + (size_t)m * DM) + c.lane; float s = 0.f;
#pragma unroll
        for (int j = 0; j < 4; ++j) { const f32x4 v = xr[64 * j]; s += (v.x * v.x + v.y * v.y) + (v.z * v.z + v.w * v.w); u32x2 w; w.x = pk2(v.x, v.y); w.y = pk2(v.z, v.w); o8[64 * j] = w; }
        s = wave_sum(s, c.lane); if (c.lane < 16) ssq[(size_t)m * 16 + c.lane] = c.lane == 0 ? s : 0.f;
    }
    const int gt = c.gw * 64 + c.lane, ngt = c.ngw * 64;
    float* xs = WSP(float, WS_XS);
    for (int i = gt; i < SBATCH * DM; i += ngt) xs[i] = c.x_sample[i];
    bf16_t* wab = WSP(bf16_t, WS_WAB);
    for (int i = gt; i < DEPTH * 8 * DM; i += ngt) { const int l = i / (8 * DM), r = i % (8 * DM); wab[(size_t)l * 16 * DM + 8 * DM + r] = 0; }
    unsigned* wm = WSP(unsigned, WS_WM);
    for (int i = gt; i < DEPTH * 4 * 128 * 64; i += ngt) { const int e = 2 * i, ii = (e >> 7) & 127, jj = e & 127;
        const float a = ii >= jj ? c.w_s[e] : 0.f, b = ii >= jj + 1 ? c.w_s[e + 1] : 0.f; wm[i] = pk2(a, b); }
}

template <int NT, bool NORM, int EPI>
DI void sgemm_block(const Ctx& c, const float* A, int lda, int K, const bf16_t* Bt, int ncg, float* out, int ldo, LAS unsigned char* lds, const bf16_t* Bab) {
    int lane = c.lane; asm volatile("" : "+v"(lane));
    const int wave = c.wave, fr = lane & 15, fq = lane >> 4;
    LAS f32x4* red = (LAS f32x4*)lds;
    LAS float* ssr = (LAS float*)(lds + 8 * NT * 64 * 16);
    const int kw = K / 8, k0 = wave * kw;
    for (int u = c.bx; u < 8 * ncg; u += c.nb) {
        const int rt = u & 7, cg = u >> 3;
        const bool abg = (Bab != nullptr) && (cg == ncg - 1);
        const bf16_t* bp = (abg ? Bab : Bt + (size_t)cg * NT * 16 * K) + (size_t)fr * K + k0 + 8 * fq;
        const float* ap = A + (size_t)(rt * 16 + fr) * lda + k0 + 8 * fq;
        f32x4 acc[NT]; float ss = 0.f;
#pragma unroll
        for (int nt = 0; nt < NT; ++nt) acc[nt] = (f32x4){0.f, 0.f, 0.f, 0.f};
#pragma unroll 4
        for (int k = 0; k < kw; k += 32) {
            const f32x4 a0 = *(const f32x4*)(ap + k), a1 = *(const f32x4*)(ap + k + 4);
            if (NORM) ss += (a0.x * a0.x + a0.y * a0.y) + (a0.z * a0.z + a0.w * a0.w) + (a1.x * a1.x + a1.y * a1.y) + (a1.z * a1.z + a1.w * a1.w);
            u32x4 a; a.x = pk2(a0.x, a0.y); a.y = pk2(a0.z, a0.w); a.z = pk2(a1.x, a1.y); a.w = pk2(a1.z, a1.w);
#pragma unroll
            for (int nt = 0; nt < NT; ++nt) if (nt == 0 || !abg) { const bf16x8 bf = *(const bf16x8*)(bp + (size_t)nt * 16 * K + k); acc[nt] = MFMA16(as_bf(a), bf, acc[nt]); }
        }
        if (NORM) { ss += xlane(ss, lane ^ 16); ss += xlane(ss, lane ^ 32); if (fq == 0) ssr[wave * 16 + fr] = ss; }
#pragma unroll
        for (int nt = 0; nt < NT; ++nt) red[(wave * NT + nt) * 64 + lane] = acc[nt];
        __syncthreads();
        if (wave < NT && (wave == 0 || !abg)) {
            f32x4 t = red[wave * 64 + lane];
#pragma unroll
            for (int w = 1; w < 8; ++w) t += red[(w * NT + wave) * 64 + lane];
            const int col = (cg * NT + wave) * 16 + fr;
#pragma unroll
            for (int j = 0; j < 4; ++j) { const int rl = 4 * fq + j; float rs = 1.f;
                if (NORM) { float sq = 0.f;
#pragma unroll
                    for (int w = 0; w < 8; ++w) sq += ssr[w * 16 + rl];
                    rs = rsqrtf(sq * (1.0f / DM) + EPS); }
                float* o = out + (size_t)(rt * 16 + rl) * ldo + col;
                if (EPI == 0) *o = t[j] * rs; else if (EPI == 1) *o += t[j]; else { const float v = fmaxf(t[j] * rs, 0.f); *o = v * v; } }
        }
        __syncthreads();
    }
}
DI void sgemm1(const Ctx& c, int l, LAS unsigned char* lds) {
    sgemm_block<4, true, 0>(c, WSP(float, WS_XS), DM, DM, WSP(bf16_t, WS_WIN) + (size_t)l * NP * DM, 49, WSP(float, WS_PS), NPS, lds, WSP(bf16_t, WS_WAB) + (size_t)l * 16 * DM);
}
DI void sgemm2(const Ctx& c, int l, LAS unsigned char* lds) {
    sgemm_block<2, false, 1>(c, WSP(float, WS_AMIXS), DM, DM, WSP(bf16_t, WS_WO) + (size_t)l * DM * DM, 32, WSP(float, WS_XS), DM, lds, nullptr);
}
DI void sgemm3(const Ctx& c, int l, LAS unsigned char* lds) {
    sgemm_block<4, true, 2>(c, WSP(float, WS_XS), DM, DM, WSP(bf16_t, WS_WUP) + (size_t)l * FF * DM, 64, WSP(float, WS_HS), FF, lds, nullptr);
}
DI void sgemm4(const Ctx& c, int l, LAS unsigned char* lds) {
    sgemm_block<2, false, 1>(c, WSP(float, WS_HS), FF, FF, WSP(bf16_t, WS_WDN) + (size_t)l * DM * FF, 32, WSP(float, WS_XS), DM, lds, nullptr);
}

DI void b0_block_ab(const Ctx& c, int l, int chunk, LAS unsigned char* lds) {
    int lane = c.lane; asm volatile("" : "+v"(lane));
    const int wave = c.wave, fr = lane & 15, fq = lane >> 4, tok0 = chunk * 64, k0 = wave * 128;
    const bf16_t* ap = WSP(bf16_t, WS_XB16) + (size_t)(tok0 + fr) * DM + k0 + 8 * fq;
    const bf16_t* bp = WSP(bf16_t, WS_WAB) + (size_t)l * 16 * DM + (size_t)fr * DM + k0 + 8 * fq;
    f32x4 acc[4];
#pragma unroll
    for (int mt = 0; mt < 4; ++mt) acc[mt] = (f32x4){0.f, 0.f, 0.f, 0.f};
#pragma unroll
    for (int k = 0; k < 128; k += 32) {
        const bf16x8 bf = *(const bf16x8*)(bp + k);
#pragma unroll
        for (int mt = 0; mt < 4; ++mt) { const bf16x8 a = *(const bf16x8*)(ap + (size_t)mt * 16 * DM + k); acc[mt] = MFMA16(a, bf, acc[mt]); }
    }
    LAS f32x4* red = (LAS f32x4*)lds;
#pragma unroll
    for (int mt = 0; mt < 4; ++mt) red[(wave * 4 + mt) * 64 + lane] = acc[mt];
    __syncthreads();
    if (wave < 4 && fr < 8) { const int mt = wave;
        f32x4 t = red[mt * 64 + lane];
#pragma unroll
        for (int w = 1; w < 8; ++w) t += red[(w * 4 + mt) * 64 + lane];
        const float* ssq = WSP(float, WS_SSQ) + (size_t)(2 * l) * MP * 16;
        float* gb = WSP(float, WS_G); float* bb = WSP(float, WS_BETA);
        const int hh = fr & 3; const float al = -__expf(c.A_log[l * 4 + hh]), dtb = c.dt_bias[l * 4 + hh];
#pragma unroll
        for (int j = 0; j < 4; ++j) { const int tok = tok0 + 16 * mt + 4 * fq + j; const float v = t[j] * rsqrtf(ssq_sum(ssq + (size_t)tok * 16) * (1.0f / DM) + EPS);
            if (fr < 4) gb[tok * 4 + hh] = al * softplus_f(v + dtb); else bb[tok * 4 + hh] = sigmoid_f(v); } }
    __syncthreads();
}
DI float dot2bf(unsigned a, unsigned b, float c) { float r; asm("v_dot2c_f32_bf16 %0, %1, %2" : "=v"(r) : "s"(b), "v"(a), "0"(c)); return r; }
constexpr int B0_STRIDE = 272, B0_WAVE_LDS = 18432;
DI void b0_task_conv(const Ctx& c, int l, int b, int n, int s, int hh, LAS unsigned char* wl) {
    int lane = c.lane; asm volatile("" : "+v"(lane));
    const int tok0 = b * SEQ + n * 64, cb = s * 512 + hh * 128, piece = lane & 15;
    const bf16_t* P = WSP(bf16_t, WS_P) + (size_t)tok0 * NP + cb + piece * 8;
#pragma unroll
    for (int k = 0; k < 17; ++k) { const int row = 4 * k + (lane >> 4);
        if (row < 67) { u32x4 v = (u32x4){0u, 0u, 0u, 0u}; if (n > 0 || row >= 3) v = *(const u32x4*)(P + (long)(row - 3) * NP);
            *(LAS u32x4*)(wl + row * B0_STRIDE + piece * 16) = v; } }
    const unsigned* cwl = (const unsigned*)(c.conv_w + (size_t)l * 4 * QKV + cb);
    if (n == 31) {
        float* ocp = c.out + O_CP + ((size_t)(l * NBATCH + b) * 3) * QKV + cb;
#pragma unroll
        for (int t = 0; t < 6; ++t) { const int idx = lane + 64 * t, row = idx >> 7, ch = idx & 127; ocp[(size_t)row * QKV + ch] = bf2f(*(const LAS bf16_t*)(wl + (64 + row) * B0_STRIDE + ch * 2)); } }
    float ss = 0.f;
#pragma unroll 1
    for (int i = 0; i < 16; ++i) {
        u32x4 rws[4];
#pragma unroll
        for (int j = 0; j < 4; ++j) rws[j] = *(const LAS u32x4*)(wl + (lane + j) * B0_STRIDE + i * 16);
        u32x8 w0, w1, w2, w3; const unsigned* wp = cwl + 8 * i;
        asm volatile("s_load_dwordx8 %0, %4, 0x0\n\ts_load_dwordx8 %1, %4, 0x1800\n\ts_load_dwordx8 %2, %4, 0x3000\n\ts_load_dwordx8 %3, %4, 0x4800\n\ts_waitcnt lgkmcnt(0)"
                     : "=&s"(w0), "=&s"(w1), "=&s"(w2), "=&s"(w3) : "s"(wp) : "memory");
        float y[8];
#pragma unroll
        for (int e = 0; e < 8; ++e) { float a = 0.f;
            a = dot2bf(rws[0][e >> 1], (e & 1) ? ((w0[e] + 0x8000u) & 0xffff0000u) : ((w0[e] + 0x8000u) >> 16), a);
            a = dot2bf(rws[1][e >> 1], (e & 1) ? ((w1[e] + 0x8000u) & 0xffff0000u) : ((w1[e] + 0x8000u) >> 16), a);
            a = dot2bf(rws[2][e >> 1], (e & 1) ? ((w2[e] + 0x8000u) & 0xffff0000u) : ((w2[e] + 0x8000u) >> 16), a);
            a = dot2bf(rws[3][e >> 1], (e & 1) ? ((w3[e] + 0x8000u) & 0xffff0000u) : ((w3[e] + 0x8000u) >> 16), a);
            y[e] = silu_f(a); ss += y[e] * y[e]; }
        u32x4 w; w.x = pk2(y[0], y[1]); w.y = pk2(y[2], y[3]); w.z = pk2(y[4], y[5]); w.w = pk2(y[6], y[7]);
        *(LAS u32x4*)(wl + (lane + 3) * B0_STRIDE + i * 16) = w;
    }
    const float sc = s == 0 ? rsqrtf(ss + EPS) * 0.08838834764831845f : (s == 1 ? rsqrtf(ss + EPS) : 1.0f);
    const size_t unit = (size_t)((b * 4 + hh) * 32 + n);
    bf16_t* ot = (s == 1 ? WSP(bf16_t, WS_KNT) : WSP(bf16_t, WS_VT)) + unit * 128 * 64 + lane;
#pragma unroll 2
    for (int i = 0; i < 16; ++i) { const u32x4 v = *(const LAS u32x4*)(wl + (lane + 3) * B0_STRIDE + i * 16); u32x4 w;
#pragma unroll
        for (int e = 0; e < 4; ++e) w[e] = pk2(bflo(v[e]) * sc, bfhi(v[e]) * sc);
        if (s < 2) *(LAS u32x4*)(wl + (lane + 3) * B0_STRIDE + i * 16) = w;
        if (s >= 1) {
#pragma unroll
            for (int e = 0; e < 8; ++e) ot[(8 * i + e) * 64] = (bf16_t)((e & 1) ? (w[e >> 1] >> 16) : (w[e >> 1] & 0xffffu)); } }
    if (s < 2) { bf16_t* o = (s == 0 ? WSP(bf16_t, WS_QN) : WSP(bf16_t, WS_KN)) + (size_t)tok0 * 512 + hh * 128 + piece * 8;
#pragma unroll
        for (int k = 0; k < 16; ++k) { const int row = 4 * k + (lane >> 4); *(u32x4*)(o + (size_t)row * 512) = *(const LAS u32x4*)(wl + (row + 3) * B0_STRIDE + piece * 16); } }
}
DI void b0_task_vb(const Ctx& c, int l, int b, int n, int hb, LAS unsigned char* wl) {
    int lane = c.lane; asm volatile("" : "+v"(lane));
    const int tok0 = b * SEQ + n * 64, piece = lane & 15;
    const bf16_t* P = WSP(bf16_t, WS_P) + (size_t)tok0 * NP + 2560 + hb * 128 + piece * 8;
#pragma unroll
    for (int k = 0; k < 16; ++k) { const int row = 4 * k + (lane >> 4); *(LAS u32x4*)(wl + row * B0_STRIDE + piece * 16) = *(const u32x4*)(P + (size_t)row * NP); }
    const float* vp = WSP(float, WS_VSS) + (size_t)(tok0 + lane) * 8; const f32x4 p0 = *(const f32x4*)vp, p1 = *(const f32x4*)(vp + 4);
    const float rs = rsqrtf((((p0.x + p0.y) + (p0.z + p0.w)) + ((p1.x + p1.y) + (p1.z + p1.w))) * (1.0f / 512.0f) + EPS);
    const float* vg = c.v_norm_g + l * 512 + hb * 128;
    bf16_t* vbt = WSP(bf16_t, WS_VBT) + ((size_t)((b * 16 + (n >> 1)) * 4 + hb) * 128) * 128 + (n & 1) * 64 + lane;
#pragma unroll 2
    for (int i = 0; i < 16; ++i) { const u32x4 v = *(const LAS u32x4*)(wl + lane * B0_STRIDE + i * 16);
#pragma unroll
        for (int e = 0; e < 8; ++e) { const float pv = (e & 1) ? bfhi(v[e >> 1]) : bflo(v[e >> 1]); vbt[(size_t)(8 * i + e) * 128] = f2bf(pv * rs * vg[8 * i + e]); } }
}
DI void b0_task_sample(const Ctx& c, int l, int bs) {
    const float* ps = WSP(float, WS_PS) + (size_t)bs * NPS;
    if (c.lane < 4) { const int hh = c.lane;
        WSP(float, WS_GS)[bs * 4 + hh] = -__expf(c.A_log[l * 4 + hh]) * softplus_f(ps[3072 + hh] + c.dt_bias[l * 4 + hh]);
        WSP(float, WS_BS)[bs * 4 + hh] = sigmoid_f(ps[3076 + hh]); }
    const float* sc = c.state_conv + (size_t)(l * SBATCH + bs) * 3 * QKV;
    const float* cw = c.conv_w + (size_t)l * 4 * QKV;
    float* ocs = c.out + O_CS + (size_t)(l * SBATCH + bs) * 3 * QKV;
    float* qkvs = WSP(float, WS_QS) + bs * 512;
#pragma unroll 1
    for (int sh = 0; sh < 12; ++sh) {
        float y[2];
#pragma unroll
        for (int t = 0; t < 2; ++t) { const int ch = sh * 128 + t * 64 + c.lane; const float s0 = sc[ch], s1 = sc[QKV + ch], s2 = sc[2 * QKV + ch], cur = ps[ch];
            ocs[ch] = s1; ocs[QKV + ch] = s2; ocs[2 * QKV + ch] = cur;
            y[t] = silu_f(s0 * cw[ch] + s1 * cw[QKV + ch] + s2 * cw[2 * QKV + ch] + cur * cw[3 * QKV + ch]); }
        float scale = 1.0f;
        if (sh < 8) { const float ssum = wave_sum(y[0] * y[0] + y[1] * y[1], c.lane); scale = rsqrtf(ssum + EPS) * (sh < 4 ? 0.08838834764831845f : 1.0f); }
        float* o = qkvs + (size_t)(sh >> 2) * SBATCH * 512 + (sh & 3) * 128;
        o[c.lane] = y[0] * scale; o[64 + c.lane] = y[1] * scale;
    }
    float pv[8]; float ss = 0.f;
#pragma unroll
    for (int i = 0; i < 8; ++i) { pv[i] = ps[2560 + c.lane + 64 * i]; ss += pv[i] * pv[i]; }
    ss = wave_sum(ss, c.lane); const float rs = rsqrtf(ss * (1.0f / 512.0f) + EPS);
    float* am = WSP(float, WS_AMIXS) + (size_t)bs * DM; float* ovs = c.out + O_VS + (size_t)(l * SBATCH + bs) * 512;
#pragma unroll
    for (int i = 0; i < 8; ++i) { const int ch = c.lane + 64 * i, hb = ch >> 7; const float vb = pv[i] * rs * c.v_norm_g[l * 512 + ch];
        ovs[ch] = vb; am[512 + ch] = ps[2048 + ch] * (c.w_s[(size_t)(l * 4 + hb) * 128 * 128] * vb + c.b_s[(l * 4 + hb) * 128]); }
}
DI void phase_b0(const Ctx& c, int l, LAS unsigned char* lds) {
    for (int ch = c.bx; ch < 256; ch += c.nb) b0_block_ab(c, l, ch, lds);
    constexpr int NPT = 256 * 12;
    LAS unsigned char* wl = lds + c.wave * B0_WAVE_LDS;
    for (int t = c.gw; t < NPT + SBATCH; t += c.ngw) {
        if (t >= NPT) { if (SUB(0)) b0_task_sample(c, l, t - NPT); continue; }
        const int chunk = t / 12, k = t % 12, b = chunk >> 5, n = chunk & 31;
        if (SUB(3)) b0_task_conv(c, l, b, n, k >> 2, k & 3, wl);
    }
}

DI void b1_prep(const Ctx& c, int l, int unit, LAS unsigned char* wl, LAS float* sg, LAS float* sb) {
    int lane = c.lane; asm volatile("" : "+v"(lane));
    const int r = lane & 31, h = lane >> 5;
    const int n = unit & 31, bh = unit >> 5, hh = bh & 3, b = bh >> 2, tok0 = b * SEQ + n * 64;
    const float bt = WSP(float, WS_BETA)[(tok0 + lane) * 4 + hh];
    float gc = WSP(float, WS_G)[(tok0 + lane) * 4 + hh];
#pragma unroll
    for (int o = 1; o < 64; o <<= 1) { const float t = xlane(gc, lane - o); if (lane >= o) gc += t; }
    sg[lane] = gc; sb[lane] = bt;
    const float glast = __builtin_bit_cast(float, __builtin_amdgcn_readlane(__builtin_bit_cast(int, gc), 63));
    if (lane == 0) WSP(float, WS_EG)[unit] = __expf(glast);
    unsigned char* img = c.ws + WS_IMG + (size_t)unit * IMG_BYTES;
    const bf16_t* Kn = WSP(bf16_t, WS_KN) + (size_t)tok0 * 512 + hh * 128;
    const bf16_t* Qn = WSP(bf16_t, WS_QN) + (size_t)tok0 * 512 + hh * 128;
    const bf16_t* KnT = WSP(bf16_t, WS_KNT) + (size_t)unit * 128 * 64;
    const bf16_t* VT = WSP(bf16_t, WS_VT) + (size_t)unit * 128 * 64;
    LAS float* L = (LAS float*)wl;
    {
        bf16x8 Kf[2][8];
#pragma unroll
        for (int t = 0; t < 2; ++t)
#pragma unroll
            for (int ks = 0; ks < 8; ++ks) Kf[t][ks] = *(const bf16x8*)(Kn + (size_t)(32 * t + r) * 512 + 16 * ks + 8 * h);
#pragma unroll
        for (int tt = 0; tt < 3; ++tt) { const int mt = tt == 0 ? 0 : 1, nt = tt == 2 ? 1 : 0;
            f32x16 acc = zero16();
#pragma unroll
            for (int ks = 0; ks < 8; ++ks) acc = MFMA32(Kf[mt][ks], Kf[nt][ks], acc);
            const int j = 32 * nt + r; const float gj = sg[j];
#pragma unroll
            for (int g4 = 0; g4 < 4; ++g4) { const f32x4 gi4 = *(const LAS f32x4*)(sg + 32 * mt + 8 * g4 + 4 * h), bi4 = *(const LAS f32x4*)(sb + 32 * mt + 8 * g4 + 4 * h);
#pragma unroll
                for (int q = 0; q < 4; ++q) { const int i = 32 * mt + 8 * g4 + 4 * h + q; const float arg = i > j ? gi4[q] - gj : 0.f;
                    L[i * 64 + j] = i > j ? acc[4 * g4 + q] * bi4[q] * __expf(arg) : 0.f; } } }
#pragma unroll
        for (int mt = 0; mt < 2; ++mt) {
            bf16x8 Qf[8];
#pragma unroll
            for (int ks = 0; ks < 8; ++ks) Qf[ks] = *(const bf16x8*)(Qn + (size_t)(32 * mt + r) * 512 + 16 * ks + 8 * h);
            const int i = 32 * mt + r; const float gi = sg[i];
#pragma unroll
            for (int mp = 0; mp <= mt; ++mp) {
                f32x16 acc = zero16();
#pragma unroll
                for (int ks = 0; ks < 8; ++ks) acc = MFMA32(Kf[mp][ks], Qf[ks], acc);
#pragma unroll
                for (int g4 = 0; g4 < 4; ++g4) { const f32x4 gj4 = *(const LAS f32x4*)(sg + 32 * mp + 8 * g4 + 4 * h);
#pragma unroll
                    for (int q = 0; q < 4; ++q) { const int j = 32 * mp + 8 * g4 + 4 * h + q; const float arg = i >= j ? gi - gj4[q] : 0.f;
                        acc[4 * g4 + q] = i >= j ? acc[4 * g4 + q] * __expf(arg) : 0.f; } }
                const int fb = (mt == 0 ? 0 : 1 + mp) * 2;
#pragma unroll
                for (int s = 0; s < 2; ++s) *(u32x4*)(img + 49152 + (fb + s) * 1024 + lane * 16) = pack8(acc, s);
            }
        }
    }
    float Tr[64];
    {
        f32x4 lb[2][16];
#pragma unroll
        for (int i = 0; i < 64; ++i) {
            if (i + 1 < 64) {
#pragma unroll
                for (int j4 = 0; j4 < (i + 1 + 3) / 4; ++j4) lb[(i + 1) & 1][j4] = *(const LAS f32x4*)(L + (i + 1) * 64 + 4 * j4); }
            asm volatile("" ::: "memory");
            float a0 = lane == i ? 1.f : 0.f, a1 = 0.f;
#pragma unroll
            for (int j4 = 0; j4 < (i + 3) / 4; ++j4) {
#pragma unroll
                for (int q = 0; q < 4; ++q) { const int j = 4 * j4 + q; if (j < i) { if (q & 1) a1 -= lb[i & 1][j4][q] * Tr[j]; else a0 -= lb[i & 1][j4][q] * Tr[j]; } } }
            Tr[i] = a0 + a1;
        }
    }
    LAS bf16_t* T1 = (LAS bf16_t*)wl;
    asm volatile("" ::: "memory");
    {
        const float sc1 = bt * __expf(gc);
#pragma unroll
        for (int i = 0; i < 64; ++i) T1[i * 72 + lane] = f2bf(Tr[i] * sc1);
        bf16x8 Tf[2][4];
#pragma unroll
        for (int mt = 0; mt < 2; ++mt)
#pragma unroll
            for (int ks = 0; ks < 4; ++ks) Tf[mt][ks] = *(const LAS bf16x8*)(T1 + (32 * mt + r) * 72 + 16 * ks + 8 * h);
#pragma unroll
        for (int dt = 0; dt < 4; ++dt) {
            bf16x8 Kt[4];
#pragma unroll
            for (int ks = 0; ks < 4; ++ks) Kt[ks] = *(const bf16x8*)(KnT + (size_t)(32 * dt + r) * 64 + 16 * ks + 8 * h);
#pragma unroll
            for (int mt = 0; mt < 2; ++mt) { f32x16 acc = zero16();
#pragma unroll
                for (int ks = 0; ks < 2 * (mt + 1); ++ks) acc = MFMA32(Kt[ks], Tf[mt][ks], acc);
                acc = -acc;
#pragma unroll
                for (int s = 0; s < 2; ++s) *(u32x4*)(img + ((mt * 4 + dt) * 2 + s) * 1024 + lane * 16) = pack8(acc, s); }
        }
    }
    asm volatile("" ::: "memory");
    {
#pragma unroll
        for (int i = 0; i < 64; ++i) T1[i * 72 + lane] = f2bf(Tr[i] * bt);
        bf16x8 Tf[2][4];
#pragma unroll
        for (int mt = 0; mt < 2; ++mt)
#pragma unroll
            for (int ks = 0; ks < 4; ++ks) Tf[mt][ks] = *(const LAS bf16x8*)(T1 + (32 * mt + r) * 72 + 16 * ks + 8 * h);
        bf16_t* uimg = WSP(bf16_t, WS_UIMG) + (size_t)unit * 8192;
#pragma unroll
        for (int et = 0; et < 4; ++et) {
            bf16x8 Vt[4];
#pragma unroll
            for (int ks = 0; ks < 4; ++ks) Vt[ks] = *(const bf16x8*)(VT + (size_t)(32 * et + r) * 64 + 16 * ks + 8 * h);
#pragma unroll
            for (int mt = 0; mt < 2; ++mt) { f32x16 acc = zero16();
#pragma unroll
                for (int ks = 0; ks < 2 * (mt + 1); ++ks) acc = MFMA32(Tf[mt][ks], Vt[ks], acc);
#pragma unroll
                for (int g4 = 0; g4 < 4; ++g4) { u32x2 w; w.x = pk2(acc[4 * g4], acc[4 * g4 + 1]); w.y = pk2(acc[4 * g4 + 2], acc[4 * g4 + 3]); *(u32x2*)(uimg + ((et * 2 + mt) * 4 + g4) * 256 + lane * 4) = w; } }
        }
    }
    asm volatile("" ::: "memory");
#pragma unroll
    for (int mt = 0; mt < 2; ++mt) { const float ei = __expf(sg[32 * mt + r]);
#pragma unroll
        for (int dt = 0; dt < 4; ++dt)
#pragma unroll
            for (int s = 0; s < 2; ++s) { const bf16_t* qp = Qn + (size_t)(32 * mt + r) * 512 + 32 * dt + 16 * s + 4 * h;
                const u32x2 p0 = *(const u32x2*)qp, p1 = *(const u32x2*)(qp + 8);
                u32x4 w; w.x = pk2(bflo(p0.x) * ei, bfhi(p0.x) * ei); w.y = pk2(bflo(p0.y) * ei, bfhi(p0.y) * ei); w.z = pk2(bflo(p1.x) * ei, bfhi(p1.x) * ei); w.w = pk2(bflo(p1.y) * ei, bfhi(p1.y) * ei);
                *(u32x4*)(img + 16384 + ((mt * 4 + dt) * 2 + s) * 1024 + lane * 16) = w; } }
#pragma unroll
    for (int mp = 0; mp < 2; ++mp)
#pragma unroll
        for (int s = 0; s < 2; ++s) { const f32x4 ga = *(const LAS f32x4*)(sg + 32 * mp + 16 * s + 4 * h), gb = *(const LAS f32x4*)(sg + 32 * mp + 16 * s + 8 + 4 * h);
            float sc[8];
#pragma unroll
            for (int q = 0; q < 4; ++q) { sc[q] = __expf(glast - ga[q]); sc[4 + q] = __expf(glast - gb[q]); }
#pragma unroll
            for (int dt = 0; dt < 4; ++dt) { const bf16_t* kp = KnT + (size_t)(32 * dt + r) * 64 + 32 * mp + 16 * s + 4 * h;
                const u32x2 p0 = *(const u32x2*)kp, p1 = *(const u32x2*)(kp + 8);
                u32x4 w; w.x = pk2(bflo(p0.x) * sc[0], bfhi(p0.x) * sc[1]); w.y = pk2(bflo(p0.y) * sc[2], bfhi(p0.y) * sc[3]); w.z = pk2(bflo(p1.x) * sc[4], bfhi(p1.x) * sc[5]); w.w = pk2(bflo(p1.y) * sc[6], bfhi(p1.y) * sc[7]);
                *(u32x4*)(img + 32768 + ((dt * 2 + mp) * 2 + s) * 1024 + lane * 16) = w; } }
}
DI void b1_gmlp(const Ctx& c, int l, int unit) {
    int lane = c.lane; asm volatile("" : "+v"(lane));
    const int r = lane & 31, h = lane >> 5;
    const int hb = unit & 3, cc = (unit >> 2) & 15, b = unit >> 6, tokc0 = b * SEQ + cc * 128;
    const bf16_t* A = WSP(bf16_t, WS_VBT) + (size_t)unit * 128 * 128;
    const bf16_t* B = WSP(bf16_t, WS_WM) + (size_t)(l * 4 + hb) * 128 * 128;
    const bf16_t* P = WSP(bf16_t, WS_P); bf16_t* AM = WSP(bf16_t, WS_AMIX);
#pragma unroll
    for (int nt = 0; nt < 4; ++nt) {
        f32x16 acc[4];
#pragma unroll
        for (int mt = 0; mt < 4; ++mt) acc[mt] = zero16();
#pragma unroll
        for (int ks = 0; ks < 2 * (nt + 1); ++ks) { const bf16x8 bf = *(const bf16x8*)(B + (size_t)(32 * nt + r) * 128 + 16 * ks + 8 * h);
#pragma unroll
            for (int mt = 0; mt < 4; ++mt) { const bf16x8 af = *(const bf16x8*)(A + (size_t)(32 * mt + r) * 128 + 16 * ks + 8 * h); acc[mt] = MFMA32(af, bf, acc[mt]); } }
        const int tok = tokc0 + 32 * nt + r; const float bsi = c.b_s[(l * 4 + hb) * 128 + 32 * nt + r];
#pragma unroll
        for (int mt = 0; mt < 4; ++mt)
#pragma unroll
            for (int g4 = 0; g4 < 4; ++g4) { const int dch0 = 32 * mt + 8 * g4 + 4 * h;
                const u32x2 u4 = *(const u32x2*)(P + (size_t)tok * NP + 2048 + hb * 128 + dch0);
                u32x2 w; w.x = pk2(bflo(u4.x) * (acc[mt][4 * g4] + bsi), bfhi(u4.x) * (acc[mt][4 * g4 + 1] + bsi)); w.y = pk2(bflo(u4.y) * (acc[mt][4 * g4 + 2] + bsi), bfhi(u4.y) * (acc[mt][4 * g4 + 3] + bsi));
                *(u32x2*)(AM + (size_t)tok * DM + 512 + hb * 128 + dch0) = w; }
    }
}
DI void phase_b1(const Ctx& c, int l, LAS unsigned char* lds) {
    LAS unsigned char* wl = lds + c.wave * 16384; LAS float* sg = (LAS float*)(lds + 131072 + c.wave * 512); LAS float* sb = sg + 64;
    for (int t = c.wave < 4 ? c.bx * 4 + c.wave : 1024; t < 1024; t += c.nb * 4) {
        if (SUB(0)) b1_prep(c, l, t, wl, sg, sb);
    }
}


constexpr int OB_STRIDE = 136;
constexpr int IMG_LDS = 57344;
constexpr int LDS_OBUF = 2 * IMG_LDS, OBUF_BYTES = 64 * OB_STRIDE * 2;
static_assert(LDS_OBUF + 2 * OBUF_BYTES <= LDS_BYTES, "scan LDS");
DI void scan_post(const Ctx& c, int l, int b, int hh, int n, const LAS bf16_t* ob, int lid, const u32x4 (&gt4)[4]) {
    const int i = lid >> 2, q = lid & 3, tok = b * SEQ + n * 64 + i;
    u32x4 ov[4]; float ss = 0.f;
#pragma unroll
    for (int x = 0; x < 4; ++x) { ov[x] = *(const LAS u32x4*)(ob + i * OB_STRIDE + 32 * q + 8 * x);
#pragma unroll
        for (int e = 0; e < 4; ++e) { const float a = bflo(ov[x][e]), bq = bfhi(ov[x][e]); ss += a * a + bq * bq; } }
    ss += xlane(ss, (lid & 63) ^ 1); ss += xlane(ss, (lid & 63) ^ 2);
    const float rs = rsqrtf(ss * (1.0f / 128.0f) + EPS);
    bf16_t* op = WSP(bf16_t, WS_AMIX) + (size_t)tok * DM + hh * 128 + 32 * q;
#pragma unroll
    for (int x = 0; x < 4; ++x) { u32x4 w;
#pragma unroll
        for (int e = 0; e < 4; ++e) w[e] = pk2(bflo(ov[x][e]) * rs * bflo(gt4[x][e]), bfhi(ov[x][e]) * rs * bfhi(gt4[x][e]));
        *(u32x4*)(op + 8 * x) = w; }
}
DI void scan_loader_step(const Ctx& c, int l, int b, int hh, int n, LAS unsigned char* lds, const unsigned char* img0, const bf16_t* gbase, int lw, int lane, int lid, u32x4 (&regs)[14], u32x4 (&gt)[4]) {
    u32x4 gcur[4];
#pragma unroll
    for (int x = 0; x < 4; ++x) gcur[x] = gt[x];
#pragma unroll
    for (int x = 0; x < 4; ++x) gt[x] = *(const u32x4*)(gbase + (size_t)n * 64 * NP + 8 * x);
    const unsigned voff = (unsigned)(lw * 14336 + lane * 16);
    if (n + 1 < 32) { LAS unsigned char* dst = lds + ((n + 1) & 1) * IMG_LDS + voff;
#pragma unroll
        for (int i = 0; i < 14; ++i) *(LAS u32x4*)(dst + i * 1024) = regs[i]; }
    if (n + 3 < 32) { const unsigned char* src = img0 + (size_t)(n + 3) * IMG_BYTES;
#pragma unroll
        for (int i = 0; i < 14; ++i) regs[i] = *(const u32x4*)(src + voff + i * 1024); }
    if (n >= 1) scan_post(c, l, b, hh, n - 1, (const LAS bf16_t*)(lds + LDS_OBUF + ((n - 1) & 1) * OBUF_BYTES), lid, gcur);
    __syncthreads();
}
DI void scan_consumer_step(int n, LAS unsigned char* lds, f32x16 (&S)[4], u32x2 (&ucur)[8], float& egc, const bf16_t* uimg0, const float* egp, int lane, int ws, int r, int h) {
    const LAS unsigned char* buf = lds + (n & 1) * IMG_LDS + lane * 16;
    f32x16 av[2], ao[2]; ao[0] = zero16(); ao[1] = zero16();
#pragma unroll
    for (int mt = 0; mt < 2; ++mt)
#pragma unroll
        for (int g4 = 0; g4 < 4; ++g4) { const u32x2 w = ucur[mt * 4 + g4]; av[mt][4 * g4] = bflo(w.x); av[mt][4 * g4 + 1] = bfhi(w.x); av[mt][4 * g4 + 2] = bflo(w.y); av[mt][4 * g4 + 3] = bfhi(w.y); }
    const float eg = egc;
    if (n + 2 < 32) { const bf16_t* up = uimg0 + (size_t)(n + 2) * 8192;
#pragma unroll
        for (int x = 0; x < 8; ++x) ucur[x] = *(const u32x2*)(up + x * 256);
        egc = egp[n + 2]; }
    {
        bf16x8 fg[2][4];
#pragma unroll
        for (int mt = 0; mt < 2; ++mt) { fg[0][mt] = *(const LAS bf16x8*)(buf + (mt * 8) * 1024); fg[0][2 + mt] = *(const LAS bf16x8*)(buf + 16384 + (mt * 8) * 1024); }
#pragma unroll
        for (int gI = 0; gI < 8; ++gI) { const int dt = gI >> 1, s = gI & 1;
            if (gI + 1 < 8) {
#pragma unroll
                for (int mt = 0; mt < 2; ++mt) { fg[(gI + 1) & 1][mt] = *(const LAS bf16x8*)(buf + (mt * 8 + gI + 1) * 1024); fg[(gI + 1) & 1][2 + mt] = *(const LAS bf16x8*)(buf + 16384 + (mt * 8 + gI + 1) * 1024); } }
            asm volatile("" ::: "memory");
            const bf16x8 sb = as_bf(pack8(S[dt], s));
            av[0] = MFMA32(fg[gI & 1][0], sb, av[0]); av[1] = MFMA32(fg[gI & 1][1], sb, av[1]);
            ao[0] = MFMA32(sb, fg[gI & 1][2], ao[0]); ao[1] = MFMA32(sb, fg[gI & 1][3], ao[1]); }
    }
    bf16x8 vb[2][2];
#pragma unroll
    for (int mp = 0; mp < 2; ++mp)
#pragma unroll
        for (int s = 0; s < 2; ++s) vb[mp][s] = as_bf(pack8(av[mp], s));
    {
        bf16x8 qf[6];
#pragma unroll
        for (int f = 0; f < 6; ++f) qf[f] = *(const LAS bf16x8*)(buf + 49152 + f * 1024);
        asm volatile("" ::: "memory");
#pragma unroll
        for (int s = 0; s < 2; ++s) { ao[0] = MFMA32(vb[0][s], qf[s], ao[0]); ao[1] = MFMA32(vb[0][s], qf[2 + s], ao[1]); ao[1] = MFMA32(vb[1][s], qf[4 + s], ao[1]); }
    }
    LAS bf16_t* ob = (LAS bf16_t*)(lds + LDS_OBUF + (n & 1) * OBUF_BYTES);
#pragma unroll
    for (int mt = 0; mt < 2; ++mt)
#pragma unroll
        for (int g4 = 0; g4 < 4; ++g4) { u32x2 w; w.x = pk2(ao[mt][4 * g4], ao[mt][4 * g4 + 1]); w.y = pk2(ao[mt][4 * g4 + 2], ao[mt][4 * g4 + 3]);
            *(LAS u32x2*)(ob + (32 * mt + r) * OB_STRIDE + 32 * ws + 8 * g4 + 4 * h) = w; }
    bf16x8 kf[2][4];
#pragma unroll
    for (int f = 0; f < 4; ++f) kf[0][f] = *(const LAS bf16x8*)(buf + 32768 + f * 1024);
#pragma unroll
    for (int dt = 0; dt < 4; ++dt) {
        if (dt + 1 < 4) {
#pragma unroll
            for (int f = 0; f < 4; ++f) kf[(dt + 1) & 1][f] = *(const LAS bf16x8*)(buf + 32768 + ((dt + 1) * 4 + f) * 1024); }
        asm volatile("" ::: "memory");
        S[dt] = S[dt] * eg;
#pragma unroll
        for (int mp = 0; mp < 2; ++mp)
#pragma unroll
            for (int s = 0; s < 2; ++s) S[dt] = MFMA32(kf[dt & 1][mp * 2 + s], vb[mp][s], S[dt]); }
    __syncthreads();
}
DI void scan_block(const Ctx& c, int l, int bh, LAS unsigned char* lds) {
    const int wave = c.wave, b = bh >> 2, hh = bh & 3;
    const unsigned char* img0 = c.ws + WS_IMG + (size_t)bh * 32 * IMG_BYTES;
    if (wave >= 4) { if (SUB2(0)) {
        int lane = c.lane; asm volatile("" : "+v"(lane));
        const int lw = wave - 4, lid = lw * 64 + lane;
        u32x4 regs0[14], regs1[14], gt0[4];
        const bf16_t* gbase = WSP(bf16_t, WS_P) + (size_t)(b * SEQ + (lid >> 2)) * NP + 1536 + hh * 128 + 32 * (lid & 3);
        const unsigned voff0 = (unsigned)(lw * 14336 + lane * 16);
#pragma unroll
        for (int i = 0; i < 14; ++i) regs0[i] = *(const u32x4*)(img0 + voff0 + i * 1024);
#pragma unroll
        for (int i = 0; i < 14; ++i) *(LAS u32x4*)(lds + voff0 + i * 1024) = regs0[i];
#pragma unroll
        for (int i = 0; i < 14; ++i) { regs1[i] = *(const u32x4*)(img0 + (size_t)IMG_BYTES + voff0 + i * 1024); regs0[i] = *(const u32x4*)(img0 + (size_t)2 * IMG_BYTES + voff0 + i * 1024); }
#pragma unroll
        for (int x = 0; x < 4; ++x) gt0[x] = (u32x4){0u, 0u, 0u, 0u};
        __syncthreads();
        for (int n = 0; n < 32; n += 2) {
            scan_loader_step(c, l, b, hh, n, lds, img0, gbase, lw, lane, lid, regs1, gt0);
            scan_loader_step(c, l, b, hh, n + 1, lds, img0, gbase, lw, lane, lid, regs0, gt0);
        }
        scan_post(c, l, b, hh, 31, (const LAS bf16_t*)(lds + LDS_OBUF + (31 & 1) * OBUF_BYTES), lid, gt0);
    } } else if (SUB2(1)) {
        int lane = c.lane; asm volatile("" : "+v"(lane));
        const int ws = wave, r = lane & 31, h = lane >> 5;
        f32x16 S[4];
#pragma unroll
        for (int dt = 0; dt < 4; ++dt) S[dt] = zero16();
        const bf16_t* uimg0 = WSP(bf16_t, WS_UIMG) + (size_t)bh * 32 * 8192 + (size_t)ws * 2 * 4 * 256 + lane * 4;
        const float* egp = WSP(float, WS_EG) + bh * 32;
        u32x2 u0[8], u1[8];
#pragma unroll
        for (int x = 0; x < 8; ++x) { u0[x] = *(const u32x2*)(uimg0 + x * 256); u1[x] = *(const u32x2*)(uimg0 + 8192 + x * 256); }
        float eg0 = egp[0], eg1 = egp[1];
        __syncthreads();
        for (int n = 0; n < 32; n += 2) {
            scan_consumer_step(n, lds, S, u0, eg0, uimg0, egp, lane, ws, r, h);
            scan_consumer_step(n + 1, lds, S, u1, eg1, uimg0, egp, lane, ws, r, h);
        }
        const char* od = (const char*)(c.out + O_DP + (size_t)(l * 32 + bh) * 128 * 128);
        unsigned voff = (unsigned)((4 * h) * 128 + 32 * ws + r) * 4u;
        asm volatile("" : "+v"(voff));
#pragma unroll
        for (int dt = 0; dt < 4; ++dt)
#pragma unroll
            for (int reg = 0; reg < 16; ++reg) *(float*)(od + (32 * dt + (reg & 3) + 8 * (reg >> 2)) * 512 + voff) = S[dt][reg];
    }
}
DI float rdlane(float v, int l) { return __builtin_bit_cast(float, __builtin_amdgcn_readlane(__builtin_bit_cast(int, v), l)); }
DI void sample_recurrent(const Ctx& c, int l, int unit) {
    int lane = c.lane; asm volatile("" : "+v"(lane));
    const int bs = unit >> 2, hh = unit & 3, e2 = 2 * lane;
    const float* S0 = c.state_delta + (size_t)((l * SBATCH + bs) * 4 + hh) * 128 * 128 + e2;
    float* S1 = c.out + O_DS + (size_t)((l * SBATCH + bs) * 4 + hh) * 128 * 128 + e2;
    const float* q = WSP(float, WS_QS) + bs * 512 + hh * 128; const float* k = WSP(float, WS_KS) + bs * 512 + hh * 128; const float* v = WSP(float, WS_VS) + bs * 512 + hh * 128;
    const float eg = __expf(WSP(float, WS_GS)[bs * 4 + hh]), beta = WSP(float, WS_BS)[bs * 4 + hh];
    const float k0 = k[lane], k1 = k[64 + lane], q0 = q[lane], q1 = q[64 + lane];
    f32x2 kv = {0.f, 0.f};
#pragma unroll
    for (int d0 = 0; d0 < 128; d0 += 32) { f32x2 sv[32];
#pragma unroll
        for (int j = 0; j < 32; ++j) sv[j] = *(const f32x2*)(S0 + (d0 + j) * 128);
#pragma unroll
        for (int j = 0; j < 32; ++j) { const int dd = d0 + j; kv += sv[j] * rdlane(dd < 64 ? k0 : k1, dd & 63); } }
    const f32x2 v2 = *(const f32x2*)(v + e2);
    const f32x2 delta = (v2 - kv * eg) * beta;
    f32x2 oo = {0.f, 0.f};
#pragma unroll
    for (int d0 = 0; d0 < 128; d0 += 32) { f32x2 sv[32];
#pragma unroll
        for (int j = 0; j < 32; ++j) sv[j] = *(const f32x2*)(S0 + (d0 + j) * 128);
#pragma unroll
        for (int j = 0; j < 32; ++j) { const int dd = d0 + j; const f32x2 sn = sv[j] * eg + delta * rdlane(dd < 64 ? k0 : k1, dd & 63); oo += sn * rdlane(dd < 64 ? q0 : q1, dd & 63); *(f32x2*)(S1 + dd * 128) = sn; } }
    const float ss = wave_sum(oo.x * oo.x + oo.y * oo.y, lane); const float rs = rsqrtf(ss * (1.0f / 128.0f) + EPS);
    const float* ps = WSP(float, WS_PS) + (size_t)bs * NPS + 1536 + hh * 128 + e2; float* am = WSP(float, WS_AMIXS) + (size_t)bs * DM + hh * 128 + e2;
    const float* og = c.o_norm_g + l * 128 + e2;
    am[0] = oo.x * rs * og[0] * silu_f(ps[0]); am[1] = oo.y * rs * og[1] * silu_f(ps[1]);
}
DI void phase_scan(const Ctx& c, int l, LAS unsigned char* lds) {
    if (c.bx < 32) { if (SUB(0)) scan_block(c, l, c.bx, lds); return; }
    const int w0 = (c.bx - 32) * 8 + c.wave, nw = (c.nb - 32) * 8;
    LAS unsigned char* wl = lds + c.wave * B0_WAVE_LDS;
    for (int u = w0; u < SBATCH * 4 + 512; u += nw) {
        if (u < SBATCH * 4) { if (SUB(1)) sample_recurrent(c, l, u); continue; }
        const int g = u - SBATCH * 4, hb = g & 3, cc = (g >> 2) & 15, b = g >> 6;
        b0_task_vb(c, l, b, 2 * cc, hb, wl); b0_task_vb(c, l, b, 2 * cc + 1, hb, wl);
        asm volatile("s_waitcnt vmcnt(0)" ::: "memory");
        b1_gmlp(c, l, g);
    }
    if (l + 1 < DEPTH) convert_layer_weights(c, l + 1, w0, nw, lds);

}

DI void phase_final(const Ctx& c) {
    const f32x4* gr = (const f32x4*)c.norm_f_g + c.lane;
    for (int m = c.gw; m < MP + SBATCH; m += c.ngw) {
        f32x4 v[4]; float s = 0.f;
        if (m < MP) { const u32x2* xr = (const u32x2*)(WSP(bf16_t, WS_XB16) + (size_t)m * DM) + c.lane;
#pragma unroll
            for (int j = 0; j < 4; ++j) { const u32x2 w = xr[64 * j]; v[j] = (f32x4){bflo(w.x), bfhi(w.x), bflo(w.y), bfhi(w.y)}; } }
        else { const f32x4* xr = (const f32x4*)(WSP(float, WS_XS) + (size_t)(m - MP) * DM) + c.lane;
#pragma unroll
            for (int j = 0; j < 4; ++j) v[j] = xr[64 * j]; }
        float* dst = m < MP ? c.out + O_YP + (size_t)m * DM : c.out + O_YS + (size_t)(m - MP) * DM;
#pragma unroll
        for (int j = 0; j < 4; ++j) s += (v[j].x * v[j].x + v[j].y * v[j].y) + (v[j].z * v[j].z + v[j].w * v[j].w);
        const float rs = rsqrtf(wave_sum(s, c.lane) * (1.0f / DM) + EPS);
#pragma unroll
        for (int j = 0; j < 4; ++j) ((f32x4*)dst + c.lane)[64 * j] = v[j] * rs * gr[64 * j];
    }
}

#define XB_TMO      128
#define XB_XCNT(j)  (256  + 64 * (j))
#define XB_XSUB(j)  (1280 + 64 * (j))
#define XB_XGEN(j)  (2304 + 64 * (j))
#define XB_TOP      3328
#define XB_TOPGEN   3392
#define XCD_BAR_WORDS 3456
#define XB_SPIN_CAP (1u << 18)

__device__ __forceinline__ unsigned xb_ld(unsigned* p)              { return __hip_atomic_load(p, __ATOMIC_RELAXED, __HIP_MEMORY_SCOPE_AGENT); }
__device__ __forceinline__ unsigned xb_add(unsigned* p, unsigned v) { return __hip_atomic_fetch_add(p, v, __ATOMIC_RELAXED, __HIP_MEMORY_SCOPE_AGENT); }
__device__ __forceinline__ unsigned xb_xcc_id() { return (unsigned)__builtin_amdgcn_s_getreg((3 << 11) | 20) & 0xFu; }
#define XB_SPIN(cond, bar) do { unsigned _sp = 0; while (cond) { __builtin_amdgcn_s_sleep(8); \
    if ((++_sp & 255u) == 0u) { if (xb_ld(&(bar)[XB_TMO])) break; if (_sp > XB_SPIN_CAP) { atomicAdd(&(bar)[XB_TMO], 1u); break; } } } } while (0)

struct XcdBarrier {
    unsigned* bar; unsigned x;
    volatile LAS unsigned* st;
};

__device__ __forceinline__ XcdBarrier xcd_barrier_post(unsigned* bar, volatile LAS unsigned* st) {
    XcdBarrier b; b.bar = bar; b.x = xb_xcc_id(); b.st = st;
    if (threadIdx.x == 0) (void)xb_add(&bar[XB_XCNT(b.x)], 1u);
    return b;
}
__device__ __forceinline__ void xcd_barrier_complete(unsigned* bar, unsigned x, unsigned& nloc, unsigned& nx) {
    const unsigned G = gridDim.x * gridDim.y * gridDim.z;
    unsigned sum, cnt, mine, sp = 0u;
    for (;;) {
        sum = 0u; cnt = 0u; mine = 0u;
#pragma unroll
        for (unsigned j = 0; j < 16; ++j) { const unsigned c = xb_ld(&bar[XB_XCNT(j)]); sum += c; cnt += (c > 0u) ? 1u : 0u; mine = (j == x) ? c : mine; }
        if (sum == G) break;
        __builtin_amdgcn_s_sleep(1);
        if ((++sp & 255u) == 0u) { if (xb_ld(&bar[XB_TMO])) break; if (sp > XB_SPIN_CAP) { atomicAdd(&bar[XB_TMO], 1u); break; } }
    }
    nloc = mine > 0u ? mine : 1u; nx = cnt > 0u ? cnt : 1u;
}

__device__ __forceinline__ void xcd_barrier(const XcdBarrier& b) {
    asm volatile("s_waitcnt vmcnt(0)" ::: "memory");
    __syncthreads();
    if (threadIdx.x == 0) {
        unsigned* bar = b.bar;
        __builtin_amdgcn_s_waitcnt(0);
        unsigned nloc = b.st[0], nx = b.st[1];
        if (nloc == 0u) { xcd_barrier_complete(bar, b.x, nloc, nx); b.st[0] = nloc; b.st[1] = nx; }
        const unsigned old = xb_add(&bar[XB_XSUB(b.x)], 1u);
        const unsigned gen = old / nloc;
        if (old + 1u == (gen + 1u) * nloc) {
            __builtin_amdgcn_fence(__ATOMIC_RELEASE, "agent");
            asm volatile("s_waitcnt vmcnt(0)" ::: "memory");
            const unsigned og = xb_add(&bar[XB_TOP], 1u);
            const unsigned tg = og / nx;
            if (og + 1u == (tg + 1u) * nx) xb_add(&bar[XB_TOPGEN], 1u);
            else XB_SPIN(xb_ld(&bar[XB_TOPGEN]) == tg, bar);
            __builtin_amdgcn_fence(__ATOMIC_ACQUIRE, "agent");
            xb_add(&bar[XB_XGEN(b.x)], 1u);
            asm volatile("s_waitcnt vmcnt(0)" ::: "memory");
        } else {
            XB_SPIN(xb_ld(&bar[XB_XGEN(b.x)]) == gen, bar);
            __builtin_amdgcn_fence(__ATOMIC_ACQUIRE, "agent");
            asm volatile("s_waitcnt vmcnt(0)" ::: "memory");
        }
    }
    __syncthreads();
}
#ifndef ONLY
#define ONLY -1
#endif
#ifndef REPMASK
#define REPMASK 0
#endif
#define EN(x) (ONLY < 0 || ONLY == (x))
__global__ void __launch_bounds__(512, 2) hymba_fwd(Args args) {
    extern __shared__ __attribute__((aligned(16))) unsigned char lds_raw[];
    LAS unsigned char* lds = (LAS unsigned char*)lds_raw;
    cg::grid_group grid = cg::this_grid();
    Ctx c;
    c.x_prompt = args.in[0]; c.x_sample = args.in[1]; c.state_delta = args.in[2]; c.state_conv = args.in[3]; c.norm_mix_g = args.in[4]; c.w_in = args.in[5]; c.conv_w = args.in[6];
    c.A_log = args.in[7]; c.dt_bias = args.in[8]; c.o_norm_g = args.in[9]; c.v_norm_g = args.in[10]; c.w_s = args.in[11]; c.b_s = args.in[12]; c.w_o = args.in[13]; c.norm_ffn_g = args.in[14];
    c.w_up = args.in[15]; c.w_down = args.in[16]; c.norm_f_g = args.in[17]; c.out = args.out; c.ws = args.ws;
    c.lane = threadIdx.x & 63; c.wave = __builtin_amdgcn_readfirstlane(threadIdx.x >> 6); c.gw = blockIdx.x * 8 + c.wave; c.ngw = gridDim.x * 8; c.bx = blockIdx.x; c.nb = gridDim.x;
    volatile LAS unsigned* bst = (volatile LAS unsigned*)(lds + LDS_BYTES - 16);
    if (threadIdx.x < 2) bst[threadIdx.x] = 0u;
    __syncthreads();
    XcdBarrier xbar = xcd_barrier_post((unsigned*)args.ws, bst);
    grid.sync();
    for (int step = 2 * args.ph_lo; step < 2 * args.ph_hi; ++step) {
        const int ph = step >> 1;
        const int ptype = ph == 0 ? 0 : (ph == 29 ? 8 : 1 + (ph - 1) % 7);
        if ((step & 1) && !((REPMASK >> ptype) & 1)) continue;
        { int tl = threadIdx.x; asm volatile("" : "+v"(tl)); c.lane = tl & 63; int bxo = blockIdx.x, nbo = gridDim.x; asm volatile("" : "+s"(bxo), "+s"(nbo)); c.bx = bxo; c.nb = nbo; c.wave = __builtin_amdgcn_readfirstlane(tl >> 6); c.gw = bxo * 8 + c.wave; c.ngw = nbo * 8; unsigned char* wsp = args.ws; asm volatile("" : "+s"(wsp)); c.ws = wsp; float* op = args.out; asm volatile("" : "+s"(op)); c.out = op; }
        if (step & 1) __syncthreads();
        if (ph == 0) { if (EN(0)) phase_prologue(c, lds); }
        else if (ph == 29) { if (EN(8)) phase_final(c); }
        else {
            const int l = (ph - 1) / 7, s = (ph - 1) % 7;
            float* ssq = WSP(float, WS_SSQ);
            if (s == 0) { if (EN(1)) { sgemm1(c, l, lds); if ((REPMASK >> 10) & 1) sgemm1(c, l, lds);
                pg8::Gemm g{WSP(bf16_t, WS_XB16), WSP(bf16_t, WS_WIN) + (size_t)l * NP * DM, MP, NP, DM}; pg8::StaticOrder S; S.init(MP, NP, c.nb, c.bx);
                pg8::EpiScaleBf16 E{WSP(bf16_t, WS_P), NP, ssq + (size_t)(2 * l) * MP * 16, 0, WSP(float, WS_VSS), c.o_norm_g + l * 128}; pg8::gemm_phase(lds, g, S, E); } }
            else if (s == 1) { if (EN(2)) phase_b0(c, l, lds); }
            else if (s == 2) { if (EN(3)) phase_b1(c, l, lds); }
            else if (s == 3) { if (EN(4)) phase_scan(c, l, lds); if ((REPMASK >> 12) & 1) { __syncthreads(); if (c.bx < 32) scan_block(c, l, c.bx, lds); } if ((REPMASK >> 13) & 1) { if (c.bx >= 32) { const int w0 = (c.bx - 32) * 8 + c.wave, nw = (c.nb - 32) * 8; for (int u = w0; u < SBATCH * 4; u += nw) sample_recurrent(c, l, u); } } }
            else if (s == 4) { if (EN(5)) { if (!(step & 1)) sgemm2(c, l, lds);
                pg8::Gemm g{WSP(bf16_t, WS_AMIX), WSP(bf16_t, WS_WO) + (size_t)l * DM * DM, MP, DM, DM}; pg8::StaticOrder S; S.init(MP, DM, c.nb, c.bx);
                pg8::EpiResid E{WSP(bf16_t, WS_XB16), ssq + (size_t)(2 * l + 1) * MP * 16}; pg8::gemm_phase(lds, g, S, E); } }
            else if (s == 5) { if (EN(6)) { sgemm3(c, l, lds); if ((REPMASK >> 11) & 1) sgemm3(c, l, lds);
                pg8::Gemm g{WSP(bf16_t, WS_XB16), WSP(bf16_t, WS_WUP) + (size_t)l * FF * DM, MP, FF, DM}; pg8::StaticOrder S; S.init(MP, FF, c.nb, c.bx);
                pg8::EpiScaleBf16 E{WSP(bf16_t, WS_UNION), FF, ssq + (size_t)(2 * l + 1) * MP * 16, 1, nullptr, nullptr}; pg8::gemm_phase(lds, g, S, E); } }
            else { if (EN(7)) { if (!(step & 1)) sgemm4(c, l, lds);
                pg8::Gemm g{WSP(bf16_t, WS_UNION), WSP(bf16_t, WS_WDN) + (size_t)l * DM * FF, MP, DM, FF}; pg8::StaticOrder S; S.init(MP, DM, c.nb, c.bx);
                pg8::EpiResid E{WSP(bf16_t, WS_XB16), ssq + (size_t)(2 * l + 2) * MP * 16}; pg8::gemm_phase(lds, g, S, E); } }
        }
        if (!(step & 1) && ((REPMASK >> ptype) & 1)) continue;
        if ((REPMASK >> 9) & 1) { if (ph + 1 < args.ph_hi) xcd_barrier(xbar); }
        if (ph + 1 < args.ph_hi) {
            xcd_barrier(xbar);
        }
    }
}

extern "C" void kernel_launch(void* const* d_in, const int* in_sizes, int n_in, void* d_out, int out_size, void* d_ws, size_t ws_size, hipStream_t stream) {
    static int grid = 0;
    if (grid == 0) {
        int dev = 0, cus = 0, per_cu = 0;
        (void)hipGetDevice(&dev); (void)hipDeviceGetAttribute(&cus, hipDeviceAttributeMultiprocessorCount, dev);
        if (hipFuncSetAttribute((const void*)hymba_fwd, hipFuncAttributeMaxDynamicSharedMemorySize, LDS_BYTES) != hipSuccess) fprintf(stderr, "kernel_launch: hipFuncSetAttribute failed\n");
        if (hipOccupancyMaxActiveBlocksPerMultiprocessor(&per_cu, (const void*)hymba_fwd, 512, LDS_BYTES) != hipSuccess || per_cu < 1) { fprintf(stderr, "kernel_launch: occupancy query says %d\n", per_cu); per_cu = 1; }
        (void)hipGetLastError();
        grid = cus * 1;
        if (ws_size < WS_END) fprintf(stderr, "kernel_launch: workspace too small: %zu < %zu\n", ws_size, (size_t)WS_END);
    }
    (void)hipMemsetAsync(d_ws, 0, 65536, stream);
    Args a{};
    for (int i = 0; i < 18; ++i) a.in[i] = (const float*)d_in[i];
    a.out = (float*)d_out; a.ws = (unsigned char*)d_ws; a.ph_lo = 0; a.ph_hi = 30;
    void* kargs[] = {&a};
    hipError_t e = hipLaunchCooperativeKernel((const void*)hymba_fwd, dim3(grid), dim3(512), kargs, LDS_BYTES, stream);
    if (e != hipSuccess) fprintf(stderr, "kernel_launch: cooperative launch failed: %s (grid %d)\n", hipGetErrorString(e), grid);
}
```

```cpp
#include <hip/hip_runtime.h>
#include <hip/hip_cooperative_groups.h>
#include <cstdio>
namespace cg = cooperative_groups;

#define LAS __attribute__((address_space(3)))
#define DI __device__ __forceinline__
typedef unsigned short bf16_t;
typedef short bf16x8 __attribute__((ext_vector_type(8)));
typedef float f32x4 __attribute__((ext_vector_type(4)));
typedef float f32x2 __attribute__((ext_vector_type(2)));
typedef float f32x16 __attribute__((ext_vector_type(16)));
typedef unsigned u32x4 __attribute__((ext_vector_type(4)));
typedef unsigned u32x2 __attribute__((ext_vector_type(2)));
typedef __bf16 bf2_t __attribute__((ext_vector_type(2)));
typedef unsigned u32x8 __attribute__((ext_vector_type(8)));

#ifndef SUBSEL
#define SUBSEL -1
#endif
#define SUB(x) (SUBSEL < 0 || SUBSEL == (x))
#ifndef SUBSEL2
#define SUBSEL2 -1
#endif
#define SUB2(x) (SUBSEL2 < 0 || SUBSEL2 == (x))
constexpr int DM = 1024, NBATCH = 8, SEQ = 2048, MP = NBATCH * SEQ, DEPTH = 4, SBATCH = 128;
constexpr int NH = 4, QKV = 1536, NP = 3072, PROJ = 3080, FF = 4096, NPS = 3088;
constexpr float EPS = 1e-6f;
constexpr int IMG_BYTES = 55296;
constexpr int LDS_BYTES = 150528;
constexpr size_t O_YP = 0, O_YS = 16777216, O_DP = 16908288, O_CP = 19005440, O_DS = 19152896, O_CS = 52707328, O_VS = 55066624;
constexpr size_t WS_WIN = 65536;
constexpr size_t WS_WAB = WS_WIN + (size_t)DEPTH * NP * DM * 2;
constexpr size_t WS_WO = WS_WAB + (size_t)DEPTH * 16 * DM * 2;
constexpr size_t WS_WUP = WS_WO + (size_t)DEPTH * DM * DM * 2;
constexpr size_t WS_WDN = WS_WUP + (size_t)DEPTH * FF * DM * 2;
constexpr size_t WS_WM = WS_WDN + (size_t)DEPTH * FF * DM * 2;
constexpr size_t WS_XBUF = WS_WM + (size_t)DEPTH * 4 * 128 * 128 * 2;
constexpr size_t WS_XB16 = WS_XBUF + (size_t)MP * DM * 4;
constexpr size_t WS_SSQ = WS_XB16 + (size_t)MP * DM * 2;
constexpr size_t WS_UNION = WS_SSQ + (size_t)9 * MP * 16 * 4;
constexpr size_t WS_P = WS_UNION;
constexpr size_t WS_QN = WS_P + (size_t)MP * NP * 2;
constexpr size_t WS_KN = WS_QN + (size_t)MP * 512 * 2;
constexpr size_t WS_KNT = WS_UNION + (size_t)MP * FF * 2;
constexpr size_t WS_VT = WS_KNT + (size_t)MP * 512 * 2;
constexpr size_t WS_VBT = WS_VT + (size_t)MP * 512 * 2;
constexpr size_t WS_G = WS_VBT + (size_t)MP * 512 * 2;
constexpr size_t WS_BETA = WS_G + (size_t)MP * 4 * 4;
constexpr size_t WS_EG = WS_BETA + (size_t)MP * 4 * 4;
constexpr size_t WS_IMG = WS_EG + 4096;
constexpr size_t WS_UIMG = WS_IMG + (size_t)1024 * IMG_BYTES;
constexpr size_t WS_AMIX = WS_UIMG + (size_t)1024 * 32768;
constexpr size_t WS_XS = WS_AMIX + (size_t)MP * DM * 2;
constexpr size_t WS_PS = WS_XS + (size_t)SBATCH * DM * 4;
constexpr size_t WS_QS = WS_PS + (size_t)SBATCH * NPS * 4;
constexpr size_t WS_KS = WS_QS + (size_t)SBATCH * 512 * 4;
constexpr size_t WS_VS = WS_KS + (size_t)SBATCH * 512 * 4;
constexpr size_t WS_GS = WS_VS + (size_t)SBATCH * 512 * 4;
constexpr size_t WS_BS = WS_GS + (size_t)SBATCH * 4 * 4;
constexpr size_t WS_AMIXS = WS_BS + (size_t)SBATCH * 4 * 4;
constexpr size_t WS_HS = WS_AMIXS + (size_t)SBATCH * DM * 4;
constexpr size_t WS_XP = WS_HS + (size_t)SBATCH * FF * 4;
constexpr size_t WS_VSS = WS_XP + (size_t)4 * SBATCH * DM * 4;
constexpr size_t WS_CWP = WS_VSS + (size_t)MP * 8 * 4;
constexpr size_t WS_END = WS_CWP + (size_t)DEPTH * 4 * QKV * 4;
static_assert(WS_QN + 2 * (size_t)MP * 512 * 2 == WS_KNT, "union");
static_assert(WS_END <= (size_t)536870912, "workspace");

DI unsigned pk2(float lo, float hi) { f32x2 v = {lo, hi}; return __builtin_bit_cast(unsigned, __builtin_convertvector(v, bf2_t)); }
DI float bflo(unsigned w) { return __uint_as_float(w << 16); }
DI float bfhi(unsigned w) { return __uint_as_float(w & 0xffff0000u); }
DI float bf2f(bf16_t b) { return __uint_as_float(((unsigned)b) << 16); }
DI bf16_t f2bf(float f) { return (bf16_t)(pk2(f, 0.f) & 0xffffu); }
DI float xlane(float v, int srclane) { return __builtin_bit_cast(float, __builtin_amdgcn_ds_bpermute(srclane << 2, __builtin_bit_cast(int, v))); }
DI float wave_sum(float v, int lane) {
#pragma unroll
    for (int o = 1; o < 64; o <<= 1) v += xlane(v, lane ^ o);
    return v;
}
DI float silu_f(float x) { return x * __builtin_amdgcn_rcpf(1.f + __expf(-x)); }
DI float sigmoid_f(float x) { return __builtin_amdgcn_rcpf(1.f + __expf(-x)); }
DI float softplus_f(float x) { const float e = __expf(-fabsf(x)); const float l = e < 0.01f ? e * (1.f - e * (0.5f - 0.33333334f * e)) : __logf(1.f + e); return fmaxf(x, 0.f) + l; }
DI u32x4 pack8(const f32x16& x, int s) {
    u32x4 p; p.x = pk2(x[8 * s], x[8 * s + 1]); p.y = pk2(x[8 * s + 2], x[8 * s + 3]); p.z = pk2(x[8 * s + 4], x[8 * s + 5]); p.w = pk2(x[8 * s + 6], x[8 * s + 7]); return p;
}
DI float ssq_sum(const float* p) {
    const f32x4 a = *(const f32x4*)p, b = *(const f32x4*)(p + 4), c2 = *(const f32x4*)(p + 8), d2 = *(const f32x4*)(p + 12);
    return ((a.x + a.y) + (a.z + a.w)) + ((b.x + b.y) + (b.z + b.w)) + ((c2.x + c2.y) + (c2.z + c2.w)) + ((d2.x + d2.y) + (d2.z + d2.w));
}
DI int crow(int reg, int h) { return (reg & 3) + 8 * (reg >> 2) + 4 * h; }
#define MFMA32(a, b, c) __builtin_amdgcn_mfma_f32_32x32x16_bf16((a), (b), (c), 0, 0, 0)
#define MFMA16(a, b, c) __builtin_amdgcn_mfma_f32_16x16x32_bf16((a), (b), (c), 0, 0, 0)
DI bf16x8 as_bf(u32x4 v) { return __builtin_bit_cast(bf16x8, v); }
DI f32x16 zero16() { f32x16 z;
#pragma unroll
    for (int i = 0; i < 16; ++i) z[i] = 0.f; return z; }

namespace pg8 {
constexpr int BM = 256, BK = 64, HALF = 128, HTB = HALF * BK * 2, STAGE_BYTES = 8 * HTB, NXCD = 8, WGM = 8;
DI int lds_byte(int r, int c) { const int st = (r >> 4) * 2 + (c >> 5), rr = r & 15, cc = c & 31, ob = rr * 64 + cc * 2; return st * 1024 + (ob ^ (((ob >> 9) & 1) << 5)); }
DI void stage_rc(int b, int& R, int& C) { const int st = b / 1024, sb = b % 1024, swz = sb ^ (((sb >> 9) & 1) << 5); R = (st >> 1) * 16 + swz / 64; C = (st & 1) * 32 + (swz % 64) / 2; }
DI int perm32(int rho) { const int n = rho >> 4, i = rho & 15; return 8 * (i >> 2) + 4 * n + (i & 3); }
struct Unit { int pm, pn; };
struct Gemm { const bf16_t* A; const bf16_t* Bt; int M, N, K; };
struct StaticOrder {
    int nM, nN, nwg, G, c;
    DI void init(int M, int N, int G_, int c_) { nM = M / BM; nN = N / BM; nwg = nM * nN; G = G_; c = c_; }
    DI bool next(int i, Unit& u) const {
        const long L = (long)i * G + c; if (L >= nwg) return false;
        int wgid = (int)L; { const int q = nwg / NXCD, r = nwg % NXCD, xcd = wgid % NXCD, off = wgid / NXCD; wgid = (xcd < r ? xcd * (q + 1) : r * (q + 1) + (xcd - r) * q) + off; }
        const int nig = WGM * nN, gid = wgid / nig, fm = gid * WGM, gsz = (nM - fm) < WGM ? (nM - fm) : WGM;
        u.pm = fm + ((wgid % nig) % gsz); u.pn = (wgid % nig) / gsz; return true;
    }
};
template <class Epi>
DI void gemm_phase(LAS unsigned char* lds, const Gemm g, const StaticOrder& S, const Epi& E) {
    int tid = threadIdx.x; asm volatile("" : "+v"(tid));
    const int wid = __builtin_amdgcn_readfirstlane(tid >> 6), lane = tid & 63, wr = wid >> 2, wc = wid & 3, fr = lane & 15, fq = lane >> 4;
    const int K = g.K, nt = K / BK;
    unsigned voffA[2], voffB[2];
#pragma unroll
    for (int i = 0; i < 2; ++i) { int R, C; stage_rc(tid * 16 + i * 8192, R, C); const int Rb = (R & ~31) + perm32(R & 31);
        voffA[i] = (unsigned)(R * K + C) * 2u; voffB[i] = (unsigned)(Rb * K + C) * 2u; }
    const size_t kstep = (size_t)(BK * 2);
    const size_t hstep = (size_t)HALF * K * 2;
    const size_t tstep = 2 * hstep;
    const unsigned ldsw = (unsigned)wid * 1024u;
    const int aoff = lds_byte(wr * 64 + fr, fq * 8), boff = lds_byte(wc * 32 + fr, fq * 8);
#define PG8_SA(b, h) (((b) * 2 + (h)) * HTB)
#define PG8_SB(b, h) ((4 + (b) * 2 + (h)) * HTB)
#define PG8_STAGE(bufoff, gbase, voff) do { _Pragma("unroll") for (int _i = 0; _i < 2; ++_i) \
        __builtin_amdgcn_global_load_lds((const unsigned*)((const char*)(gbase) + (voff)[_i]), (LAS unsigned*)(lds + (bufoff) + ldsw + _i * 8192), 16, 0, 0); } while (0)
#define PG8_LDA(dst, b, h) do { _Pragma("unroll") for (int m = 0; m < 4; ++m) _Pragma("unroll") for (int k = 0; k < 2; ++k) dst[m][k] = *(const LAS bf16x8*)(lds + PG8_SA(b, h) + aoff + m * 2048 + k * 1024); } while (0)
#define PG8_LDB(dst, b, h) do { _Pragma("unroll") for (int n = 0; n < 2; ++n) _Pragma("unroll") for (int k = 0; k < 2; ++k) dst[n][k] = *(const LAS bf16x8*)(lds + PG8_SB(b, h) + boff + n * 2048 + k * 1024); } while (0)
#define PG8_MMA(ai, bj, At, Bt) do { __builtin_amdgcn_s_setprio(1); _Pragma("unroll") for (int m = 0; m < 4; ++m) _Pragma("unroll") for (int n = 0; n < 2; ++n) _Pragma("unroll") for (int k = 0; k < 2; ++k) \
        acc[ai][bj][m][n] = __builtin_amdgcn_mfma_f32_16x16x32_bf16(Bt[n][k], At[m][k], acc[ai][bj][m][n], 0, 0, 0); __builtin_amdgcn_s_setprio(0); } while (0)
#define PG8_WAIT_V(n) asm volatile("s_waitcnt vmcnt(" #n ")" ::: "memory")
#define PG8_WAIT_L(n) asm volatile("s_waitcnt lgkmcnt(" #n ")" ::: "memory")
#define PG8_BAR __builtin_amdgcn_s_barrier()
#define PG8_SCHED __builtin_amdgcn_sched_barrier(0)
    Unit cur, nxt; int ui = 0;
    if (!S.next(0, cur)) return;
    f32x4 acc[2][2][4][2];
#pragma unroll
    for (int a = 0; a < 2; ++a)
#pragma unroll
        for (int b = 0; b < 2; ++b)
#pragma unroll
            for (int m = 0; m < 4; ++m)
#pragma unroll
                for (int n = 0; n < 2; ++n) acc[a][b][m][n] = (f32x4){0.f, 0.f, 0.f, 0.f};
    bf16x8 At[4][2], B0[2][2], B1[2][2];
    const char* cA = (const char*)g.A + (size_t)cur.pm * tstep; const char* cB = (const char*)g.Bt + (size_t)cur.pn * tstep;
    PG8_STAGE(PG8_SB(0, 0), cB, voffB); PG8_STAGE(PG8_SA(0, 0), cA, voffA); PG8_STAGE(PG8_SB(0, 1), cB + hstep, voffB); PG8_STAGE(PG8_SA(0, 1), cA + hstep, voffA);
    if (wr == 1) PG8_BAR;
    PG8_WAIT_V(4); PG8_BAR;
    PG8_STAGE(PG8_SB(1, 0), cB + kstep, voffB); PG8_STAGE(PG8_SA(1, 0), cA + kstep, voffA); PG8_STAGE(PG8_SB(1, 1), cB + hstep + kstep, voffB);
    PG8_WAIT_V(6); PG8_BAR;
    for (;;) {
        const bool has_next = S.next(ui + 1, nxt);
        const char* nA = has_next ? (const char*)g.A + (size_t)nxt.pm * tstep : cA; const char* nB = has_next ? (const char*)g.Bt + (size_t)nxt.pn * tstep : cB;
        for (int t = 0; t < nt; t += 2) {
            const bool last = (t == nt - 2);
            const char* a1 = cA + (size_t)(t + 1) * kstep;
            const char* a2 = last ? nA : cA + (size_t)(t + 2) * kstep; const char* b2 = last ? nB : cB + (size_t)(t + 2) * kstep;
            const char* a3 = a2 + kstep; const char* b3 = b2 + kstep;
            PG8_LDB(B0, 0, 0); PG8_SCHED; PG8_LDA(At, 0, 0); PG8_STAGE(PG8_SA(1, 1), a1 + hstep, voffA);
            PG8_WAIT_L(8); PG8_BAR; PG8_WAIT_L(0); PG8_MMA(0, 0, At, B0); PG8_BAR; PG8_SCHED;
            PG8_LDB(B1, 0, 1); PG8_STAGE(PG8_SB(0, 0), b2, voffB);
            PG8_BAR; PG8_WAIT_L(0); PG8_MMA(0, 1, At, B1); PG8_BAR;
            PG8_LDA(At, 0, 1); PG8_STAGE(PG8_SA(0, 0), a2, voffA);
            PG8_BAR; PG8_WAIT_L(0); PG8_MMA(1, 0, At, B0); PG8_BAR; PG8_SCHED;
            PG8_STAGE(PG8_SB(0, 1), b2 + hstep, voffB);
            PG8_WAIT_V(6); PG8_BAR; PG8_MMA(1, 1, At, B1); PG8_BAR;
            PG8_LDB(B0, 1, 0); PG8_SCHED; PG8_LDA(At, 1, 0); PG8_STAGE(PG8_SA(0, 1), a2 + hstep, voffA);
            PG8_WAIT_L(8); PG8_BAR; PG8_WAIT_L(0); PG8_MMA(0, 0, At, B0); PG8_BAR; PG8_SCHED;
            PG8_LDB(B1, 1, 1); PG8_STAGE(PG8_SB(1, 0), b3, voffB);
            PG8_BAR; PG8_WAIT_L(0); PG8_MMA(0, 1, At, B1); PG8_BAR;
            PG8_LDA(At, 1, 1); PG8_STAGE(PG8_SA(1, 0), a3, voffA);
            PG8_BAR; PG8_WAIT_L(0); PG8_MMA(1, 0, At, B0); PG8_BAR; PG8_SCHED;
            PG8_STAGE(PG8_SB(1, 1), b3 + hstep, voffB);
            PG8_WAIT_V(6); PG8_BAR; PG8_MMA(1, 1, At, B1); PG8_BAR;
        }
        E(acc, cur, wr, wc, fr, fq);
        if (!has_next) break;
#pragma unroll
        for (int a = 0; a < 2; ++a)
#pragma unroll
            for (int b = 0; b < 2; ++b)
#pragma unroll
                for (int m = 0; m < 4; ++m)
#pragma unroll
                    for (int n = 0; n < 2; ++n) acc[a][b][m][n] = (f32x4){0.f, 0.f, 0.f, 0.f};
        cur = nxt; cA = nA; cB = nB; ++ui;
    }
    PG8_WAIT_V(0);
    if (wr == 0) PG8_BAR;
    PG8_BAR;
#undef PG8_SA
#undef PG8_SB
#undef PG8_STAGE
#undef PG8_LDA
#undef PG8_LDB
#undef PG8_MMA
#undef PG8_WAIT_V
#undef PG8_WAIT_L
#undef PG8_BAR
#undef PG8_SCHED
}
struct EpiScaleBf16 {
    bf16_t* O; int ldc; const float* ssq; int act; float* vss; const float* og;
    DI void operator()(const f32x4 (&acc)[2][2][4][2], const Unit& u, int wr, int wc, int fr, int fq) const {
        const int row0 = u.pm * BM + wr * 64 + fr, col0 = u.pn * BM + wc * 32 + 8 * fq;
#pragma unroll
        for (int ai = 0; ai < 2; ++ai)
#pragma unroll
            for (int m = 0; m < 4; ++m) { const int row = row0 + ai * HALF + m * 16;
                float rq; { const f32x4 p4 = *(const f32x4*)(ssq + (size_t)row * 16 + 4 * fq); rq = (p4.x + p4.y) + (p4.z + p4.w); const int ln = fq * 16 + fr; rq += xlane(rq, ln ^ 16); rq += xlane(rq, ln ^ 32); }
                const float rs = rsqrtf(rq * (1.0f / DM) + EPS);
                bf16_t* rowp = O + (size_t)row * ldc + col0; float vs = 0.f;
#pragma unroll
                for (int bj = 0; bj < 2; ++bj) { f32x4 v0 = acc[ai][bj][m][0] * rs, v1 = acc[ai][bj][m][1] * rs;
                    if (act) {
#pragma unroll
                        for (int j = 0; j < 4; ++j) { const float a = fmaxf(v0[j], 0.f), b = fmaxf(v1[j], 0.f); v0[j] = a * a; v1[j] = b * b; } }
                    if (og != nullptr && (u.pn == 6 || u.pn == 7)) { const float* gp = og + ((col0 + bj * HALF) & 127); const f32x4 g0 = *(const f32x4*)gp, g1 = *(const f32x4*)(gp + 4);
#pragma unroll
                        for (int j = 0; j < 4; ++j) { v0[j] = silu_f(v0[j]) * g0[j]; v1[j] = silu_f(v1[j]) * g1[j]; } }
                    u32x4 w; w.x = pk2(v0[0], v0[1]); w.y = pk2(v0[2], v0[3]); w.z = pk2(v1[0], v1[1]); w.w = pk2(v1[2], v1[3]);
                    *(u32x4*)(rowp + bj * HALF) = w;
                    vs += (v0[0] * v0[0] + v0[1] * v0[1]) + (v0[2] * v0[2] + v0[3] * v0[3]) + (v1[0] * v1[0] + v1[1] * v1[1]) + (v1[2] * v1[2] + v1[3] * v1[3]); }
                if (vss != nullptr && u.pn >= 10) { { const int ln = fq * 16 + fr; vs += xlane(vs, ln ^ 16); vs += xlane(vs, ln ^ 32); } if (fq == 0) vss[(size_t)row * 8 + (u.pn - 10) * 4 + wc] = vs; } }
    }
};
struct EpiResid {
    bf16_t* xb; float* ssq;
    DI void operator()(const f32x4 (&acc)[2][2][4][2], const Unit& u, int wr, int wc, int fr, int fq) const {
        const int row0 = u.pm * BM + wr * 64 + fr, col0 = u.pn * BM + wc * 32 + 8 * fq;
#pragma unroll
        for (int ai = 0; ai < 2; ++ai)
#pragma unroll
            for (int m = 0; m < 4; ++m) { const int row = row0 + ai * HALF + m * 16; const size_t off = (size_t)row * DM + col0; float ss = 0.f;
#pragma unroll
                for (int bj = 0; bj < 2; ++bj) {
                    const u32x4 b = *(const u32x4*)(xb + off + bj * HALF);
                    const f32x4 o0 = (f32x4){bflo(b.x), bfhi(b.x), bflo(b.y), bfhi(b.y)} + acc[ai][bj][m][0], o1 = (f32x4){bflo(b.z), bfhi(b.z), bflo(b.w), bfhi(b.w)} + acc[ai][bj][m][1];
                    u32x4 w; w.x = pk2(o0[0], o0[1]); w.y = pk2(o0[2], o0[3]); w.z = pk2(o1[0], o1[1]); w.w = pk2(o1[2], o1[3]);
                    *(u32x4*)(xb + off + bj * HALF) = w;
                    ss += (o0[0] * o0[0] + o0[1] * o0[1]) + (o0[2] * o0[2] + o0[3] * o0[3]) + (o1[0] * o1[0] + o1[1] * o1[1]) + (o1[2] * o1[2] + o1[3] * o1[3]); }
                { const int ln = fq * 16 + fr; ss += xlane(ss, ln ^ 16); ss += xlane(ss, ln ^ 32); }
                if (fq == 0) ssq[(size_t)row * 16 + u.pn * 4 + wc] = ss;
                asm volatile("" ::: "memory"); }
    }
};
}

struct Args { const float* in[18]; float* out; unsigned char* ws; int ph_lo, ph_hi; };
struct Ctx {
    const float *x_prompt, *x_sample, *state_delta, *state_conv, *norm_mix_g, *w_in, *conv_w, *A_log, *dt_bias, *o_norm_g, *v_norm_g, *w_s, *b_s, *w_o, *norm_ffn_g, *w_up, *w_down, *norm_f_g;
    float* out; unsigned char* ws;
    int lane, wave, gw, ngw, bx, nb;
};
#define WSP(T, off) ((T*)(c.ws + (off)))

DI void transpose_item(const float* W, int K, int N, const float* kscale, bf16_t* WT, bf16_t* WAB, int mode, int item, int nblk, LAS float* scr, int lane) {
    const int kb = item / nblk, nb = item % nblk, k0 = 64 * kb, n0 = 64 * nb;
    const int c4 = lane & 15, rsub = lane >> 4;
    const bool cval = n0 + 4 * c4 + 3 < N;
#pragma unroll 4
    for (int kk = 0; kk < 64; kk += 4) { const int row = kk + rsub;
        f32x4 v = (f32x4){0.f, 0.f, 0.f, 0.f}; if (cval) { v = *(const f32x4*)(W + (size_t)(k0 + row) * N + n0 + 4 * c4); if (kscale) v = v * kscale[k0 + row]; }
        LAS float* p = scr + row * 65 + 4 * c4; p[0] = v.x; p[1] = v.y; p[2] = v.z; p[3] = v.w; }
    asm volatile("s_waitcnt lgkmcnt(0)" ::: "memory");
    const int kc = lane & 7;
#pragma unroll
    for (int it = 0; it < 8; ++it) { const int n = 8 * it + (lane >> 3), ns = n0 + n; const LAS float* s = scr + (8 * kc) * 65 + n;
        u32x4 o; o.x = pk2(s[0 * 65], s[1 * 65]); o.y = pk2(s[2 * 65], s[3 * 65]); o.z = pk2(s[4 * 65], s[5 * 65]); o.w = pk2(s[6 * 65], s[7 * 65]);
        if (ns < N) {
            bf16_t* rowp;
            if (mode == 0) rowp = WT + (size_t)ns * K;
            else rowp = ns < 2048 ? WT + (size_t)ns * K : (ns < 2056 ? WAB + (size_t)(ns - 2048) * K : WT + (size_t)(ns - 8) * K);
            *(u32x4*)(rowp + k0 + 8 * kc) = o; } }
    asm volatile("s_waitcnt lgkmcnt(0)" ::: "memory");
}
DI void convert_layer_weights(const Ctx& c, int l, int w0, int nw, LAS unsigned char* lds) {
    LAS float* scr = (LAS float*)(lds + c.wave * 18432);
    constexpr int I_IN = 16 * 49, I_O = 16 * 16, I_UP = 16 * 64, I_DN = 64 * 16, I_L = I_IN + I_O + I_UP + I_DN;
    for (int it = w0; it < I_L; it += nw) {
        int r = it;
        if (r < I_IN) { transpose_item(c.w_in + (size_t)l * DM * PROJ, DM, PROJ, c.norm_mix_g + l * DM, WSP(bf16_t, WS_WIN) + (size_t)l * NP * DM, WSP(bf16_t, WS_WAB) + (size_t)l * 16 * DM, 1, r, 49, scr, c.lane); continue; } r -= I_IN;
        if (r < I_O) { transpose_item(c.w_o + (size_t)l * DM * DM, DM, DM, nullptr, WSP(bf16_t, WS_WO) + (size_t)l * DM * DM, nullptr, 0, r, 16, scr, c.lane); continue; } r -= I_O;
        if (r < I_UP) { transpose_item(c.w_up + (size_t)l * DM * FF, DM, FF, c.norm_ffn_g + l * DM, WSP(bf16_t, WS_WUP) + (size_t)l * FF * DM, nullptr, 0, r, 64, scr, c.lane); continue; } r -= I_UP;
        transpose_item(c.w_down + (size_t)l * FF * DM, FF, DM, nullptr, WSP(bf16_t, WS_WDN) + (size_t)l * DM * FF, nullptr, 0, r, 16, scr, c.lane);
    }
}
DI void phase_prologue(const Ctx& c, LAS unsigned char* lds) {
    convert_layer_weights(c, 0, c.gw, c.ngw, lds);
    float* ssq = WSP(float, WS_SSQ);
    for (int m = c.gw; m < MP; m += c.ngw) {
        const f32x4* xr = (const f32x4*)(c.x_prompt + (size_t)m * DM) + c.lane; u32x2* o8 = (u32x2*)(WSP(bf16_t, WS_XB16) + (size_t)m * DM) + c.lane; float s = 0.f;
#pragma unroll
        for (int j = 0; j < 4; ++j) { const f32x4 v = xr[64 * j]; s += (v.x * v.x + v.y * v.y) + (v.z * v.z + v.w * v.w); u32x2 w; w.x = pk2(v.x, v.y); w.y = pk2(v.z, v.w); o8[64 * j] = w; }
        s = wave_sum(s, c.lane); if (c.lane < 16) ssq[(size_t)m * 16 + c.lane] = c.lane == 0 ? s : 0.f;
    }
    const int gt = c.gw * 64 + c.lane, ngt = c.ngw * 64;
    float* xs = WSP(float, WS_XS);
    for (int i = gt; i < SBATCH * DM; i += ngt) xs[i] = c.x_sample[i];
    bf16_t* wab = WSP(bf16_t, WS_WAB);
    for (int i = gt; i < DEPTH * 8 * DM; i += ngt) { const int l = i / (8 * DM), r = i % (8 * DM); wab[(size_t)l * 16 * DM + 8 * DM + r] = 0; }
    unsigned* wm = WSP(unsigned, WS_WM);
    for (int i = gt; i < DEPTH * 4 * 128 * 64; i += ngt) { const int e = 2 * i, ii = (e >> 7) & 127, jj = e & 127;
        const float a = ii >= jj ? c.w_s[e] : 0.f, b = ii >= jj + 1 ? c.w_s[e + 1] : 0.f; wm[i] = pk2(a, b); }
}

template <int NT, bool NORM, int EPI>
DI void sgemm_block(const Ctx& c, const float* A, int lda, int K, const bf16_t* Bt, int ncg, float* out, int ldo, LAS unsigned char* lds, const bf16_t* Bab) {
    int lane = c.lane; asm volatile("" : "+v"(lane));
    const int wave = c.wave, fr = lane & 15, fq = lane >> 4;
    LAS f32x4* red = (LAS f32x4*)lds;
    LAS float* ssr = (LAS float*)(lds + 8 * NT * 64 * 16);
    const int kw = K / 8, k0 = wave * kw;
    for (int u = c.bx; u < 8 * ncg; u += c.nb) {
        const int rt = u & 7, cg = u >> 3;
        const bool abg = (Bab != nullptr) && (cg == ncg - 1);
        const bf16_t* bp = (abg ? Bab : Bt + (size_t)cg * NT * 16 * K) + (size_t)fr * K + k0 + 8 * fq;
        const float* ap = A + (size_t)(rt * 16 + fr) * lda + k0 + 8 * fq;
        f32x4 acc[NT]; float ss = 0.f;
#pragma unroll
        for (int nt = 0; nt < NT; ++nt) acc[nt] = (f32x4){0.f, 0.f, 0.f, 0.f};
#pragma unroll 4
        for (int k = 0; k < kw; k += 32) {
            const f32x4 a0 = *(const f32x4*)(ap + k), a1 = *(const f32x4*)(ap + k + 4);
            if (NORM) ss += (a0.x * a0.x + a0.y * a0.y) + (a0.z * a0.z + a0.w * a0.w) + (a1.x * a1.x + a1.y * a1.y) + (a1.z * a1.z + a1.w * a1.w);
            u32x4 a; a.x = pk2(a0.x, a0.y); a.y = pk2(a0.z, a0.w); a.z = pk2(a1.x, a1.y); a.w = pk2(a1.z, a1.w);
#pragma unroll
            for (int nt = 0; nt < NT; ++nt) if (nt == 0 || !abg) { const bf16x8 bf = *(const bf16x8*)(bp + (size_t)nt * 16 * K + k); acc[nt] = MFMA16(as_bf(a), bf, acc[nt]); }
        }
        if (NORM) { ss += xlane(ss, lane ^ 16); ss += xlane(ss, lane ^ 32); if (fq == 0) ssr[wave * 16 + fr] = ss; }
#pragma unroll
        for (int nt = 0; nt < NT; ++nt) red[(wave * NT + nt) * 64 + lane] = acc[nt];
        __syncthreads();
        if (wave < NT && (wave == 0 || !abg)) {
            f32x4 t = red[wave * 64 + lane];
#pragma unroll
            for (int w = 1; w < 8; ++w) t += red[(w * NT + wave) * 64 + lane];
            const int col = (cg * NT + wave) * 16 + fr;
#pragma unroll
            for (int j = 0; j < 4; ++j) { const int rl = 4 * fq + j; float rs = 1.f;
                if (NORM) { float sq = 0.f;
#pragma unroll
                    for (int w = 0; w < 8; ++w) sq += ssr[w * 16 + rl];
                    rs = rsqrtf(sq * (1.0f / DM) + EPS); }
                float* o = out + (size_t)(rt * 16 + rl) * ldo + col;
                if (EPI == 0) *o = t[j] * rs; else if (EPI == 1) *o += t[j]; else { const float v = fmaxf(t[j] * rs, 0.f); *o = v * v; } }
        }
        __syncthreads();
    }
}
DI void sgemm1(const Ctx& c, int l, LAS unsigned char* lds) {
    sgemm_block<4, true, 0>(c, WSP(float, WS_XS), DM, DM, WSP(bf16_t, WS_WIN) + (size_t)l * NP * DM, 49, WSP(float, WS_PS), NPS, lds, WSP(bf16_t, WS_WAB) + (size_t)l * 16 * DM);
}
DI void sgemm2(const Ctx& c, int l, LAS unsigned char* lds) {
    sgemm_block<2, false, 1>(c, WSP(float, WS_AMIXS), DM, DM, WSP(bf16_t, WS_WO) + (size_t)l * DM * DM, 32, WSP(float, WS_XS), DM, lds, nullptr);
}
DI void sgemm3(const Ctx& c, int l, LAS unsigned char* lds) {
    sgemm_block<4, true, 2>(c, WSP(float, WS_XS), DM, DM, WSP(bf16_t, WS_WUP) + (size_t)l * FF * DM, 64, WSP(float, WS_HS), FF, lds, nullptr);
}
DI void sgemm4(const Ctx& c, int l, LAS unsigned char* lds) {
    sgemm_block<2, false, 1>(c, WSP(float, WS_HS), FF, FF, WSP(bf16_t, WS_WDN) + (size_t)l * DM * FF, 32, WSP(float, WS_XS), DM, lds, nullptr);
}

DI void b0_block_ab(const Ctx& c, int l, int chunk, LAS unsigned char* lds) {
    int lane = c.lane; asm volatile("" : "+v"(lane));
    const int wave = c.wave, fr = lane & 15, fq = lane >> 4, tok0 = chunk * 64, k0 = wave * 128;
    const bf16_t* ap = WSP(bf16_t, WS_XB16) + (size_t)(tok0 + fr) * DM + k0 + 8 * fq;
    const bf16_t* bp = WSP(bf16_t, WS_WAB) + (size_t)l * 16 * DM + (size_t)fr * DM + k0 + 8 * fq;
    f32x4 acc[4];
#pragma unroll
    for (int mt = 0; mt < 4; ++mt) acc[mt] = (f32x4){0.f, 0.f, 0.f, 0.f};
#pragma unroll
    for (int k = 0; k < 128; k += 32) {
        const bf16x8 bf = *(const bf16x8*)(bp + k);
#pragma unroll
        for (int mt = 0; mt < 4; ++mt) { const bf16x8 a = *(const bf16x8*)(ap + (size_t)mt * 16 * DM + k); acc[mt] = MFMA16(a, bf, acc[mt]); }
    }
    LAS f32x4* red = (LAS f32x4*)lds;
#pragma unroll
    for (int mt = 0; mt < 4; ++mt) red[(wave * 4 + mt) * 64 + lane] = acc[mt];
    __syncthreads();
    if (wave < 4 && fr < 8) { const int mt = wave;
        f32x4 t = red[mt * 64 + lane];
#pragma unroll
        for (int w = 1; w < 8; ++w) t += red[(w * 4 + mt) * 64 + lane];
        const float* ssq = WSP(float, WS_SSQ) + (size_t)(2 * l) * MP * 16;
        float* gb = WSP(float, WS_G); float* bb = WSP(float, WS_BETA);
        const int hh = fr & 3; const float al = -__expf(c.A_log[l * 4 + hh]), dtb = c.dt_bias[l * 4 + hh];
#pragma unroll
        for (int j = 0; j < 4; ++j) { const int tok = tok0 + 16 * mt + 4 * fq + j; const float v = t[j] * rsqrtf(ssq_sum(ssq + (size_t)tok * 16) * (1.0f / DM) + EPS);
            if (fr < 4) gb[tok * 4 + hh] = al * softplus_f(v + dtb); else bb[tok * 4 + hh] = sigmoid_f(v); } }
    __syncthreads();
}
DI float dot2bf(unsigned a, unsigned b, float c) { float r; asm("v_dot2c_f32_bf16 %0, %1, %2" : "=v"(r) : "s"(b), "v"(a), "0"(c)); return r; }
constexpr int B0_STRIDE = 272, B0_WAVE_LDS = 18432;
DI void b0_task_conv(const Ctx& c, int l, int b, int n, int s, int hh, LAS unsigned char* wl) {
    int lane = c.lane; asm volatile("" : "+v"(lane));
    const int tok0 = b * SEQ + n * 64, cb = s * 512 + hh * 128, piece = lane & 15;
    const bf16_t* P = WSP(bf16_t, WS_P) + (size_t)tok0 * NP + cb + piece * 8;
#pragma unroll
    for (int k = 0; k < 17; ++k) { const int row = 4 * k + (lane >> 4);
        if (row < 67) { u32x4 v = (u32x4){0u, 0u, 0u, 0u}; if (n > 0 || row >= 3) v = *(const u32x4*)(P + (long)(row - 3) * NP);
            *(LAS u32x4*)(wl + row * B0_STRIDE + piece * 16) = v; } }
    const unsigned* cwl = (const unsigned*)(c.conv_w + (size_t)l * 4 * QKV + cb);
    if (n == 31) {
        float* ocp = c.out + O_CP + ((size_t)(l * NBATCH + b) * 3) * QKV + cb;
#pragma unroll
        for (int t = 0; t < 6; ++t) { const int idx = lane + 64 * t, row = idx >> 7, ch = idx & 127; ocp[(size_t)row * QKV + ch] = bf2f(*(const LAS bf16_t*)(wl + (64 + row) * B0_STRIDE + ch * 2)); } }
    float ss = 0.f;
#pragma unroll 1
    for (int i = 0; i < 16; ++i) {
        u32x4 rws[4];
#pragma unroll
        for (int j = 0; j < 4; ++j) rws[j] = *(const LAS u32x4*)(wl + (lane + j) * B0_STRIDE + i * 16);
        u32x8 w0, w1, w2, w3; const unsigned* wp = cwl + 8 * i;
        asm volatile("s_load_dwordx8 %0, %4, 0x0\n\ts_load_dwordx8 %1, %4, 0x1800\n\ts_load_dwordx8 %2, %4, 0x3000\n\ts_load_dwordx8 %3, %4, 0x4800\n\ts_waitcnt lgkmcnt(0)"
                     : "=&s"(w0), "=&s"(w1), "=&s"(w2), "=&s"(w3) : "s"(wp) : "memory");
        float y[8];
#pragma unroll
        for (int e = 0; e < 8; ++e) { float a = 0.f;
            a = dot2bf(rws[0][e >> 1], (e & 1) ? ((w0[e] + 0x8000u) & 0xffff0000u) : ((w0[e] + 0x8000u) >> 16), a);
            a = dot2bf(rws[1][e >> 1], (e & 1) ? ((w1[e] + 0x8000u) & 0xffff0000u) : ((w1[e] + 0x8000u) >> 16), a);
            a = dot2bf(rws[2][e >> 1], (e & 1) ? ((w2[e] + 0x8000u) & 0xffff0000u) : ((w2[e] + 0x8000u) >> 16), a);
            a = dot2bf(rws[3][e >> 1], (e & 1) ? ((w3[e] + 0x8000u) & 0xffff0000u) : ((w3[e] + 0x8000u) >> 16), a);
            y[e] = silu_f(a); ss += y[e] * y[e]; }
        u32x4 w; w.x = pk2(y[0], y[1]); w.y = pk2(y[2], y[3]); w.z = pk2(y[4], y[5]); w.w = pk2(y[6], y[7]);
        *(LAS u32x4*)(wl + (lane + 3) * B0_STRIDE + i * 16) = w;
    }
    const float sc = s == 0 ? rsqrtf(ss + EPS) * 0.08838834764831845f : (s == 1 ? rsqrtf(ss + EPS) : 1.0f);
    const size_t unit = (size_t)((b * 4 + hh) * 32 + n);
    bf16_t* ot = (s == 1 ? WSP(bf16_t, WS_KNT) : WSP(bf16_t, WS_VT)) + unit * 128 * 64 + lane;
#pragma unroll 2
    for (int i = 0; i < 16; ++i) { const u32x4 v = *(const LAS u32x4*)(wl + (lane + 3) * B0_STRIDE + i * 16); u32x4 w;
#pragma unroll
        for (int e = 0; e < 4; ++e) w[e] = pk2(bflo(v[e]) * sc, bfhi(v[e]) * sc);
        if (s < 2) *(LAS u32x4*)(wl + (lane + 3) * B0_STRIDE + i * 16) = w;
        if (s >= 1) {
#pragma unroll
            for (int e = 0; e < 8; ++e) ot[(8 * i + e) * 64] = (bf16_t)((e & 1) ? (w[e >> 1] >> 16) : (w[e >> 1] & 0xffffu)); } }
    if (s < 2) { bf16_t* o = (s == 0 ? WSP(bf16_t, WS_QN) : WSP(bf16_t, WS_KN)) + (size_t)tok0 * 512 + hh * 128 + piece * 8;
#pragma unroll
        for (int k = 0; k < 16; ++k) { const int row = 4 * k + (lane >> 4); *(u32x4*)(o + (size_t)row * 512) = *(const LAS u32x4*)(wl + (row + 3) * B0_STRIDE + piece * 16); } }
}
DI void b0_task_vb(const Ctx& c, int l, int b, int n, int hb, LAS unsigned char* wl) {
    int lane = c.lane; asm volatile("" : "+v"(lane));
    const int tok0 = b * SEQ + n * 64, piece = lane & 15;
    const bf16_t* P = WSP(bf16_t, WS_P) + (size_t)tok0 * NP + 2560 + hb * 128 + piece * 8;
#pragma unroll
    for (int k = 0; k < 16; ++k) { const int row = 4 * k + (lane >> 4); *(LAS u32x4*)(wl + row * B0_STRIDE + piece * 16) = *(const u32x4*)(P + (size_t)row * NP); }
    const float* vp = WSP(float, WS_VSS) + (size_t)(tok0 + lane) * 8; const f32x4 p0 = *(const f32x4*)vp, p1 = *(const f32x4*)(vp + 4);
    const float rs = rsqrtf((((p0.x + p0.y) + (p0.z + p0.w)) + ((p1.x + p1.y) + (p1.z + p1.w))) * (1.0f / 512.0f) + EPS);
    const float* vg = c.v_norm_g + l * 512 + hb * 128;
    bf16_t* vbt = WSP(bf16_t, WS_VBT) + ((size_t)((b * 16 + (n >> 1)) * 4 + hb) * 128) * 128 + (n & 1) * 64 + lane;
#pragma unroll 2
    for (int i = 0; i < 16; ++i) { const u32x4 v = *(const LAS u32x4*)(wl + lane * B0_STRIDE + i * 16);
#pragma unroll
        for (int e = 0; e < 8; ++e) { const float pv = (e & 1) ? bfhi(v[e >> 1]) : bflo(v[e >> 1]); vbt[(size_t)(8 * i + e) * 128] = f2bf(pv * rs * vg[8 * i + e]); } }
}
DI void b0_task_sample(const Ctx& c, int l, int bs) {
    const float* ps = WSP(float, WS_PS) + (size_t)bs * NPS;
    if (c.lane < 4) { const int hh = c.lane;
        WSP(float, WS_GS)[bs * 4 + hh] = -__expf(c.A_log[l * 4 + hh]) * softplus_f(ps[3072 + hh] + c.dt_bias[l * 4 + hh]);
        WSP(float, WS_BS)[bs * 4 + hh] = sigmoid_f(ps[3076 + hh]); }
    const float* sc = c.state_conv + (size_t)(l * SBATCH + bs) * 3 * QKV;
    const float* cw = c.conv_w + (size_t)l * 4 * QKV;
    float* ocs = c.out + O_CS + (size_t)(l * SBATCH + bs) * 3 * QKV;
    float* qkvs = WSP(float, WS_QS) + bs * 512;
#pragma unroll 1
    for (int sh = 0; sh < 12; ++sh) {
        float y[2];
#pragma unroll
        for (int t = 0; t < 2; ++t) { const int ch = sh * 128 + t * 64 + c.lane; const float s0 = sc[ch], s1 = sc[QKV + ch], s2 = sc[2 * QKV + ch], cur = ps[ch];
            ocs[ch] = s1; ocs[QKV + ch] = s2; ocs[2 * QKV + ch] = cur;
            y[t] = silu_f(s0 * cw[ch] + s1 * cw[QKV + ch] + s2 * cw[2 * QKV + ch] + cur * cw[3 * QKV + ch]); }
        float scale = 1.0f;
        if (sh < 8) { const float ssum = wave_sum(y[0] * y[0] + y[1] * y[1], c.lane); scale = rsqrtf(ssum + EPS) * (sh < 4 ? 0.08838834764831845f : 1.0f); }
        float* o = qkvs + (size_t)(sh >> 2) * SBATCH * 512 + (sh & 3) * 128;
        o[c.lane] = y[0] * scale; o[64 + c.lane] = y[1] * scale;
    }
    float pv[8]; float ss = 0.f;
#pragma unroll
    for (int i = 0; i < 8; ++i) { pv[i] = ps[2560 + c.lane + 64 * i]; ss += pv[i] * pv[i]; }
    ss = wave_sum(ss, c.lane); const float rs = rsqrtf(ss * (1.0f / 512.0f) + EPS);
    float* am = WSP(float, WS_AMIXS) + (size_t)bs * DM; float* ovs = c.out + O_VS + (size_t)(l * SBATCH + bs) * 512;
#pragma unroll
    for (int i = 0; i < 8; ++i) { const int ch = c.lane + 64 * i, hb = ch >> 7; const float vb = pv[i] * rs * c.v_norm_g[l * 512 + ch];
        ovs[ch] = vb; am[512 + ch] = ps[2048 + ch] * (c.w_s[(size_t)(l * 4 + hb) * 128 * 128] * vb + c.b_s[(l * 4 + hb) * 128]); }
}
DI void phase_b0(const Ctx& c, int l, LAS unsigned char* lds) {
    for (int ch = c.bx; ch < 256; ch += c.nb) b0_block_ab(c, l, ch, lds);
    constexpr int NPT = 256 * 12;
    LAS unsigned char* wl = lds + c.wave * B0_WAVE_LDS;
    for (int t = c.wave * c.nb + c.bx; t < NPT + SBATCH; t += c.ngw) {
        if (t >= NPT) { if (SUB(0)) b0_task_sample(c, l, t - NPT); continue; }
        const int chunk = t / 12, k = t % 12, b = chunk >> 5, n = chunk & 31;
        if (SUB(3)) b0_task_conv(c, l, b, n, k >> 2, k & 3, wl);
    }
}

DI void b1_prep(const Ctx& c, int l, int unit, LAS unsigned char* wl, LAS float* sg, LAS float* sb) {
    int lane = c.lane; asm volatile("" : "+v"(lane));
    const int r = lane & 31, h = lane >> 5;
    const int n = unit & 31, bh = unit >> 5, hh = bh & 3, b = bh >> 2, tok0 = b * SEQ + n * 64;
    const float bt = WSP(float, WS_BETA)[(tok0 + lane) * 4 + hh];
    float gc = WSP(float, WS_G)[(tok0 + lane) * 4 + hh];
#pragma unroll
    for (int o = 1; o < 64; o <<= 1) { const float t = xlane(gc, lane - o); if (lane >= o) gc += t; }
    sg[lane] = gc; sb[lane] = bt;
    const float glast = __builtin_bit_cast(float, __builtin_amdgcn_readlane(__builtin_bit_cast(int, gc), 63));
    if (lane == 0) WSP(float, WS_EG)[unit] = __expf(glast);
    unsigned char* img = c.ws + WS_IMG + (size_t)unit * IMG_BYTES;
    const bf16_t* Kn = WSP(bf16_t, WS_KN) + (size_t)tok0 * 512 + hh * 128;
    const bf16_t* Qn = WSP(bf16_t, WS_QN) + (size_t)tok0 * 512 + hh * 128;
    const bf16_t* KnT = WSP(bf16_t, WS_KNT) + (size_t)unit * 128 * 64;
    const bf16_t* VT = WSP(bf16_t, WS_VT) + (size_t)unit * 128 * 64;
    LAS float* L = (LAS float*)wl;
    {
        bf16x8 Kf[2][8];
#pragma unroll
        for (int t = 0; t < 2; ++t)
#pragma unroll
            for (int ks = 0; ks < 8; ++ks) Kf[t][ks] = *(const bf16x8*)(Kn + (size_t)(32 * t + r) * 512 + 16 * ks + 8 * h);
#pragma unroll
        for (int tt = 0; tt < 3; ++tt) { const int mt = tt == 0 ? 0 : 1, nt = tt == 2 ? 1 : 0;
            f32x16 acc = zero16();
#pragma unroll
            for (int ks = 0; ks < 8; ++ks) acc = MFMA32(Kf[mt][ks], Kf[nt][ks], acc);
            const int j = 32 * nt + r; const float gj = sg[j];
#pragma unroll
            for (int g4 = 0; g4 < 4; ++g4) { const f32x4 gi4 = *(const LAS f32x4*)(sg + 32 * mt + 8 * g4 + 4 * h), bi4 = *(const LAS f32x4*)(sb + 32 * mt + 8 * g4 + 4 * h);
#pragma unroll
                for (int q = 0; q < 4; ++q) { const int i = 32 * mt + 8 * g4 + 4 * h + q; const float arg = i > j ? gi4[q] - gj : 0.f;
                    L[i * 64 + j] = i > j ? acc[4 * g4 + q] * bi4[q] * __expf(arg) : 0.f; } } }
#pragma unroll
        for (int mt = 0; mt < 2; ++mt) {
            bf16x8 Qf[8];
#pragma unroll
            for (int ks = 0; ks < 8; ++ks) Qf[ks] = *(const bf16x8*)(Qn + (size_t)(32 * mt + r) * 512 + 16 * ks + 8 * h);
            const int i = 32 * mt + r; const float gi = sg[i];
#pragma unroll
            for (int mp = 0; mp <= mt; ++mp) {
                f32x16 acc = zero16();
#pragma unroll
                for (int ks = 0; ks < 8; ++ks) acc = MFMA32(Kf[mp][ks], Qf[ks], acc);
#pragma unroll
                for (int g4 = 0; g4 < 4; ++g4) { const f32x4 gj4 = *(const LAS f32x4*)(sg + 32 * mp + 8 * g4 + 4 * h);
#pragma unroll
                    for (int q = 0; q < 4; ++q) { const int j = 32 * mp + 8 * g4 + 4 * h + q; const float arg = i >= j ? gi - gj4[q] : 0.f;
                        acc[4 * g4 + q] = i >= j ? acc[4 * g4 + q] * __expf(arg) : 0.f; } }
                const int fb = (mt == 0 ? 0 : 1 + mp) * 2;
#pragma unroll
                for (int s = 0; s < 2; ++s) *(u32x4*)(img + 49152 + (fb + s) * 1024 + lane * 16) = pack8(acc, s);
            }
        }
    }
    float Tr[64];
    {
        f32x4 lb[2][16];
#pragma unroll
        for (int i = 0; i < 64; ++i) {
            if (i + 1 < 64) {
#pragma unroll
                for (int j4 = 0; j4 < (i + 1 + 3) / 4; ++j4) lb[(i + 1) & 1][j4] = *(const LAS f32x4*)(L + (i + 1) * 64 + 4 * j4); }
            asm volatile("" ::: "memory");
            float a0 = lane == i ? 1.f : 0.f, a1 = 0.f;
#pragma unroll
            for (int j4 = 0; j4 < (i + 3) / 4; ++j4) {
#pragma unroll
                for (int q = 0; q < 4; ++q) { const int j = 4 * j4 + q; if (j < i) { if (q & 1) a1 -= lb[i & 1][j4][q] * Tr[j]; else a0 -= lb[i & 1][j4][q] * Tr[j]; } } }
            Tr[i] = a0 + a1;
        }
    }
    LAS bf16_t* T1 = (LAS bf16_t*)wl;
    asm volatile("" ::: "memory");
    {
        const float sc1 = bt * __expf(gc);
#pragma unroll
        for (int i = 0; i < 64; ++i) T1[i * 72 + lane] = f2bf(Tr[i] * sc1);
        bf16x8 Tf[2][4];
#pragma unroll
        for (int mt = 0; mt < 2; ++mt)
#pragma unroll
            for (int ks = 0; ks < 4; ++ks) Tf[mt][ks] = *(const LAS bf16x8*)(T1 + (32 * mt + r) * 72 + 16 * ks + 8 * h);
#pragma unroll
        for (int dt = 0; dt < 4; ++dt) {
            bf16x8 Kt[4];
#pragma unroll
            for (int ks = 0; ks < 4; ++ks) Kt[ks] = *(const bf16x8*)(KnT + (size_t)(32 * dt + r) * 64 + 16 * ks + 8 * h);
#pragma unroll
            for (int mt = 0; mt < 2; ++mt) { f32x16 acc = zero16();
#pragma unroll
                for (int ks = 0; ks < 2 * (mt + 1); ++ks) acc = MFMA32(Kt[ks], Tf[mt][ks], acc);
                acc = -acc;
#pragma unroll
                for (int s = 0; s < 2; ++s) *(u32x4*)(img + ((mt * 4 + dt) * 2 + s) * 1024 + lane * 16) = pack8(acc, s); }
        }
    }
    asm volatile("" ::: "memory");
    {
#pragma unroll
        for (int i = 0; i < 64; ++i) T1[i * 72 + lane] = f2bf(Tr[i] * bt);
        bf16x8 Tf[2][4];
#pragma unroll
        for (int mt = 0; mt < 2; ++mt)
#pragma unroll
            for (int ks = 0; ks < 4; ++ks) Tf[mt][ks] = *(const LAS bf16x8*)(T1 + (32 * mt + r) * 72 + 16 * ks + 8 * h);
        bf16_t* uimg = WSP(bf16_t, WS_UIMG) + (size_t)unit * 8192;
#pragma unroll
        for (int et = 0; et < 4; ++et) {
            bf16x8 Vt[4];
#pragma unroll
            for (int ks = 0; ks < 4; ++ks) Vt[ks] = *(const bf16x8*)(VT + (size_t)(32 * et + r) * 64 + 16 * ks + 8 * h);
#pragma unroll
            for (int mt = 0; mt < 2; ++mt) { f32x16 acc = zero16();
#pragma unroll
                for (int ks = 0; ks < 2 * (mt + 1); ++ks) acc = MFMA32(Tf[mt][ks], Vt[ks], acc);
#pragma unroll
                for (int g4 = 0; g4 < 4; ++g4) { u32x2 w; w.x = pk2(acc[4 * g4], acc[4 * g4 + 1]); w.y = pk2(acc[4 * g4 + 2], acc[4 * g4 + 3]); *(u32x2*)(uimg + ((et * 2 + mt) * 4 + g4) * 256 + lane * 4) = w; } }
        }
    }
    asm volatile("" ::: "memory");
#pragma unroll
    for (int mt = 0; mt < 2; ++mt) { const float ei = __expf(sg[32 * mt + r]);
#pragma unroll
        for (int dt = 0; dt < 4; ++dt)
#pragma unroll
            for (int s = 0; s < 2; ++s) { const bf16_t* qp = Qn + (size_t)(32 * mt + r) * 512 + 32 * dt + 16 * s + 4 * h;
                const u32x2 p0 = *(const u32x2*)qp, p1 = *(const u32x2*)(qp + 8);
                u32x4 w; w.x = pk2(bflo(p0.x) * ei, bfhi(p0.x) * ei); w.y = pk2(bflo(p0.y) * ei, bfhi(p0.y) * ei); w.z = pk2(bflo(p1.x) * ei, bfhi(p1.x) * ei); w.w = pk2(bflo(p1.y) * ei, bfhi(p1.y) * ei);
                *(u32x4*)(img + 16384 + ((mt * 4 + dt) * 2 + s) * 1024 + lane * 16) = w; } }
#pragma unroll
    for (int mp = 0; mp < 2; ++mp)
#pragma unroll
        for (int s = 0; s < 2; ++s) { const f32x4 ga = *(const LAS f32x4*)(sg + 32 * mp + 16 * s + 4 * h), gb = *(const LAS f32x4*)(sg + 32 * mp + 16 * s + 8 + 4 * h);
            float sc[8];
#pragma unroll
            for (int q = 0; q < 4; ++q) { sc[q] = __expf(glast - ga[q]); sc[4 + q] = __expf(glast - gb[q]); }
#pragma unroll
            for (int dt = 0; dt < 4; ++dt) { const bf16_t* kp = KnT + (size_t)(32 * dt + r) * 64 + 32 * mp + 16 * s + 4 * h;
                const u32x2 p0 = *(const u32x2*)kp, p1 = *(const u32x2*)(kp + 8);
                u32x4 w; w.x = pk2(bflo(p0.x) * sc[0], bfhi(p0.x) * sc[1]); w.y = pk2(bflo(p0.y) * sc[2], bfhi(p0.y) * sc[3]); w.z = pk2(bflo(p1.x) * sc[4], bfhi(p1.x) * sc[5]); w.w = pk2(bflo(p1.y) * sc[6], bfhi(p1.y) * sc[7]);
                *(u32x4*)(img + 32768 + ((dt * 2 + mp) * 2 + s) * 1024 + lane * 16) = w; } }
}
DI void b1_gmlp(const Ctx& c, int l, int unit) {
    int lane = c.lane; asm volatile("" : "+v"(lane));
    const int r = lane & 31, h = lane >> 5;
    const int hb = unit & 3, cc = (unit >> 2) & 15, b = unit >> 6, tokc0 = b * SEQ + cc * 128;
    const bf16_t* A = WSP(bf16_t, WS_VBT) + (size_t)unit * 128 * 128;
    const bf16_t* B = WSP(bf16_t, WS_WM) + (size_t)(l * 4 + hb) * 128 * 128;
    const bf16_t* P = WSP(bf16_t, WS_P); bf16_t* AM = WSP(bf16_t, WS_AMIX);
#pragma unroll
    for (int nt = 0; nt < 4; ++nt) {
        f32x16 acc[4];
#pragma unroll
        for (int mt = 0; mt < 4; ++mt) acc[mt] = zero16();
#pragma unroll
        for (int ks = 0; ks < 2 * (nt + 1); ++ks) { const bf16x8 bf = *(const bf16x8*)(B + (size_t)(32 * nt + r) * 128 + 16 * ks + 8 * h);
#pragma unroll
            for (int mt = 0; mt < 4; ++mt) { const bf16x8 af = *(const bf16x8*)(A + (size_t)(32 * mt + r) * 128 + 16 * ks + 8 * h); acc[mt] = MFMA32(af, bf, acc[mt]); } }
        const int tok = tokc0 + 32 * nt + r; const float bsi = c.b_s[(l * 4 + hb) * 128 + 32 * nt + r];
#pragma unroll
        for (int mt = 0; mt < 4; ++mt)
#pragma unroll
            for (int g4 = 0; g4 < 4; ++g4) { const int dch0 = 32 * mt + 8 * g4 + 4 * h;
                const u32x2 u4 = *(const u32x2*)(P + (size_t)tok * NP + 2048 + hb * 128 + dch0);
                u32x2 w; w.x = pk2(bflo(u4.x) * (acc[mt][4 * g4] + bsi), bfhi(u4.x) * (acc[mt][4 * g4 + 1] + bsi)); w.y = pk2(bflo(u4.y) * (acc[mt][4 * g4 + 2] + bsi), bfhi(u4.y) * (acc[mt][4 * g4 + 3] + bsi));
                *(u32x2*)(AM + (size_t)tok * DM + 512 + hb * 128 + dch0) = w; }
    }
}
DI void phase_b1(const Ctx& c, int l, LAS unsigned char* lds) {
    LAS unsigned char* wl = lds + c.wave * 16384; LAS float* sg = (LAS float*)(lds + 131072 + c.wave * 512); LAS float* sb = sg + 64;
    for (int t = c.wave < 4 ? c.bx * 4 + c.wave : 1024; t < 1024; t += c.nb * 4) {
        if (SUB(0)) b1_prep(c, l, t, wl, sg, sb);
    }
}


constexpr int OB_STRIDE = 136;
constexpr int IMG_LDS = 57344;
constexpr int LDS_OBUF = 2 * IMG_LDS, OBUF_BYTES = 64 * OB_STRIDE * 2;
static_assert(LDS_OBUF + 2 * OBUF_BYTES <= LDS_BYTES, "scan LDS");
DI void scan_post(const Ctx& c, int l, int b, int hh, int n, const LAS bf16_t* ob, int lid, const u32x4 (&gt4)[4]) {
    const int i = lid >> 2, q = lid & 3, tok = b * SEQ + n * 64 + i;
    u32x4 ov[4]; float ss = 0.f;
#pragma unroll
    for (int x = 0; x < 4; ++x) { ov[x] = *(const LAS u32x4*)(ob + i * OB_STRIDE + 32 * q + 8 * x);
#pragma unroll
        for (int e = 0; e < 4; ++e) { const float a = bflo(ov[x][e]), bq = bfhi(ov[x][e]); ss += a * a + bq * bq; } }
    ss += xlane(ss, (lid & 63) ^ 1); ss += xlane(ss, (lid & 63) ^ 2);
    const float rs = rsqrtf(ss * (1.0f / 128.0f) + EPS);
    bf16_t* op = WSP(bf16_t, WS_AMIX) + (size_t)tok * DM + hh * 128 + 32 * q;
#pragma unroll
    for (int x = 0; x < 4; ++x) { u32x4 w;
#pragma unroll
        for (int e = 0; e < 4; ++e) w[e] = pk2(bflo(ov[x][e]) * rs * bflo(gt4[x][e]), bfhi(ov[x][e]) * rs * bfhi(gt4[x][e]));
        *(u32x4*)(op + 8 * x) = w; }
}
DI void scan_loader_step(const Ctx& c, int l, int b, int hh, int n, LAS unsigned char* lds, const unsigned char* img0, const bf16_t* gbase, int lw, int lane, int lid, u32x4 (&regs)[14], u32x4 (&gt)[4]) {
    u32x4 gcur[4];
#pragma unroll
    for (int x = 0; x < 4; ++x) gcur[x] = gt[x];
#pragma unroll
    for (int x = 0; x < 4; ++x) gt[x] = *(const u32x4*)(gbase + (size_t)n * 64 * NP + 8 * x);
    const unsigned voff = (unsigned)(lw * 14336 + lane * 16);
    if (n + 1 < 32) { LAS unsigned char* dst = lds + ((n + 1) & 1) * IMG_LDS + voff;
#pragma unroll
        for (int i = 0; i < 14; ++i) *(LAS u32x4*)(dst + i * 1024) = regs[i]; }
    if (n + 3 < 32) { const unsigned char* src = img0 + (size_t)(n + 3) * IMG_BYTES;
#pragma unroll
        for (int i = 0; i < 14; ++i) regs[i] = *(const u32x4*)(src + voff + i * 1024); }
    if (n >= 1) scan_post(c, l, b, hh, n - 1, (const LAS bf16_t*)(lds + LDS_OBUF + ((n - 1) & 1) * OBUF_BYTES), lid, gcur);
    __syncthreads();
}
DI void scan_consumer_step(int n, LAS unsigned char* lds, f32x16 (&S)[4], u32x2 (&ucur)[8], float& egc, const bf16_t* uimg0, const float* egp, int lane, int ws, int r, int h) {
    const LAS unsigned char* buf = lds + (n & 1) * IMG_LDS + lane * 16;
    f32x16 av[2], ao[2]; ao[0] = zero16(); ao[1] = zero16();
#pragma unroll
    for (int mt = 0; mt < 2; ++mt)
#pragma unroll
        for (int g4 = 0; g4 < 4; ++g4) { const u32x2 w = ucur[mt * 4 + g4]; av[mt][4 * g4] = bflo(w.x); av[mt][4 * g4 + 1] = bfhi(w.x); av[mt][4 * g4 + 2] = bflo(w.y); av[mt][4 * g4 + 3] = bfhi(w.y); }
    const float eg = egc;
    if (n + 2 < 32) { const bf16_t* up = uimg0 + (size_t)(n + 2) * 8192;
#pragma unroll
        for (int x = 0; x < 8; ++x) ucur[x] = *(const u32x2*)(up + x * 256);
        egc = egp[n + 2]; }
    {
        bf16x8 fg[2][4];
#pragma unroll
        for (int mt = 0; mt < 2; ++mt) { fg[0][mt] = *(const LAS bf16x8*)(buf + (mt * 8) * 1024); fg[0][2 + mt] = *(const LAS bf16x8*)(buf + 16384 + (mt * 8) * 1024); }
#pragma unroll
        for (int gI = 0; gI < 8; ++gI) { const int dt = gI >> 1, s = gI & 1;
            if (gI + 1 < 8) {
#pragma unroll
                for (int mt = 0; mt < 2; ++mt) { fg[(gI + 1) & 1][mt] = *(const LAS bf16x8*)(buf + (mt * 8 + gI + 1) * 1024); fg[(gI + 1) & 1][2 + mt] = *(const LAS bf16x8*)(buf + 16384 + (mt * 8 + gI + 1) * 1024); } }
            asm volatile("" ::: "memory");
            const bf16x8 sb = as_bf(pack8(S[dt], s));
            av[0] = MFMA32(fg[gI & 1][0], sb, av[0]); av[1] = MFMA32(fg[gI & 1][1], sb, av[1]);
            ao[0] = MFMA32(sb, fg[gI & 1][2], ao[0]); ao[1] = MFMA32(sb, fg[gI & 1][3], ao[1]); }
    }
    bf16x8 vb[2][2];
#pragma unroll
    for (int mp = 0; mp < 2; ++mp)
#pragma unroll
        for (int s = 0; s < 2; ++s) vb[mp][s] = as_bf(pack8(av[mp], s));
    {
        bf16x8 qf[6];
#pragma unroll
        for (int f = 0; f < 6; ++f) qf[f] = *(const LAS bf16x8*)(buf + 49152 + f * 1024);
        asm volatile("" ::: "memory");
#pragma unroll
        for (int s = 0; s < 2; ++s) { ao[0] = MFMA32(vb[0][s], qf[s], ao[0]); ao[1] = MFMA32(vb[0][s], qf[2 + s], ao[1]); ao[1] = MFMA32(vb[1][s], qf[4 + s], ao[1]); }
    }
    LAS bf16_t* ob = (LAS bf16_t*)(lds + LDS_OBUF + (n & 1) * OBUF_BYTES);
#pragma unroll
    for (int mt = 0; mt < 2; ++mt)
#pragma unroll
        for (int g4 = 0; g4 < 4; ++g4) { u32x2 w; w.x = pk2(ao[mt][4 * g4], ao[mt][4 * g4 + 1]); w.y = pk2(ao[mt][4 * g4 + 2], ao[mt][4 * g4 + 3]);
            *(LAS u32x2*)(ob + (32 * mt + r) * OB_STRIDE + 32 * ws + 8 * g4 + 4 * h) = w; }
    bf16x8 kf[2][4];
#pragma unroll
    for (int f = 0; f < 4; ++f) kf[0][f] = *(const LAS bf16x8*)(buf + 32768 + f * 1024);
#pragma unroll
    for (int dt = 0; dt < 4; ++dt) {
        if (dt + 1 < 4) {
#pragma unroll
            for (int f = 0; f < 4; ++f) kf[(dt + 1) & 1][f] = *(const LAS bf16x8*)(buf + 32768 + ((dt + 1) * 4 + f) * 1024); }
        asm volatile("" ::: "memory");
        S[dt] = S[dt] * eg;
#pragma unroll
        for (int mp = 0; mp < 2; ++mp)
#pragma unroll
            for (int s = 0; s < 2; ++s) S[dt] = MFMA32(kf[dt & 1][mp * 2 + s], vb[mp][s], S[dt]); }
    __syncthreads();
}
DI void scan_block(const Ctx& c, int l, int bh, LAS unsigned char* lds) {
    const int wave = c.wave, b = bh >> 2, hh = bh & 3;
    const unsigned char* img0 = c.ws + WS_IMG + (size_t)bh * 32 * IMG_BYTES;
    if (wave >= 4) { if (SUB2(0)) {
        int lane = c.lane; asm volatile("" : "+v"(lane));
        const int lw = wave - 4, lid = lw * 64 + lane;
        u32x4 regs0[14], regs1[14], gt0[4];
        const bf16_t* gbase = WSP(bf16_t, WS_P) + (size_t)(b * SEQ + (lid >> 2)) * NP + 1536 + hh * 128 + 32 * (lid & 3);
        const unsigned voff0 = (unsigned)(lw * 14336 + lane * 16);
#pragma unroll
        for (int i = 0; i < 14; ++i) regs0[i] = *(const u32x4*)(img0 + voff0 + i * 1024);
#pragma unroll
        for (int i = 0; i < 14; ++i) *(LAS u32x4*)(lds + voff0 + i * 1024) = regs0[i];
#pragma unroll
        for (int i = 0; i < 14; ++i) { regs1[i] = *(const u32x4*)(img0 + (size_t)IMG_BYTES + voff0 + i * 1024); regs0[i] = *(const u32x4*)(img0 + (size_t)2 * IMG_BYTES + voff0 + i * 1024); }
#pragma unroll
        for (int x = 0; x < 4; ++x) gt0[x] = (u32x4){0u, 0u, 0u, 0u};
        __syncthreads();
        for (int n = 0; n < 32; n += 2) {
            scan_loader_step(c, l, b, hh, n, lds, img0, gbase, lw, lane, lid, regs1, gt0);
            scan_loader_step(c, l, b, hh, n + 1, lds, img0, gbase, lw, lane, lid, regs0, gt0);
        }
        scan_post(c, l, b, hh, 31, (const LAS bf16_t*)(lds + LDS_OBUF + (31 & 1) * OBUF_BYTES), lid, gt0);
    } } else if (SUB2(1)) {
        int lane = c.lane; asm volatile("" : "+v"(lane));
        const int ws = wave, r = lane & 31, h = lane >> 5;
        f32x16 S[4];
#pragma unroll
        for (int dt = 0; dt < 4; ++dt) S[dt] = zero16();
        const bf16_t* uimg0 = WSP(bf16_t, WS_UIMG) + (size_t)bh * 32 * 8192 + (size_t)ws * 2 * 4 * 256 + lane * 4;
        const float* egp = WSP(float, WS_EG) + bh * 32;
        u32x2 u0[8], u1[8];
#pragma unroll
        for (int x = 0; x < 8; ++x) { u0[x] = *(const u32x2*)(uimg0 + x * 256); u1[x] = *(const u32x2*)(uimg0 + 8192 + x * 256); }
        float eg0 = egp[0], eg1 = egp[1];
        __syncthreads();
        for (int n = 0; n < 32; n += 2) {
            scan_consumer_step(n, lds, S, u0, eg0, uimg0, egp, lane, ws, r, h);
            scan_consumer_step(n + 1, lds, S, u1, eg1, uimg0, egp, lane, ws, r, h);
        }
        const char* od = (const char*)(c.out + O_DP + (size_t)(l * 32 + bh) * 128 * 128);
        unsigned voff = (unsigned)((4 * h) * 128 + 32 * ws + r) * 4u;
        asm volatile("" : "+v"(voff));
#pragma unroll
        for (int dt = 0; dt < 4; ++dt)
#pragma unroll
            for (int reg = 0; reg < 16; ++reg) *(float*)(od + (32 * dt + (reg & 3) + 8 * (reg >> 2)) * 512 + voff) = S[dt][reg];
    }
}
DI float rdlane(float v, int l) { return __builtin_bit_cast(float, __builtin_amdgcn_readlane(__builtin_bit_cast(int, v), l)); }
DI void sample_recurrent(const Ctx& c, int l, int unit) {
    int lane = c.lane; asm volatile("" : "+v"(lane));
    const int bs = unit >> 2, hh = unit & 3, e2 = 2 * lane;
    const float* S0 = c.state_delta + (size_t)((l * SBATCH + bs) * 4 + hh) * 128 * 128 + e2;
    float* S1 = c.out + O_DS + (size_t)((l * SBATCH + bs) * 4 + hh) * 128 * 128 + e2;
    const float* q = WSP(float, WS_QS) + bs * 512 + hh * 128; const float* k = WSP(float, WS_KS) + bs * 512 + hh * 128; const float* v = WSP(float, WS_VS) + bs * 512 + hh * 128;
    const float eg = __expf(WSP(float, WS_GS)[bs * 4 + hh]), beta = WSP(float, WS_BS)[bs * 4 + hh];
    const float k0 = k[lane], k1 = k[64 + lane], q0 = q[lane], q1 = q[64 + lane];
    f32x2 kv = {0.f, 0.f};
#pragma unroll
    for (int d0 = 0; d0 < 128; d0 += 32) { f32x2 sv[32];
#pragma unroll
        for (int j = 0; j < 32; ++j) sv[j] = *(const f32x2*)(S0 + (d0 + j) * 128);
#pragma unroll
        for (int j = 0; j < 32; ++j) { const int dd = d0 + j; kv += sv[j] * rdlane(dd < 64 ? k0 : k1, dd & 63); } }
    const f32x2 v2 = *(const f32x2*)(v + e2);
    const f32x2 delta = (v2 - kv * eg) * beta;
    f32x2 oo = {0.f, 0.f};
#pragma unroll
    for (int d0 = 0; d0 < 128; d0 += 32) { f32x2 sv[32];
#pragma unroll
        for (int j = 0; j < 32; ++j) sv[j] = *(const f32x2*)(S0 + (d0 + j) * 128);
#pragma unroll
        for (int j = 0; j < 32; ++j) { const int dd = d0 + j; const f32x2 sn = sv[j] * eg + delta * rdlane(dd < 64 ? k0 : k1, dd & 63); oo += sn * rdlane(dd < 64 ? q0 : q1, dd & 63); *(f32x2*)(S1 + dd * 128) = sn; } }
    const float ss = wave_sum(oo.x * oo.x + oo.y * oo.y, lane); const float rs = rsqrtf(ss * (1.0f / 128.0f) + EPS);
    const float* ps = WSP(float, WS_PS) + (size_t)bs * NPS + 1536 + hh * 128 + e2; float* am = WSP(float, WS_AMIXS) + (size_t)bs * DM + hh * 128 + e2;
    const float* og = c.o_norm_g + l * 128 + e2;
    am[0] = oo.x * rs * og[0] * silu_f(ps[0]); am[1] = oo.y * rs * og[1] * silu_f(ps[1]);
}
DI void phase_scan(const Ctx& c, int l, LAS unsigned char* lds) {
    if (c.bx < 32) { if (SUB(0)) scan_block(c, l, c.bx, lds); return; }
    const int w0 = (c.bx - 32) * 8 + c.wave, nw = (c.nb - 32) * 8;
    LAS unsigned char* wl = lds + c.wave * B0_WAVE_LDS;
    for (int u = w0; u < SBATCH * 4 + 512; u += nw) {
        if (u < SBATCH * 4) { if (SUB(1)) sample_recurrent(c, l, u); continue; }
        const int g = u - SBATCH * 4, hb = g & 3, cc = (g >> 2) & 15, b = g >> 6;
        b0_task_vb(c, l, b, 2 * cc, hb, wl); b0_task_vb(c, l, b, 2 * cc + 1, hb, wl);
        asm volatile("s_waitcnt vmcnt(0)" ::: "memory");
        b1_gmlp(c, l, g);
    }
    if (l + 1 < DEPTH) convert_layer_weights(c, l + 1, w0, nw, lds);

}

DI void phase_final(const Ctx& c) {
    const f32x4* gr = (const f32x4*)c.norm_f_g + c.lane;
    for (int m = c.gw; m < MP + SBATCH; m += c.ngw) {
        f32x4 v[4]; float s = 0.f;
        if (m < MP) { const u32x2* xr = (const u32x2*)(WSP(bf16_t, WS_XB16) + (size_t)m * DM) + c.lane;
#pragma unroll
            for (int j = 0; j < 4; ++j) { const u32x2 w = xr[64 * j]; v[j] = (f32x4){bflo(w.x), bfhi(w.x), bflo(w.y), bfhi(w.y)}; } }
        else { const f32x4* xr = (const f32x4*)(WSP(float, WS_XS) + (size_t)(m - MP) * DM) + c.lane;
#pragma unroll
            for (int j = 0; j < 4; ++j) v[j] = xr[64 * j]; }
        float* dst = m < MP ? c.out + O_YP + (size_t)m * DM : c.out + O_YS + (size_t)(m - MP) * DM;
#pragma unroll
        for (int j = 0; j < 4; ++j) s += (v[j].x * v[j].x + v[j].y * v[j].y) + (v[j].z * v[j].z + v[j].w * v[j].w);
        const float rs = rsqrtf(wave_sum(s, c.lane) * (1.0f / DM) + EPS);
#pragma unroll
        for (int j = 0; j < 4; ++j) ((f32x4*)dst + c.lane)[64 * j] = v[j] * rs * gr[64 * j];
    }
}

#define XB_TMO      128
#define XB_XCNT(j)  (256  + 64 * (j))
#define XB_XSUB(j)  (1280 + 64 * (j))
#define XB_XGEN(j)  (2304 + 64 * (j))
#define XB_TOP      3328
#define XB_TOPGEN   3392
#define XCD_BAR_WORDS 3456
#define XB_SPIN_CAP (1u << 18)

__device__ __forceinline__ unsigned xb_ld(unsigned* p)              { return __hip_atomic_load(p, __ATOMIC_RELAXED, __HIP_MEMORY_SCOPE_AGENT); }
__device__ __forceinline__ unsigned xb_add(unsigned* p, unsigned v) { return __hip_atomic_fetch_add(p, v, __ATOMIC_RELAXED, __HIP_MEMORY_SCOPE_AGENT); }
__device__ __forceinline__ unsigned xb_xcc_id() { return (unsigned)__builtin_amdgcn_s_getreg((3 << 11) | 20) & 0xFu; }
#define XB_SPIN(cond, bar) do { unsigned _sp = 0; while (cond) { __builtin_amdgcn_s_sleep(8); \
    if ((++_sp & 255u) == 0u) { if (xb_ld(&(bar)[XB_TMO])) break; if (_sp > XB_SPIN_CAP) { atomicAdd(&(bar)[XB_TMO], 1u); break; } } } } while (0)

struct XcdBarrier {
    unsigned* bar; unsigned x;
    volatile LAS unsigned* st;
};

__device__ __forceinline__ XcdBarrier xcd_barrier_post(unsigned* bar, volatile LAS unsigned* st) {
    XcdBarrier b; b.bar = bar; b.x = xb_xcc_id(); b.st = st;
    if (threadIdx.x == 0) (void)xb_add(&bar[XB_XCNT(b.x)], 1u);
    return b;
}
__device__ __forceinline__ void xcd_barrier_complete(unsigned* bar, unsigned x, unsigned& nloc, unsigned& nx) {
    const unsigned G = gridDim.x * gridDim.y * gridDim.z;
    unsigned sum, cnt, mine, sp = 0u;
    for (;;) {
        sum = 0u; cnt = 0u; mine = 0u;
#pragma unroll
        for (unsigned j = 0; j < 16; ++j) { const unsigned c = xb_ld(&bar[XB_XCNT(j)]); sum += c; cnt += (c > 0u) ? 1u : 0u; mine = (j == x) ? c : mine; }
        if (sum == G) break;
        __builtin_amdgcn_s_sleep(1);
        if ((++sp & 255u) == 0u) { if (xb_ld(&bar[XB_TMO])) break; if (sp > XB_SPIN_CAP) { atomicAdd(&bar[XB_TMO], 1u); break; } }
    }
    nloc = mine > 0u ? mine : 1u; nx = cnt > 0u ? cnt : 1u;
}

__device__ __forceinline__ void xcd_barrier(const XcdBarrier& b) {
    asm volatile("s_waitcnt vmcnt(0)" ::: "memory");
    __syncthreads();
    if (threadIdx.x == 0) {
        unsigned* bar = b.bar;
        __builtin_amdgcn_s_waitcnt(0);
        unsigned nloc = b.st[0], nx = b.st[1];
        if (nloc == 0u) { xcd_barrier_complete(bar, b.x, nloc, nx); b.st[0] = nloc; b.st[1] = nx; }
        const unsigned old = xb_add(&bar[XB_XSUB(b.x)], 1u);
        const unsigned gen = old / nloc;
        if (old + 1u == (gen + 1u) * nloc) {
            __builtin_amdgcn_fence(__ATOMIC_RELEASE, "agent");
            asm volatile("s_waitcnt vmcnt(0)" ::: "memory");
            const unsigned og = xb_add(&bar[XB_TOP], 1u);
            const unsigned tg = og / nx;
            if (og + 1u == (tg + 1u) * nx) xb_add(&bar[XB_TOPGEN], 1u);
            else XB_SPIN(xb_ld(&bar[XB_TOPGEN]) == tg, bar);
            __builtin_amdgcn_fence(__ATOMIC_ACQUIRE, "agent");
            xb_add(&bar[XB_XGEN(b.x)], 1u);
            asm volatile("s_waitcnt vmcnt(0)" ::: "memory");
        } else {
            XB_SPIN(xb_ld(&bar[XB_XGEN(b.x)]) == gen, bar);
            __builtin_amdgcn_fence(__ATOMIC_ACQUIRE, "agent");
            asm volatile("s_waitcnt vmcnt(0)" ::: "memory");
        }
    }
    __syncthreads();
}
#ifndef ONLY
#define ONLY -1
#endif
#ifndef REPMASK
#define REPMASK 0
#endif
#define EN(x) (ONLY < 0 || ONLY == (x))
__global__ void __launch_bounds__(512, 2) hymba_fwd(Args args) {
    extern __shared__ __attribute__((aligned(16))) unsigned char lds_raw[];
    LAS unsigned char* lds = (LAS unsigned char*)lds_raw;
    cg::grid_group grid = cg::this_grid();
    Ctx c;
    c.x_prompt = args.in[0]; c.x_sample = args.in[1]; c.state_delta = args.in[2]; c.state_conv = args.in[3]; c.norm_mix_g = args.in[4]; c.w_in = args.in[5]; c.conv_w = args.in[6];
    c.A_log = args.in[7]; c.dt_bias = args.in[8]; c.o_norm_g = args.in[9]; c.v_norm_g = args.in[10]; c.w_s = args.in[11]; c.b_s = args.in[12]; c.w_o = args.in[13]; c.norm_ffn_g = args.in[14];
    c.w_up = args.in[15]; c.w_down = args.in[16]; c.norm_f_g = args.in[17]; c.out = args.out; c.ws = args.ws;
    c.lane = threadIdx.x & 63; c.wave = __builtin_amdgcn_readfirstlane(threadIdx.x >> 6); c.gw = blockIdx.x * 8 + c.wave; c.ngw = gridDim.x * 8; c.bx = blockIdx.x; c.nb = gridDim.x;
    volatile LAS unsigned* bst = (volatile LAS unsigned*)(lds + LDS_BYTES - 16);
    if (threadIdx.x < 2) bst[threadIdx.x] = 0u;
    __syncthreads();
    XcdBarrier xbar = xcd_barrier_post((unsigned*)args.ws, bst);
    grid.sync();
    for (int step = 2 * args.ph_lo; step < 2 * args.ph_hi; ++step) {
        const int ph = step >> 1;
        const int ptype = ph == 0 ? 0 : (ph == 29 ? 8 : 1 + (ph - 1) % 7);
        if ((step & 1) && !((REPMASK >> ptype) & 1)) continue;
        { int tl = threadIdx.x; asm volatile("" : "+v"(tl)); c.lane = tl & 63; int bxo = blockIdx.x, nbo = gridDim.x; asm volatile("" : "+s"(bxo), "+s"(nbo)); c.bx = bxo; c.nb = nbo; c.wave = __builtin_amdgcn_readfirstlane(tl >> 6); c.gw = bxo * 8 + c.wave; c.ngw = nbo * 8; unsigned char* wsp = args.ws; asm volatile("" : "+s"(wsp)); c.ws = wsp; float* op = args.out; asm volatile("" : "+s"(op)); c.out = op; }
        if (step & 1) __syncthreads();
        if (ph == 0) { if (EN(0)) phase_prologue(c, lds); }
        else if (ph == 29) { if (EN(8)) phase_final(c); }
        else {
            const int l = (ph - 1) / 7, s = (ph - 1) % 7;
            float* ssq = WSP(float, WS_SSQ);
            if (s == 0) { if (EN(1)) { sgemm1(c, l, lds); if ((REPMASK >> 10) & 1) sgemm1(c, l, lds);
                pg8::Gemm g{WSP(bf16_t, WS_XB16), WSP(bf16_t, WS_WIN) + (size_t)l * NP * DM, MP, NP, DM}; pg8::StaticOrder S; S.init(MP, NP, c.nb, c.bx);
                pg8::EpiScaleBf16 E{WSP(bf16_t, WS_P), NP, ssq + (size_t)(2 * l) * MP * 16, 0, WSP(float, WS_VSS), c.o_norm_g + l * 128}; pg8::gemm_phase(lds, g, S, E); } }
            else if (s == 1) { if (EN(2)) phase_b0(c, l, lds); }
            else if (s == 2) { if (EN(3)) phase_b1(c, l, lds); }
            else if (s == 3) { if (EN(4)) phase_scan(c, l, lds); if ((REPMASK >> 12) & 1) { __syncthreads(); if (c.bx < 32) scan_block(c, l, c.bx, lds); } if ((REPMASK >> 13) & 1) { if (c.bx >= 32) { const int w0 = (c.bx - 32) * 8 + c.wave, nw = (c.nb - 32) * 8; for (int u = w0; u < SBATCH * 4; u += nw) sample_recurrent(c, l, u); } } }
            else if (s == 4) { if (EN(5)) { if (!(step & 1)) sgemm2(c, l, lds);
                pg8::Gemm g{WSP(bf16_t, WS_AMIX), WSP(bf16_t, WS_WO) + (size_t)l * DM * DM, MP, DM, DM}; pg8::StaticOrder S; S.init(MP, DM, c.nb, c.bx);
                pg8::EpiResid E{WSP(bf16_t, WS_XB16), ssq + (size_t)(2 * l + 1) * MP * 16}; pg8::gemm_phase(lds, g, S, E); } }
            else if (s == 5) { if (EN(6)) { sgemm3(c, l, lds); if ((REPMASK >> 11) & 1) sgemm3(c, l, lds);
                pg8::Gemm g{WSP(bf16_t, WS_XB16), WSP(bf16_t, WS_WUP) + (size_t)l * FF * DM, MP, FF, DM}; pg8::StaticOrder S; S.init(MP, FF, c.nb, c.bx);
                pg8::EpiScaleBf16 E{WSP(bf16_t, WS_UNION), FF, ssq + (size_t)(2 * l + 1) * MP * 16, 1, nullptr, nullptr}; pg8::gemm_phase(lds, g, S, E); } }
            else { if (EN(7)) { if (!(step & 1)) sgemm4(c, l, lds);
                pg8::Gemm g{WSP(bf16_t, WS_UNION), WSP(bf16_t, WS_WDN) + (size_t)l * DM * FF, MP, DM, FF}; pg8::StaticOrder S; S.init(MP, DM, c.nb, c.bx);
                pg8::EpiResid E{WSP(bf16_t, WS_XB16), ssq + (size_t)(2 * l + 2) * MP * 16}; pg8::gemm_phase(lds, g, S, E); } }
        }
        if (!(step & 1) && ((REPMASK >> ptype) & 1)) continue;
        if ((REPMASK >> 9) & 1) { if (ph + 1 < args.ph_hi) xcd_barrier(xbar); }
        if (ph + 1 < args.ph_hi) {
            xcd_barrier(xbar);
        }
    }
}

extern "C" void kernel_launch(void* const* d_in, const int* in_sizes, int n_in, void* d_out, int out_size, void* d_ws, size_t ws_size, hipStream_t stream) {
    static int grid = 0;
    if (grid == 0) {
        int dev = 0, cus = 0, per_cu = 0;
        (void)hipGetDevice(&dev); (void)hipDeviceGetAttribute(&cus, hipDeviceAttributeMultiprocessorCount, dev);
        if (hipFuncSetAttribute((const void*)hymba_fwd, hipFuncAttributeMaxDynamicSharedMemorySize, LDS_BYTES) != hipSuccess) fprintf(stderr, "kernel_launch: hipFuncSetAttribute failed\n");
        if (hipOccupancyMaxActiveBlocksPerMultiprocessor(&per_cu, (const void*)hymba_fwd, 512, LDS_BYTES) != hipSuccess || per_cu < 1) { fprintf(stderr, "kernel_launch: occupancy query says %d\n", per_cu); per_cu = 1; }
        (void)hipGetLastError();
        grid = cus * 1;
        if (ws_size < WS_END) fprintf(stderr, "kernel_launch: workspace too small: %zu < %zu\n", ws_size, (size_t)WS_END);
    }
    (void)hipMemsetAsync(d_ws, 0, 65536, stream);
    Args a{};
    for (int i = 0; i < 18; ++i) a.in[i] = (const float*)d_in[i];
    a.out = (float*)d_out; a.ws = (unsigned char*)d_ws; a.ph_lo = 0; a.ph_hi = 30;
    void* kargs[] = {&a};
    hipError_t e = hipLaunchCooperativeKernel((const void*)hymba_fwd, dim3(grid), dim3(512), kargs, LDS_BYTES, stream);
    if (e != hipSuccess) fprintf(stderr, "kernel_launch: cooperative launch failed: %s (grid %d)\n", hipGetErrorString(e), grid);
}
```

```cpp
#include <hip/hip_runtime.h>
#include <hip/hip_cooperative_groups.h>
#include <cstdio>
namespace cg = cooperative_groups;

#define LAS __attribute__((address_space(3)))
#define DI __device__ __forceinline__
typedef unsigned short bf16_t;
typedef short bf16x8 __attribute__((ext_vector_type(8)));
typedef float f32x4 __attribute__((ext_vector_type(4)));
typedef float f32x2 __attribute__((ext_vector_type(2)));
typedef float f32x16 __attribute__((ext_vector_type(16)));
typedef unsigned u32x4 __attribute__((ext_vector_type(4)));
typedef unsigned u32x2 __attribute__((ext_vector_type(2)));
typedef __bf16 bf2_t __attribute__((ext_vector_type(2)));
typedef unsigned u32x8 __attribute__((ext_vector_type(8)));

#ifndef SUBSEL
#define SUBSEL -1
#endif
#define SUB(x) (SUBSEL < 0 || SUBSEL == (x))
#ifndef SUBSEL2
#define SUBSEL2 -1
#endif
#define SUB2(x) (SUBSEL2 < 0 || SUBSEL2 == (x))
constexpr int DM = 1024, NBATCH = 8, SEQ = 2048, MP = NBATCH * SEQ, DEPTH = 4, SBATCH = 128;
constexpr int NH = 4, QKV = 1536, NP = 3072, PROJ = 3080, FF = 4096, NPS = 3088;
constexpr float EPS = 1e-6f;
constexpr int IMG_BYTES = 55296;
constexpr int LDS_BYTES = 150528;
constexpr size_t O_YP = 0, O_YS = 16777216, O_DP = 16908288, O_CP = 19005440, O_DS = 19152896, O_CS = 52707328, O_VS = 55066624;
constexpr size_t WS_WIN = 65536;
constexpr size_t WS_WAB = WS_WIN + (size_t)DEPTH * NP * DM * 2;
constexpr size_t WS_WO = WS_WAB + (size_t)DEPTH * 16 * DM * 2;
constexpr size_t WS_WUP = WS_WO + (size_t)DEPTH * DM * DM * 2;
constexpr size_t WS_WDN = WS_WUP + (size_t)DEPTH * FF * DM * 2;
constexpr size_t WS_WM = WS_WDN + (size_t)DEPTH * FF * DM * 2;
constexpr size_t WS_XBUF = WS_WM + (size_t)DEPTH * 4 * 128 * 128 * 2;
constexpr size_t WS_XB16 = WS_XBUF + (size_t)MP * DM * 4;
constexpr size_t WS_SSQ = WS_XB16 + (size_t)MP * DM * 2;
constexpr size_t WS_UNION = WS_SSQ + (size_t)9 * MP * 16 * 4;
constexpr size_t WS_P = WS_UNION;
constexpr size_t WS_QN = WS_P + (size_t)MP * NP * 2;
constexpr size_t WS_KN = WS_QN + (size_t)MP * 512 * 2;
constexpr size_t WS_KNT = WS_UNION + (size_t)MP * FF * 2;
constexpr size_t WS_VT = WS_KNT + (size_t)MP * 512 * 2;
constexpr size_t WS_VBT = WS_VT + (size_t)MP * 512 * 2;
constexpr size_t WS_G = WS_VBT + (size_t)MP * 512 * 2;
constexpr size_t WS_BETA = WS_G + (size_t)MP * 4 * 4;
constexpr size_t WS_EG = WS_BETA + (size_t)MP * 4 * 4;
constexpr size_t WS_IMG = WS_EG + 4096;
constexpr size_t WS_UIMG = WS_IMG + (size_t)1024 * IMG_BYTES;
constexpr size_t WS_AMIX = WS_UIMG + (size_t)1024 * 32768;
constexpr size_t WS_XS = WS_AMIX + (size_t)MP * DM * 2;
constexpr size_t WS_PS = WS_XS + (size_t)SBATCH * DM * 4;
constexpr size_t WS_QS = WS_PS + (size_t)SBATCH * NPS * 4;
constexpr size_t WS_KS = WS_QS + (size_t)SBATCH * 512 * 4;
constexpr size_t WS_VS = WS_KS + (size_t)SBATCH * 512 * 4;
constexpr size_t WS_GS = WS_VS + (size_t)SBATCH * 512 * 4;
constexpr size_t WS_BS = WS_GS + (size_t)SBATCH * 4 * 4;
constexpr size_t WS_AMIXS = WS_BS + (size_t)SBATCH * 4 * 4;
constexpr size_t WS_HS = WS_AMIXS + (size_t)SBATCH * DM * 4;
constexpr size_t WS_XP = WS_HS + (size_t)SBATCH * FF * 4;
constexpr size_t WS_VSS = WS_XP + (size_t)4 * SBATCH * DM * 4;
constexpr size_t WS_CWP = WS_VSS + (size_t)MP * 8 * 4;
constexpr size_t WS_END = WS_CWP + (size_t)DEPTH * 4 * QKV * 4;
static_assert(WS_QN + 2 * (size_t)MP * 512 * 2 == WS_KNT, "union");
static_assert(WS_END <= (size_t)536870912, "workspace");

DI unsigned pk2(float lo, float hi) { f32x2 v = {lo, hi}; return __builtin_bit_cast(unsigned, __builtin_convertvector(v, bf2_t)); }
DI float bflo(unsigned w) { return __uint_as_float(w << 16); }
DI float bfhi(unsigned w) { return __uint_as_float(w & 0xffff0000u); }
DI float bf2f(bf16_t b) { return __uint_as_float(((unsigned)b) << 16); }
DI bf16_t f2bf(float f) { return (bf16_t)(pk2(f, 0.f) & 0xffffu); }
DI float xlane(float v, int srclane) { return __builtin_bit_cast(float, __builtin_amdgcn_ds_bpermute(srclane << 2, __builtin_bit_cast(int, v))); }
DI float wave_sum(float v, int lane) {
#pragma unroll
    for (int o = 1; o < 64; o <<= 1) v += xlane(v, lane ^ o);
    return v;
}
DI float silu_f(float x) { return x * __builtin_amdgcn_rcpf(1.f + __expf(-x)); }
DI float sigmoid_f(float x) { return __builtin_amdgcn_rcpf(1.f + __expf(-x)); }
DI float softplus_f(float x) { const float e = __expf(-fabsf(x)); const float l = e < 0.01f ? e * (1.f - e * (0.5f - 0.33333334f * e)) : __logf(1.f + e); return fmaxf(x, 0.f) + l; }
DI u32x4 pack8(const f32x16& x, int s) {
    u32x4 p; p.x = pk2(x[8 * s], x[8 * s + 1]); p.y = pk2(x[8 * s + 2], x[8 * s + 3]); p.z = pk2(x[8 * s + 4], x[8 * s + 5]); p.w = pk2(x[8 * s + 6], x[8 * s + 7]); return p;
}
DI float ssq_sum(const float* p) {
    const f32x4 a = *(const f32x4*)p, b = *(const f32x4*)(p + 4), c2 = *(const f32x4*)(p + 8), d2 = *(const f32x4*)(p + 12);
    return ((a.x + a.y) + (a.z + a.w)) + ((b.x + b.y) + (b.z + b.w)) + ((c2.x + c2.y) + (c2.z + c2.w)) + ((d2.x + d2.y) + (d2.z + d2.w));
}
DI int crow(int reg, int h) { return (reg & 3) + 8 * (reg >> 2) + 4 * h; }
#define MFMA32(a, b, c) __builtin_amdgcn_mfma_f32_32x32x16_bf16((a), (b), (c), 0, 0, 0)
#define MFMA16(a, b, c) __builtin_amdgcn_mfma_f32_16x16x32_bf16((a), (b), (c), 0, 0, 0)
DI bf16x8 as_bf(u32x4 v) { return __builtin_bit_cast(bf16x8, v); }
DI f32x16 zero16() { f32x16 z;
#pragma unroll
    for (int i = 0; i < 16; ++i) z[i] = 0.f; return z; }

namespace pg8 {
constexpr int BM = 256, BK = 64, HALF = 128, HTB = HALF * BK * 2, STAGE_BYTES = 8 * HTB, NXCD = 8, WGM = 8;
DI int lds_byte(int r, int c) { const int st = (r >> 4) * 2 + (c >> 5), rr = r & 15, cc = c & 31, ob = rr * 64 + cc * 2; return st * 1024 + (ob ^ (((ob >> 9) & 1) << 5)); }
DI void stage_rc(int b, int& R, int& C) { const int st = b / 1024, sb = b % 1024, swz = sb ^ (((sb >> 9) & 1) << 5); R = (st >> 1) * 16 + swz / 64; C = (st & 1) * 32 + (swz % 64) / 2; }
DI int perm32(int rho) { const int n = rho >> 4, i = rho & 15; return 8 * (i >> 2) + 4 * n + (i & 3); }
struct Unit { int pm, pn; };
struct Gemm { const bf16_t* A; const bf16_t* Bt; int M, N, K; };
struct StaticOrder {
    int nM, nN, nwg, G, c;
    DI void init(int M, int N, int G_, int c_) { nM = M / BM; nN = N / BM; nwg = nM * nN; G = G_; c = c_; }
    DI bool next(int i, Unit& u) const {
        const long L = (long)i * G + c; if (L >= nwg) return false;
        int wgid = (int)L; { const int q = nwg / NXCD, r = nwg % NXCD, xcd = wgid % NXCD, off = wgid / NXCD; wgid = (xcd < r ? xcd * (q + 1) : r * (q + 1) + (xcd - r) * q) + off; }
        const int nig = WGM * nN, gid = wgid / nig, fm = gid * WGM, gsz = (nM - fm) < WGM ? (nM - fm) : WGM;
        u.pm = fm + ((wgid % nig) % gsz); u.pn = (wgid % nig) / gsz; return true;
    }
};
template <class Epi>
DI void gemm_phase(LAS unsigned char* lds, const Gemm g, const StaticOrder& S, const Epi& E) {
    int tid = threadIdx.x; asm volatile("" : "+v"(tid));
    const int wid = __builtin_amdgcn_readfirstlane(tid >> 6), lane = tid & 63, wr = wid >> 2, wc = wid & 3, fr = lane & 15, fq = lane >> 4;
    const int K = g.K, nt = K / BK;
    unsigned voffA[2], voffB[2];
#pragma unroll
    for (int i = 0; i < 2; ++i) { int R, C; stage_rc(tid * 16 + i * 8192, R, C); const int Rb = (R & ~31) + perm32(R & 31);
        voffA[i] = (unsigned)(R * K + C) * 2u; voffB[i] = (unsigned)(Rb * K + C) * 2u; }
    const size_t kstep = (size_t)(BK * 2);
    const size_t hstep = (size_t)HALF * K * 2;
    const size_t tstep = 2 * hstep;
    const unsigned ldsw = (unsigned)wid * 1024u;
    const int aoff = lds_byte(wr * 64 + fr, fq * 8), boff = lds_byte(wc * 32 + fr, fq * 8);
#define PG8_SA(b, h) (((b) * 2 + (h)) * HTB)
#define PG8_SB(b, h) ((4 + (b) * 2 + (h)) * HTB)
#define PG8_STAGE(bufoff, gbase, voff) do { _Pragma("unroll") for (int _i = 0; _i < 2; ++_i) \
        __builtin_amdgcn_global_load_lds((const unsigned*)((const char*)(gbase) + (voff)[_i]), (LAS unsigned*)(lds + (bufoff) + ldsw + _i * 8192), 16, 0, 0); } while (0)
#define PG8_LDA(dst, b, h) do { _Pragma("unroll") for (int m = 0; m < 4; ++m) _Pragma("unroll") for (int k = 0; k < 2; ++k) dst[m][k] = *(const LAS bf16x8*)(lds + PG8_SA(b, h) + aoff + m * 2048 + k * 1024); } while (0)
#define PG8_LDB(dst, b, h) do { _Pragma("unroll") for (int n = 0; n < 2; ++n) _Pragma("unroll") for (int k = 0; k < 2; ++k) dst[n][k] = *(const LAS bf16x8*)(lds + PG8_SB(b, h) + boff + n * 2048 + k * 1024); } while (0)
#define PG8_MMA(ai, bj, At, Bt) do { __builtin_amdgcn_s_setprio(1); _Pragma("unroll") for (int m = 0; m < 4; ++m) _Pragma("unroll") for (int n = 0; n < 2; ++n) _Pragma("unroll") for (int k = 0; k < 2; ++k) \
        acc[ai][bj][m][n] = __builtin_amdgcn_mfma_f32_16x16x32_bf16(Bt[n][k], At[m][k], acc[ai][bj][m][n], 0, 0, 0); __builtin_amdgcn_s_setprio(0); } while (0)
#define PG8_WAIT_V(n) asm volatile("s_waitcnt vmcnt(" #n ")" ::: "memory")
#define PG8_WAIT_L(n) asm volatile("s_waitcnt lgkmcnt(" #n ")" ::: "memory")
#define PG8_BAR __builtin_amdgcn_s_barrier()
#define PG8_SCHED __builtin_amdgcn_sched_barrier(0)
    Unit cur, nxt; int ui = 0;
    if (!S.next(0, cur)) return;
    f32x4 acc[2][2][4][2];
#pragma unroll
    for (int a = 0; a < 2; ++a)
#pragma unroll
        for (int b = 0; b < 2; ++b)
#pragma unroll
            for (int m = 0; m < 4; ++m)
#pragma unroll
                for (int n = 0; n < 2; ++n) acc[a][b][m][n] = (f32x4){0.f, 0.f, 0.f, 0.f};
    bf16x8 At[4][2], B0[2][2], B1[2][2];
    const char* cA = (const char*)g.A + (size_t)cur.pm * tstep; const char* cB = (const char*)g.Bt + (size_t)cur.pn * tstep;
    PG8_STAGE(PG8_SB(0, 0), cB, voffB); PG8_STAGE(PG8_SA(0, 0), cA, voffA); PG8_STAGE(PG8_SB(0, 1), cB + hstep, voffB); PG8_STAGE(PG8_SA(0, 1), cA + hstep, voffA);
    if (wr == 1) PG8_BAR;
    PG8_WAIT_V(4); PG8_BAR;
    PG8_STAGE(PG8_SB(1, 0), cB + kstep, voffB); PG8_STAGE(PG8_SA(1, 0), cA + kstep, voffA); PG8_STAGE(PG8_SB(1, 1), cB + hstep + kstep, voffB);
    PG8_WAIT_V(6); PG8_BAR;
    for (;;) {
        const bool has_next = S.next(ui + 1, nxt);
        const char* nA = has_next ? (const char*)g.A + (size_t)nxt.pm * tstep : cA; const char* nB = has_next ? (const char*)g.Bt + (size_t)nxt.pn * tstep : cB;
        for (int t = 0; t < nt; t += 2) {
            const bool last = (t == nt - 2);
            const char* a1 = cA + (size_t)(t + 1) * kstep;
            const char* a2 = last ? nA : cA + (size_t)(t + 2) * kstep; const char* b2 = last ? nB : cB + (size_t)(t + 2) * kstep;
            const char* a3 = a2 + kstep; const char* b3 = b2 + kstep;
            PG8_LDB(B0, 0, 0); PG8_SCHED; PG8_LDA(At, 0, 0); PG8_STAGE(PG8_SA(1, 1), a1 + hstep, voffA);
            PG8_WAIT_L(8); PG8_BAR; PG8_WAIT_L(0); PG8_MMA(0, 0, At, B0); PG8_BAR; PG8_SCHED;
            PG8_LDB(B1, 0, 1); PG8_STAGE(PG8_SB(0, 0), b2, voffB);
            PG8_BAR; PG8_WAIT_L(0); PG8_MMA(0, 1, At, B1); PG8_BAR;
            PG8_LDA(At, 0, 1); PG8_STAGE(PG8_SA(0, 0), a2, voffA);
            PG8_BAR; PG8_WAIT_L(0); PG8_MMA(1, 0, At, B0); PG8_BAR; PG8_SCHED;
            PG8_STAGE(PG8_SB(0, 1), b2 + hstep, voffB);
            PG8_WAIT_V(6); PG8_BAR; PG8_MMA(1, 1, At, B1); PG8_BAR;
            PG8_LDB(B0, 1, 0); PG8_SCHED; PG8_LDA(At, 1, 0); PG8_STAGE(PG8_SA(0, 1), a2 + hstep, voffA);
            PG8_WAIT_L(8); PG8_BAR; PG8_WAIT_L(0); PG8_MMA(0, 0, At, B0); PG8_BAR; PG8_SCHED;
            PG8_LDB(B1, 1, 1); PG8_STAGE(PG8_SB(1, 0), b3, voffB);
            PG8_BAR; PG8_WAIT_L(0); PG8_MMA(0, 1, At, B1); PG8_BAR;
            PG8_LDA(At, 1, 1); PG8_STAGE(PG8_SA(1, 0), a3, voffA);
            PG8_BAR; PG8_WAIT_L(0); PG8_MMA(1, 0, At, B0); PG8_BAR; PG8_SCHED;
            PG8_STAGE(PG8_SB(1, 1), b3 + hstep, voffB);
            PG8_WAIT_V(6); PG8_BAR; PG8_MMA(1, 1, At, B1); PG8_BAR;
        }
        E(acc, cur, wr, wc, fr, fq);
        if (!has_next) break;
#pragma unroll
        for (int a = 0; a < 2; ++a)
#pragma unroll
            for (int b = 0; b < 2; ++b)
#pragma unroll
                for (int m = 0; m < 4; ++m)
#pragma unroll
                    for (int n = 0; n < 2; ++n) acc[a][b][m][n] = (f32x4){0.f, 0.f, 0.f, 0.f};
        cur = nxt; cA = nA; cB = nB; ++ui;
    }
    PG8_WAIT_V(0);
    if (wr == 0) PG8_BAR;
    PG8_BAR;
#undef PG8_SA
#undef PG8_SB
#undef PG8_STAGE
#undef PG8_LDA
#undef PG8_LDB
#undef PG8_MMA
#undef PG8_WAIT_V
#undef PG8_WAIT_L
#undef PG8_BAR
#undef PG8_SCHED
}
struct EpiScaleBf16 {
    bf16_t* O; int ldc; const float* ssq; int act; float* vss; const float* og;
    DI void operator()(const f32x4 (&acc)[2][2][4][2], const Unit& u, int wr, int wc, int fr, int fq) const {
        const int row0 = u.pm * BM + wr * 64 + fr, col0 = u.pn * BM + wc * 32 + 8 * fq;
#pragma unroll
        for (int ai = 0; ai < 2; ++ai)
#pragma unroll
            for (int m = 0; m < 4; ++m) { const int row = row0 + ai * HALF + m * 16;
                float rq; { const f32x4 p4 = *(const f32x4*)(ssq + (size_t)row * 16 + 4 * fq); rq = (p4.x + p4.y) + (p4.z + p4.w); const int ln = fq * 16 + fr; rq += xlane(rq, ln ^ 16); rq += xlane(rq, ln ^ 32); }
                const float rs = rsqrtf(rq * (1.0f / DM) + EPS);
                bf16_t* rowp = O + (size_t)row * ldc + col0; float vs = 0.f;
#pragma unroll
                for (int bj = 0; bj < 2; ++bj) { f32x4 v0 = acc[ai][bj][m][0] * rs, v1 = acc[ai][bj][m][1] * rs;
                    if (act) {
#pragma unroll
                        for (int j = 0; j < 4; ++j) { const float a = fmaxf(v0[j], 0.f), b = fmaxf(v1[j], 0.f); v0[j] = a * a; v1[j] = b * b; } }
                    if (og != nullptr && (u.pn == 6 || u.pn == 7)) { const float* gp = og + ((col0 + bj * HALF) & 127); const f32x4 g0 = *(const f32x4*)gp, g1 = *(const f32x4*)(gp + 4);
#pragma unroll
                        for (int j = 0; j < 4; ++j) { v0[j] = silu_f(v0[j]) * g0[j]; v1[j] = silu_f(v1[j]) * g1[j]; } }
                    u32x4 w; w.x = pk2(v0[0], v0[1]); w.y = pk2(v0[2], v0[3]); w.z = pk2(v1[0], v1[1]); w.w = pk2(v1[2], v1[3]);
                    *(u32x4*)(rowp + bj * HALF) = w;
                    vs += (v0[0] * v0[0] + v0[1] * v0[1]) + (v0[2] * v0[2] + v0[3] * v0[3]) + (v1[0] * v1[0] + v1[1] * v1[1]) + (v1[2] * v1[2] + v1[3] * v1[3]); }
                if (vss != nullptr && u.pn >= 10) { { const int ln = fq * 16 + fr; vs += xlane(vs, ln ^ 16); vs += xlane(vs, ln ^ 32); } if (fq == 0) vss[(size_t)row * 8 + (u.pn - 10) * 4 + wc] = vs; } }
    }
};
struct EpiResid {
    bf16_t* xb; float* ssq;
    DI void operator()(const f32x4 (&acc)[2][2][4][2], const Unit& u, int wr, int wc, int fr, int fq) const {
        const int row0 = u.pm * BM + wr * 64 + fr, col0 = u.pn * BM + wc * 32 + 8 * fq;
#pragma unroll
        for (int ai = 0; ai < 2; ++ai)
#pragma unroll
            for (int m = 0; m < 4; ++m) { const int row = row0 + ai * HALF + m * 16; const size_t off = (size_t)row * DM + col0; float ss = 0.f;
#pragma unroll
                for (int bj = 0; bj < 2; ++bj) {
                    const u32x4 b = *(const u32x4*)(xb + off + bj * HALF);
                    const f32x4 o0 = (f32x4){bflo(b.x), bfhi(b.x), bflo(b.y), bfhi(b.y)} + acc[ai][bj][m][0], o1 = (f32x4){bflo(b.z), bfhi(b.z), bflo(b.w), bfhi(b.w)} + acc[ai][bj][m][1];
                    u32x4 w; w.x = pk2(o0[0], o0[1]); w.y = pk2(o0[2], o0[3]); w.z = pk2(o1[0], o1[1]); w.w = pk2(o1[2], o1[3]);
                    *(u32x4*)(xb + off + bj * HALF) = w;
                    ss += (o0[0] * o0[0] + o0[1] * o0[1]) + (o0[2] * o0[2] + o0[3] * o0[3]) + (o1[0] * o1[0] + o1[1] * o1[1]) + (o1[2] * o1[2] + o1[3] * o1[3]); }
                { const int ln = fq * 16 + fr; ss += xlane(ss, ln ^ 16); ss += xlane(ss, ln ^ 32); }
                if (fq == 0) ssq[(size_t)row * 16 + u.pn * 4 + wc] = ss;
                asm volatile("" ::: "memory"); }
    }
};
}

struct Args { const float* in[18]; float* out; unsigned char* ws; int ph_lo, ph_hi; };
struct Ctx {
    const float *x_prompt, *x_sample, *state_delta, *state_conv, *norm_mix_g, *w_in, *conv_w, *A_log, *dt_bias, *o_norm_g, *v_norm_g, *w_s, *b_s, *w_o, *norm_ffn_g, *w_up, *w_down, *norm_f_g;
    float* out; unsigned char* ws;
    int lane, wave, gw, ngw, bx, nb;
};
#define WSP(T, off) ((T*)(c.ws + (off)))

DI void transpose_item(const float* W, int K, int N, const float* kscale, bf16_t* WT, bf16_t* WAB, int mode, int item, int nblk, LAS float* scr, int lane) {
    const int kb = item / nblk, nb = item % nblk, k0 = 64 * kb, n0 = 64 * nb;
    const int c4 = lane & 15, rsub = lane >> 4;
    const bool cval = n0 + 4 * c4 + 3 < N;
#pragma unroll 4
    for (int kk = 0; kk < 64; kk += 4) { const int row = kk + rsub;
        f32x4 v = (f32x4){0.f, 0.f, 0.f, 0.f}; if (cval) { v = *(const f32x4*)(W + (size_t)(k0 + row) * N + n0 + 4 * c4); if (kscale) v = v * kscale[k0 + row]; }
        LAS float* p = scr + row * 65 + 4 * c4; p[0] = v.x; p[1] = v.y; p[2] = v.z; p[3] = v.w; }
    asm volatile("s_waitcnt lgkmcnt(0)" ::: "memory");
    const int kc = lane & 7;
#pragma unroll
    for (int it = 0; it < 8; ++it) { const int n = 8 * it + (lane >> 3), ns = n0 + n; const LAS float* s = scr + (8 * kc) * 65 + n;
        u32x4 o; o.x = pk2(s[0 * 65], s[1 * 65]); o.y = pk2(s[2 * 65], s[3 * 65]); o.z = pk2(s[4 * 65], s[5 * 65]); o.w = pk2(s[6 * 65], s[7 * 65]);
        if (ns < N) {
            bf16_t* rowp;
            if (mode == 0) rowp = WT + (size_t)ns * K;
            else rowp = ns < 2048 ? WT + (size_t)ns * K : (ns < 2056 ? WAB + (size_t)(ns - 2048) * K : WT + (size_t)(ns - 8) * K);
            *(u32x4*)(rowp + k0 + 8 * kc) = o; } }
    asm volatile("s_waitcnt lgkmcnt(0)" ::: "memory");
}
DI void convert_layer_weights(const Ctx& c, int l, int w0, int nw, LAS unsigned char* lds) {
    LAS float* scr = (LAS float*)(lds + c.wave * 18432);
    constexpr int I_IN = 16 * 49, I_O = 16 * 16, I_UP = 16 * 64, I_DN = 64 * 16, I_L = I_IN + I_O + I_UP + I_DN;
    for (int it = w0; it < I_L; it += nw) {
        int r = it;
        if (r < I_IN) { transpose_item(c.w_in + (size_t)l * DM * PROJ, DM, PROJ, c.norm_mix_g + l * DM, WSP(bf16_t, WS_WIN) + (size_t)l * NP * DM, WSP(bf16_t, WS_WAB) + (size_t)l * 16 * DM, 1, r, 49, scr, c.lane); continue; } r -= I_IN;
        if (r < I_O) { transpose_item(c.w_o + (size_t)l * DM * DM, DM, DM, nullptr, WSP(bf16_t, WS_WO) + (size_t)l * DM * DM, nullptr, 0, r, 16, scr, c.lane); continue; } r -= I_O;
        if (r < I_UP) { transpose_item(c.w_up + (size_t)l * DM * FF, DM, FF, c.norm_ffn_g + l * DM, WSP(bf16_t, WS_WUP) + (size_t)l * FF * DM, nullptr, 0, r, 64, scr, c.lane); continue; } r -= I_UP;
        transpose_item(c.w_down + (size_t)l * FF * DM, FF, DM, nullptr, WSP(bf16_t, WS_WDN) + (size_t)l * DM * FF, nullptr, 0, r, 16, scr, c.lane);
    }
}
DI void phase_prologue(const Ctx& c, LAS unsigned char* lds) {
    convert_layer_weights(c, 0, c.gw, c.ngw, lds);
    float* ssq = WSP(float, WS_SSQ);
    for (int m = c.gw; m < MP; m += c.ngw) {
        const f32x4* xr = (const f32x4*)(c.x_prompt + (size_t)m * DM) + c.lane; u32x2* o8 = (u32x2*)(WSP(bf16_t, WS_XB16) + (size_t)m * DM) + c.lane; float s = 0.f;
#pragma unroll
        for (int j = 0; j < 4; ++j) { const f32x4 v = xr[64 * j]; s += (v.x * v.x + v.y * v.y) + (v.z * v.z + v.w * v.w); u32x2 w; w.x = pk2(v.x, v.y); w.y = pk2(v.z, v.w); o8[64 * j] = w; }
        s = wave_sum(s, c.lane); if (c.lane < 16) ssq[(size_t)m * 16 + c.lane] = c.lane == 0 ? s : 0.f;
    }
    const int gt = c.gw * 64 + c.lane, ngt = c.ngw * 64;
    float* xs = WSP(float, WS_XS);
    for (int i = gt; i < SBATCH * DM; i += ngt) xs[i] = c.x_sample[i];
    bf16_t* wab = WSP(bf16_t, WS_WAB);
    for (int i = gt; i < DEPTH * 8 * DM; i += ngt) { const int l = i / (8 * DM), r = i % (8 * DM); wab[(size_t)l * 16 * DM + 8 * DM + r] = 0; }
    unsigned* wm = WSP(unsigned, WS_WM);
    for (int i = gt; i < DEPTH * 4 * 128 * 64; i += ngt) { const int e = 2 * i, ii = (e >> 7) & 127, jj = e & 127;
        const float a = ii >= jj ? c.w_s[e] : 0.f, b = ii >= jj + 1 ? c.w_s[e + 1] : 0.f; wm[i] = pk2(a, b); }
}

template <int NT, bool NORM, int EPI>
DI void sgemm_block(const Ctx& c, const float* A, int lda, int K, const bf16_t* Bt, int ncg, float* out, int ldo, LAS unsigned char* lds, const bf16_t* Bab) {
    int lane = c.lane; asm volatile("" : "+v"(lane));
    const int wave = c.wave, fr = lane & 15, fq = lane >> 4;
    LAS f32x4* red = (LAS f32x4*)lds;
    LAS float* ssr = (LAS float*)(lds + 8 * NT * 64 * 16);
    const int kw = K / 8, k0 = wave * kw;
    for (int u = c.bx; u < 8 * ncg; u += c.nb) {
        const int rt = u & 7, cg = u >> 3;
        const bool abg = (Bab != nullptr) && (cg == ncg - 1);
        const bf16_t* bp = (abg ? Bab : Bt + (size_t)cg * NT * 16 * K) + (size_t)fr * K + k0 + 8 * fq;
        const float* ap = A + (size_t)(rt * 16 + fr) * lda + k0 + 8 * fq;
        f32x4 acc[NT]; float ss = 0.f;
#pragma unroll
        for (int nt = 0; nt < NT; ++nt) acc[nt] = (f32x4){0.f, 0.f, 0.f, 0.f};
#pragma unroll 4
        for (int k = 0; k < kw; k += 32) {
            const f32x4 a0 = *(const f32x4*)(ap + k), a1 = *(const f32x4*)(ap + k + 4);
            if (NORM) ss += (a0.x * a0.x + a0.y * a0.y) + (a0.z * a0.z + a0.w * a0.w) + (a1.x * a1.x + a1.y * a1.y) + (a1.z * a1.z + a1.w * a1.w);
            u32x4 a; a.x = pk2(a0.x, a0.y); a.y = pk2(a0.z, a0.w); a.z = pk2(a1.x, a1.y); a.w = pk2(a1.z, a1.w);
#pragma unroll
            for (int nt = 0; nt < NT; ++nt) if (nt == 0 || !abg) { const bf16x8 bf = *(const bf16x8*)(bp + (size_t)nt * 16 * K + k); acc[nt] = MFMA16(as_bf(a), bf, acc[nt]); }
        }
        if (NORM) { ss += xlane(ss, lane ^ 16); ss += xlane(ss, lane ^ 32); if (fq == 0) ssr[wave * 16 + fr] = ss; }
#pragma unroll
        for (int nt = 0; nt < NT; ++nt) red[(wave * NT + nt) * 64 + lane] = acc[nt];
        __syncthreads();
        if (wave < NT && (wave == 0 || !abg)) {
            f32x4 t = red[wave * 64 + lane];
#pragma unroll
            for (int w = 1; w < 8; ++w) t += red[(w * NT + wave) * 64 + lane];
            const int col = (cg * NT + wave) * 16 + fr;
#pragma unroll
            for (int j = 0; j < 4; ++j) { const int rl = 4 * fq + j; float rs = 1.f;
                if (NORM) { float sq = 0.f;
#pragma unroll
                    for (int w = 0; w < 8; ++w) sq += ssr[w * 16 + rl];
                    rs = rsqrtf(sq * (1.0f / DM) + EPS); }
                float* o = out + (size_t)(rt * 16 + rl) * ldo + col;
                if (EPI == 0) *o = t[j] * rs; else if (EPI == 1) *o += t[j]; else { const float v = fmaxf(t[j] * rs, 0.f); *o = v * v; } }
        }
        __syncthreads();
    }
}
DI void sgemm1(const Ctx& c, int l, LAS unsigned char* lds) {
    sgemm_block<4, true, 0>(c, WSP(float, WS_XS), DM, DM, WSP(bf16_t, WS_WIN) + (size_t)l * NP * DM, 49, WSP(float, WS_PS), NPS, lds, WSP(bf16_t, WS_WAB) + (size_t)l * 16 * DM);
}
DI void sgemm2(const Ctx& c, int l, LAS unsigned char* lds) {
    sgemm_block<2, false, 1>(c, WSP(float, WS_AMIXS), DM, DM, WSP(bf16_t, WS_WO) + (size_t)l * DM * DM, 32, WSP(float, WS_XS), DM, lds, nullptr);
}
DI void sgemm3(const Ctx& c, int l, LAS unsigned char* lds) {
    sgemm_block<4, true, 2>(c, WSP(float, WS_XS), DM, DM, WSP(bf16_t, WS_WUP) + (size_t)l * FF * DM, 64, WSP(float, WS_HS), FF, lds, nullptr);
}
DI void sgemm4(const Ctx& c, int l, LAS unsigned char* lds) {
    sgemm_block<2, false, 1>(c, WSP(float, WS_HS), FF, FF, WSP(bf16_t, WS_WDN) + (size_t)l * DM * FF, 32, WSP(float, WS_XS), DM, lds, nullptr);
}

DI void b0_block_ab(const Ctx& c, int l, int chunk, LAS unsigned char* lds) {
    int lane = c.lane; asm volatile("" : "+v"(lane));
    const int wave = c.wave, fr = lane & 15, fq = lane >> 4, tok0 = chunk * 64, k0 = wave * 128;
    const bf16_t* ap = WSP(bf16_t, WS_XB16) + (size_t)(tok0 + fr) * DM + k0 + 8 * fq;
    const bf16_t* bp = WSP(bf16_t, WS_WAB) + (size_t)l * 16 * DM + (size_t)fr * DM + k0 + 8 * fq;
    f32x4 acc[4];
#pragma unroll
    for (int mt = 0; mt < 4; ++mt) acc[mt] = (f32x4){0.f, 0.f, 0.f, 0.f};
#pragma unroll
    for (int k = 0; k < 128; k += 32) {
        const bf16x8 bf = *(const bf16x8*)(bp + k);
#pragma unroll
        for (int mt = 0; mt < 4; ++mt) { const bf16x8 a = *(const bf16x8*)(ap + (size_t)mt * 16 * DM + k); acc[mt] = MFMA16(a, bf, acc[mt]); }
    }
    LAS f32x4* red = (LAS f32x4*)lds;
#pragma unroll
    for (int mt = 0; mt < 4; ++mt) red[(wave * 4 + mt) * 64 + lane] = acc[mt];
    __syncthreads();
    if (wave < 4 && fr < 8) { const int mt = wave;
        f32x4 t = red[mt * 64 + lane];
#pragma unroll
        for (int w = 1; w < 8; ++w) t += red[(w * 4 + mt) * 64 + lane];
        const float* ssq = WSP(float, WS_SSQ) + (size_t)(2 * l) * MP * 16;
        float* gb = WSP(float, WS_G); float* bb = WSP(float, WS_BETA);
        const int hh = fr & 3; const float al = -__expf(c.A_log[l * 4 + hh]), dtb = c.dt_bias[l * 4 + hh];
#pragma unroll
        for (int j = 0; j < 4; ++j) { const int tok = tok0 + 16 * mt + 4 * fq + j; const float v = t[j] * rsqrtf(ssq_sum(ssq + (size_t)tok * 16) * (1.0f / DM) + EPS);
            if (fr < 4) gb[tok * 4 + hh] = al * softplus_f(v + dtb); else bb[tok * 4 + hh] = sigmoid_f(v); } }
    __syncthreads();
}
DI float dot2bf(unsigned a, unsigned b, float c) { float r; asm("v_dot2c_f32_bf16 %0, %1, %2" : "=v"(r) : "s"(b), "v"(a), "0"(c)); return r; }
constexpr int B0_STRIDE = 272, B0_WAVE_LDS = 18432;
DI void b0_task_conv(const Ctx& c, int l, int b, int n, int s, int hh, LAS unsigned char* wl) {
    int lane = c.lane; asm volatile("" : "+v"(lane));
    const int tok0 = b * SEQ + n * 64, cb = s * 512 + hh * 128, piece = lane & 15;
    const bf16_t* P = WSP(bf16_t, WS_P) + (size_t)tok0 * NP + cb + piece * 8;
#pragma unroll
    for (int k = 0; k < 17; ++k) { const int row = 4 * k + (lane >> 4);
        if (row < 67) { u32x4 v = (u32x4){0u, 0u, 0u, 0u}; if (n > 0 || row >= 3) v = *(const u32x4*)(P + (long)(row - 3) * NP);
            *(LAS u32x4*)(wl + row * B0_STRIDE + piece * 16) = v; } }
    const unsigned* cwl = (const unsigned*)(c.conv_w + (size_t)l * 4 * QKV + cb);
    if (n == 31) {
        float* ocp = c.out + O_CP + ((size_t)(l * NBATCH + b) * 3) * QKV + cb;
#pragma unroll
        for (int t = 0; t < 6; ++t) { const int idx = lane + 64 * t, row = idx >> 7, ch = idx & 127; ocp[(size_t)row * QKV + ch] = bf2f(*(const LAS bf16_t*)(wl + (64 + row) * B0_STRIDE + ch * 2)); } }
    float ss = 0.f;
#pragma unroll 1
    for (int i = 0; i < 16; ++i) {
        u32x4 rws[4];
#pragma unroll
        for (int j = 0; j < 4; ++j) rws[j] = *(const LAS u32x4*)(wl + (lane + j) * B0_STRIDE + i * 16);
        u32x8 w0, w1, w2, w3; const unsigned* wp = cwl + 8 * i;
        asm volatile("s_load_dwordx8 %0, %4, 0x0\n\ts_load_dwordx8 %1, %4, 0x1800\n\ts_load_dwordx8 %2, %4, 0x3000\n\ts_load_dwordx8 %3, %4, 0x4800\n\ts_waitcnt lgkmcnt(0)"
                     : "=&s"(w0), "=&s"(w1), "=&s"(w2), "=&s"(w3) : "s"(wp) : "memory");
        float y[8];
#pragma unroll
        for (int e = 0; e < 8; ++e) { float a = 0.f;
            a = dot2bf(rws[0][e >> 1], (e & 1) ? ((w0[e] + 0x8000u) & 0xffff0000u) : ((w0[e] + 0x8000u) >> 16), a);
            a = dot2bf(rws[1][e >> 1], (e & 1) ? ((w1[e] + 0x8000u) & 0xffff0000u) : ((w1[e] + 0x8000u) >> 16), a);
            a = dot2bf(rws[2][e >> 1], (e & 1) ? ((w2[e] + 0x8000u) & 0xffff0000u) : ((w2[e] + 0x8000u) >> 16), a);
            a = dot2bf(rws[3][e >> 1], (e & 1) ? ((w3[e] + 0x8000u) & 0xffff0000u) : ((w3[e] + 0x8000u) >> 16), a);
            y[e] = silu_f(a); ss += y[e] * y[e]; }
        u32x4 w; w.x = pk2(y[0], y[1]); w.y = pk2(y[2], y[3]); w.z = pk2(y[4], y[5]); w.w = pk2(y[6], y[7]);
        *(LAS u32x4*)(wl + (lane + 3) * B0_STRIDE + i * 16) = w;
    }
    const float sc = s == 0 ? rsqrtf(ss + EPS) * 0.08838834764831845f : (s == 1 ? rsqrtf(ss + EPS) : 1.0f);
    const size_t unit = (size_t)((b * 4 + hh) * 32 + n);
    bf16_t* ot = (s == 1 ? WSP(bf16_t, WS_KNT) : WSP(bf16_t, WS_VT)) + unit * 128 * 64 + lane;
#pragma unroll 2
    for (int i = 0; i < 16; ++i) { const u32x4 v = *(const LAS u32x4*)(wl + (lane + 3) * B0_STRIDE + i * 16); u32x4 w;
#pragma unroll
        for (int e = 0; e < 4; ++e) w[e] = pk2(bflo(v[e]) * sc, bfhi(v[e]) * sc);
        if (s < 2) *(LAS u32x4*)(wl + (lane + 3) * B0_STRIDE + i * 16) = w;
        if (s >= 1) {
#pragma unroll
            for (int e = 0; e < 8; ++e) ot[(8 * i + e) * 64] = (bf16_t)((e & 1) ? (w[e >> 1] >> 16) : (w[e >> 1] & 0xffffu)); } }
    if (s < 2) { bf16_t* o = (s == 0 ? WSP(bf16_t, WS_QN) : WSP(bf16_t, WS_KN)) + (size_t)tok0 * 512 + hh * 128 + piece * 8;
#pragma unroll
        for (int k = 0; k < 16; ++k) { const int row = 4 * k + (lane >> 4); *(u32x4*)(o + (size_t)row * 512) = *(const LAS u32x4*)(wl + (row + 3) * B0_STRIDE + piece * 16); } }
}
DI void b0_task_vb(const Ctx& c, int l, int b, int n, int hb, LAS unsigned char* wl) {
    int lane = c.lane; asm volatile("" : "+v"(lane));
    const int tok0 = b * SEQ + n * 64, piece = lane & 15;
    const bf16_t* P = WSP(bf16_t, WS_P) + (size_t)tok0 * NP + 2560 + hb * 128 + piece * 8;
#pragma unroll
    for (int k = 0; k < 16; ++k) { const int row = 4 * k + (lane >> 4); *(LAS u32x4*)(wl + row * B0_STRIDE + piece * 16) = *(const u32x4*)(P + (size_t)row * NP); }
    const float* vp = WSP(float, WS_VSS) + (size_t)(tok0 + lane) * 8; const f32x4 p0 = *(const f32x4*)vp, p1 = *(const f32x4*)(vp + 4);
    const float rs = rsqrtf((((p0.x + p0.y) + (p0.z + p0.w)) + ((p1.x + p1.y) + (p1.z + p1.w))) * (1.0f / 512.0f) + EPS);
    const float* vg = c.v_norm_g + l * 512 + hb * 128;
    bf16_t* vbt = WSP(bf16_t, WS_VBT) + ((size_t)((b * 16 + (n >> 1)) * 4 + hb) * 128) * 128 + (n & 1) * 64 + lane;
#pragma unroll 2
    for (int i = 0; i < 16; ++i) { const u32x4 v = *(const LAS u32x4*)(wl + lane * B0_STRIDE + i * 16);
#pragma unroll
        for (int e = 0; e < 8; ++e) { const float pv = (e & 1) ? bfhi(v[e >> 1]) : bflo(v[e >> 1]); vbt[(size_t)(8 * i + e) * 128] = f2bf(pv * rs * vg[8 * i + e]); } }
}
DI void b0_task_sample(const Ctx& c, int l, int bs) {
    const float* ps = WSP(float, WS_PS) + (size_t)bs * NPS;
    if (c.lane < 4) { const int hh = c.lane;
        WSP(float, WS_GS)[bs * 4 + hh] = -__expf(c.A_log[l * 4 + hh]) * softplus_f(ps[3072 + hh] + c.dt_bias[l * 4 + hh]);
        WSP(float, WS_BS)[bs * 4 + hh] = sigmoid_f(ps[3076 + hh]); }
    const float* sc = c.state_conv + (size_t)(l * SBATCH + bs) * 3 * QKV;
    const float* cw = c.conv_w + (size_t)l * 4 * QKV;
    float* ocs = c.out + O_CS + (size_t)(l * SBATCH + bs) * 3 * QKV;
    float* qkvs = WSP(float, WS_QS) + bs * 512;
#pragma unroll 1
    for (int sh = 0; sh < 12; ++sh) {
        float y[2];
#pragma unroll
        for (int t = 0; t < 2; ++t) { const int ch = sh * 128 + t * 64 + c.lane; const float s0 = sc[ch], s1 = sc[QKV + ch], s2 = sc[2 * QKV + ch], cur = ps[ch];
            ocs[ch] = s1; ocs[QKV + ch] = s2; ocs[2 * QKV + ch] = cur;
            y[t] = silu_f(s0 * cw[ch] + s1 * cw[QKV + ch] + s2 * cw[2 * QKV + ch] + cur * cw[3 * QKV + ch]); }
        float scale = 1.0f;
        if (sh < 8) { const float ssum = wave_sum(y[0] * y[0] + y[1] * y[1], c.lane); scale = rsqrtf(ssum + EPS) * (sh < 4 ? 0.08838834764831845f : 1.0f); }
        float* o = qkvs + (size_t)(sh >> 2) * SBATCH * 512 + (sh & 3) * 128;
        o[c.lane] = y[0] * scale; o[64 + c.lane] = y[1] * scale;
    }
    float pv[8]; float ss = 0.f;
#pragma unroll
    for (int i = 0; i < 8; ++i) { pv[i] = ps[2560 + c.lane + 64 * i]; ss += pv[i] * pv[i]; }
    ss = wave_sum(ss, c.lane); const float rs = rsqrtf(ss * (1.0f / 512.0f) + EPS);
    float* am = WSP(float, WS_AMIXS) + (size_t)bs * DM; float* ovs = c.out + O_VS + (size_t)(l * SBATCH + bs) * 512;
#pragma unroll
    for (int i = 0; i < 8; ++i) { const int ch = c.lane + 64 * i, hb = ch >> 7; const float vb = pv[i] * rs * c.v_norm_g[l * 512 + ch];
        ovs[ch] = vb; am[512 + ch] = ps[2048 + ch] * (c.w_s[(size_t)(l * 4 + hb) * 128 * 128] * vb + c.b_s[(l * 4 + hb) * 128]); }
}
DI void phase_b0(const Ctx& c, int l, LAS unsigned char* lds) {
    for (int ch = c.bx; ch < 256; ch += c.nb) b0_block_ab(c, l, ch, lds);
    constexpr int NPT = 256 * 12;
    LAS unsigned char* wl = lds + c.wave * B0_WAVE_LDS;
    for (int t = c.wave * c.nb + c.bx; t < NPT + SBATCH; t += c.ngw) {
        if (t >= NPT) { if (SUB(0)) b0_task_sample(c, l, t - NPT); continue; }
        const int chunk = t / 12, k = t % 12, b = chunk >> 5, n = chunk & 31;
        if (SUB(3)) b0_task_conv(c, l, b, n, k >> 2, k & 3, wl);
    }
}

DI void b1_prep(const Ctx& c, int l, int unit, int part, LAS unsigned char* wl, LAS float* sg, LAS float* sb) {
    int lane = c.lane; asm volatile("" : "+v"(lane));
    const int r = lane & 31, h = lane >> 5;
    const int n = unit & 31, bh = unit >> 5, hh = bh & 3, b = bh >> 2, tok0 = b * SEQ + n * 64;
    const float bt = WSP(float, WS_BETA)[(tok0 + lane) * 4 + hh];
    float gc = WSP(float, WS_G)[(tok0 + lane) * 4 + hh];
#pragma unroll
    for (int o = 1; o < 64; o <<= 1) { const float t = xlane(gc, lane - o); if (lane >= o) gc += t; }
    sg[lane] = gc; sb[lane] = bt;
    const float glast = __builtin_bit_cast(float, __builtin_amdgcn_readlane(__builtin_bit_cast(int, gc), 63));
    if (part == 0 && lane == 0) WSP(float, WS_EG)[unit] = __expf(glast);
    unsigned char* img = c.ws + WS_IMG + (size_t)unit * IMG_BYTES;
    const bf16_t* Kn = WSP(bf16_t, WS_KN) + (size_t)tok0 * 512 + hh * 128;
    const bf16_t* Qn = WSP(bf16_t, WS_QN) + (size_t)tok0 * 512 + hh * 128;
    const bf16_t* KnT = WSP(bf16_t, WS_KNT) + (size_t)unit * 128 * 64;
    const bf16_t* VT = WSP(bf16_t, WS_VT) + (size_t)unit * 128 * 64;
    LAS float* L = (LAS float*)wl;
    {
        bf16x8 Kf[2][8];
#pragma unroll
        for (int t = 0; t < 2; ++t)
#pragma unroll
            for (int ks = 0; ks < 8; ++ks) Kf[t][ks] = *(const bf16x8*)(Kn + (size_t)(32 * t + r) * 512 + 16 * ks + 8 * h);
        if (part == 0) {
#pragma unroll
        for (int tt = 0; tt < 3; ++tt) { const int mt = tt == 0 ? 0 : 1, nt = tt == 2 ? 1 : 0;
            f32x16 acc = zero16();
#pragma unroll
            for (int ks = 0; ks < 8; ++ks) acc = MFMA32(Kf[mt][ks], Kf[nt][ks], acc);
            const int j = 32 * nt + r; const float gj = sg[j];
#pragma unroll
            for (int g4 = 0; g4 < 4; ++g4) { const f32x4 gi4 = *(const LAS f32x4*)(sg + 32 * mt + 8 * g4 + 4 * h), bi4 = *(const LAS f32x4*)(sb + 32 * mt + 8 * g4 + 4 * h);
#pragma unroll
                for (int q = 0; q < 4; ++q) { const int i = 32 * mt + 8 * g4 + 4 * h + q; const float arg = i > j ? gi4[q] - gj : 0.f;
                    L[i * 64 + j] = i > j ? acc[4 * g4 + q] * bi4[q] * __expf(arg) : 0.f; } } }
        }
        if (part == 1) {
#pragma unroll
        for (int mt = 0; mt < 2; ++mt) {
            bf16x8 Qf[8];
#pragma unroll
            for (int ks = 0; ks < 8; ++ks) Qf[ks] = *(const bf16x8*)(Qn + (size_t)(32 * mt + r) * 512 + 16 * ks + 8 * h);
            const int i = 32 * mt + r; const float gi = sg[i];
#pragma unroll
            for (int mp = 0; mp <= mt; ++mp) {
                f32x16 acc = zero16();
#pragma unroll
                for (int ks = 0; ks < 8; ++ks) acc = MFMA32(Kf[mp][ks], Qf[ks], acc);
#pragma unroll
                for (int g4 = 0; g4 < 4; ++g4) { const f32x4 gj4 = *(const LAS f32x4*)(sg + 32 * mp + 8 * g4 + 4 * h);
#pragma unroll
                    for (int q = 0; q < 4; ++q) { const int j = 32 * mp + 8 * g4 + 4 * h + q; const float arg = i >= j ? gi - gj4[q] : 0.f;
                        acc[4 * g4 + q] = i >= j ? acc[4 * g4 + q] * __expf(arg) : 0.f; } }
                const int fb = (mt == 0 ? 0 : 1 + mp) * 2;
#pragma unroll
                for (int s = 0; s < 2; ++s) *(u32x4*)(img + 49152 + (fb + s) * 1024 + lane * 16) = pack8(acc, s);
            }
        }
        }
    }
    if (part == 0) {
    float Tr[64];
    {
        f32x4 lb[2][16];
#pragma unroll
        for (int i = 0; i < 64; ++i) {
            if (i + 1 < 64) {
#pragma unroll
                for (int j4 = 0; j4 < (i + 1 + 3) / 4; ++j4) lb[(i + 1) & 1][j4] = *(const LAS f32x4*)(L + (i + 1) * 64 + 4 * j4); }
            asm volatile("" ::: "memory");
            float a0 = lane == i ? 1.f : 0.f, a1 = 0.f;
#pragma unroll
            for (int j4 = 0; j4 < (i + 3) / 4; ++j4) {
#pragma unroll
                for (int q = 0; q < 4; ++q) { const int j = 4 * j4 + q; if (j < i) { if (q & 1) a1 -= lb[i & 1][j4][q] * Tr[j]; else a0 -= lb[i & 1][j4][q] * Tr[j]; } } }
            Tr[i] = a0 + a1;
        }
    }
    LAS bf16_t* T1 = (LAS bf16_t*)wl;
    asm volatile("" ::: "memory");
    {
        const float sc1 = bt * __expf(gc);
#pragma unroll
        for (int i = 0; i < 64; ++i) T1[i * 72 + lane] = f2bf(Tr[i] * sc1);
        bf16x8 Tf[2][4];
#pragma unroll
        for (int mt = 0; mt < 2; ++mt)
#pragma unroll
            for (int ks = 0; ks < 4; ++ks) Tf[mt][ks] = *(const LAS bf16x8*)(T1 + (32 * mt + r) * 72 + 16 * ks + 8 * h);
#pragma unroll
        for (int dt = 0; dt < 4; ++dt) {
            bf16x8 Kt[4];
#pragma unroll
            for (int ks = 0; ks < 4; ++ks) Kt[ks] = *(const bf16x8*)(KnT + (size_t)(32 * dt + r) * 64 + 16 * ks + 8 * h);
#pragma unroll
            for (int mt = 0; mt < 2; ++mt) { f32x16 acc = zero16();
#pragma unroll
                for (int ks = 0; ks < 2 * (mt + 1); ++ks) acc = MFMA32(Kt[ks], Tf[mt][ks], acc);
                acc = -acc;
#pragma unroll
                for (int s = 0; s < 2; ++s) *(u32x4*)(img + ((mt * 4 + dt) * 2 + s) * 1024 + lane * 16) = pack8(acc, s); }
        }
    }
    asm volatile("" ::: "memory");
    {
#pragma unroll
        for (int i = 0; i < 64; ++i) T1[i * 72 + lane] = f2bf(Tr[i] * bt);
        bf16x8 Tf[2][4];
#pragma unroll
        for (int mt = 0; mt < 2; ++mt)
#pragma unroll
            for (int ks = 0; ks < 4; ++ks) Tf[mt][ks] = *(const LAS bf16x8*)(T1 + (32 * mt + r) * 72 + 16 * ks + 8 * h);
        bf16_t* uimg = WSP(bf16_t, WS_UIMG) + (size_t)unit * 8192;
#pragma unroll
        for (int et = 0; et < 4; ++et) {
            bf16x8 Vt[4];
#pragma unroll
            for (int ks = 0; ks < 4; ++ks) Vt[ks] = *(const bf16x8*)(VT + (size_t)(32 * et + r) * 64 + 16 * ks + 8 * h);
#pragma unroll
            for (int mt = 0; mt < 2; ++mt) { f32x16 acc = zero16();
#pragma unroll
                for (int ks = 0; ks < 2 * (mt + 1); ++ks) acc = MFMA32(Tf[mt][ks], Vt[ks], acc);
#pragma unroll
                for (int g4 = 0; g4 < 4; ++g4) { u32x2 w; w.x = pk2(acc[4 * g4], acc[4 * g4 + 1]); w.y = pk2(acc[4 * g4 + 2], acc[4 * g4 + 3]); *(u32x2*)(uimg + ((et * 2 + mt) * 4 + g4) * 256 + lane * 4) = w; } }
        }
    }
    }
    if (part == 1) {
#pragma unroll
    for (int mt = 0; mt < 2; ++mt) { const float ei = __expf(sg[32 * mt + r]);
#pragma unroll
        for (int dt = 0; dt < 4; ++dt)
#pragma unroll
            for (int s = 0; s < 2; ++s) { const bf16_t* qp = Qn + (size_t)(32 * mt + r) * 512 + 32 * dt + 16 * s + 4 * h;
                const u32x2 p0 = *(const u32x2*)qp, p1 = *(const u32x2*)(qp + 8);
                u32x4 w; w.x = pk2(bflo(p0.x) * ei, bfhi(p0.x) * ei); w.y = pk2(bflo(p0.y) * ei, bfhi(p0.y) * ei); w.z = pk2(bflo(p1.x) * ei, bfhi(p1.x) * ei); w.w = pk2(bflo(p1.y) * ei, bfhi(p1.y) * ei);
                *(u32x4*)(img + 16384 + ((mt * 4 + dt) * 2 + s) * 1024 + lane * 16) = w; } }
#pragma unroll
    for (int mp = 0; mp < 2; ++mp)
#pragma unroll
        for (int s = 0; s < 2; ++s) { const f32x4 ga = *(const LAS f32x4*)(sg + 32 * mp + 16 * s + 4 * h), gb = *(const LAS f32x4*)(sg + 32 * mp + 16 * s + 8 + 4 * h);
            float sc[8];
#pragma unroll
            for (int q = 0; q < 4; ++q) { sc[q] = __expf(glast - ga[q]); sc[4 + q] = __expf(glast - gb[q]); }
#pragma unroll
            for (int dt = 0; dt < 4; ++dt) { const bf16_t* kp = KnT + (size_t)(32 * dt + r) * 64 + 32 * mp + 16 * s + 4 * h;
                const u32x2 p0 = *(const u32x2*)kp, p1 = *(const u32x2*)(kp + 8);
                u32x4 w; w.x = pk2(bflo(p0.x) * sc[0], bfhi(p0.x) * sc[1]); w.y = pk2(bflo(p0.y) * sc[2], bfhi(p0.y) * sc[3]); w.z = pk2(bflo(p1.x) * sc[4], bfhi(p1.x) * sc[5]); w.w = pk2(bflo(p1.y) * sc[6], bfhi(p1.y) * sc[7]);
                *(u32x4*)(img + 32768 + ((dt * 2 + mp) * 2 + s) * 1024 + lane * 16) = w; } }
    }
}
DI void b1_gmlp(const Ctx& c, int l, int unit) {
    int lane = c.lane; asm volatile("" : "+v"(lane));
    const int r = lane & 31, h = lane >> 5;
    const int hb = unit & 3, cc = (unit >> 2) & 15, b = unit >> 6, tokc0 = b * SEQ + cc * 128;
    const bf16_t* A = WSP(bf16_t, WS_VBT) + (size_t)unit * 128 * 128;
    const bf16_t* B = WSP(bf16_t, WS_WM) + (size_t)(l * 4 + hb) * 128 * 128;
    const bf16_t* P = WSP(bf16_t, WS_P); bf16_t* AM = WSP(bf16_t, WS_AMIX);
#pragma unroll
    for (int nt = 0; nt < 4; ++nt) {
        f32x16 acc[4];
#pragma unroll
        for (int mt = 0; mt < 4; ++mt) acc[mt] = zero16();
#pragma unroll
        for (int ks = 0; ks < 2 * (nt + 1); ++ks) { const bf16x8 bf = *(const bf16x8*)(B + (size_t)(32 * nt + r) * 128 + 16 * ks + 8 * h);
#pragma unroll
            for (int mt = 0; mt < 4; ++mt) { const bf16x8 af = *(const bf16x8*)(A + (size_t)(32 * mt + r) * 128 + 16 * ks + 8 * h); acc[mt] = MFMA32(af, bf, acc[mt]); } }
        const int tok = tokc0 + 32 * nt + r; const float bsi = c.b_s[(l * 4 + hb) * 128 + 32 * nt + r];
#pragma unroll
        for (int mt = 0; mt < 4; ++mt)
#pragma unroll
            for (int g4 = 0; g4 < 4; ++g4) { const int dch0 = 32 * mt + 8 * g4 + 4 * h;
                const u32x2 u4 = *(const u32x2*)(P + (size_t)tok * NP + 2048 + hb * 128 + dch0);
                u32x2 w; w.x = pk2(bflo(u4.x) * (acc[mt][4 * g4] + bsi), bfhi(u4.x) * (acc[mt][4 * g4 + 1] + bsi)); w.y = pk2(bflo(u4.y) * (acc[mt][4 * g4 + 2] + bsi), bfhi(u4.y) * (acc[mt][4 * g4 + 3] + bsi));
                *(u32x2*)(AM + (size_t)tok * DM + 512 + hb * 128 + dch0) = w; }
    }
}
DI void phase_b1(const Ctx& c, int l, LAS unsigned char* lds) {
    LAS unsigned char* wl = lds + c.wave * 16384; LAS float* sg = (LAS float*)(lds + 131072 + c.wave * 512); LAS float* sb = sg + 64;
    for (int t = c.bx * 4 + (c.wave & 3); t < 1024; t += c.nb * 4) {
        if (SUB(0)) b1_prep(c, l, t, c.wave >> 2, wl, sg, sb);
    }
}


constexpr int OB_STRIDE = 136;
constexpr int IMG_LDS = 57344;
constexpr int LDS_OBUF = 2 * IMG_LDS, OBUF_BYTES = 64 * OB_STRIDE * 2;
static_assert(LDS_OBUF + 2 * OBUF_BYTES <= LDS_BYTES, "scan LDS");
DI void scan_post(const Ctx& c, int l, int b, int hh, int n, const LAS bf16_t* ob, int lid, const u32x4 (&gt4)[4]) {
    const int i = lid >> 2, q = lid & 3, tok = b * SEQ + n * 64 + i;
    u32x4 ov[4]; float ss = 0.f;
#pragma unroll
    for (int x = 0; x < 4; ++x) { ov[x] = *(const LAS u32x4*)(ob + i * OB_STRIDE + 32 * q + 8 * x);
#pragma unroll
        for (int e = 0; e < 4; ++e) { const float a = bflo(ov[x][e]), bq = bfhi(ov[x][e]); ss += a * a + bq * bq; } }
    ss += xlane(ss, (lid & 63) ^ 1); ss += xlane(ss, (lid & 63) ^ 2);
    const float rs = rsqrtf(ss * (1.0f / 128.0f) + EPS);
    bf16_t* op = WSP(bf16_t, WS_AMIX) + (size_t)tok * DM + hh * 128 + 32 * q;
#pragma unroll
    for (int x = 0; x < 4; ++x) { u32x4 w;
#pragma unroll
        for (int e = 0; e < 4; ++e) w[e] = pk2(bflo(ov[x][e]) * rs * bflo(gt4[x][e]), bfhi(ov[x][e]) * rs * bfhi(gt4[x][e]));
        *(u32x4*)(op + 8 * x) = w; }
}
DI void scan_loader_step(const Ctx& c, int l, int b, int hh, int n, LAS unsigned char* lds, const unsigned char* img0, const bf16_t* gbase, int lw, int lane, int lid, u32x4 (&regs)[14], u32x4 (&gt)[4]) {
    u32x4 gcur[4];
#pragma unroll
    for (int x = 0; x < 4; ++x) gcur[x] = gt[x];
#pragma unroll
    for (int x = 0; x < 4; ++x) gt[x] = *(const u32x4*)(gbase + (size_t)n * 64 * NP + 8 * x);
    const unsigned voff = (unsigned)(lw * 14336 + lane * 16);
    if (n + 1 < 32) { LAS unsigned char* dst = lds + ((n + 1) & 1) * IMG_LDS + voff;
#pragma unroll
        for (int i = 0; i < 14; ++i) *(LAS u32x4*)(dst + i * 1024) = regs[i]; }
    if (n + 3 < 32) { const unsigned char* src = img0 + (size_t)(n + 3) * IMG_BYTES;
#pragma unroll
        for (int i = 0; i < 14; ++i) regs[i] = *(const u32x4*)(src + voff + i * 1024); }
    if (n >= 1) scan_post(c, l, b, hh, n - 1, (const LAS bf16_t*)(lds + LDS_OBUF + ((n - 1) & 1) * OBUF_BYTES), lid, gcur);
    __syncthreads();
}
DI void scan_consumer_step(int n, LAS unsigned char* lds, f32x16 (&S)[4], u32x2 (&ucur)[8], float& egc, const bf16_t* uimg0, const float* egp, int lane, int ws, int r, int h) {
    const LAS unsigned char* buf = lds + (n & 1) * IMG_LDS + lane * 16;
    f32x16 av[2], ao[2]; ao[0] = zero16(); ao[1] = zero16();
#pragma unroll
    for (int mt = 0; mt < 2; ++mt)
#pragma unroll
        for (int g4 = 0; g4 < 4; ++g4) { const u32x2 w = ucur[mt * 4 + g4]; av[mt][4 * g4] = bflo(w.x); av[mt][4 * g4 + 1] = bfhi(w.x); av[mt][4 * g4 + 2] = bflo(w.y); av[mt][4 * g4 + 3] = bfhi(w.y); }
    const float eg = egc;
    if (n + 2 < 32) { const bf16_t* up = uimg0 + (size_t)(n + 2) * 8192;
#pragma unroll
        for (int x = 0; x < 8; ++x) ucur[x] = *(const u32x2*)(up + x * 256);
        egc = egp[n + 2]; }
    {
        bf16x8 fg[2][4];
#pragma unroll
        for (int mt = 0; mt < 2; ++mt) { fg[0][mt] = *(const LAS bf16x8*)(buf + (mt * 8) * 1024); fg[0][2 + mt] = *(const LAS bf16x8*)(buf + 16384 + (mt * 8) * 1024); }
#pragma unroll
        for (int gI = 0; gI < 8; ++gI) { const int dt = gI >> 1, s = gI & 1;
            if (gI + 1 < 8) {
#pragma unroll
                for (int mt = 0; mt < 2; ++mt) { fg[(gI + 1) & 1][mt] = *(const LAS bf16x8*)(buf + (mt * 8 + gI + 1) * 1024); fg[(gI + 1) & 1][2 + mt] = *(const LAS bf16x8*)(buf + 16384 + (mt * 8 + gI + 1) * 1024); } }
            asm volatile("" ::: "memory");
            const bf16x8 sb = as_bf(pack8(S[dt], s));
            av[0] = MFMA32(fg[gI & 1][0], sb, av[0]); av[1] = MFMA32(fg[gI & 1][1], sb, av[1]);
            ao[0] = MFMA32(sb, fg[gI & 1][2], ao[0]); ao[1] = MFMA32(sb, fg[gI & 1][3], ao[1]); }
    }
    bf16x8 vb[2][2];
#pragma unroll
    for (int mp = 0; mp < 2; ++mp)
#pragma unroll
        for (int s = 0; s < 2; ++s) vb[mp][s] = as_bf(pack8(av[mp], s));
    {
        bf16x8 qf[6];
#pragma unroll
        for (int f = 0; f < 6; ++f) qf[f] = *(const LAS bf16x8*)(buf + 49152 + f * 1024);
        asm volatile("" ::: "memory");
#pragma unroll
        for (int s = 0; s < 2; ++s) { ao[0] = MFMA32(vb[0][s], qf[s], ao[0]); ao[1] = MFMA32(vb[0][s], qf[2 + s], ao[1]); ao[1] = MFMA32(vb[1][s], qf[4 + s], ao[1]); }
    }
    LAS bf16_t* ob = (LAS bf16_t*)(lds + LDS_OBUF + (n & 1) * OBUF_BYTES);
#pragma unroll
    for (int mt = 0; mt < 2; ++mt)
#pragma unroll
        for (int g4 = 0; g4 < 4; ++g4) { u32x2 w; w.x = pk2(ao[mt][4 * g4], ao[mt][4 * g4 + 1]); w.y = pk2(ao[mt][4 * g4 + 2], ao[mt][4 * g4 + 3]);
            *(LAS u32x2*)(ob + (32 * mt + r) * OB_STRIDE + 32 * ws + 8 * g4 + 4 * h) = w; }
    bf16x8 kf[2][4];
#pragma unroll
    for (int f = 0; f < 4; ++f) kf[0][f] = *(const LAS bf16x8*)(buf + 32768 + f * 1024);
#pragma unroll
    for (int dt = 0; dt < 4; ++dt) {
        if (dt + 1 < 4) {
#pragma unroll
            for (int f = 0; f < 4; ++f) kf[(dt + 1) & 1][f] = *(const LAS bf16x8*)(buf + 32768 + ((dt + 1) * 4 + f) * 1024); }
        asm volatile("" ::: "memory");
        S[dt] = S[dt] * eg;
#pragma unroll
        for (int mp = 0; mp < 2; ++mp)
#pragma unroll
            for (int s = 0; s < 2; ++s) S[dt] = MFMA32(kf[dt & 1][mp * 2 + s], vb[mp][s], S[dt]); }
    __syncthreads();
}
DI void scan_block(const Ctx& c, int l, int bh, LAS unsigned char* lds) {
    const int wave = c.wave, b = bh >> 2, hh = bh & 3;
    const unsigned char* img0 = c.ws + WS_IMG + (size_t)bh * 32 * IMG_BYTES;
    if (wave >= 4) { if (SUB2(0)) {
        int lane = c.lane; asm volatile("" : "+v"(lane));
        const int lw = wave - 4, lid = lw * 64 + lane;
        u32x4 regs0[14], regs1[14], gt0[4];
        const bf16_t* gbase = WSP(bf16_t, WS_P) + (size_t)(b * SEQ + (lid >> 2)) * NP + 1536 + hh * 128 + 32 * (lid & 3);
        const unsigned voff0 = (unsigned)(lw * 14336 + lane * 16);
#pragma unroll
        for (int i = 0; i < 14; ++i) regs0[i] = *(const u32x4*)(img0 + voff0 + i * 1024);
#pragma unroll
        for (int i = 0; i < 14; ++i) *(LAS u32x4*)(lds + voff0 + i * 1024) = regs0[i];
#pragma unroll
        for (int i = 0; i < 14; ++i) { regs1[i] = *(const u32x4*)(img0 + (size_t)IMG_BYTES + voff0 + i * 1024); regs0[i] = *(const u32x4*)(img0 + (size_t)2 * IMG_BYTES + voff0 + i * 1024); }
#pragma unroll
        for (int x = 0; x < 4; ++x) gt0[x] = (u32x4){0u, 0u, 0u, 0u};
        __syncthreads();
        for (int n = 0; n < 32; n += 2) {
            scan_loader_step(c, l, b, hh, n, lds, img0, gbase, lw, lane, lid, regs1, gt0);
            scan_loader_step(c, l, b, hh, n + 1, lds, img0, gbase, lw, lane, lid, regs0, gt0);
        }
        scan_post(c, l, b, hh, 31, (const LAS bf16_t*)(lds + LDS_OBUF + (31 & 1) * OBUF_BYTES), lid, gt0);
    } } else if (SUB2(1)) {
        int lane = c.lane; asm volatile("" : "+v"(lane));
        const int ws = wave, r = lane & 31, h = lane >> 5;
        f32x16 S[4];
#pragma unroll
        for (int dt = 0; dt < 4; ++dt) S[dt] = zero16();
        const bf16_t* uimg0 = WSP(bf16_t, WS_UIMG) + (size_t)bh * 32 * 8192 + (size_t)ws * 2 * 4 * 256 + lane * 4;
        const float* egp = WSP(float, WS_EG) + bh * 32;
        u32x2 u0[8], u1[8];
#pragma unroll
        for (int x = 0; x < 8; ++x) { u0[x] = *(const u32x2*)(uimg0 + x * 256); u1[x] = *(const u32x2*)(uimg0 + 8192 + x * 256); }
        float eg0 = egp[0], eg1 = egp[1];
        __syncthreads();
        for (int n = 0; n < 32; n += 2) {
            scan_consumer_step(n, lds, S, u0, eg0, uimg0, egp, lane, ws, r, h);
            scan_consumer_step(n + 1, lds, S, u1, eg1, uimg0, egp, lane, ws, r, h);
        }
        const char* od = (const char*)(c.out + O_DP + (size_t)(l * 32 + bh) * 128 * 128);
        unsigned voff = (unsigned)((4 * h) * 128 + 32 * ws + r) * 4u;
        asm volatile("" : "+v"(voff));
#pragma unroll
        for (int dt = 0; dt < 4; ++dt)
#pragma unroll
            for (int reg = 0; reg < 16; ++reg) *(float*)(od + (32 * dt + (reg & 3) + 8 * (reg >> 2)) * 512 + voff) = S[dt][reg];
    }
}
DI float rdlane(float v, int l) { return __builtin_bit_cast(float, __builtin_amdgcn_readlane(__builtin_bit_cast(int, v), l)); }
DI void sample_recurrent(const Ctx& c, int l, int unit) {
    int lane = c.lane; asm volatile("" : "+v"(lane));
    const int bs = unit >> 2, hh = unit & 3, e2 = 2 * lane;
    const float* S0 = c.state_delta + (size_t)((l * SBATCH + bs) * 4 + hh) * 128 * 128 + e2;
    float* S1 = c.out + O_DS + (size_t)((l * SBATCH + bs) * 4 + hh) * 128 * 128 + e2;
    const float* q = WSP(float, WS_QS) + bs * 512 + hh * 128; const float* k = WSP(float, WS_KS) + bs * 512 + hh * 128; const float* v = WSP(float, WS_VS) + bs * 512 + hh * 128;
    const float eg = __expf(WSP(float, WS_GS)[bs * 4 + hh]), beta = WSP(float, WS_BS)[bs * 4 + hh];
    const float k0 = k[lane], k1 = k[64 + lane], q0 = q[lane], q1 = q[64 + lane];
    f32x2 kv = {0.f, 0.f};
#pragma unroll
    for (int d0 = 0; d0 < 128; d0 += 32) { f32x2 sv[32];
#pragma unroll
        for (int j = 0; j < 32; ++j) sv[j] = *(const f32x2*)(S0 + (d0 + j) * 128);
#pragma unroll
        for (int j = 0; j < 32; ++j) { const int dd = d0 + j; kv += sv[j] * rdlane(dd < 64 ? k0 : k1, dd & 63); } }
    const f32x2 v2 = *(const f32x2*)(v + e2);
    const f32x2 delta = (v2 - kv * eg) * beta;
    f32x2 oo = {0.f, 0.f};
#pragma unroll
    for (int d0 = 0; d0 < 128; d0 += 32) { f32x2 sv[32];
#pragma unroll
        for (int j = 0; j < 32; ++j) sv[j] = *(const f32x2*)(S0 + (d0 + j) * 128);
#pragma unroll
        for (int j = 0; j < 32; ++j) { const int dd = d0 + j; const f32x2 sn = sv[j] * eg + delta * rdlane(dd < 64 ? k0 : k1, dd & 63); oo += sn * rdlane(dd < 64 ? q0 : q1, dd & 63); *(f32x2*)(S1 + dd * 128) = sn; } }
    const float ss = wave_sum(oo.x * oo.x + oo.y * oo.y, lane); const float rs = rsqrtf(ss * (1.0f / 128.0f) + EPS);
    const float* ps = WSP(float, WS_PS) + (size_t)bs * NPS + 1536 + hh * 128 + e2; float* am = WSP(float, WS_AMIXS) + (size_t)bs * DM + hh * 128 + e2;
    const float* og = c.o_norm_g + l * 128 + e2;
    am[0] = oo.x * rs * og[0] * silu_f(ps[0]); am[1] = oo.y * rs * og[1] * silu_f(ps[1]);
}
DI void phase_scan(const Ctx& c, int l, LAS unsigned char* lds) {
    if (c.bx < 32) { if (SUB(0)) scan_block(c, l, c.bx, lds); return; }
    const int w0 = (c.bx - 32) * 8 + c.wave, nw = (c.nb - 32) * 8;
    LAS unsigned char* wl = lds + c.wave * B0_WAVE_LDS;
    for (int u = w0; u < SBATCH * 4 + 512; u += nw) {
        if (u < SBATCH * 4) { if (SUB(1)) sample_recurrent(c, l, u); continue; }
        const int g = u - SBATCH * 4, hb = g & 3, cc = (g >> 2) & 15, b = g >> 6;
        b0_task_vb(c, l, b, 2 * cc, hb, wl); b0_task_vb(c, l, b, 2 * cc + 1, hb, wl);
        asm volatile("s_waitcnt vmcnt(0)" ::: "memory");
        b1_gmlp(c, l, g);
    }
    if (l + 1 < DEPTH) convert_layer_weights(c, l + 1, w0, nw, lds);

}

DI void phase_final(const Ctx& c) {
    const f32x4* gr = (const f32x4*)c.norm_f_g + c.lane;
    for (int m = c.gw; m < MP + SBATCH; m += c.ngw) {
        f32x4 v[4]; float s = 0.f;
        if (m < MP) { const u32x2* xr = (const u32x2*)(WSP(bf16_t, WS_XB16) + (size_t)m * DM) + c.lane;
#pragma unroll
            for (int j = 0; j < 4; ++j) { const u32x2 w = xr[64 * j]; v[j] = (f32x4){bflo(w.x), bfhi(w.x), bflo(w.y), bfhi(w.y)}; } }
        else { const f32x4* xr = (const f32x4*)(WSP(float, WS_XS) + (size_t)(m - MP) * DM) + c.lane;
#pragma unroll
            for (int j = 0; j < 4; ++j) v[j] = xr[64 * j]; }
        float* dst = m < MP ? c.out + O_YP + (size_t)m * DM : c.out + O_YS + (size_t)(m - MP) * DM;
#pragma unroll
        for (int j = 0; j < 4; ++j) s += (v[j].x * v[j].x + v[j].y * v[j].y) + (v[j].z * v[j].z + v[j].w * v[j].w);
        const float rs = rsqrtf(wave_sum(s, c.lane) * (1.0f / DM) + EPS);
#pragma unroll
        for (int j = 0; j < 4; ++j) ((f32x4*)dst + c.lane)[64 * j] = v[j] * rs * gr[64 * j];
    }
}

#define XB_TMO      128
#define XB_XCNT(j)  (256  + 64 * (j))
#define XB_XSUB(j)  (1280 + 64 * (j))
#define XB_XGEN(j)  (2304 + 64 * (j))
#define XB_TOP      3328
#define XB_TOPGEN   3392
#define XCD_BAR_WORDS 3456
#define XB_SPIN_CAP (1u << 18)

__device__ __forceinline__ unsigned xb_ld(unsigned* p)              { return __hip_atomic_load(p, __ATOMIC_RELAXED, __HIP_MEMORY_SCOPE_AGENT); }
__device__ __forceinline__ unsigned xb_add(unsigned* p, unsigned v) { return __hip_atomic_fetch_add(p, v, __ATOMIC_RELAXED, __HIP_MEMORY_SCOPE_AGENT); }
__device__ __forceinline__ unsigned xb_xcc_id() { return (unsigned)__builtin_amdgcn_s_getreg((3 << 11) | 20) & 0xFu; }
#define XB_SPIN(cond, bar) do { unsigned _sp = 0; while (cond) { __builtin_amdgcn_s_sleep(8); \
    if ((++_sp & 255u) == 0u) { if (xb_ld(&(bar)[XB_TMO])) break; if (_sp > XB_SPIN_CAP) { atomicAdd(&(bar)[XB_TMO], 1u); break; } } } } while (0)

struct XcdBarrier {
    unsigned* bar; unsigned x;
    volatile LAS unsigned* st;
};

__device__ __forceinline__ XcdBarrier xcd_barrier_post(unsigned* bar, volatile LAS unsigned* st) {
    XcdBarrier b; b.bar = bar; b.x = xb_xcc_id(); b.st = st;
    if (threadIdx.x == 0) (void)xb_add(&bar[XB_XCNT(b.x)], 1u);
    return b;
}
__device__ __forceinline__ void xcd_barrier_complete(unsigned* bar, unsigned x, unsigned& nloc, unsigned& nx) {
    const unsigned G = gridDim.x * gridDim.y * gridDim.z;
    unsigned sum, cnt, mine, sp = 0u;
    for (;;) {
        sum = 0u; cnt = 0u; mine = 0u;
#pragma unroll
        for (unsigned j = 0; j < 16; ++j) { const unsigned c = xb_ld(&bar[XB_XCNT(j)]); sum += c; cnt += (c > 0u) ? 1u : 0u; mine = (j == x) ? c : mine; }
        if (sum == G) break;
        __builtin_amdgcn_s_sleep(1);
        if ((++sp & 255u) == 0u) { if (xb_ld(&bar[XB_TMO])) break; if (sp > XB_SPIN_CAP) { atomicAdd(&bar[XB_TMO], 1u); break; } }
    }
    nloc = mine > 0u ? mine : 1u; nx = cnt > 0u ? cnt : 1u;
}

__device__ __forceinline__ void xcd_barrier(const XcdBarrier& b) {
    asm volatile("s_waitcnt vmcnt(0)" ::: "memory");
    __syncthreads();
    if (threadIdx.x == 0) {
        unsigned* bar = b.bar;
        __builtin_amdgcn_s_waitcnt(0);
        unsigned nloc = b.st[0], nx = b.st[1];
        if (nloc == 0u) { xcd_barrier_complete(bar, b.x, nloc, nx); b.st[0] = nloc; b.st[1] = nx; }
        const unsigned old = xb_add(&bar[XB_XSUB(b.x)], 1u);
        const unsigned gen = old / nloc;
        if (old + 1u == (gen + 1u) * nloc) {
            __builtin_amdgcn_fence(__ATOMIC_RELEASE, "agent");
            asm volatile("s_waitcnt vmcnt(0)" ::: "memory");
            const unsigned og = xb_add(&bar[XB_TOP], 1u);
            const unsigned tg = og / nx;
            if (og + 1u == (tg + 1u) * nx) xb_add(&bar[XB_TOPGEN], 1u);
            else XB_SPIN(xb_ld(&bar[XB_TOPGEN]) == tg, bar);
            __builtin_amdgcn_fence(__ATOMIC_ACQUIRE, "agent");
            xb_add(&bar[XB_XGEN(b.x)], 1u);
            asm volatile("s_waitcnt vmcnt(0)" ::: "memory");
        } else {
            XB_SPIN(xb_ld(&bar[XB_XGEN(b.x)]) == gen, bar);
            __builtin_amdgcn_fence(__ATOMIC_ACQUIRE, "agent");
            asm volatile("s_waitcnt vmcnt(0)" ::: "memory");
        }
    }
    __syncthreads();
}
#ifndef ONLY
#define ONLY -1
#endif
#ifndef REPMASK
#define REPMASK 0
#endif
#define EN(x) (ONLY < 0 || ONLY == (x))
__global__ void __launch_bounds__(512, 2) hymba_fwd(Args args) {
    extern __shared__ __attribute__((aligned(16))) unsigned char lds_raw[];
    LAS unsigned char* lds = (LAS unsigned char*)lds_raw;
    cg::grid_group grid = cg::this_grid();
    Ctx c;
    c.x_prompt = args.in[0]; c.x_sample = args.in[1]; c.state_delta = args.in[2]; c.state_conv = args.in[3]; c.norm_mix_g = args.in[4]; c.w_in = args.in[5]; c.conv_w = args.in[6];
    c.A_log = args.in[7]; c.dt_bias = args.in[8]; c.o_norm_g = args.in[9]; c.v_norm_g = args.in[10]; c.w_s = args.in[11]; c.b_s = args.in[12]; c.w_o = args.in[13]; c.norm_ffn_g = args.in[14];
    c.w_up = args.in[15]; c.w_down = args.in[16]; c.norm_f_g = args.in[17]; c.out = args.out; c.ws = args.ws;
    c.lane = threadIdx.x & 63; c.wave = __builtin_amdgcn_readfirstlane(threadIdx.x >> 6); c.gw = blockIdx.x * 8 + c.wave; c.ngw = gridDim.x * 8; c.bx = blockIdx.x; c.nb = gridDim.x;
    volatile LAS unsigned* bst = (volatile LAS unsigned*)(lds + LDS_BYTES - 16);
    if (threadIdx.x < 2) bst[threadIdx.x] = 0u;
    __syncthreads();
    XcdBarrier xbar = xcd_barrier_post((unsigned*)args.ws, bst);
    grid.sync();
    for (int step = 2 * args.ph_lo; step < 2 * args.ph_hi; ++step) {
        const int ph = step >> 1;
        const int ptype = ph == 0 ? 0 : (ph == 29 ? 8 : 1 + (ph - 1) % 7);
        if ((step & 1) && !((REPMASK >> ptype) & 1)) continue;
        { int tl = threadIdx.x; asm volatile("" : "+v"(tl)); c.lane = tl & 63; int bxo = blockIdx.x, nbo = gridDim.x; asm volatile("" : "+s"(bxo), "+s"(nbo)); c.bx = bxo; c.nb = nbo; c.wave = __builtin_amdgcn_readfirstlane(tl >> 6); c.gw = bxo * 8 + c.wave; c.ngw = nbo * 8; unsigned char* wsp = args.ws; asm volatile("" : "+s"(wsp)); c.ws = wsp; float* op = args.out; asm volatile("" : "+s"(op)); c.out = op; }
        if (step & 1) __syncthreads();
        if (ph == 0) { if (EN(0)) phase_prologue(c, lds); }
        else if (ph == 29) { if (EN(8)) phase_final(c); }
        else {
            const int l = (ph - 1) / 7, s = (ph - 1) % 7;
            float* ssq = WSP(float, WS_SSQ);
            if (s == 0) { if (EN(1)) { sgemm1(c, l, lds); if ((REPMASK >> 10) & 1) sgemm1(c, l, lds);
                pg8::Gemm g{WSP(bf16_t, WS_XB16), WSP(bf16_t, WS_WIN) + (size_t)l * NP * DM, MP, NP, DM}; pg8::StaticOrder S; S.init(MP, NP, c.nb, c.bx);
                pg8::EpiScaleBf16 E{WSP(bf16_t, WS_P), NP, ssq + (size_t)(2 * l) * MP * 16, 0, WSP(float, WS_VSS), c.o_norm_g + l * 128}; pg8::gemm_phase(lds, g, S, E); } }
            else if (s == 1) { if (EN(2)) phase_b0(c, l, lds); }
            else if (s == 2) { if (EN(3)) phase_b1(c, l, lds); }
            else if (s == 3) { if (EN(4)) phase_scan(c, l, lds); if ((REPMASK >> 12) & 1) { __syncthreads(); if (c.bx < 32) scan_block(c, l, c.bx, lds); } if ((REPMASK >> 13) & 1) { if (c.bx >= 32) { const int w0 = (c.bx - 32) * 8 + c.wave, nw = (c.nb - 32) * 8; for (int u = w0; u < SBATCH * 4; u += nw) sample_recurrent(c, l, u); } } }
            else if (s == 4) { if (EN(5)) { if (!(step & 1)) sgemm2(c, l, lds);
                pg8::Gemm g{WSP(bf16_t, WS_AMIX), WSP(bf16_t, WS_WO) + (size_t)l * DM * DM, MP, DM, DM}; pg8::StaticOrder S; S.init(MP, DM, c.nb, c.bx);
                pg8::EpiResid E{WSP(bf16_t, WS_XB16), ssq + (size_t)(2 * l + 1) * MP * 16}; pg8::gemm_phase(lds, g, S, E); } }
            else if (s == 5) { if (EN(6)) { sgemm3(c, l, lds); if ((REPMASK >> 11) & 1) sgemm3(c, l, lds);
                pg8::Gemm g{WSP(bf16_t, WS_XB16), WSP(bf16_t, WS_WUP) + (size_t)l * FF * DM, MP, FF, DM}; pg8::StaticOrder S; S.init(MP, FF, c.nb, c.bx);
                pg8::EpiScaleBf16 E{WSP(bf16_t, WS_UNION), FF, ssq + (size_t)(2 * l + 1) * MP * 16, 1, nullptr, nullptr}; pg8::gemm_phase(lds, g, S, E); } }
            else { if (EN(7)) { if (!(step & 1)) sgemm4(c, l, lds);
                pg8::Gemm g{WSP(bf16_t, WS_UNION), WSP(bf16_t, WS_WDN) + (size_t)l * DM * FF, MP, DM, FF}; pg8::StaticOrder S; S.init(MP, DM, c.nb, c.bx);
                pg8::EpiResid E{WSP(bf16_t, WS_XB16), ssq + (size_t)(2 * l + 2) * MP * 16}; pg8::gemm_phase(lds, g, S, E); } }
        }
        if (!(step & 1) && ((REPMASK >> ptype) & 1)) continue;
        if ((REPMASK >> 9) & 1) { if (ph + 1 < args.ph_hi) xcd_barrier(xbar); }
        if (ph + 1 < args.ph_hi) {
            xcd_barrier(xbar);
        }
    }
}

extern "C" void kernel_launch(void* const* d_in, const int* in_sizes, int n_in, void* d_out, int out_size, void* d_ws, size_t ws_size, hipStream_t stream) {
    static int grid = 0;
    if (grid == 0) {
        int dev = 0, cus = 0, per_cu = 0;
        (void)hipGetDevice(&dev); (void)hipDeviceGetAttribute(&cus, hipDeviceAttributeMultiprocessorCount, dev);
        if (hipFuncSetAttribute((const void*)hymba_fwd, hipFuncAttributeMaxDynamicSharedMemorySize, LDS_BYTES) != hipSuccess) fprintf(stderr, "kernel_launch: hipFuncSetAttribute failed\n");
        if (hipOccupancyMaxActiveBlocksPerMultiprocessor(&per_cu, (const void*)hymba_fwd, 512, LDS_BYTES) != hipSuccess || per_cu < 1) { fprintf(stderr, "kernel_launch: occupancy query says %d\n", per_cu); per_cu = 1; }
        (void)hipGetLastError();
        grid = cus * 1;
        if (ws_size < WS_END) fprintf(stderr, "kernel_launch: workspace too small: %zu < %zu\n", ws_size, (size_t)WS_END);
    }
    (void)hipMemsetAsync(d_ws, 0, 65536, stream);
    Args a{};
    for (int i = 0; i < 18; ++i) a.in[i] = (const float*)d_in[i];
    a.out = (float*)d_out; a.ws = (unsigned char*)d_ws; a.ph_lo = 0; a.ph_hi = 30;
    void* kargs[] = {&a};
    hipError_t e = hipLaunchCooperativeKernel((const void*)hymba_fwd, dim3(grid), dim3(512), kargs, LDS_BYTES, stream);
    if (e != hipSuccess) fprintf(stderr, "kernel_launch: cooperative launch failed: %s (grid %d)\n", hipGetErrorString(e), grid);
}
```

```cpp
#include <hip/hip_runtime.h>
#include <hip/hip_cooperative_groups.h>
#include <cstdio>
namespace cg = cooperative_groups;

#define LAS __attribute__((address_space(3)))
#define DI __device__ __forceinline__
typedef unsigned short bf16_t;
typedef short bf16x8 __attribute__((ext_vector_type(8)));
typedef float f32x4 __attribute__((ext_vector_type(4)));
typedef float f32x2 __attribute__((ext_vector_type(2)));
typedef float f32x16 __attribute__((ext_vector_type(16)));
typedef unsigned u32x4 __attribute__((ext_vector_type(4)));
typedef unsigned u32x2 __attribute__((ext_vector_type(2)));
typedef __bf16 bf2_t __attribute__((ext_vector_type(2)));
typedef unsigned u32x8 __attribute__((ext_vector_type(8)));

#ifndef SUBSEL
#define SUBSEL -1
#endif
#define SUB(x) (SUBSEL < 0 || SUBSEL == (x))
#ifndef SUBSEL2
#define SUBSEL2 -1
#endif
#define SUB2(x) (SUBSEL2 < 0 || SUBSEL2 == (x))
constexpr int DM = 1024, NBATCH = 8, SEQ = 2048, MP = NBATCH * SEQ, DEPTH = 4, SBATCH = 128;
constexpr int NH = 4, QKV = 1536, NP = 3072, PROJ = 3080, FF = 4096, NPS = 3088;
constexpr float EPS = 1e-6f;
constexpr int IMG_BYTES = 55296;
constexpr int LDS_BYTES = 150528;
constexpr size_t O_YP = 0, O_YS = 16777216, O_DP = 16908288, O_CP = 19005440, O_DS = 19152896, O_CS = 52707328, O_VS = 55066624;
constexpr size_t WS_WIN = 65536;
constexpr size_t WS_WAB = WS_WIN + (size_t)DEPTH * NP * DM * 2;
constexpr size_t WS_WO = WS_WAB + (size_t)DEPTH * 16 * DM * 2;
constexpr size_t WS_WUP = WS_WO + (size_t)DEPTH * DM * DM * 2;
constexpr size_t WS_WDN = WS_WUP + (size_t)DEPTH * FF * DM * 2;
constexpr size_t WS_WM = WS_WDN + (size_t)DEPTH * FF * DM * 2;
constexpr size_t WS_XBUF = WS_WM + (size_t)DEPTH * 4 * 128 * 128 * 2;
constexpr size_t WS_XB16 = WS_XBUF + (size_t)MP * DM * 4;
constexpr size_t WS_SSQ = WS_XB16 + (size_t)MP * DM * 2;
constexpr size_t WS_UNION = WS_SSQ + (size_t)9 * MP * 16 * 4;
constexpr size_t WS_P = WS_UNION;
constexpr size_t WS_QN = WS_P + (size_t)MP * NP * 2;
constexpr size_t WS_KN = WS_QN + (size_t)MP * 512 * 2;
constexpr size_t WS_KNT = WS_UNION + (size_t)MP * FF * 2;
constexpr size_t WS_VT = WS_KNT + (size_t)MP * 512 * 2;
constexpr size_t WS_VBT = WS_VT + (size_t)MP * 512 * 2;
constexpr size_t WS_G = WS_VBT + (size_t)MP * 512 * 2;
constexpr size_t WS_BETA = WS_G + (size_t)MP * 4 * 4;
constexpr size_t WS_EG = WS_BETA + (size_t)MP * 4 * 4;
constexpr size_t WS_IMG = WS_EG + 4096;
constexpr size_t WS_UIMG = WS_IMG + (size_t)1024 * IMG_BYTES;
constexpr size_t WS_AMIX = WS_UIMG + (size_t)1024 * 32768;
constexpr size_t WS_XS = WS_AMIX + (size_t)MP * DM * 2;
constexpr size_t WS_PS = WS_XS + (size_t)SBATCH * DM * 4;
constexpr size_t WS_QS = WS_PS + (size_t)SBATCH * NPS * 4;
constexpr size_t WS_KS = WS_QS + (size_t)SBATCH * 512 * 4;
constexpr size_t WS_VS = WS_KS + (size_t)SBATCH * 512 * 4;
constexpr size_t WS_GS = WS_VS + (size_t)SBATCH * 512 * 4;
constexpr size_t WS_BS = WS_GS + (size_t)SBATCH * 4 * 4;
constexpr size_t WS_AMIXS = WS_BS + (size_t)SBATCH * 4 * 4;
constexpr size_t WS_HS = WS_AMIXS + (size_t)SBATCH * DM * 4;
constexpr size_t WS_XP = WS_HS + (size_t)SBATCH * FF * 4;
constexpr size_t WS_VSS = WS_XP + (size_t)4 * SBATCH * DM * 4;
constexpr size_t WS_CWP = WS_VSS + (size_t)MP * 8 * 4;
constexpr size_t WS_END = WS_CWP + (size_t)DEPTH * 4 * QKV * 4;
static_assert(WS_QN + 2 * (size_t)MP * 512 * 2 == WS_KNT, "union");
static_assert(WS_END <= (size_t)536870912, "workspace");

DI unsigned pk2(float lo, float hi) { f32x2 v = {lo, hi}; return __builtin_bit_cast(unsigned, __builtin_convertvector(v, bf2_t)); }
DI float bflo(unsigned w) { return __uint_as_float(w << 16); }
DI float bfhi(unsigned w) { return __uint_as_float(w & 0xffff0000u); }
DI float bf2f(bf16_t b) { return __uint_as_float(((unsigned)b) << 16); }
DI bf16_t f2bf(float f) { return (bf16_t)(pk2(f, 0.f) & 0xffffu); }
DI float xlane(float v, int srclane) { return __builtin_bit_cast(float, __builtin_amdgcn_ds_bpermute(srclane << 2, __builtin_bit_cast(int, v))); }
DI float wave_sum(float v, int lane) {
#pragma unroll
    for (int o = 1; o < 64; o <<= 1) v += xlane(v, lane ^ o);
    return v;
}
DI float silu_f(float x) { return x * __builtin_amdgcn_rcpf(1.f + __expf(-x)); }
DI float sigmoid_f(float x) { return __builtin_amdgcn_rcpf(1.f + __expf(-x)); }
DI float softplus_f(float x) { const float e = __expf(-fabsf(x)); const float l = e < 0.01f ? e * (1.f - e * (0.5f - 0.33333334f * e)) : __logf(1.f + e); return fmaxf(x, 0.f) + l; }
DI u32x4 pack8(const f32x16& x, int s) {
    u32x4 p; p.x = pk2(x[8 * s], x[8 * s + 1]); p.y = pk2(x[8 * s + 2], x[8 * s + 3]); p.z = pk2(x[8 * s + 4], x[8 * s + 5]); p.w = pk2(x[8 * s + 6], x[8 * s + 7]); return p;
}
DI float ssq_sum(const float* p) {
    const f32x4 a = *(const f32x4*)p, b = *(const f32x4*)(p + 4), c2 = *(const f32x4*)(p + 8), d2 = *(const f32x4*)(p + 12);
    return ((a.x + a.y) + (a.z + a.w)) + ((b.x + b.y) + (b.z + b.w)) + ((c2.x + c2.y) + (c2.z + c2.w)) + ((d2.x + d2.y) + (d2.z + d2.w));
}
DI int crow(int reg, int h) { return (reg & 3) + 8 * (reg >> 2) + 4 * h; }
#define MFMA32(a, b, c) __builtin_amdgcn_mfma_f32_32x32x16_bf16((a), (b), (c), 0, 0, 0)
#define MFMA16(a, b, c) __builtin_amdgcn_mfma_f32_16x16x32_bf16((a), (b), (c), 0, 0, 0)
DI bf16x8 as_bf(u32x4 v) { return __builtin_bit_cast(bf16x8, v); }
DI f32x16 zero16() { f32x16 z;
#pragma unroll
    for (int i = 0; i < 16; ++i) z[i] = 0.f; return z; }

namespace pg8 {
constexpr int BM = 256, BK = 64, HALF = 128, HTB = HALF * BK * 2, STAGE_BYTES = 8 * HTB, NXCD = 8, WGM = 8;
DI int lds_byte(int r, int c) { const int st = (r >> 4) * 2 + (c >> 5), rr = r & 15, cc = c & 31, ob = rr * 64 + cc * 2; return st * 1024 + (ob ^ (((ob >> 9) & 1) << 5)); }
DI void stage_rc(int b, int& R, int& C) { const int st = b / 1024, sb = b % 1024, swz = sb ^ (((sb >> 9) & 1) << 5); R = (st >> 1) * 16 + swz / 64; C = (st & 1) * 32 + (swz % 64) / 2; }
DI int perm32(int rho) { const int n = rho >> 4, i = rho & 15; return 8 * (i >> 2) + 4 * n + (i & 3); }
struct Unit { int pm, pn; };
struct Gemm { const bf16_t* A; const bf16_t* Bt; int M, N, K; };
struct StaticOrder {
    int nM, nN, nwg, G, c;
    DI void init(int M, int N, int G_, int c_) { nM = M / BM; nN = N / BM; nwg = nM * nN; G = G_; c = c_; }
    DI bool next(int i, Unit& u) const {
        const long L = (long)i * G + c; if (L >= nwg) return false;
        int wgid = (int)L; { const int q = nwg / NXCD, r = nwg % NXCD, xcd = wgid % NXCD, off = wgid / NXCD; wgid = (xcd < r ? xcd * (q + 1) : r * (q + 1) + (xcd - r) * q) + off; }
        const int nig = WGM * nN, gid = wgid / nig, fm = gid * WGM, gsz = (nM - fm) < WGM ? (nM - fm) : WGM;
        u.pm = fm + ((wgid % nig) % gsz); u.pn = (wgid % nig) / gsz; return true;
    }
};
template <class Epi>
DI void gemm_phase(LAS unsigned char* lds, const Gemm g, const StaticOrder& S, const Epi& E) {
    int tid = threadIdx.x; asm volatile("" : "+v"(tid));
    const int wid = __builtin_amdgcn_readfirstlane(tid >> 6), lane = tid & 63, wr = wid >> 2, wc = wid & 3, fr = lane & 15, fq = lane >> 4;
    const int K = g.K, nt = K / BK;
    unsigned voffA[2], voffB[2];
#pragma unroll
    for (int i = 0; i < 2; ++i) { int R, C; stage_rc(tid * 16 + i * 8192, R, C); const int Rb = (R & ~31) + perm32(R & 31);
        voffA[i] = (unsigned)(R * K + C) * 2u; voffB[i] = (unsigned)(Rb * K + C) * 2u; }
    const size_t kstep = (size_t)(BK * 2);
    const size_t hstep = (size_t)HALF * K * 2;
    const size_t tstep = 2 * hstep;
    const unsigned ldsw = (unsigned)wid * 1024u;
    const int aoff = lds_byte(wr * 64 + fr, fq * 8), boff = lds_byte(wc * 32 + fr, fq * 8);
#define PG8_SA(b, h) (((b) * 2 + (h)) * HTB)
#define PG8_SB(b, h) ((4 + (b) * 2 + (h)) * HTB)
#define PG8_STAGE(bufoff, gbase, voff) do { _Pragma("unroll") for (int _i = 0; _i < 2; ++_i) \
        __builtin_amdgcn_global_load_lds((const unsigned*)((const char*)(gbase) + (voff)[_i]), (LAS unsigned*)(lds + (bufoff) + ldsw + _i * 8192), 16, 0, 0); } while (0)
#define PG8_LDA(dst, b, h) do { _Pragma("unroll") for (int m = 0; m < 4; ++m) _Pragma("unroll") for (int k = 0; k < 2; ++k) dst[m][k] = *(const LAS bf16x8*)(lds + PG8_SA(b, h) + aoff + m * 2048 + k * 1024); } while (0)
#define PG8_LDB(dst, b, h) do { _Pragma("unroll") for (int n = 0; n < 2; ++n) _Pragma("unroll") for (int k = 0; k < 2; ++k) dst[n][k] = *(const LAS bf16x8*)(lds + PG8_SB(b, h) + boff + n * 2048 + k * 1024); } while (0)
#define PG8_MMA(ai, bj, At, Bt) do { __builtin_amdgcn_s_setprio(1); _Pragma("unroll") for (int m = 0; m < 4; ++m) _Pragma("unroll") for (int n = 0; n < 2; ++n) _Pragma("unroll") for (int k = 0; k < 2; ++k) \
        acc[ai][bj][m][n] = __builtin_amdgcn_mfma_f32_16x16x32_bf16(Bt[n][k], At[m][k], acc[ai][bj][m][n], 0, 0, 0); __builtin_amdgcn_s_setprio(0); } while (0)
#define PG8_WAIT_V(n) asm volatile("s_waitcnt vmcnt(" #n ")" ::: "memory")
#define PG8_WAIT_L(n) asm volatile("s_waitcnt lgkmcnt(" #n ")" ::: "memory")
#define PG8_BAR __builtin_amdgcn_s_barrier()
#define PG8_SCHED __builtin_amdgcn_sched_barrier(0)
    Unit cur, nxt; int ui = 0;
    if (!S.next(0, cur)) return;
    f32x4 acc[2][2][4][2];
#pragma unroll
    for (int a = 0; a < 2; ++a)
#pragma unroll
        for (int b = 0; b < 2; ++b)
#pragma unroll
            for (int m = 0; m < 4; ++m)
#pragma unroll
                for (int n = 0; n < 2; ++n) acc[a][b][m][n] = (f32x4){0.f, 0.f, 0.f, 0.f};
    bf16x8 At[4][2], B0[2][2], B1[2][2];
    const char* cA = (const char*)g.A + (size_t)cur.pm * tstep; const char* cB = (const char*)g.Bt + (size_t)cur.pn * tstep;
    PG8_STAGE(PG8_SB(0, 0), cB, voffB); PG8_STAGE(PG8_SA(0, 0), cA, voffA); PG8_STAGE(PG8_SB(0, 1), cB + hstep, voffB); PG8_STAGE(PG8_SA(0, 1), cA + hstep, voffA);
    if (wr == 1) PG8_BAR;
    PG8_WAIT_V(4); PG8_BAR;
    PG8_STAGE(PG8_SB(1, 0), cB + kstep, voffB); PG8_STAGE(PG8_SA(1, 0), cA + kstep, voffA); PG8_STAGE(PG8_SB(1, 1), cB + hstep + kstep, voffB);
    PG8_WAIT_V(6); PG8_BAR;
    for (;;) {
        const bool has_next = S.next(ui + 1, nxt);
        const char* nA = has_next ? (const char*)g.A + (size_t)nxt.pm * tstep : cA; const char* nB = has_next ? (const char*)g.Bt + (size_t)nxt.pn * tstep : cB;
        for (int t = 0; t < nt; t += 2) {
            const bool last = (t == nt - 2);
            const char* a1 = cA + (size_t)(t + 1) * kstep;
            const char* a2 = last ? nA : cA + (size_t)(t + 2) * kstep; const char* b2 = last ? nB : cB + (size_t)(t + 2) * kstep;
            const char* a3 = a2 + kstep; const char* b3 = b2 + kstep;
            PG8_LDB(B0, 0, 0); PG8_SCHED; PG8_LDA(At, 0, 0); PG8_STAGE(PG8_SA(1, 1), a1 + hstep, voffA);
            PG8_WAIT_L(8); PG8_BAR; PG8_WAIT_L(0); PG8_MMA(0, 0, At, B0); PG8_BAR; PG8_SCHED;
            PG8_LDB(B1, 0, 1); PG8_STAGE(PG8_SB(0, 0), b2, voffB);
            PG8_BAR; PG8_WAIT_L(0); PG8_MMA(0, 1, At, B1); PG8_BAR;
            PG8_LDA(At, 0, 1); PG8_STAGE(PG8_SA(0, 0), a2, voffA);
            PG8_BAR; PG8_WAIT_L(0); PG8_MMA(1, 0, At, B0); PG8_BAR; PG8_SCHED;
            PG8_STAGE(PG8_SB(0, 1), b2 + hstep, voffB);
            PG8_WAIT_V(6); PG8_BAR; PG8_MMA(1, 1, At, B1); PG8_BAR;
            PG8_LDB(B0, 1, 0); PG8_SCHED; PG8_LDA(At, 1, 0); PG8_STAGE(PG8_SA(0, 1), a2 + hstep, voffA);
            PG8_WAIT_L(8); PG8_BAR; PG8_WAIT_L(0); PG8_MMA(0, 0, At, B0); PG8_BAR; PG8_SCHED;
            PG8_LDB(B1, 1, 1); PG8_STAGE(PG8_SB(1, 0), b3, voffB);
            PG8_BAR; PG8_WAIT_L(0); PG8_MMA(0, 1, At, B1); PG8_BAR;
            PG8_LDA(At, 1, 1); PG8_STAGE(PG8_SA(1, 0), a3, voffA);
            PG8_BAR; PG8_WAIT_L(0); PG8_MMA(1, 0, At, B0); PG8_BAR; PG8_SCHED;
            PG8_STAGE(PG8_SB(1, 1), b3 + hstep, voffB);
            PG8_WAIT_V(6); PG8_BAR; PG8_MMA(1, 1, At, B1); PG8_BAR;
        }
        E(acc, cur, wr, wc, fr, fq);
        if (!has_next) break;
#pragma unroll
        for (int a = 0; a < 2; ++a)
#pragma unroll
            for (int b = 0; b < 2; ++b)
#pragma unroll
                for (int m = 0; m < 4; ++m)
#pragma unroll
                    for (int n = 0; n < 2; ++n) acc[a][b][m][n] = (f32x4){0.f, 0.f, 0.f, 0.f};
        cur = nxt; cA = nA; cB = nB; ++ui;
    }
    PG8_WAIT_V(0);
    if (wr == 0) PG8_BAR;
    PG8_BAR;
#undef PG8_SA
#undef PG8_SB
#undef PG8_STAGE
#undef PG8_LDA
#undef PG8_LDB
#undef PG8_MMA
#undef PG8_WAIT_V
#undef PG8_WAIT_L
#undef PG8_BAR
#undef PG8_SCHED
}
struct EpiScaleBf16 {
    bf16_t* O; int ldc; const float* ssq; int act; float* vss; const float* og;
    DI void operator()(const f32x4 (&acc)[2][2][4][2], const Unit& u, int wr, int wc, int fr, int fq) const {
        const int row0 = u.pm * BM + wr * 64 + fr, col0 = u.pn * BM + wc * 32 + 8 * fq;
#pragma unroll
        for (int ai = 0; ai < 2; ++ai)
#pragma unroll
            for (int m = 0; m < 4; ++m) { const int row = row0 + ai * HALF + m * 16;
                float rq; { const f32x4 p4 = *(const f32x4*)(ssq + (size_t)row * 16 + 4 * fq); rq = (p4.x + p4.y) + (p4.z + p4.w); const int ln = fq * 16 + fr; rq += xlane(rq, ln ^ 16); rq += xlane(rq, ln ^ 32); }
                const float rs = rsqrtf(rq * (1.0f / DM) + EPS);
                bf16_t* rowp = O + (size_t)row * ldc + col0; float vs = 0.f;
#pragma unroll
                for (int bj = 0; bj < 2; ++bj) { f32x4 v0 = acc[ai][bj][m][0] * rs, v1 = acc[ai][bj][m][1] * rs;
                    if (act) {
#pragma unroll
                        for (int j = 0; j < 4; ++j) { const float a = fmaxf(v0[j], 0.f), b = fmaxf(v1[j], 0.f); v0[j] = a * a; v1[j] = b * b; } }
                    if (og != nullptr && (u.pn == 6 || u.pn == 7)) { const float* gp = og + ((col0 + bj * HALF) & 127); const f32x4 g0 = *(const f32x4*)gp, g1 = *(const f32x4*)(gp + 4);
#pragma unroll
                        for (int j = 0; j < 4; ++j) { v0[j] = silu_f(v0[j]) * g0[j]; v1[j] = silu_f(v1[j]) * g1[j]; } }
                    u32x4 w; w.x = pk2(v0[0], v0[1]); w.y = pk2(v0[2], v0[3]); w.z = pk2(v1[0], v1[1]); w.w = pk2(v1[2], v1[3]);
                    *(u32x4*)(rowp + bj * HALF) = w;
                    vs += (v0[0] * v0[0] + v0[1] * v0[1]) + (v0[2] * v0[2] + v0[3] * v0[3]) + (v1[0] * v1[0] + v1[1] * v1[1]) + (v1[2] * v1[2] + v1[3] * v1[3]); }
                if (vss != nullptr && u.pn >= 10) { { const int ln = fq * 16 + fr; vs += xlane(vs, ln ^ 16); vs += xlane(vs, ln ^ 32); } if (fq == 0) vss[(size_t)row * 8 + (u.pn - 10) * 4 + wc] = vs; } }
    }
};
struct EpiResid {
    bf16_t* xb; float* ssq;
    DI void operator()(const f32x4 (&acc)[2][2][4][2], const Unit& u, int wr, int wc, int fr, int fq) const {
        const int row0 = u.pm * BM + wr * 64 + fr, col0 = u.pn * BM + wc * 32 + 8 * fq;
#pragma unroll
        for (int ai = 0; ai < 2; ++ai)
#pragma unroll
            for (int m = 0; m < 4; ++m) { const int row = row0 + ai * HALF + m * 16; const size_t off = (size_t)row * DM + col0; float ss = 0.f;
#pragma unroll
                for (int bj = 0; bj < 2; ++bj) {
                    const u32x4 b = *(const u32x4*)(xb + off + bj * HALF);
                    const f32x4 o0 = (f32x4){bflo(b.x), bfhi(b.x), bflo(b.y), bfhi(b.y)} + acc[ai][bj][m][0], o1 = (f32x4){bflo(b.z), bfhi(b.z), bflo(b.w), bfhi(b.w)} + acc[ai][bj][m][1];
                    u32x4 w; w.x = pk2(o0[0], o0[1]); w.y = pk2(o0[2], o0[3]); w.z = pk2(o1[0], o1[1]); w.w = pk2(o1[2], o1[3]);
                    *(u32x4*)(xb + off + bj * HALF) = w;
                    ss += (o0[0] * o0[0] + o0[1] * o0[1]) + (o0[2] * o0[2] + o0[3] * o0[3]) + (o1[0] * o1[0] + o1[1] * o1[1]) + (o1[2] * o1[2] + o1[3] * o1[3]); }
                { const int ln = fq * 16 + fr; ss += xlane(ss, ln ^ 16); ss += xlane(ss, ln ^ 32); }
                if (fq == 0) ssq[(size_t)row * 16 + u.pn * 4 + wc] = ss;
                asm volatile("" ::: "memory"); }
    }
};
}

struct Args { const float* in[18]; float* out; unsigned char* ws; int ph_lo, ph_hi; };
struct Ctx {
    const float *x_prompt, *x_sample, *state_delta, *state_conv, *norm_mix_g, *w_in, *conv_w, *A_log, *dt_bias, *o_norm_g, *v_norm_g, *w_s, *b_s, *w_o, *norm_ffn_g, *w_up, *w_down, *norm_f_g;
    float* out; unsigned char* ws;
    int lane, wave, gw, ngw, bx, nb;
};
#define WSP(T, off) ((T*)(c.ws + (off)))

DI void transpose_item(const float* W, int K, int N, const float* kscale, bf16_t* WT, bf16_t* WAB, int mode, int item, int nblk, LAS float* scr, int lane) {
    const int kb = item / nblk, nb = item % nblk, k0 = 64 * kb, n0 = 64 * nb;
    const int c4 = lane & 15, rsub = lane >> 4;
    const bool cval = n0 + 4 * c4 + 3 < N;
#pragma unroll 4
    for (int kk = 0; kk < 64; kk += 4) { const int row = kk + rsub;
        f32x4 v = (f32x4){0.f, 0.f, 0.f, 0.f}; if (cval) { v = *(const f32x4*)(W + (size_t)(k0 + row) * N + n0 + 4 * c4); if (kscale) v = v * kscale[k0 + row]; }
        LAS float* p = scr + row * 65 + 4 * c4; p[0] = v.x; p[1] = v.y; p[2] = v.z; p[3] = v.w; }
    asm volatile("s_waitcnt lgkmcnt(0)" ::: "memory");
    const int kc = lane & 7;
#pragma unroll
    for (int it = 0; it < 8; ++it) { const int n = 8 * it + (lane >> 3), ns = n0 + n; const LAS float* s = scr + (8 * kc) * 65 + n;
        u32x4 o; o.x = pk2(s[0 * 65], s[1 * 65]); o.y = pk2(s[2 * 65], s[3 * 65]); o.z = pk2(s[4 * 65], s[5 * 65]); o.w = pk2(s[6 * 65], s[7 * 65]);
        if (ns < N) {
            bf16_t* rowp;
            if (mode == 0) rowp = WT + (size_t)ns * K;
            else rowp = ns < 2048 ? WT + (size_t)ns * K : (ns < 2056 ? WAB + (size_t)(ns - 2048) * K : WT + (size_t)(ns - 8) * K);
            *(u32x4*)(rowp + k0 + 8 * kc) = o; } }
    asm volatile("s_waitcnt lgkmcnt(0)" ::: "memory");
}
DI void convert_layer_weights(const Ctx& c, int l, int w0, int nw, LAS unsigned char* lds) {
    LAS float* scr = (LAS float*)(lds + c.wave * 18432);
    constexpr int I_IN = 16 * 49, I_O = 16 * 16, I_UP = 16 * 64, I_DN = 64 * 16, I_L = I_IN + I_O + I_UP + I_DN;
    for (int it = w0; it < I_L; it += nw) {
        int r = it;
        if (r < I_IN) { transpose_item(c.w_in + (size_t)l * DM * PROJ, DM, PROJ, c.norm_mix_g + l * DM, WSP(bf16_t, WS_WIN) + (size_t)l * NP * DM, WSP(bf16_t, WS_WAB) + (size_t)l * 16 * DM, 1, r, 49, scr, c.lane); continue; } r -= I_IN;
        if (r < I_O) { transpose_item(c.w_o + (size_t)l * DM * DM, DM, DM, nullptr, WSP(bf16_t, WS_WO) + (size_t)l * DM * DM, nullptr, 0, r, 16, scr, c.lane); continue; } r -= I_O;
        if (r < I_UP) { transpose_item(c.w_up + (size_t)l * DM * FF, DM, FF, c.norm_ffn_g + l * DM, WSP(bf16_t, WS_WUP) + (size_t)l * FF * DM, nullptr, 0, r, 64, scr, c.lane); continue; } r -= I_UP;
        transpose_item(c.w_down + (size_t)l * FF * DM, FF, DM, nullptr, WSP(bf16_t, WS_WDN) + (size_t)l * DM * FF, nullptr, 0, r, 16, scr, c.lane);
    }
}
DI void phase_prologue(const Ctx& c, LAS unsigned char* lds) {
    convert_layer_weights(c, 0, c.gw, c.ngw, lds);
    float* ssq = WSP(float, WS_SSQ);
    for (int m = c.gw; m < MP; m += c.ngw) {
        const f32x4* xr = (const f32x4*)(c.x_prompt + (size_t)m * DM) + c.lane; u32x2* o8 = (u32x2*)(WSP(bf16_t, WS_XB16) + (size_t)m * DM) + c.lane; float s = 0.f;
#pragma unroll
        for (int j = 0; j < 4; ++j) { const f32x4 v = xr[64 * j]; s += (v.x * v.x + v.y * v.y) + (v.z * v.z + v.w * v.w); u32x2 w; w.x = pk2(v.x, v.y); w.y = pk2(v.z, v.w); o8[64 * j] = w; }
        s = wave_sum(s, c.lane); if (c.lane < 16) ssq[(size_t)m * 16 + c.lane] = c.lane == 0 ? s : 0.f;
    }
    const int gt = c.gw * 64 + c.lane, ngt = c.ngw * 64;
    float* xs = WSP(float, WS_XS);
    for (int i = gt; i < SBATCH * DM; i += ngt) xs[i] = c.x_sample[i];
    bf16_t* wab = WSP(bf16_t, WS_WAB);
    for (int i = gt; i < DEPTH * 8 * DM; i += ngt) { const int l = i / (8 * DM), r = i % (8 * DM); wab[(size_t)l * 16 * DM + 8 * DM + r] = 0; }
    unsigned* wm = WSP(unsigned, WS_WM);
    for (int i = gt; i < DEPTH * 4 * 128 * 64; i += ngt) { const int e = 2 * i, ii = (e >> 7) & 127, jj = e & 127;
        const float a = ii >= jj ? c.w_s[e] : 0.f, b = ii >= jj + 1 ? c.w_s[e + 1] : 0.f; wm[i] = pk2(a, b); }
}

template <int NT, bool NORM, int EPI>
DI void sgemm_block(const Ctx& c, const float* A, int lda, int K, const bf16_t* Bt, int ncg, float* out, int ldo, LAS unsigned char* lds, const bf16_t* Bab) {
    int lane = c.lane; asm volatile("" : "+v"(lane));
    const int wave = c.wave, fr = lane & 15, fq = lane >> 4;
    LAS f32x4* red = (LAS f32x4*)lds;
    LAS float* ssr = (LAS float*)(lds + 8 * NT * 64 * 16);
    const int kw = K / 8, k0 = wave * kw;
    for (int u = c.bx; u < 8 * ncg; u += c.nb) {
        const int rt = u & 7, cg = u >> 3;
        const bool abg = (Bab != nullptr) && (cg == ncg - 1);
        const bf16_t* bp = (abg ? Bab : Bt + (size_t)cg * NT * 16 * K) + (size_t)fr * K + k0 + 8 * fq;
        const float* ap = A + (size_t)(rt * 16 + fr) * lda + k0 + 8 * fq;
        f32x4 acc[NT]; float ss = 0.f;
#pragma unroll
        for (int nt = 0; nt < NT; ++nt) acc[nt] = (f32x4){0.f, 0.f, 0.f, 0.f};
#pragma unroll 4
        for (int k = 0; k < kw; k += 32) {
            const f32x4 a0 = *(const f32x4*)(ap + k), a1 = *(const f32x4*)(ap + k + 4);
            if (NORM) ss += (a0.x * a0.x + a0.y * a0.y) + (a0.z * a0.z + a0.w * a0.w) + (a1.x * a1.x + a1.y * a1.y) + (a1.z * a1.z + a1.w * a1.w);
            u32x4 a; a.x = pk2(a0.x, a0.y); a.y = pk2(a0.z, a0.w); a.z = pk2(a1.x, a1.y); a.w = pk2(a1.z, a1.w);
#pragma unroll
            for (int nt = 0; nt < NT; ++nt) if (nt == 0 || !abg) { const bf16x8 bf = *(const bf16x8*)(bp + (size_t)nt * 16 * K + k); acc[nt] = MFMA16(as_bf(a), bf, acc[nt]); }
        }
        if (NORM) { ss += xlane(ss, lane ^ 16); ss += xlane(ss, lane ^ 32); if (fq == 0) ssr[wave * 16 + fr] = ss; }
#pragma unroll
        for (int nt = 0; nt < NT; ++nt) red[(wave * NT + nt) * 64 + lane] = acc[nt];
        __syncthreads();
        if (wave < NT && (wave == 0 || !abg)) {
            f32x4 t = red[wave * 64 + lane];
#pragma unroll
            for (int w = 1; w < 8; ++w) t += red[(w * NT + wave) * 64 + lane];
            const int col = (cg * NT + wave) * 16 + fr;
#pragma unroll
            for (int j = 0; j < 4; ++j) { const int rl = 4 * fq + j; float rs = 1.f;
                if (NORM) { float sq = 0.f;
#pragma unroll
                    for (int w = 0; w < 8; ++w) sq += ssr[w * 16 + rl];
                    rs = rsqrtf(sq * (1.0f / DM) + EPS); }
                float* o = out + (size_t)(rt * 16 + rl) * ldo + col;
                if (EPI == 0) *o = t[j] * rs; else if (EPI == 1) *o += t[j]; else { const float v = fmaxf(t[j] * rs, 0.f); *o = v * v; } }
        }
        __syncthreads();
    }
}
DI void sgemm1(const Ctx& c, int l, LAS unsigned char* lds) {
    sgemm_block<4, true, 0>(c, WSP(float, WS_XS), DM, DM, WSP(bf16_t, WS_WIN) + (size_t)l * NP * DM, 49, WSP(float, WS_PS), NPS, lds, WSP(bf16_t, WS_WAB) + (size_t)l * 16 * DM);
}
DI void sgemm2(const Ctx& c, int l, LAS unsigned char* lds) {
    sgemm_block<2, false, 1>(c, WSP(float, WS_AMIXS), DM, DM, WSP(bf16_t, WS_WO) + (size_t)l * DM * DM, 32, WSP(float, WS_XS), DM, lds, nullptr);
}
DI void sgemm3(const Ctx& c, int l, LAS unsigned char* lds) {
    sgemm_block<4, true, 2>(c, WSP(float, WS_XS), DM, DM, WSP(bf16_t, WS_WUP) + (size_t)l * FF * DM, 64, WSP(float, WS_HS), FF, lds, nullptr);
}
DI void sgemm4(const Ctx& c, int l, LAS unsigned char* lds) {
    sgemm_block<2, false, 1>(c, WSP(float, WS_HS), FF, FF, WSP(bf16_t, WS_WDN) + (size_t)l * DM * FF, 32, WSP(float, WS_XS), DM, lds, nullptr);
}

DI void b0_block_ab(const Ctx& c, int l, int chunk, LAS unsigned char* lds) {
    int lane = c.lane; asm volatile("" : "+v"(lane));
    const int wave = c.wave, fr = lane & 15, fq = lane >> 4, tok0 = chunk * 64, k0 = wave * 128;
    const bf16_t* ap = WSP(bf16_t, WS_XB16) + (size_t)(tok0 + fr) * DM + k0 + 8 * fq;
    const bf16_t* bp = WSP(bf16_t, WS_WAB) + (size_t)l * 16 * DM + (size_t)fr * DM + k0 + 8 * fq;
    f32x4 acc[4];
#pragma unroll
    for (int mt = 0; mt < 4; ++mt) acc[mt] = (f32x4){0.f, 0.f, 0.f, 0.f};
#pragma unroll
    for (int k = 0; k < 128; k += 32) {
        const bf16x8 bf = *(const bf16x8*)(bp + k);
#pragma unroll
        for (int mt = 0; mt < 4; ++mt) { const bf16x8 a = *(const bf16x8*)(ap + (size_t)mt * 16 * DM + k); acc[mt] = MFMA16(a, bf, acc[mt]); }
    }
    LAS f32x4* red = (LAS f32x4*)lds;
#pragma unroll
    for (int mt = 0; mt < 4; ++mt) red[(wave * 4 + mt) * 64 + lane] = acc[mt];
    __syncthreads();
    if (wave < 4 && fr < 8) { const int mt = wave;
        f32x4 t = red[mt * 64 + lane];
#pragma unroll
        for (int w = 1; w < 8; ++w) t += red[(w * 4 + mt) * 64 + lane];
        const float* ssq = WSP(float, WS_SSQ) + (size_t)(2 * l) * MP * 16;
        float* gb = WSP(float, WS_G); float* bb = WSP(float, WS_BETA);
        const int hh = fr & 3; const float al = -__expf(c.A_log[l * 4 + hh]), dtb = c.dt_bias[l * 4 + hh];
#pragma unroll
        for (int j = 0; j < 4; ++j) { const int tok = tok0 + 16 * mt + 4 * fq + j; const float v = t[j] * rsqrtf(ssq_sum(ssq + (size_t)tok * 16) * (1.0f / DM) + EPS);
            if (fr < 4) gb[tok * 4 + hh] = al * softplus_f(v + dtb); else bb[tok * 4 + hh] = sigmoid_f(v); } }
    __syncthreads();
}
DI float dot2bf(unsigned a, unsigned b, float c) { float r; asm("v_dot2c_f32_bf16 %0, %1, %2" : "=v"(r) : "s"(b), "v"(a), "0"(c)); return r; }
constexpr int B0_STRIDE = 272, B0_WAVE_LDS = 18432;
DI void b0_task_conv(const Ctx& c, int l, int b, int n, int s, int hh, LAS unsigned char* wl) {
    int lane = c.lane; asm volatile("" : "+v"(lane));
    const int tok0 = b * SEQ + n * 64, cb = s * 512 + hh * 128, piece = lane & 15;
    const bf16_t* P = WSP(bf16_t, WS_P) + (size_t)tok0 * NP + cb + piece * 8;
#pragma unroll
    for (int k = 0; k < 17; ++k) { const int row = 4 * k + (lane >> 4);
        if (row < 67) { u32x4 v = (u32x4){0u, 0u, 0u, 0u}; if (n > 0 || row >= 3) v = *(const u32x4*)(P + (long)(row - 3) * NP);
            *(LAS u32x4*)(wl + row * B0_STRIDE + piece * 16) = v; } }
    const unsigned* cwl = (const unsigned*)(c.conv_w + (size_t)l * 4 * QKV + cb);
    if (n == 31) {
        float* ocp = c.out + O_CP + ((size_t)(l * NBATCH + b) * 3) * QKV + cb;
#pragma unroll
        for (int t = 0; t < 6; ++t) { const int idx = lane + 64 * t, row = idx >> 7, ch = idx & 127; ocp[(size_t)row * QKV + ch] = bf2f(*(const LAS bf16_t*)(wl + (64 + row) * B0_STRIDE + ch * 2)); } }
    float ss = 0.f;
#pragma unroll 1
    for (int i = 0; i < 16; ++i) {
        u32x4 rws[4];
#pragma unroll
        for (int j = 0; j < 4; ++j) rws[j] = *(const LAS u32x4*)(wl + (lane + j) * B0_STRIDE + i * 16);
        u32x8 w0, w1, w2, w3; const unsigned* wp = cwl + 8 * i;
        asm volatile("s_load_dwordx8 %0, %4, 0x0\n\ts_load_dwordx8 %1, %4, 0x1800\n\ts_load_dwordx8 %2, %4, 0x3000\n\ts_load_dwordx8 %3, %4, 0x4800\n\ts_waitcnt lgkmcnt(0)"
                     : "=&s"(w0), "=&s"(w1), "=&s"(w2), "=&s"(w3) : "s"(wp) : "memory");
        float y[8];
#pragma unroll
        for (int e = 0; e < 8; ++e) { float a = 0.f;
            a = dot2bf(rws[0][e >> 1], (e & 1) ? ((w0[e] + 0x8000u) & 0xffff0000u) : ((w0[e] + 0x8000u) >> 16), a);
            a = dot2bf(rws[1][e >> 1], (e & 1) ? ((w1[e] + 0x8000u) & 0xffff0000u) : ((w1[e] + 0x8000u) >> 16), a);
            a = dot2bf(rws[2][e >> 1], (e & 1) ? ((w2[e] + 0x8000u) & 0xffff0000u) : ((w2[e] + 0x8000u) >> 16), a);
            a = dot2bf(rws[3][e >> 1], (e & 1) ? ((w3[e] + 0x8000u) & 0xffff0000u) : ((w3[e] + 0x8000u) >> 16), a);
            y[e] = silu_f(a); ss += y[e] * y[e]; }
        u32x4 w; w.x = pk2(y[0], y[1]); w.y = pk2(y[2], y[3]); w.z = pk2(y[4], y[5]); w.w = pk2(y[6], y[7]);
        *(LAS u32x4*)(wl + (lane + 3) * B0_STRIDE + i * 16) = w;
    }
    const float sc = s == 0 ? rsqrtf(ss + EPS) * 0.08838834764831845f : (s == 1 ? rsqrtf(ss + EPS) : 1.0f);
    const size_t unit = (size_t)((b * 4 + hh) * 32 + n);
    bf16_t* ot = (s == 1 ? WSP(bf16_t, WS_KNT) : WSP(bf16_t, WS_VT)) + unit * 128 * 64 + lane;
#pragma unroll 2
    for (int i = 0; i < 16; ++i) { const u32x4 v = *(const LAS u32x4*)(wl + (lane + 3) * B0_STRIDE + i * 16); u32x4 w;
#pragma unroll
        for (int e = 0; e < 4; ++e) w[e] = pk2(bflo(v[e]) * sc, bfhi(v[e]) * sc);
        if (s < 2) *(LAS u32x4*)(wl + (lane + 3) * B0_STRIDE + i * 16) = w;
        if (s >= 1) {
#pragma unroll
            for (int e = 0; e < 8; ++e) ot[(8 * i + e) * 64] = (bf16_t)((e & 1) ? (w[e >> 1] >> 16) : (w[e >> 1] & 0xffffu)); } }
    if (s < 2) { bf16_t* o = (s == 0 ? WSP(bf16_t, WS_QN) : WSP(bf16_t, WS_KN)) + (size_t)tok0 * 512 + hh * 128 + piece * 8;
#pragma unroll
        for (int k = 0; k < 16; ++k) { const int row = 4 * k + (lane >> 4); *(u32x4*)(o + (size_t)row * 512) = *(const LAS u32x4*)(wl + (row + 3) * B0_STRIDE + piece * 16); } }
}
DI void b0_task_vb(const Ctx& c, int l, int b, int n, int hb, LAS unsigned char* wl) {
    int lane = c.lane; asm volatile("" : "+v"(lane));
    const int tok0 = b * SEQ + n * 64, piece = lane & 15;
    const bf16_t* P = WSP(bf16_t, WS_P) + (size_t)tok0 * NP + 2560 + hb * 128 + piece * 8;
#pragma unroll
    for (int k = 0; k < 16; ++k) { const int row = 4 * k + (lane >> 4); *(LAS u32x4*)(wl + row * B0_STRIDE + piece * 16) = *(const u32x4*)(P + (size_t)row * NP); }
    const float* vp = WSP(float, WS_VSS) + (size_t)(tok0 + lane) * 8; const f32x4 p0 = *(const f32x4*)vp, p1 = *(const f32x4*)(vp + 4);
    const float rs = rsqrtf((((p0.x + p0.y) + (p0.z + p0.w)) + ((p1.x + p1.y) + (p1.z + p1.w))) * (1.0f / 512.0f) + EPS);
    const float* vg = c.v_norm_g + l * 512 + hb * 128;
    bf16_t* vbt = WSP(bf16_t, WS_VBT) + ((size_t)((b * 16 + (n >> 1)) * 4 + hb) * 128) * 128 + (n & 1) * 64 + lane;
#pragma unroll 2
    for (int i = 0; i < 16; ++i) { const u32x4 v = *(const LAS u32x4*)(wl + lane * B0_STRIDE + i * 16);
#pragma unroll
        for (int e = 0; e < 8; ++e) { const float pv = (e & 1) ? bfhi(v[e >> 1]) : bflo(v[e >> 1]); vbt[(size_t)(8 * i + e) * 128] = f2bf(pv * rs * vg[8 * i + e]); } }
}
DI void b0_task_sample(const Ctx& c, int l, int bs) {
    const float* ps = WSP(float, WS_PS) + (size_t)bs * NPS;
    if (c.lane < 4) { const int hh = c.lane;
        WSP(float, WS_GS)[bs * 4 + hh] = -__expf(c.A_log[l * 4 + hh]) * softplus_f(ps[3072 + hh] + c.dt_bias[l * 4 + hh]);
        WSP(float, WS_BS)[bs * 4 + hh] = sigmoid_f(ps[3076 + hh]); }
    const float* sc = c.state_conv + (size_t)(l * SBATCH + bs) * 3 * QKV;
    const float* cw = c.conv_w + (size_t)l * 4 * QKV;
    float* ocs = c.out + O_CS + (size_t)(l * SBATCH + bs) * 3 * QKV;
    float* qkvs = WSP(float, WS_QS) + bs * 512;
#pragma unroll 1
    for (int sh = 0; sh < 12; ++sh) {
        float y[2];
#pragma unroll
        for (int t = 0; t < 2; ++t) { const int ch = sh * 128 + t * 64 + c.lane; const float s0 = sc[ch], s1 = sc[QKV + ch], s2 = sc[2 * QKV + ch], cur = ps[ch];
            ocs[ch] = s1; ocs[QKV + ch] = s2; ocs[2 * QKV + ch] = cur;
            y[t] = silu_f(s0 * cw[ch] + s1 * cw[QKV + ch] + s2 * cw[2 * QKV + ch] + cur * cw[3 * QKV + ch]); }
        float scale = 1.0f;
        if (sh < 8) { const float ssum = wave_sum(y[0] * y[0] + y[1] * y[1], c.lane); scale = rsqrtf(ssum + EPS) * (sh < 4 ? 0.08838834764831845f : 1.0f); }
        float* o = qkvs + (size_t)(sh >> 2) * SBATCH * 512 + (sh & 3) * 128;
        o[c.lane] = y[0] * scale; o[64 + c.lane] = y[1] * scale;
    }
    float pv[8]; float ss = 0.f;
#pragma unroll
    for (int i = 0; i < 8; ++i) { pv[i] = ps[2560 + c.lane + 64 * i]; ss += pv[i] * pv[i]; }
    ss = wave_sum(ss, c.lane); const float rs = rsqrtf(ss * (1.0f / 512.0f) + EPS);
    float* am = WSP(float, WS_AMIXS) + (size_t)bs * DM; float* ovs = c.out + O_VS + (size_t)(l * SBATCH + bs) * 512;
#pragma unroll
    for (int i = 0; i < 8; ++i) { const int ch = c.lane + 64 * i, hb = ch >> 7; const float vb = pv[i] * rs * c.v_norm_g[l * 512 + ch];
        ovs[ch] = vb; am[512 + ch] = ps[2048 + ch] * (c.w_s[(size_t)(l * 4 + hb) * 128 * 128] * vb + c.b_s[(l * 4 + hb) * 128]); }
}
DI void phase_b0(const Ctx& c, int l, LAS unsigned char* lds) {
    for (int ch = c.bx; ch < 256; ch += c.nb) b0_block_ab(c, l, ch, lds);
    constexpr int NPT = 256 * 12;
    LAS unsigned char* wl = lds + c.wave * B0_WAVE_LDS;
    for (int t = c.wave * c.nb + c.bx; t < NPT + SBATCH; t += c.ngw) {
        if (t >= NPT) { if (SUB(0)) b0_task_sample(c, l, t - NPT); continue; }
        const int chunk = t / 12, k = t % 12, b = chunk >> 5, n = chunk & 31;
        if (SUB(3)) b0_task_conv(c, l, b, n, k >> 2, k & 3, wl);
    }
}

DI void b1_prep(const Ctx& c, int l, int unit, int part, LAS unsigned char* wl, LAS float* sg, LAS float* sb) {
    int lane = c.lane; asm volatile("" : "+v"(lane));
    const int r = lane & 31, h = lane >> 5;
    const int n = unit & 31, bh = unit >> 5, hh = bh & 3, b = bh >> 2, tok0 = b * SEQ + n * 64;
    const float bt = WSP(float, WS_BETA)[(tok0 + lane) * 4 + hh];
    float gc = WSP(float, WS_G)[(tok0 + lane) * 4 + hh];
#pragma unroll
    for (int o = 1; o < 64; o <<= 1) { const float t = xlane(gc, lane - o); if (lane >= o) gc += t; }
    sg[lane] = gc; sb[lane] = bt;
    const float glast = __builtin_bit_cast(float, __builtin_amdgcn_readlane(__builtin_bit_cast(int, gc), 63));
    if (part == 0 && lane == 0) WSP(float, WS_EG)[unit] = __expf(glast);
    unsigned char* img = c.ws + WS_IMG + (size_t)unit * IMG_BYTES;
    const bf16_t* Kn = WSP(bf16_t, WS_KN) + (size_t)tok0 * 512 + hh * 128;
    const bf16_t* Qn = WSP(bf16_t, WS_QN) + (size_t)tok0 * 512 + hh * 128;
    const bf16_t* KnT = WSP(bf16_t, WS_KNT) + (size_t)unit * 128 * 64;
    const bf16_t* VT = WSP(bf16_t, WS_VT) + (size_t)unit * 128 * 64;
    LAS float* L = (LAS float*)wl;
    {
        bf16x8 Kf[2][8];
#pragma unroll
        for (int t = 0; t < 2; ++t)
#pragma unroll
            for (int ks = 0; ks < 8; ++ks) Kf[t][ks] = *(const bf16x8*)(Kn + (size_t)(32 * t + r) * 512 + 16 * ks + 8 * h);
        if (part == 0) {
#pragma unroll
        for (int tt = 0; tt < 3; ++tt) { const int mt = tt == 0 ? 0 : 1, nt = tt == 2 ? 1 : 0;
            f32x16 acc = zero16();
#pragma unroll
            for (int ks = 0; ks < 8; ++ks) acc = MFMA32(Kf[mt][ks], Kf[nt][ks], acc);
            const int j = 32 * nt + r; const float gj = sg[j];
#pragma unroll
            for (int g4 = 0; g4 < 4; ++g4) { const f32x4 gi4 = *(const LAS f32x4*)(sg + 32 * mt + 8 * g4 + 4 * h), bi4 = *(const LAS f32x4*)(sb + 32 * mt + 8 * g4 + 4 * h);
#pragma unroll
                for (int q = 0; q < 4; ++q) { const int i = 32 * mt + 8 * g4 + 4 * h + q; const float arg = i > j ? gi4[q] - gj : 0.f;
                    L[i * 64 + j] = i > j ? acc[4 * g4 + q] * bi4[q] * __expf(arg) : 0.f; } } }
        }
        if (part == 1) {
#pragma unroll
        for (int mt = 0; mt < 2; ++mt) {
            bf16x8 Qf[8];
#pragma unroll
            for (int ks = 0; ks < 8; ++ks) Qf[ks] = *(const bf16x8*)(Qn + (size_t)(32 * mt + r) * 512 + 16 * ks + 8 * h);
            const int i = 32 * mt + r; const float gi = sg[i];
#pragma unroll
            for (int mp = 0; mp <= mt; ++mp) {
                f32x16 acc = zero16();
#pragma unroll
                for (int ks = 0; ks < 8; ++ks) acc = MFMA32(Kf[mp][ks], Qf[ks], acc);
#pragma unroll
                for (int g4 = 0; g4 < 4; ++g4) { const f32x4 gj4 = *(const LAS f32x4*)(sg + 32 * mp + 8 * g4 + 4 * h);
#pragma unroll
                    for (int q = 0; q < 4; ++q) { const int j = 32 * mp + 8 * g4 + 4 * h + q; const float arg = i >= j ? gi - gj4[q] : 0.f;
                        acc[4 * g4 + q] = i >= j ? acc[4 * g4 + q] * __expf(arg) : 0.f; } }
                const int fb = (mt == 0 ? 0 : 1 + mp) * 2;
#pragma unroll
                for (int s = 0; s < 2; ++s) *(u32x4*)(img + 49152 + (fb + s) * 1024 + lane * 16) = pack8(acc, s);
            }
        }
        }
    }
    if (part == 0) {
    float Tr[64];
    {
        f32x4 lb[2][16];
#pragma unroll
        for (int i = 0; i < 64; ++i) {
            if (i + 1 < 64) {
#pragma unroll
                for (int j4 = 0; j4 < (i + 1 + 3) / 4; ++j4) lb[(i + 1) & 1][j4] = *(const LAS f32x4*)(L + (i + 1) * 64 + 4 * j4); }
            asm volatile("" ::: "memory");
            float a0 = lane == i ? 1.f : 0.f, a1 = 0.f;
#pragma unroll
            for (int j4 = 0; j4 < (i + 3) / 4; ++j4) {
#pragma unroll
                for (int q = 0; q < 4; ++q) { const int j = 4 * j4 + q; if (j < i) { if (q & 1) a1 -= lb[i & 1][j4][q] * Tr[j]; else a0 -= lb[i & 1][j4][q] * Tr[j]; } } }
            Tr[i] = a0 + a1;
        }
    }
    LAS bf16_t* T1 = (LAS bf16_t*)wl;
    asm volatile("" ::: "memory");
    {
        const float sc1 = bt * __expf(gc);
#pragma unroll
        for (int i = 0; i < 64; ++i) T1[i * 72 + lane] = f2bf(Tr[i] * sc1);
        bf16x8 Tf[2][4];
#pragma unroll
        for (int mt = 0; mt < 2; ++mt)
#pragma unroll
            for (int ks = 0; ks < 4; ++ks) Tf[mt][ks] = *(const LAS bf16x8*)(T1 + (32 * mt + r) * 72 + 16 * ks + 8 * h);
#pragma unroll
        for (int dt = 0; dt < 4; ++dt) {
            bf16x8 Kt[4];
#pragma unroll
            for (int ks = 0; ks < 4; ++ks) Kt[ks] = *(const bf16x8*)(KnT + (size_t)(32 * dt + r) * 64 + 16 * ks + 8 * h);
#pragma unroll
            for (int mt = 0; mt < 2; ++mt) { f32x16 acc = zero16();
#pragma unroll
                for (int ks = 0; ks < 2 * (mt + 1); ++ks) acc = MFMA32(Kt[ks], Tf[mt][ks], acc);
                acc = -acc;
#pragma unroll
                for (int s = 0; s < 2; ++s) *(u32x4*)(img + ((mt * 4 + dt) * 2 + s) * 1024 + lane * 16) = pack8(acc, s); }
        }
    }
    asm volatile("" ::: "memory");
    {
#pragma unroll
        for (int i = 0; i < 64; ++i) T1[i * 72 + lane] = f2bf(Tr[i] * bt);
        bf16x8 Tf[2][4];
#pragma unroll
        for (int mt = 0; mt < 2; ++mt)
#pragma unroll
            for (int ks = 0; ks < 4; ++ks) Tf[mt][ks] = *(const LAS bf16x8*)(T1 + (32 * mt + r) * 72 + 16 * ks + 8 * h);
        bf16_t* uimg = WSP(bf16_t, WS_UIMG) + (size_t)unit * 8192;
#pragma unroll
        for (int et = 0; et < 4; ++et) {
            bf16x8 Vt[4];
#pragma unroll
            for (int ks = 0; ks < 4; ++ks) Vt[ks] = *(const bf16x8*)(VT + (size_t)(32 * et + r) * 64 + 16 * ks + 8 * h);
#pragma unroll
            for (int mt = 0; mt < 2; ++mt) { f32x16 acc = zero16();
#pragma unroll
                for (int ks = 0; ks < 2 * (mt + 1); ++ks) acc = MFMA32(Tf[mt][ks], Vt[ks], acc);
#pragma unroll
                for (int g4 = 0; g4 < 4; ++g4) { u32x2 w; w.x = pk2(acc[4 * g4], acc[4 * g4 + 1]); w.y = pk2(acc[4 * g4 + 2], acc[4 * g4 + 3]); *(u32x2*)(uimg + ((et * 2 + mt) * 4 + g4) * 256 + lane * 4) = w; } }
        }
    }
    }
    if (part == 1) {
#pragma unroll
    for (int mt = 0; mt < 2; ++mt) { const float ei = __expf(sg[32 * mt + r]);
#pragma unroll
        for (int dt = 0; dt < 4; ++dt)
#pragma unroll
            for (int s = 0; s < 2; ++s) { const bf16_t* qp = Qn + (size_t)(32 * mt + r) * 512 + 32 * dt + 16 * s + 4 * h;
                const u32x2 p0 = *(const u32x2*)qp, p1 = *(const u32x2*)(qp + 8);
                u32x4 w; w.x = pk2(bflo(p0.x) * ei, bfhi(p0.x) * ei); w.y = pk2(bflo(p0.y) * ei, bfhi(p0.y) * ei); w.z = pk2(bflo(p1.x) * ei, bfhi(p1.x) * ei); w.w = pk2(bflo(p1.y) * ei, bfhi(p1.y) * ei);
                *(u32x4*)(img + 16384 + ((mt * 4 + dt) * 2 + s) * 1024 + lane * 16) = w; } }
#pragma unroll
    for (int mp = 0; mp < 2; ++mp)
#pragma unroll
        for (int s = 0; s < 2; ++s) { const f32x4 ga = *(const LAS f32x4*)(sg + 32 * mp + 16 * s + 4 * h), gb = *(const LAS f32x4*)(sg + 32 * mp + 16 * s + 8 + 4 * h);
            float sc[8];
#pragma unroll
            for (int q = 0; q < 4; ++q) { sc[q] = __expf(glast - ga[q]); sc[4 + q] = __expf(glast - gb[q]); }
#pragma unroll
            for (int dt = 0; dt < 4; ++dt) { const bf16_t* kp = KnT + (size_t)(32 * dt + r) * 64 + 32 * mp + 16 * s + 4 * h;
                const u32x2 p0 = *(const u32x2*)kp, p1 = *(const u32x2*)(kp + 8);
                u32x4 w; w.x = pk2(bflo(p0.x) * sc[0], bfhi(p0.x) * sc[1]); w.y = pk2(bflo(p0.y) * sc[2], bfhi(p0.y) * sc[3]); w.z = pk2(bflo(p1.x) * sc[4], bfhi(p1.x) * sc[5]); w.w = pk2(bflo(p1.y) * sc[6], bfhi(p1.y) * sc[7]);
                *(u32x4*)(img + 32768 + ((dt * 2 + mp) * 2 + s) * 1024 + lane * 16) = w; } }
    }
}
DI void b1_gmlp(const Ctx& c, int l, int unit) {
    int lane = c.lane; asm volatile("" : "+v"(lane));
    const int r = lane & 31, h = lane >> 5;
    const int hb = unit & 3, cc = (unit >> 2) & 15, b = unit >> 6, tokc0 = b * SEQ + cc * 128;
    const bf16_t* A = WSP(bf16_t, WS_VBT) + (size_t)unit * 128 * 128;
    const bf16_t* B = WSP(bf16_t, WS_WM) + (size_t)(l * 4 + hb) * 128 * 128;
    const bf16_t* P = WSP(bf16_t, WS_P); bf16_t* AM = WSP(bf16_t, WS_AMIX);
#pragma unroll
    for (int nt = 0; nt < 4; ++nt) {
        f32x16 acc[4];
#pragma unroll
        for (int mt = 0; mt < 4; ++mt) acc[mt] = zero16();
#pragma unroll
        for (int ks = 0; ks < 2 * (nt + 1); ++ks) { const bf16x8 bf = *(const bf16x8*)(B + (size_t)(32 * nt + r) * 128 + 16 * ks + 8 * h);
#pragma unroll
            for (int mt = 0; mt < 4; ++mt) { const bf16x8 af = *(const bf16x8*)(A + (size_t)(32 * mt + r) * 128 + 16 * ks + 8 * h); acc[mt] = MFMA32(af, bf, acc[mt]); } }
        const int tok = tokc0 + 32 * nt + r; const float bsi = c.b_s[(l * 4 + hb) * 128 + 32 * nt + r];
#pragma unroll
        for (int mt = 0; mt < 4; ++mt)
#pragma unroll
            for (int g4 = 0; g4 < 4; ++g4) { const int dch0 = 32 * mt + 8 * g4 + 4 * h;
                const u32x2 u4 = *(const u32x2*)(P + (size_t)tok * NP + 2048 + hb * 128 + dch0);
                u32x2 w; w.x = pk2(bflo(u4.x) * (acc[mt][4 * g4] + bsi), bfhi(u4.x) * (acc[mt][4 * g4 + 1] + bsi)); w.y = pk2(bflo(u4.y) * (acc[mt][4 * g4 + 2] + bsi), bfhi(u4.y) * (acc[mt][4 * g4 + 3] + bsi));
                *(u32x2*)(AM + (size_t)tok * DM + 512 + hb * 128 + dch0) = w; }
    }
}
DI void phase_b1(const Ctx& c, int l, LAS unsigned char* lds) {
    LAS unsigned char* wl = lds + c.wave * 16384; LAS float* sg = (LAS float*)(lds + 131072 + c.wave * 512); LAS float* sb = sg + 64;
    for (int t = c.bx * 4 + (c.wave & 3); t < 1024; t += c.nb * 4) {
        if (SUB(0)) b1_prep(c, l, t, c.wave >> 2, wl, sg, sb);
    }
}


constexpr int OB_STRIDE = 136;
constexpr int IMG_LDS = 57344;
constexpr int LDS_OBUF = 2 * IMG_LDS, OBUF_BYTES = 64 * OB_STRIDE * 2;
static_assert(LDS_OBUF + 2 * OBUF_BYTES <= LDS_BYTES, "scan LDS");
DI void scan_post(const Ctx& c, int l, int b, int hh, int n, const LAS bf16_t* ob, int lid, const u32x4 (&gt4)[4]) {
    const int i = lid >> 2, q = lid & 3, tok = b * SEQ + n * 64 + i;
    u32x4 ov[4]; float ss = 0.f;
#pragma unroll
    for (int x = 0; x < 4; ++x) { ov[x] = *(const LAS u32x4*)(ob + i * OB_STRIDE + 32 * q + 8 * x);
#pragma unroll
        for (int e = 0; e < 4; ++e) { const float a = bflo(ov[x][e]), bq = bfhi(ov[x][e]); ss += a * a + bq * bq; } }
    ss += xlane(ss, (lid & 63) ^ 1); ss += xlane(ss, (lid & 63) ^ 2);
    const float rs = rsqrtf(ss * (1.0f / 128.0f) + EPS);
    bf16_t* op = WSP(bf16_t, WS_AMIX) + (size_t)tok * DM + hh * 128 + 32 * q;
#pragma unroll
    for (int x = 0; x < 4; ++x) { u32x4 w;
#pragma unroll
        for (int e = 0; e < 4; ++e) w[e] = pk2(bflo(ov[x][e]) * rs * bflo(gt4[x][e]), bfhi(ov[x][e]) * rs * bfhi(gt4[x][e]));
        *(u32x4*)(op + 8 * x) = w; }
}
DI void scan_loader_step(const Ctx& c, int l, int b, int hh, int n, LAS unsigned char* lds, const unsigned char* img0, const bf16_t* gbase, int lw, int lane, int lid, u32x4 (&regs)[14], u32x4 (&gt)[4]) {
    u32x4 gcur[4];
#pragma unroll
    for (int x = 0; x < 4; ++x) gcur[x] = gt[x];
#pragma unroll
    for (int x = 0; x < 4; ++x) gt[x] = *(const u32x4*)(gbase + (size_t)n * 64 * NP + 8 * x);
    const unsigned voff = (unsigned)(lw * 14336 + lane * 16);
    if (n + 1 < 32) { LAS unsigned char* dst = lds + ((n + 1) & 1) * IMG_LDS + voff;
#pragma unroll
        for (int i = 0; i < 14; ++i) *(LAS u32x4*)(dst + i * 1024) = regs[i]; }
    if (n + 3 < 32) { const unsigned char* src = img0 + (size_t)(n + 3) * IMG_BYTES;
#pragma unroll
        for (int i = 0; i < 14; ++i) regs[i] = *(const u32x4*)(src + voff + i * 1024); }
    if (n >= 1) scan_post(c, l, b, hh, n - 1, (const LAS bf16_t*)(lds + LDS_OBUF + ((n - 1) & 1) * OBUF_BYTES), lid, gcur);
    __syncthreads();
}
DI void scan_consumer_step(int n, LAS unsigned char* lds, f32x16 (&S)[4], u32x2 (&ucur)[8], float& egc, const bf16_t* uimg0, const float* egp, int lane, int ws, int r, int h) {
    const LAS unsigned char* buf = lds + (n & 1) * IMG_LDS + lane * 16;
    f32x16 av[2], ao[2]; ao[0] = zero16(); ao[1] = zero16();
#pragma unroll
    for (int mt = 0; mt < 2; ++mt)
#pragma unroll
        for (int g4 = 0; g4 < 4; ++g4) { const u32x2 w = ucur[mt * 4 + g4]; av[mt][4 * g4] = bflo(w.x); av[mt][4 * g4 + 1] = bfhi(w.x); av[mt][4 * g4 + 2] = bflo(w.y); av[mt][4 * g4 + 3] = bfhi(w.y); }
    const float eg = egc;
    if (n + 2 < 32) { const bf16_t* up = uimg0 + (size_t)(n + 2) * 8192;
#pragma unroll
        for (int x = 0; x < 8; ++x) ucur[x] = *(const u32x2*)(up + x * 256);
        egc = egp[n + 2]; }
    {
        bf16x8 fg[2][4];
#pragma unroll
        for (int mt = 0; mt < 2; ++mt) { fg[0][mt] = *(const LAS bf16x8*)(buf + (mt * 8) * 1024); fg[0][2 + mt] = *(const LAS bf16x8*)(buf + 16384 + (mt * 8) * 1024); }
#pragma unroll
        for (int gI = 0; gI < 8; ++gI) { const int dt = gI >> 1, s = gI & 1;
            if (gI + 1 < 8) {
#pragma unroll
                for (int mt = 0; mt < 2; ++mt) { fg[(gI + 1) & 1][mt] = *(const LAS bf16x8*)(buf + (mt * 8 + gI + 1) * 1024); fg[(gI + 1) & 1][2 + mt] = *(const LAS bf16x8*)(buf + 16384 + (mt * 8 + gI + 1) * 1024); } }
            asm volatile("" ::: "memory");
            const bf16x8 sb = as_bf(pack8(S[dt], s));
            av[0] = MFMA32(fg[gI & 1][0], sb, av[0]); av[1] = MFMA32(fg[gI & 1][1], sb, av[1]);
            ao[0] = MFMA32(sb, fg[gI & 1][2], ao[0]); ao[1] = MFMA32(sb, fg[gI & 1][3], ao[1]); }
    }
    bf16x8 vb[2][2];
#pragma unroll
    for (int mp = 0; mp < 2; ++mp)
#pragma unroll
        for (int s = 0; s < 2; ++s) vb[mp][s] = as_bf(pack8(av[mp], s));
    {
        bf16x8 qf[6];
#pragma unroll
        for (int f = 0; f < 6; ++f) qf[f] = *(const LAS bf16x8*)(buf + 49152 + f * 1024);
        asm volatile("" ::: "memory");
#pragma unroll
        for (int s = 0; s < 2; ++s) { ao[0] = MFMA32(vb[0][s], qf[s], ao[0]); ao[1] = MFMA32(vb[0][s], qf[2 + s], ao[1]); ao[1] = MFMA32(vb[1][s], qf[4 + s], ao[1]); }
    }
    LAS bf16_t* ob = (LAS bf16_t*)(lds + LDS_OBUF + (n & 1) * OBUF_BYTES);
#pragma unroll
    for (int mt = 0; mt < 2; ++mt)
#pragma unroll
        for (int g4 = 0; g4 < 4; ++g4) { u32x2 w; w.x = pk2(ao[mt][4 * g4], ao[mt][4 * g4 + 1]); w.y = pk2(ao[mt][4 * g4 + 2], ao[mt][4 * g4 + 3]);
            *(LAS u32x2*)(ob + (32 * mt + r) * OB_STRIDE + 32 * ws + 8 * g4 + 4 * h) = w; }
    bf16x8 kf[2][4];
#pragma unroll
    for (int f = 0; f < 4; ++f) kf[0][f] = *(const LAS bf16x8*)(buf + 32768 + f * 1024);
#pragma unroll
    for (int dt = 0; dt < 4; ++dt) {
        if (dt + 1 < 4) {
#pragma unroll
            for (int f = 0; f < 4; ++f) kf[(dt + 1) & 1][f] = *(const LAS bf16x8*)(buf + 32768 + ((dt + 1) * 4 + f) * 1024); }
        asm volatile("" ::: "memory");
        S[dt] = S[dt] * eg;
#pragma unroll
        for (int mp = 0; mp < 2; ++mp)
#pragma unroll
            for (int s = 0; s < 2; ++s) S[dt] = MFMA32(kf[dt & 1][mp * 2 + s], vb[mp][s], S[dt]); }
    __syncthreads();
}
DI void scan_block(const Ctx& c, int l, int bh, LAS unsigned char* lds) {
    const int wave = c.wave, b = bh >> 2, hh = bh & 3;
    const unsigned char* img0 = c.ws + WS_IMG + (size_t)bh * 32 * IMG_BYTES;
    if (wave >= 4) { if (SUB2(0)) {
        int lane = c.lane; asm volatile("" : "+v"(lane));
        const int lw = wave - 4, lid = lw * 64 + lane;
        u32x4 regs0[14], regs1[14], gt0[4];
        const bf16_t* gbase = WSP(bf16_t, WS_P) + (size_t)(b * SEQ + (lid >> 2)) * NP + 1536 + hh * 128 + 32 * (lid & 3);
        const unsigned voff0 = (unsigned)(lw * 14336 + lane * 16);
#pragma unroll
        for (int i = 0; i < 14; ++i) regs0[i] = *(const u32x4*)(img0 + voff0 + i * 1024);
#pragma unroll
        for (int i = 0; i < 14; ++i) *(LAS u32x4*)(lds + voff0 + i * 1024) = regs0[i];
#pragma unroll
        for (int i = 0; i < 14; ++i) { regs1[i] = *(const u32x4*)(img0 + (size_t)IMG_BYTES + voff0 + i * 1024); regs0[i] = *(const u32x4*)(img0 + (size_t)2 * IMG_BYTES + voff0 + i * 1024); }
#pragma unroll
        for (int x = 0; x < 4; ++x) gt0[x] = (u32x4){0u, 0u, 0u, 0u};
        __syncthreads();
        for (int n = 0; n < 32; n += 2) {
            scan_loader_step(c, l, b, hh, n, lds, img0, gbase, lw, lane, lid, regs1, gt0);
            scan_loader_step(c, l, b, hh, n + 1, lds, img0, gbase, lw, lane, lid, regs0, gt0);
        }
        scan_post(c, l, b, hh, 31, (const LAS bf16_t*)(lds + LDS_OBUF + (31 & 1) * OBUF_BYTES), lid, gt0);
    } } else if (SUB2(1)) {
        int lane = c.lane; asm volatile("" : "+v"(lane));
        __builtin_amdgcn_s_setprio(3);
        const int ws = wave, r = lane & 31, h = lane >> 5;
        f32x16 S[4];
#pragma unroll
        for (int dt = 0; dt < 4; ++dt) S[dt] = zero16();
        const bf16_t* uimg0 = WSP(bf16_t, WS_UIMG) + (size_t)bh * 32 * 8192 + (size_t)ws * 2 * 4 * 256 + lane * 4;
        const float* egp = WSP(float, WS_EG) + bh * 32;
        u32x2 u0[8], u1[8];
#pragma unroll
        for (int x = 0; x < 8; ++x) { u0[x] = *(const u32x2*)(uimg0 + x * 256); u1[x] = *(const u32x2*)(uimg0 + 8192 + x * 256); }
        float eg0 = egp[0], eg1 = egp[1];
        __syncthreads();
        for (int n = 0; n < 32; n += 2) {
            scan_consumer_step(n, lds, S, u0, eg0, uimg0, egp, lane, ws, r, h);
            scan_consumer_step(n + 1, lds, S, u1, eg1, uimg0, egp, lane, ws, r, h);
        }
        const char* od = (const char*)(c.out + O_DP + (size_t)(l * 32 + bh) * 128 * 128);
        unsigned voff = (unsigned)((4 * h) * 128 + 32 * ws + r) * 4u;
        asm volatile("" : "+v"(voff));
#pragma unroll
        for (int dt = 0; dt < 4; ++dt)
#pragma unroll
            for (int reg = 0; reg < 16; ++reg) *(float*)(od + (32 * dt + (reg & 3) + 8 * (reg >> 2)) * 512 + voff) = S[dt][reg];
        __builtin_amdgcn_s_setprio(0);
    }
}
DI float rdlane(float v, int l) { return __builtin_bit_cast(float, __builtin_amdgcn_readlane(__builtin_bit_cast(int, v), l)); }
DI void sample_recurrent(const Ctx& c, int l, int unit) {
    int lane = c.lane; asm volatile("" : "+v"(lane));
    const int bs = unit >> 2, hh = unit & 3, e2 = 2 * lane;
    const float* S0 = c.state_delta + (size_t)((l * SBATCH + bs) * 4 + hh) * 128 * 128 + e2;
    float* S1 = c.out + O_DS + (size_t)((l * SBATCH + bs) * 4 + hh) * 128 * 128 + e2;
    const float* q = WSP(float, WS_QS) + bs * 512 + hh * 128; const float* k = WSP(float, WS_KS) + bs * 512 + hh * 128; const float* v = WSP(float, WS_VS) + bs * 512 + hh * 128;
    const float eg = __expf(WSP(float, WS_GS)[bs * 4 + hh]), beta = WSP(float, WS_BS)[bs * 4 + hh];
    const float k0 = k[lane], k1 = k[64 + lane], q0 = q[lane], q1 = q[64 + lane];
    f32x2 kv = {0.f, 0.f};
#pragma unroll
    for (int d0 = 0; d0 < 128; d0 += 32) { f32x2 sv[32];
#pragma unroll
        for (int j = 0; j < 32; ++j) sv[j] = *(const f32x2*)(S0 + (d0 + j) * 128);
#pragma unroll
        for (int j = 0; j < 32; ++j) { const int dd = d0 + j; kv += sv[j] * rdlane(dd < 64 ? k0 : k1, dd & 63); } }
    const f32x2 v2 = *(const f32x2*)(v + e2);
    const f32x2 delta = (v2 - kv * eg) * beta;
    f32x2 oo = {0.f, 0.f};
#pragma unroll
    for (int d0 = 0; d0 < 128; d0 += 32) { f32x2 sv[32];
#pragma unroll
        for (int j = 0; j < 32; ++j) sv[j] = *(const f32x2*)(S0 + (d0 + j) * 128);
#pragma unroll
        for (int j = 0; j < 32; ++j) { const int dd = d0 + j; const f32x2 sn = sv[j] * eg + delta * rdlane(dd < 64 ? k0 : k1, dd & 63); oo += sn * rdlane(dd < 64 ? q0 : q1, dd & 63); *(f32x2*)(S1 + dd * 128) = sn; } }
    const float ss = wave_sum(oo.x * oo.x + oo.y * oo.y, lane); const float rs = rsqrtf(ss * (1.0f / 128.0f) + EPS);
    const float* ps = WSP(float, WS_PS) + (size_t)bs * NPS + 1536 + hh * 128 + e2; float* am = WSP(float, WS_AMIXS) + (size_t)bs * DM + hh * 128 + e2;
    const float* og = c.o_norm_g + l * 128 + e2;
    am[0] = oo.x * rs * og[0] * silu_f(ps[0]); am[1] = oo.y * rs * og[1] * silu_f(ps[1]);
}
DI void phase_scan(const Ctx& c, int l, LAS unsigned char* lds) {
    if (c.bx < 32) { if (SUB(0)) scan_block(c, l, c.bx, lds); return; }
    const int w0 = c.wave * (c.nb - 32) + (c.bx - 32), nw = (c.nb - 32) * 8;
    LAS unsigned char* wl = lds + c.wave * B0_WAVE_LDS;
    for (int u = w0; u < SBATCH * 4 + 512; u += nw) {
        if (u < SBATCH * 4) { if (SUB(1)) sample_recurrent(c, l, u); continue; }
        const int g = u - SBATCH * 4, hb = g & 3, cc = (g >> 2) & 15, b = g >> 6;
        b0_task_vb(c, l, b, 2 * cc, hb, wl); b0_task_vb(c, l, b, 2 * cc + 1, hb, wl);
        asm volatile("s_waitcnt vmcnt(0)" ::: "memory");
        b1_gmlp(c, l, g);
    }
    if (l + 1 < DEPTH) convert_layer_weights(c, l + 1, w0, nw, lds);

}

DI void phase_final(const Ctx& c) {
    const f32x4* gr = (const f32x4*)c.norm_f_g + c.lane;
    for (int m = c.gw; m < MP + SBATCH; m += c.ngw) {
        f32x4 v[4]; float s = 0.f;
        if (m < MP) { const u32x2* xr = (const u32x2*)(WSP(bf16_t, WS_XB16) + (size_t)m * DM) + c.lane;
#pragma unroll
            for (int j = 0; j < 4; ++j) { const u32x2 w = xr[64 * j]; v[j] = (f32x4){bflo(w.x), bfhi(w.x), bflo(w.y), bfhi(w.y)}; } }
        else { const f32x4* xr = (const f32x4*)(WSP(float, WS_XS) + (size_t)(m - MP) * DM) + c.lane;
#pragma unroll
            for (int j = 0; j < 4; ++j) v[j] = xr[64 * j]; }
        float* dst = m < MP ? c.out + O_YP + (size_t)m * DM : c.out + O_YS + (size_t)(m - MP) * DM;
#pragma unroll
        for (int j = 0; j < 4; ++j) s += (v[j].x * v[j].x + v[j].y * v[j].y) + (v[j].z * v[j].z + v[j].w * v[j].w);
        const float rs = rsqrtf(wave_sum(s, c.lane) * (1.0f / DM) + EPS);
#pragma unroll
        for (int j = 0; j < 4; ++j) ((f32x4*)dst + c.lane)[64 * j] = v[j] * rs * gr[64 * j];
    }
}

#define XB_TMO      128
#define XB_XCNT(j)  (256  + 64 * (j))
#define XB_XSUB(j)  (1280 + 64 * (j))
#define XB_XGEN(j)  (2304 + 64 * (j))
#define XB_TOP      3328
#define XB_TOPGEN   3392
#define XCD_BAR_WORDS 3456
#define XB_SPIN_CAP (1u << 18)

__device__ __forceinline__ unsigned xb_ld(unsigned* p)              { return __hip_atomic_load(p, __ATOMIC_RELAXED, __HIP_MEMORY_SCOPE_AGENT); }
__device__ __forceinline__ unsigned xb_add(unsigned* p, unsigned v) { return __hip_atomic_fetch_add(p, v, __ATOMIC_RELAXED, __HIP_MEMORY_SCOPE_AGENT); }
__device__ __forceinline__ unsigned xb_xcc_id() { return (unsigned)__builtin_amdgcn_s_getreg((3 << 11) | 20) & 0xFu; }
#define XB_SPIN(cond, bar) do { unsigned _sp = 0; while (cond) { __builtin_amdgcn_s_sleep(8); \
    if ((++_sp & 255u) == 0u) { if (xb_ld(&(bar)[XB_TMO])) break; if (_sp > XB_SPIN_CAP) { atomicAdd(&(bar)[XB_TMO], 1u); break; } } } } while (0)

struct XcdBarrier {
    unsigned* bar; unsigned x;
    volatile LAS unsigned* st;
};

__device__ __forceinline__ XcdBarrier xcd_barrier_post(unsigned* bar, volatile LAS unsigned* st) {
    XcdBarrier b; b.bar = bar; b.x = xb_xcc_id(); b.st = st;
    if (threadIdx.x == 0) (void)xb_add(&bar[XB_XCNT(b.x)], 1u);
    return b;
}
__device__ __forceinline__ void xcd_barrier_complete(unsigned* bar, unsigned x, unsigned& nloc, unsigned& nx) {
    const unsigned G = gridDim.x * gridDim.y * gridDim.z;
    unsigned sum, cnt, mine, sp = 0u;
    for (;;) {
        sum = 0u; cnt = 0u; mine = 0u;
#pragma unroll
        for (unsigned j = 0; j < 16; ++j) { const unsigned c = xb_ld(&bar[XB_XCNT(j)]); sum += c; cnt += (c > 0u) ? 1u : 0u; mine = (j == x) ? c : mine; }
        if (sum == G) break;
        __builtin_amdgcn_s_sleep(1);
        if ((++sp & 255u) == 0u) { if (xb_ld(&bar[XB_TMO])) break; if (sp > XB_SPIN_CAP) { atomicAdd(&bar[XB_TMO], 1u); break; } }
    }
    nloc = mine > 0u ? mine : 1u; nx = cnt > 0u ? cnt : 1u;
}

__device__ __forceinline__ void xcd_barrier(const XcdBarrier& b) {
    asm volatile("s_waitcnt vmcnt(0)" ::: "memory");
    __syncthreads();
    if (threadIdx.x == 0) {
        unsigned* bar = b.bar;
        __builtin_amdgcn_s_waitcnt(0);
        unsigned nloc = b.st[0], nx = b.st[1];
        if (nloc == 0u) { xcd_barrier_complete(bar, b.x, nloc, nx); b.st[0] = nloc; b.st[1] = nx; }
        const unsigned old = xb_add(&bar[XB_XSUB(b.x)], 1u);
        const unsigned gen = old / nloc;
        if (old + 1u == (gen + 1u) * nloc) {
            __builtin_amdgcn_fence(__ATOMIC_RELEASE, "agent");
            asm volatile("s_waitcnt vmcnt(0)" ::: "memory");
            const unsigned og = xb_add(&bar[XB_TOP], 1u);
            const unsigned tg = og / nx;
            if (og + 1u == (tg + 1u) * nx) xb_add(&bar[XB_TOPGEN], 1u);
            else XB_SPIN(xb_ld(&bar[XB_TOPGEN]) == tg, bar);
            __builtin_amdgcn_fence(__ATOMIC_ACQUIRE, "agent");
            xb_add(&bar[XB_XGEN(b.x)], 1u);
            asm volatile("s_waitcnt vmcnt(0)" ::: "memory");
        } else {
            XB_SPIN(xb_ld(&bar[XB_XGEN(b.x)]) == gen, bar);
            __builtin_amdgcn_fence(__ATOMIC_ACQUIRE, "agent");
            asm volatile("s_waitcnt vmcnt(0)" ::: "memory");
        }
    }
    __syncthreads();
}
#ifndef ONLY
#define ONLY -1
#endif
#ifndef REPMASK
#define REPMASK 0
#endif
#define EN(x) (ONLY < 0 || ONLY == (x))
__global__ void __launch_bounds__(512, 2) hymba_fwd(Args args) {
    extern __shared__ __attribute__((aligned(16))) unsigned char lds_raw[];
    LAS unsigned char* lds = (LAS unsigned char*)lds_raw;
    cg::grid_group grid = cg::this_grid();
    Ctx c;
    c.x_prompt = args.in[0]; c.x_sample = args.in[1]; c.state_delta = args.in[2]; c.state_conv = args.in[3]; c.norm_mix_g = args.in[4]; c.w_in = args.in[5]; c.conv_w = args.in[6];
    c.A_log = args.in[7]; c.dt_bias = args.in[8]; c.o_norm_g = args.in[9]; c.v_norm_g = args.in[10]; c.w_s = args.in[11]; c.b_s = args.in[12]; c.w_o = args.in[13]; c.norm_ffn_g = args.in[14];
    c.w_up = args.in[15]; c.w_down = args.in[16]; c.norm_f_g = args.in[17]; c.out = args.out; c.ws = args.ws;
    c.lane = threadIdx.x & 63; c.wave = __builtin_amdgcn_readfirstlane(threadIdx.x >> 6); c.gw = blockIdx.x * 8 + c.wave; c.ngw = gridDim.x * 8; c.bx = blockIdx.x; c.nb = gridDim.x;
    volatile LAS unsigned* bst = (volatile LAS unsigned*)(lds + LDS_BYTES - 16);
    if (threadIdx.x < 2) bst[threadIdx.x] = 0u;
    __syncthreads();
    XcdBarrier xbar = xcd_barrier_post((unsigned*)args.ws, bst);
    grid.sync();
    for (int step = 2 * args.ph_lo; step < 2 * args.ph_hi; ++step) {
        const int ph = step >> 1;
        const int ptype = ph == 0 ? 0 : (ph == 29 ? 8 : 1 + (ph - 1) % 7);
        if ((step & 1) && !((REPMASK >> ptype) & 1)) continue;
        { int tl = threadIdx.x; asm volatile("" : "+v"(tl)); c.lane = tl & 63; int bxo = blockIdx.x, nbo = gridDim.x; asm volatile("" : "+s"(bxo), "+s"(nbo)); c.bx = bxo; c.nb = nbo; c.wave = __builtin_amdgcn_readfirstlane(tl >> 6); c.gw = bxo * 8 + c.wave; c.ngw = nbo * 8; unsigned char* wsp = args.ws; asm volatile("" : "+s"(wsp)); c.ws = wsp; float* op = args.out; asm volatile("" : "+s"(op)); c.out = op; }
        if (step & 1) __syncthreads();
        if (ph == 0) { if (EN(0)) phase_prologue(c, lds); }
        else if (ph == 29) { if (EN(8)) phase_final(c); }
        else {
            const int l = (ph - 1) / 7, s = (ph - 1) % 7;
            float* ssq = WSP(float, WS_SSQ);
            if (s == 0) { if (EN(1)) { sgemm1(c, l, lds); if ((REPMASK >> 10) & 1) sgemm1(c, l, lds);
                pg8::Gemm g{WSP(bf16_t, WS_XB16), WSP(bf16_t, WS_WIN) + (size_t)l * NP * DM, MP, NP, DM}; pg8::StaticOrder S; S.init(MP, NP, c.nb, c.bx);
                pg8::EpiScaleBf16 E{WSP(bf16_t, WS_P), NP, ssq + (size_t)(2 * l) * MP * 16, 0, WSP(float, WS_VSS), c.o_norm_g + l * 128}; pg8::gemm_phase(lds, g, S, E); } }
            else if (s == 1) { if (EN(2)) phase_b0(c, l, lds); }
            else if (s == 2) { if (EN(3)) phase_b1(c, l, lds); }
            else if (s == 3) { if (EN(4)) phase_scan(c, l, lds); if ((REPMASK >> 12) & 1) { __syncthreads(); if (c.bx < 32) scan_block(c, l, c.bx, lds); } if ((REPMASK >> 13) & 1) { if (c.bx >= 32) { const int w0 = (c.bx - 32) * 8 + c.wave, nw = (c.nb - 32) * 8; for (int u = w0; u < SBATCH * 4; u += nw) sample_recurrent(c, l, u); } } }
            else if (s == 4) { if (EN(5)) { if (!(step & 1)) sgemm2(c, l, lds);
                pg8::Gemm g{WSP(bf16_t, WS_AMIX), WSP(bf16_t, WS_WO) + (size_t)l * DM * DM, MP, DM, DM}; pg8::StaticOrder S; S.init(MP, DM, c.nb, c.bx);
                pg8::EpiResid E{WSP(bf16_t, WS_XB16), ssq + (size_t)(2 * l + 1) * MP * 16}; pg8::gemm_phase(lds, g, S, E); } }
            else if (s == 5) { if (EN(6)) { sgemm3(c, l, lds); if ((REPMASK >> 11) & 1) sgemm3(c, l, lds);
                pg8::Gemm g{WSP(bf16_t, WS_XB16), WSP(bf16_t, WS_WUP) + (size_t)l * FF * DM, MP, FF, DM}; pg8::StaticOrder S; S.init(MP, FF, c.nb, c.bx);
                pg8::EpiScaleBf16 E{WSP(bf16_t, WS_UNION), FF, ssq + (size_t)(2 * l + 1) * MP * 16, 1, nullptr, nullptr}; pg8::gemm_phase(lds, g, S, E); } }
            else { if (EN(7)) { if (!(step & 1)) sgemm4(c, l, lds);
                pg8::Gemm g{WSP(bf16_t, WS_UNION), WSP(bf16_t, WS_WDN) + (size_t)l * DM * FF, MP, DM, FF}; pg8::StaticOrder S; S.init(MP, DM, c.nb, c.bx);
                pg8::EpiResid E{WSP(bf16_t, WS_XB16), ssq + (size_t)(2 * l + 2) * MP * 16}; pg8::gemm_phase(lds, g, S, E); } }
        }
        if (!(step & 1) && ((REPMASK >> ptype) & 1)) continue;
        if ((REPMASK >> 9) & 1) { if (ph + 1 < args.ph_hi) xcd_barrier(xbar); }
        if (ph + 1 < args.ph_hi) {
            xcd_barrier(xbar);
        }
    }
}

extern "C" void kernel_launch(void* const* d_in, const int* in_sizes, int n_in, void* d_out, int out_size, void* d_ws, size_t ws_size, hipStream_t stream) {
    static int grid = 0;
    if (grid == 0) {
        int dev = 0, cus = 0, per_cu = 0;
        (void)hipGetDevice(&dev); (void)hipDeviceGetAttribute(&cus, hipDeviceAttributeMultiprocessorCount, dev);
        if (hipFuncSetAttribute((const void*)hymba_fwd, hipFuncAttributeMaxDynamicSharedMemorySize, LDS_BYTES) != hipSuccess) fprintf(stderr, "kernel_launch: hipFuncSetAttribute failed\n");
        if (hipOccupancyMaxActiveBlocksPerMultiprocessor(&per_cu, (const void*)hymba_fwd, 512, LDS_BYTES) != hipSuccess || per_cu < 1) { fprintf(stderr, "kernel_launch: occupancy query says %d\n", per_cu); per_cu = 1; }
        (void)hipGetLastError();
        grid = cus * 1;
        if (ws_size < WS_END) fprintf(stderr, "kernel_launch: workspace too small: %zu < %zu\n", ws_size, (size_t)WS_END);
    }
    (void)hipMemsetAsync(d_ws, 0, 65536, stream);
    Args a{};
    for (int i = 0; i < 18; ++i) a.in[i] = (const float*)d_in[i];
    a.out = (float*)d_out; a.ws = (unsigned char*)d_ws; a.ph_lo = 0; a.ph_hi = 30;
    void* kargs[] = {&a};
    hipError_t e = hipLaunchCooperativeKernel((const void*)hymba_fwd, dim3(grid), dim3(512), kargs, LDS_BYTES, stream);
    if (e != hipSuccess) fprintf(stderr, "kernel_launch: cooperative launch failed: %s (grid %d)\n", hipGetErrorString(e), grid);
}
```

```cpp
#include <hip/hip_runtime.h>
#include <hip/hip_cooperative_groups.h>
#include <cstdio>
namespace cg = cooperative_groups;

#define LAS __attribute__((address_space(3)))
#define DI __device__ __forceinline__
typedef unsigned short bf16_t;
typedef short bf16x8 __attribute__((ext_vector_type(8)));
typedef float f32x4 __attribute__((ext_vector_type(4)));
typedef float f32x2 __attribute__((ext_vector_type(2)));
typedef float f32x16 __attribute__((ext_vector_type(16)));
typedef unsigned u32x4 __attribute__((ext_vector_type(4)));
typedef unsigned u32x2 __attribute__((ext_vector_type(2)));
typedef __bf16 bf2_t __attribute__((ext_vector_type(2)));
typedef unsigned u32x8 __attribute__((ext_vector_type(8)));

#ifndef SUBSEL
#define SUBSEL -1
#endif
#define SUB(x) (SUBSEL < 0 || SUBSEL == (x))
#ifndef SUBSEL2
#define SUBSEL2 -1
#endif
#define SUB2(x) (SUBSEL2 < 0 || SUBSEL2 == (x))
constexpr int DM = 1024, NBATCH = 8, SEQ = 2048, MP = NBATCH * SEQ, DEPTH = 4, SBATCH = 128;
constexpr int NH = 4, QKV = 1536, NP = 3072, PROJ = 3080, FF = 4096, NPS = 3088;
constexpr float EPS = 1e-6f;
constexpr int IMG_BYTES = 55296;
constexpr int LDS_BYTES = 150528;
constexpr size_t O_YP = 0, O_YS = 16777216, O_DP = 16908288, O_CP = 19005440, O_DS = 19152896, O_CS = 52707328, O_VS = 55066624;
constexpr size_t WS_WIN = 65536;
constexpr size_t WS_WAB = WS_WIN + (size_t)DEPTH * NP * DM * 2;
constexpr size_t WS_WO = WS_WAB + (size_t)DEPTH * 16 * DM * 2;
constexpr size_t WS_WUP = WS_WO + (size_t)DEPTH * DM * DM * 2;
constexpr size_t WS_WDN = WS_WUP + (size_t)DEPTH * FF * DM * 2;
constexpr size_t WS_WM = WS_WDN + (size_t)DEPTH * FF * DM * 2;
constexpr size_t WS_XBUF = WS_WM + (size_t)DEPTH * 4 * 128 * 128 * 2;
constexpr size_t WS_XB16 = WS_XBUF + (size_t)MP * DM * 4;
constexpr size_t WS_SSQ = WS_XB16 + (size_t)MP * DM * 2;
constexpr size_t WS_UNION = WS_SSQ + (size_t)9 * MP * 16 * 4;
constexpr size_t WS_P = WS_UNION;
constexpr size_t WS_QN = WS_P + (size_t)MP * NP * 2;
constexpr size_t WS_KN = WS_QN + (size_t)MP * 512 * 2;
constexpr size_t WS_KNT = WS_UNION + (size_t)MP * FF * 2;
constexpr size_t WS_VT = WS_KNT + (size_t)MP * 512 * 2;
constexpr size_t WS_VBT = WS_VT + (size_t)MP * 512 * 2;
constexpr size_t WS_G = WS_VBT + (size_t)MP * 512 * 2;
constexpr size_t WS_BETA = WS_G + (size_t)MP * 4 * 4;
constexpr size_t WS_EG = WS_BETA + (size_t)MP * 4 * 4;
constexpr size_t WS_IMG = WS_EG + 4096;
constexpr size_t WS_UIMG = WS_IMG + (size_t)1024 * IMG_BYTES;
constexpr size_t WS_AMIX = WS_UIMG + (size_t)1024 * 32768;
constexpr size_t WS_XS = WS_AMIX + (size_t)MP * DM * 2;
constexpr size_t WS_PS = WS_XS + (size_t)SBATCH * DM * 4;
constexpr size_t WS_QS = WS_PS + (size_t)SBATCH * NPS * 4;
constexpr size_t WS_KS = WS_QS + (size_t)SBATCH * 512 * 4;
constexpr size_t WS_VS = WS_KS + (size_t)SBATCH * 512 * 4;
constexpr size_t WS_GS = WS_VS + (size_t)SBATCH * 512 * 4;
constexpr size_t WS_BS = WS_GS + (size_t)SBATCH * 4 * 4;
constexpr size_t WS_AMIXS = WS_BS + (size_t)SBATCH * 4 * 4;
constexpr size_t WS_HS = WS_AMIXS + (size_t)SBATCH * DM * 4;
constexpr size_t WS_XP = WS_HS + (size_t)SBATCH * FF * 4;
constexpr size_t WS_VSS = WS_XP + (size_t)4 * SBATCH * DM * 4;
constexpr size_t WS_CWP = WS_VSS + (size_t)MP * 8 * 4;
constexpr size_t WS_END = WS_CWP + (size_t)DEPTH * 4 * QKV * 4;
static_assert(WS_QN + 2 * (size_t)MP * 512 * 2 == WS_KNT, "union");
static_assert(WS_END <= (size_t)536870912, "workspace");

DI unsigned pk2(float lo, float hi) { f32x2 v = {lo, hi}; return __builtin_bit_cast(unsigned, __builtin_convertvector(v, bf2_t)); }
DI float bflo(unsigned w) { return __uint_as_float(w << 16); }
DI float bfhi(unsigned w) { return __uint_as_float(w & 0xffff0000u); }
DI float bf2f(bf16_t b) { return __uint_as_float(((unsigned)b) << 16); }
DI bf16_t f2bf(float f) { return (bf16_t)(pk2(f, 0.f) & 0xffffu); }
DI float xlane(float v, int srclane) { return __builtin_bit_cast(float, __builtin_amdgcn_ds_bpermute(srclane << 2, __builtin_bit_cast(int, v))); }
DI float wave_sum(float v, int lane) {
#pragma unroll
    for (int o = 1; o < 64; o <<= 1) v += xlane(v, lane ^ o);
    return v;
}
DI float silu_f(float x) { return x * __builtin_amdgcn_rcpf(1.f + __expf(-x)); }
DI float sigmoid_f(float x) { return __builtin_amdgcn_rcpf(1.f + __expf(-x)); }
DI float softplus_f(float x) { const float e = __expf(-fabsf(x)); const float l = e < 0.01f ? e * (1.f - e * (0.5f - 0.33333334f * e)) : __logf(1.f + e); return fmaxf(x, 0.f) + l; }
DI u32x4 pack8(const f32x16& x, int s) {
    u32x4 p; p.x = pk2(x[8 * s], x[8 * s + 1]); p.y = pk2(x[8 * s + 2], x[8 * s + 3]); p.z = pk2(x[8 * s + 4], x[8 * s + 5]); p.w = pk2(x[8 * s + 6], x[8 * s + 7]); return p;
}
DI float ssq_sum(const float* p) {
    const f32x4 a = *(const f32x4*)p, b = *(const f32x4*)(p + 4), c2 = *(const f32x4*)(p + 8), d2 = *(const f32x4*)(p + 12);
    return ((a.x + a.y) + (a.z + a.w)) + ((b.x + b.y) + (b.z + b.w)) + ((c2.x + c2.y) + (c2.z + c2.w)) + ((d2.x + d2.y) + (d2.z + d2.w));
}
DI int crow(int reg, int h) { return (reg & 3) + 8 * (reg >> 2) + 4 * h; }
#define MFMA32(a, b, c) __builtin_amdgcn_mfma_f32_32x32x16_bf16((a), (b), (c), 0, 0, 0)
#define MFMA16(a, b, c) __builtin_amdgcn_mfma_f32_16x16x32_bf16((a), (b), (c), 0, 0, 0)
DI bf16x8 as_bf(u32x4 v) { return __builtin_bit_cast(bf16x8, v); }
DI f32x16 zero16() { f32x16 z;
#pragma unroll
    for (int i = 0; i < 16; ++i) z[i] = 0.f; return z; }

namespace pg8 {
constexpr int BM = 256, BK = 64, HALF = 128, HTB = HALF * BK * 2, STAGE_BYTES = 8 * HTB, NXCD = 8, WGM = 8;
DI int lds_byte(int r, int c) { const int st = (r >> 4) * 2 + (c >> 5), rr = r & 15, cc = c & 31, ob = rr * 64 + cc * 2; return st * 1024 + (ob ^ (((ob >> 9) & 1) << 5)); }
DI void stage_rc(int b, int& R, int& C) { const int st = b / 1024, sb = b % 1024, swz = sb ^ (((sb >> 9) & 1) << 5); R = (st >> 1) * 16 + swz / 64; C = (st & 1) * 32 + (swz % 64) / 2; }
DI int perm32(int rho) { const int n = rho >> 4, i = rho & 15; return 8 * (i >> 2) + 4 * n + (i & 3); }
struct Unit { int pm, pn; };
struct Gemm { const bf16_t* A; const bf16_t* Bt; int M, N, K; };
struct StaticOrder {
    int nM, nN, nwg, G, c;
    DI void init(int M, int N, int G_, int c_) { nM = M / BM; nN = N / BM; nwg = nM * nN; G = G_; c = c_; }
    DI bool next(int i, Unit& u) const {
        const long L = (long)i * G + c; if (L >= nwg) return false;
        int wgid = (int)L; { const int q = nwg / NXCD, r = nwg % NXCD, xcd = wgid % NXCD, off = wgid / NXCD; wgid = (xcd < r ? xcd * (q + 1) : r * (q + 1) + (xcd - r) * q) + off; }
        const int nig = WGM * nN, gid = wgid / nig, fm = gid * WGM, gsz = (nM - fm) < WGM ? (nM - fm) : WGM;
        u.pm = fm + ((wgid % nig) % gsz); u.pn = (wgid % nig) / gsz; return true;
    }
};
template <class Epi>
DI void gemm_phase(LAS unsigned char* lds, const Gemm g, const StaticOrder& S, const Epi& E) {
    int tid = threadIdx.x; asm volatile("" : "+v"(tid));
    const int wid = __builtin_amdgcn_readfirstlane(tid >> 6), lane = tid & 63, wr = wid >> 2, wc = wid & 3, fr = lane & 15, fq = lane >> 4;
    const int K = g.K, nt = K / BK;
    unsigned voffA[2], voffB[2];
#pragma unroll
    for (int i = 0; i < 2; ++i) { int R, C; stage_rc(tid * 16 + i * 8192, R, C); const int Rb = (R & ~31) + perm32(R & 31);
        voffA[i] = (unsigned)(R * K + C) * 2u; voffB[i] = (unsigned)(Rb * K + C) * 2u; }
    const size_t kstep = (size_t)(BK * 2);
    const size_t hstep = (size_t)HALF * K * 2;
    const size_t tstep = 2 * hstep;
    const unsigned ldsw = (unsigned)wid * 1024u;
    const int aoff = lds_byte(wr * 64 + fr, fq * 8), boff = lds_byte(wc * 32 + fr, fq * 8);
#define PG8_SA(b, h) (((b) * 2 + (h)) * HTB)
#define PG8_SB(b, h) ((4 + (b) * 2 + (h)) * HTB)
#define PG8_STAGE(bufoff, gbase, voff) do { _Pragma("unroll") for (int _i = 0; _i < 2; ++_i) \
        __builtin_amdgcn_global_load_lds((const unsigned*)((const char*)(gbase) + (voff)[_i]), (LAS unsigned*)(lds + (bufoff) + ldsw + _i * 8192), 16, 0, 0); } while (0)
#define PG8_LDA(dst, b, h) do { _Pragma("unroll") for (int m = 0; m < 4; ++m) _Pragma("unroll") for (int k = 0; k < 2; ++k) dst[m][k] = *(const LAS bf16x8*)(lds + PG8_SA(b, h) + aoff + m * 2048 + k * 1024); } while (0)
#define PG8_LDB(dst, b, h) do { _Pragma("unroll") for (int n = 0; n < 2; ++n) _Pragma("unroll") for (int k = 0; k < 2; ++k) dst[n][k] = *(const LAS bf16x8*)(lds + PG8_SB(b, h) + boff + n * 2048 + k * 1024); } while (0)
#define PG8_MMA(ai, bj, At, Bt) do { __builtin_amdgcn_s_setprio(1); _Pragma("unroll") for (int m = 0; m < 4; ++m) _Pragma("unroll") for (int n = 0; n < 2; ++n) _Pragma("unroll") for (int k = 0; k < 2; ++k) \
        acc[ai][bj][m][n] = __builtin_amdgcn_mfma_f32_16x16x32_bf16(Bt[n][k], At[m][k], acc[ai][bj][m][n], 0, 0, 0); __builtin_amdgcn_s_setprio(0); } while (0)
#define PG8_WAIT_V(n) asm volatile("s_waitcnt vmcnt(" #n ")" ::: "memory")
#define PG8_WAIT_L(n) asm volatile("s_waitcnt lgkmcnt(" #n ")" ::: "memory")
#define PG8_BAR __builtin_amdgcn_s_barrier()
#define PG8_SCHED __builtin_amdgcn_sched_barrier(0)
    Unit cur, nxt; int ui = 0;
    if (!S.next(0, cur)) return;
    f32x4 acc[2][2][4][2];
#pragma unroll
    for (int a = 0; a < 2; ++a)
#pragma unroll
        for (int b = 0; b < 2; ++b)
#pragma unroll
            for (int m = 0; m < 4; ++m)
#pragma unroll
                for (int n = 0; n < 2; ++n) acc[a][b][m][n] = (f32x4){0.f, 0.f, 0.f, 0.f};
    bf16x8 At[4][2], B0[2][2], B1[2][2];
    const char* cA = (const char*)g.A + (size_t)cur.pm * tstep; const char* cB = (const char*)g.Bt + (size_t)cur.pn * tstep;
    PG8_STAGE(PG8_SB(0, 0), cB, voffB); PG8_STAGE(PG8_SA(0, 0), cA, voffA); PG8_STAGE(PG8_SB(0, 1), cB + hstep, voffB); PG8_STAGE(PG8_SA(0, 1), cA + hstep, voffA);
    if (wr == 1) PG8_BAR;
    PG8_WAIT_V(4); PG8_BAR;
    PG8_STAGE(PG8_SB(1, 0), cB + kstep, voffB); PG8_STAGE(PG8_SA(1, 0), cA + kstep, voffA); PG8_STAGE(PG8_SB(1, 1), cB + hstep + kstep, voffB);
    PG8_WAIT_V(6); PG8_BAR;
    for (;;) {
        const bool has_next = S.next(ui + 1, nxt);
        const char* nA = has_next ? (const char*)g.A + (size_t)nxt.pm * tstep : cA; const char* nB = has_next ? (const char*)g.Bt + (size_t)nxt.pn * tstep : cB;
        for (int t = 0; t < nt; t += 2) {
            const bool last = (t == nt - 2);
            const char* a1 = cA + (size_t)(t + 1) * kstep;
            const char* a2 = last ? nA : cA + (size_t)(t + 2) * kstep; const char* b2 = last ? nB : cB + (size_t)(t + 2) * kstep;
            const char* a3 = a2 + kstep; const char* b3 = b2 + kstep;
            PG8_LDB(B0, 0, 0); PG8_SCHED; PG8_LDA(At, 0, 0); PG8_STAGE(PG8_SA(1, 1), a1 + hstep, voffA);
            PG8_WAIT_L(8); PG8_BAR; PG8_WAIT_L(0); PG8_MMA(0, 0, At, B0); PG8_BAR; PG8_SCHED;
            PG8_LDB(B1, 0, 1); PG8_STAGE(PG8_SB(0, 0), b2, voffB);
            PG8_BAR; PG8_WAIT_L(0); PG8_MMA(0, 1, At, B1); PG8_BAR;
            PG8_LDA(At, 0, 1); PG8_STAGE(PG8_SA(0, 0), a2, voffA);
            PG8_BAR; PG8_WAIT_L(0); PG8_MMA(1, 0, At, B0); PG8_BAR; PG8_SCHED;
            PG8_STAGE(PG8_SB(0, 1), b2 + hstep, voffB);
            PG8_WAIT_V(6); PG8_BAR; PG8_MMA(1, 1, At, B1); PG8_BAR;
            PG8_LDB(B0, 1, 0); PG8_SCHED; PG8_LDA(At, 1, 0); PG8_STAGE(PG8_SA(0, 1), a2 + hstep, voffA);
            PG8_WAIT_L(8); PG8_BAR; PG8_WAIT_L(0); PG8_MMA(0, 0, At, B0); PG8_BAR; PG8_SCHED;
            PG8_LDB(B1, 1, 1); PG8_STAGE(PG8_SB(1, 0), b3, voffB);
            PG8_BAR; PG8_WAIT_L(0); PG8_MMA(0, 1, At, B1); PG8_BAR;
            PG8_LDA(At, 1, 1); PG8_STAGE(PG8_SA(1, 0), a3, voffA);
            PG8_BAR; PG8_WAIT_L(0); PG8_MMA(1, 0, At, B0); PG8_BAR; PG8_SCHED;
            PG8_STAGE(PG8_SB(1, 1), b3 + hstep, voffB);
            PG8_WAIT_V(6); PG8_BAR; PG8_MMA(1, 1, At, B1); PG8_BAR;
        }
        E(acc, cur, wr, wc, fr, fq);
        if (!has_next) break;
#pragma unroll
        for (int a = 0; a < 2; ++a)
#pragma unroll
            for (int b = 0; b < 2; ++b)
#pragma unroll
                for (int m = 0; m < 4; ++m)
#pragma unroll
                    for (int n = 0; n < 2; ++n) acc[a][b][m][n] = (f32x4){0.f, 0.f, 0.f, 0.f};
        cur = nxt; cA = nA; cB = nB; ++ui;
    }
    PG8_WAIT_V(0);
    if (wr == 0) PG8_BAR;
    PG8_BAR;
#undef PG8_SA
#undef PG8_SB
#undef PG8_STAGE
#undef PG8_LDA
#undef PG8_LDB
#undef PG8_MMA
#undef PG8_WAIT_V
#undef PG8_WAIT_L
#undef PG8_BAR
#undef PG8_SCHED
}
struct EpiScaleBf16 {
    bf16_t* O; int ldc; const float* ssq; int act; float* vss; const float* og;
    DI void operator()(const f32x4 (&acc)[2][2][4][2], const Unit& u, int wr, int wc, int fr, int fq) const {
        const int row0 = u.pm * BM + wr * 64 + fr, col0 = u.pn * BM + wc * 32 + 8 * fq;
#pragma unroll
        for (int ai = 0; ai < 2; ++ai)
#pragma unroll
            for (int m = 0; m < 4; ++m) { const int row = row0 + ai * HALF + m * 16;
                float rq; { const f32x4 p4 = *(const f32x4*)(ssq + (size_t)row * 16 + 4 * fq); rq = (p4.x + p4.y) + (p4.z + p4.w); const int ln = fq * 16 + fr; rq += xlane(rq, ln ^ 16); rq += xlane(rq, ln ^ 32); }
                const float rs = rsqrtf(rq * (1.0f / DM) + EPS);
                bf16_t* rowp = O + (size_t)row * ldc + col0; float vs = 0.f;
#pragma unroll
                for (int bj = 0; bj < 2; ++bj) { f32x4 v0 = acc[ai][bj][m][0] * rs, v1 = acc[ai][bj][m][1] * rs;
                    if (act) {
#pragma unroll
                        for (int j = 0; j < 4; ++j) { const float a = fmaxf(v0[j], 0.f), b = fmaxf(v1[j], 0.f); v0[j] = a * a; v1[j] = b * b; } }
                    if (og != nullptr && (u.pn == 6 || u.pn == 7)) { const float* gp = og + ((col0 + bj * HALF) & 127); const f32x4 g0 = *(const f32x4*)gp, g1 = *(const f32x4*)(gp + 4);
#pragma unroll
                        for (int j = 0; j < 4; ++j) { v0[j] = silu_f(v0[j]) * g0[j]; v1[j] = silu_f(v1[j]) * g1[j]; } }
                    u32x4 w; w.x = pk2(v0[0], v0[1]); w.y = pk2(v0[2], v0[3]); w.z = pk2(v1[0], v1[1]); w.w = pk2(v1[2], v1[3]);
                    *(u32x4*)(rowp + bj * HALF) = w;
                    vs += (v0[0] * v0[0] + v0[1] * v0[1]) + (v0[2] * v0[2] + v0[3] * v0[3]) + (v1[0] * v1[0] + v1[1] * v1[1]) + (v1[2] * v1[2] + v1[3] * v1[3]); }
                if (vss != nullptr && u.pn >= 10) { { const int ln = fq * 16 + fr; vs += xlane(vs, ln ^ 16); vs += xlane(vs, ln ^ 32); } if (fq == 0) vss[(size_t)row * 8 + (u.pn - 10) * 4 + wc] = vs; } }
    }
};
struct EpiResid {
    bf16_t* xb; float* ssq;
    DI void operator()(const f32x4 (&acc)[2][2][4][2], const Unit& u, int wr, int wc, int fr, int fq) const {
        const int row0 = u.pm * BM + wr * 64 + fr, col0 = u.pn * BM + wc * 32 + 8 * fq;
#pragma unroll
        for (int ai = 0; ai < 2; ++ai) {
            u32x4 bv[4][2];
#pragma unroll
            for (int m = 0; m < 4; ++m)
#pragma unroll
                for (int bj = 0; bj < 2; ++bj) bv[m][bj] = *(const u32x4*)(xb + (size_t)(row0 + ai * HALF + m * 16) * DM + col0 + bj * HALF);
#pragma unroll
            for (int m = 0; m < 4; ++m) { const int row = row0 + ai * HALF + m * 16; const size_t off = (size_t)row * DM + col0; float ss = 0.f;
#pragma unroll
                for (int bj = 0; bj < 2; ++bj) {
                    const u32x4 b = bv[m][bj];
                    const f32x4 o0 = (f32x4){bflo(b.x), bfhi(b.x), bflo(b.y), bfhi(b.y)} + acc[ai][bj][m][0], o1 = (f32x4){bflo(b.z), bfhi(b.z), bflo(b.w), bfhi(b.w)} + acc[ai][bj][m][1];
                    u32x4 w; w.x = pk2(o0[0], o0[1]); w.y = pk2(o0[2], o0[3]); w.z = pk2(o1[0], o1[1]); w.w = pk2(o1[2], o1[3]);
                    *(u32x4*)(xb + off + bj * HALF) = w;
                    ss += (o0[0] * o0[0] + o0[1] * o0[1]) + (o0[2] * o0[2] + o0[3] * o0[3]) + (o1[0] * o1[0] + o1[1] * o1[1]) + (o1[2] * o1[2] + o1[3] * o1[3]); }
                { const int ln = fq * 16 + fr; ss += xlane(ss, ln ^ 16); ss += xlane(ss, ln ^ 32); }
                if (fq == 0) ssq[(size_t)row * 16 + u.pn * 4 + wc] = ss; }
        }
    }
};
}

struct Args { const float* in[18]; float* out; unsigned char* ws; int ph_lo, ph_hi; };
struct Ctx {
    const float *x_prompt, *x_sample, *state_delta, *state_conv, *norm_mix_g, *w_in, *conv_w, *A_log, *dt_bias, *o_norm_g, *v_norm_g, *w_s, *b_s, *w_o, *norm_ffn_g, *w_up, *w_down, *norm_f_g;
    float* out; unsigned char* ws;
    int lane, wave, gw, ngw, bx, nb;
};
#define WSP(T, off) ((T*)(c.ws + (off)))

DI void transpose_item(const float* W, int K, int N, const float* kscale, bf16_t* WT, bf16_t* WAB, int mode, int item, int nblk, LAS float* scr, int lane) {
    const int kb = item / nblk, nb = item % nblk, k0 = 64 * kb, n0 = 64 * nb;
    const int c4 = lane & 15, rsub = lane >> 4;
    const bool cval = n0 + 4 * c4 + 3 < N;
#pragma unroll 4
    for (int kk = 0; kk < 64; kk += 4) { const int row = kk + rsub;
        f32x4 v = (f32x4){0.f, 0.f, 0.f, 0.f}; if (cval) { v = *(const f32x4*)(W + (size_t)(k0 + row) * N + n0 + 4 * c4); if (kscale) v = v * kscale[k0 + row]; }
        LAS float* p = scr + row * 65 + 4 * c4; p[0] = v.x; p[1] = v.y; p[2] = v.z; p[3] = v.w; }
    asm volatile("s_waitcnt lgkmcnt(0)" ::: "memory");
    const int kc = lane & 7;
#pragma unroll
    for (int it = 0; it < 8; ++it) { const int n = 8 * it + (lane >> 3), ns = n0 + n; const LAS float* s = scr + (8 * kc) * 65 + n;
        u32x4 o; o.x = pk2(s[0 * 65], s[1 * 65]); o.y = pk2(s[2 * 65], s[3 * 65]); o.z = pk2(s[4 * 65], s[5 * 65]); o.w = pk2(s[6 * 65], s[7 * 65]);
        if (ns < N) {
            bf16_t* rowp;
            if (mode == 0) rowp = WT + (size_t)ns * K;
            else rowp = ns < 2048 ? WT + (size_t)ns * K : (ns < 2056 ? WAB + (size_t)(ns - 2048) * K : WT + (size_t)(ns - 8) * K);
            *(u32x4*)(rowp + k0 + 8 * kc) = o; } }
    asm volatile("s_waitcnt lgkmcnt(0)" ::: "memory");
}
DI void convert_layer_weights(const Ctx& c, int l, int w0, int nw, LAS unsigned char* lds) {
    LAS float* scr = (LAS float*)(lds + c.wave * 18432);
    constexpr int I_IN = 16 * 49, I_O = 16 * 16, I_UP = 16 * 64, I_DN = 64 * 16, I_L = I_IN + I_O + I_UP + I_DN;
    for (int it = w0; it < I_L; it += nw) {
        int r = it;
        if (r < I_IN) { transpose_item(c.w_in + (size_t)l * DM * PROJ, DM, PROJ, c.norm_mix_g + l * DM, WSP(bf16_t, WS_WIN) + (size_t)l * NP * DM, WSP(bf16_t, WS_WAB) + (size_t)l * 16 * DM, 1, r, 49, scr, c.lane); continue; } r -= I_IN;
        if (r < I_O) { transpose_item(c.w_o + (size_t)l * DM * DM, DM, DM, nullptr, WSP(bf16_t, WS_WO) + (size_t)l * DM * DM, nullptr, 0, r, 16, scr, c.lane); continue; } r -= I_O;
        if (r < I_UP) { transpose_item(c.w_up + (size_t)l * DM * FF, DM, FF, c.norm_ffn_g + l * DM, WSP(bf16_t, WS_WUP) + (size_t)l * FF * DM, nullptr, 0, r, 64, scr, c.lane); continue; } r -= I_UP;
        transpose_item(c.w_down + (size_t)l * FF * DM, FF, DM, nullptr, WSP(bf16_t, WS_WDN) + (size_t)l * DM * FF, nullptr, 0, r, 16, scr, c.lane);
    }
}
DI void phase_prologue(const Ctx& c, LAS unsigned char* lds) {
    convert_layer_weights(c, 0, c.gw, c.ngw, lds);
    float* ssq = WSP(float, WS_SSQ);
    for (int m = c.gw; m < MP; m += c.ngw) {
        const f32x4* xr = (const f32x4*)(c.x_prompt + (size_t)m * DM) + c.lane; u32x2* o8 = (u32x2*)(WSP(bf16_t, WS_XB16) + (size_t)m * DM) + c.lane; float s = 0.f;
#pragma unroll
        for (int j = 0; j < 4; ++j) { const f32x4 v = xr[64 * j]; s += (v.x * v.x + v.y * v.y) + (v.z * v.z + v.w * v.w); u32x2 w; w.x = pk2(v.x, v.y); w.y = pk2(v.z, v.w); o8[64 * j] = w; }
        s = wave_sum(s, c.lane); if (c.lane < 16) ssq[(size_t)m * 16 + c.lane] = c.lane == 0 ? s : 0.f;
    }
    const int gt = c.gw * 64 + c.lane, ngt = c.ngw * 64;
    float* xs = WSP(float, WS_XS);
    for (int i = gt; i < SBATCH * DM; i += ngt) xs[i] = c.x_sample[i];
    bf16_t* wab = WSP(bf16_t, WS_WAB);
    for (int i = gt; i < DEPTH * 8 * DM; i += ngt) { const int l = i / (8 * DM), r = i % (8 * DM); wab[(size_t)l * 16 * DM + 8 * DM + r] = 0; }
    unsigned* wm = WSP(unsigned, WS_WM);
    for (int i = gt; i < DEPTH * 4 * 128 * 64; i += ngt) { const int e = 2 * i, ii = (e >> 7) & 127, jj = e & 127;
        const float a = ii >= jj ? c.w_s[e] : 0.f, b = ii >= jj + 1 ? c.w_s[e + 1] : 0.f; wm[i] = pk2(a, b); }
}

template <int NT, bool NORM, int EPI>
DI void sgemm_block(const Ctx& c, const float* A, int lda, int K, const bf16_t* Bt, int ncg, float* out, int ldo, LAS unsigned char* lds, const bf16_t* Bab) {
    int lane = c.lane; asm volatile("" : "+v"(lane));
    const int wave = c.wave, fr = lane & 15, fq = lane >> 4;
    LAS f32x4* red = (LAS f32x4*)lds;
    LAS float* ssr = (LAS float*)(lds + 8 * NT * 64 * 16);
    const int kw = K / 8, k0 = wave * kw;
    for (int u = c.bx; u < 8 * ncg; u += c.nb) {
        const int rt = u & 7, cg = u >> 3;
        const bool abg = (Bab != nullptr) && (cg == ncg - 1);
        const bf16_t* bp = (abg ? Bab : Bt + (size_t)cg * NT * 16 * K) + (size_t)fr * K + k0 + 8 * fq;
        const float* ap = A + (size_t)(rt * 16 + fr) * lda + k0 + 8 * fq;
        f32x4 acc[NT]; float ss = 0.f;
#pragma unroll
        for (int nt = 0; nt < NT; ++nt) acc[nt] = (f32x4){0.f, 0.f, 0.f, 0.f};
#pragma unroll 4
        for (int k = 0; k < kw; k += 32) {
            const f32x4 a0 = *(const f32x4*)(ap + k), a1 = *(const f32x4*)(ap + k + 4);
            if (NORM) ss += (a0.x * a0.x + a0.y * a0.y) + (a0.z * a0.z + a0.w * a0.w) + (a1.x * a1.x + a1.y * a1.y) + (a1.z * a1.z + a1.w * a1.w);
            u32x4 a; a.x = pk2(a0.x, a0.y); a.y = pk2(a0.z, a0.w); a.z = pk2(a1.x, a1.y); a.w = pk2(a1.z, a1.w);
#pragma unroll
            for (int nt = 0; nt < NT; ++nt) if (nt == 0 || !abg) { const bf16x8 bf = *(const bf16x8*)(bp + (size_t)nt * 16 * K + k); acc[nt] = MFMA16(as_bf(a), bf, acc[nt]); }
        }
        if (NORM) { ss += xlane(ss, lane ^ 16); ss += xlane(ss, lane ^ 32); if (fq == 0) ssr[wave * 16 + fr] = ss; }
#pragma unroll
        for (int nt = 0; nt < NT; ++nt) red[(wave * NT + nt) * 64 + lane] = acc[nt];
        __syncthreads();
        if (wave < NT && (wave == 0 || !abg)) {
            f32x4 t = red[wave * 64 + lane];
#pragma unroll
            for (int w = 1; w < 8; ++w) t += red[(w * NT + wave) * 64 + lane];
            const int col = (cg * NT + wave) * 16 + fr;
#pragma unroll
            for (int j = 0; j < 4; ++j) { const int rl = 4 * fq + j; float rs = 1.f;
                if (NORM) { float sq = 0.f;
#pragma unroll
                    for (int w = 0; w < 8; ++w) sq += ssr[w * 16 + rl];
                    rs = rsqrtf(sq * (1.0f / DM) + EPS); }
                float* o = out + (size_t)(rt * 16 + rl) * ldo + col;
                if (EPI == 0) *o = t[j] * rs; else if (EPI == 1) *o += t[j]; else { const float v = fmaxf(t[j] * rs, 0.f); *o = v * v; } }
        }
        __syncthreads();
    }
}
DI void sgemm1(const Ctx& c, int l, LAS unsigned char* lds) {
    sgemm_block<4, true, 0>(c, WSP(float, WS_XS), DM, DM, WSP(bf16_t, WS_WIN) + (size_t)l * NP * DM, 49, WSP(float, WS_PS), NPS, lds, WSP(bf16_t, WS_WAB) + (size_t)l * 16 * DM);
}
DI void sgemm2(const Ctx& c, int l, LAS unsigned char* lds) {
    sgemm_block<2, false, 1>(c, WSP(float, WS_AMIXS), DM, DM, WSP(bf16_t, WS_WO) + (size_t)l * DM * DM, 32, WSP(float, WS_XS), DM, lds, nullptr);
}
DI void sgemm3(const Ctx& c, int l, LAS unsigned char* lds) {
    sgemm_block<4, true, 2>(c, WSP(float, WS_XS), DM, DM, WSP(bf16_t, WS_WUP) + (size_t)l * FF * DM, 64, WSP(float, WS_HS), FF, lds, nullptr);
}
DI void sgemm4(const Ctx& c, int l, LAS unsigned char* lds) {
    sgemm_block<2, false, 1>(c, WSP(float, WS_HS), FF, FF, WSP(bf16_t, WS_WDN) + (size_t)l * DM * FF, 32, WSP(float, WS_XS), DM, lds, nullptr);
}

DI void b0_block_ab(const Ctx& c, int l, int chunk, LAS unsigned char* lds) {
    int lane = c.lane; asm volatile("" : "+v"(lane));
    const int wave = c.wave, fr = lane & 15, fq = lane >> 4, tok0 = chunk * 64, k0 = wave * 128;
    const bf16_t* ap = WSP(bf16_t, WS_XB16) + (size_t)(tok0 + fr) * DM + k0 + 8 * fq;
    const bf16_t* bp = WSP(bf16_t, WS_WAB) + (size_t)l * 16 * DM + (size_t)fr * DM + k0 + 8 * fq;
    f32x4 acc[4];
#pragma unroll
    for (int mt = 0; mt < 4; ++mt) acc[mt] = (f32x4){0.f, 0.f, 0.f, 0.f};
#pragma unroll
    for (int k = 0; k < 128; k += 32) {
        const bf16x8 bf = *(const bf16x8*)(bp + k);
#pragma unroll
        for (int mt = 0; mt < 4; ++mt) { const bf16x8 a = *(const bf16x8*)(ap + (size_t)mt * 16 * DM + k); acc[mt] = MFMA16(a, bf, acc[mt]); }
    }
    LAS f32x4* red = (LAS f32x4*)lds;
#pragma unroll
    for (int mt = 0; mt < 4; ++mt) red[(wave * 4 + mt) * 64 + lane] = acc[mt];
    __syncthreads();
    if (wave < 4 && fr < 8) { const int mt = wave;
        f32x4 t = red[mt * 64 + lane];
#pragma unroll
        for (int w = 1; w < 8; ++w) t += red[(w * 4 + mt) * 64 + lane];
        const float* ssq = WSP(float, WS_SSQ) + (size_t)(2 * l) * MP * 16;
        float* gb = WSP(float, WS_G); float* bb = WSP(float, WS_BETA);
        const int hh = fr & 3; const float al = -__expf(c.A_log[l * 4 + hh]), dtb = c.dt_bias[l * 4 + hh];
#pragma unroll
        for (int j = 0; j < 4; ++j) { const int tok = tok0 + 16 * mt + 4 * fq + j; const float v = t[j] * rsqrtf(ssq_sum(ssq + (size_t)tok * 16) * (1.0f / DM) + EPS);
            if (fr < 4) gb[tok * 4 + hh] = al * softplus_f(v + dtb); else bb[tok * 4 + hh] = sigmoid_f(v); } }
    __syncthreads();
}
DI float dot2bf(unsigned a, unsigned b, float c) { float r; asm("v_dot2c_f32_bf16 %0, %1, %2" : "=v"(r) : "s"(b), "v"(a), "0"(c)); return r; }
constexpr int B0_STRIDE = 272, B0_WAVE_LDS = 18432;
DI void b0_task_conv(const Ctx& c, int l, int b, int n, int s, int hh, LAS unsigned char* wl) {
    int lane = c.lane; asm volatile("" : "+v"(lane));
    const int tok0 = b * SEQ + n * 64, cb = s * 512 + hh * 128, piece = lane & 15;
    const bf16_t* P = WSP(bf16_t, WS_P) + (size_t)tok0 * NP + cb + piece * 8;
#pragma unroll
    for (int k = 0; k < 17; ++k) { const int row = 4 * k + (lane >> 4);
        if (row < 67) { u32x4 v = (u32x4){0u, 0u, 0u, 0u}; if (n > 0 || row >= 3) v = *(const u32x4*)(P + (long)(row - 3) * NP);
            *(LAS u32x4*)(wl + row * B0_STRIDE + piece * 16) = v; } }
    const unsigned* cwl = (const unsigned*)(c.conv_w + (size_t)l * 4 * QKV + cb);
    if (n == 31) {
        float* ocp = c.out + O_CP + ((size_t)(l * NBATCH + b) * 3) * QKV + cb;
#pragma unroll
        for (int t = 0; t < 6; ++t) { const int idx = lane + 64 * t, row = idx >> 7, ch = idx & 127; ocp[(size_t)row * QKV + ch] = bf2f(*(const LAS bf16_t*)(wl + (64 + row) * B0_STRIDE + ch * 2)); } }
    float ss = 0.f;
#pragma unroll 1
    for (int i = 0; i < 16; ++i) {
        u32x4 rws[4];
#pragma unroll
        for (int j = 0; j < 4; ++j) rws[j] = *(const LAS u32x4*)(wl + (lane + j) * B0_STRIDE + i * 16);
        u32x8 w0, w1, w2, w3; const unsigned* wp = cwl + 8 * i;
        asm volatile("s_load_dwordx8 %0, %4, 0x0\n\ts_load_dwordx8 %1, %4, 0x1800\n\ts_load_dwordx8 %2, %4, 0x3000\n\ts_load_dwordx8 %3, %4, 0x4800\n\ts_waitcnt lgkmcnt(0)"
                     : "=&s"(w0), "=&s"(w1), "=&s"(w2), "=&s"(w3) : "s"(wp) : "memory");
        float y[8];
#pragma unroll
        for (int e = 0; e < 8; ++e) { float a = 0.f;
            a = dot2bf(rws[0][e >> 1], (e & 1) ? ((w0[e] + 0x8000u) & 0xffff0000u) : ((w0[e] + 0x8000u) >> 16), a);
            a = dot2bf(rws[1][e >> 1], (e & 1) ? ((w1[e] + 0x8000u) & 0xffff0000u) : ((w1[e] + 0x8000u) >> 16), a);
            a = dot2bf(rws[2][e >> 1], (e & 1) ? ((w2[e] + 0x8000u) & 0xffff0000u) : ((w2[e] + 0x8000u) >> 16), a);
            a = dot2bf(rws[3][e >> 1], (e & 1) ? ((w3[e] + 0x8000u) & 0xffff0000u) : ((w3[e] + 0x8000u) >> 16), a);
            y[e] = silu_f(a); ss += y[e] * y[e]; }
        u32x4 w; w.x = pk2(y[0], y[1]); w.y = pk2(y[2], y[3]); w.z = pk2(y[4], y[5]); w.w = pk2(y[6], y[7]);
        *(LAS u32x4*)(wl + (lane + 3) * B0_STRIDE + i * 16) = w;
    }
    const float sc = s == 0 ? rsqrtf(ss + EPS) * 0.08838834764831845f : (s == 1 ? rsqrtf(ss + EPS) : 1.0f);
    const size_t unit = (size_t)((b * 4 + hh) * 32 + n);
    bf16_t* ot = (s == 1 ? WSP(bf16_t, WS_KNT) : WSP(bf16_t, WS_VT)) + unit * 128 * 64 + lane;
#pragma unroll 2
    for (int i = 0; i < 16; ++i) { const u32x4 v = *(const LAS u32x4*)(wl + (lane + 3) * B0_STRIDE + i * 16); u32x4 w;
#pragma unroll
        for (int e = 0; e < 4; ++e) w[e] = pk2(bflo(v[e]) * sc, bfhi(v[e]) * sc);
        if (s < 2) *(LAS u32x4*)(wl + (lane + 3) * B0_STRIDE + i * 16) = w;
        if (s >= 1) {
#pragma unroll
            for (int e = 0; e < 8; ++e) ot[(8 * i + e) * 64] = (bf16_t)((e & 1) ? (w[e >> 1] >> 16) : (w[e >> 1] & 0xffffu)); } }
    if (s < 2) { bf16_t* o = (s == 0 ? WSP(bf16_t, WS_QN) : WSP(bf16_t, WS_KN)) + (size_t)tok0 * 512 + hh * 128 + piece * 8;
#pragma unroll
        for (int k = 0; k < 16; ++k) { const int row = 4 * k + (lane >> 4); *(u32x4*)(o + (size_t)row * 512) = *(const LAS u32x4*)(wl + (row + 3) * B0_STRIDE + piece * 16); } }
}
DI void b0_task_vb(const Ctx& c, int l, int b, int n, int hb, LAS unsigned char* wl) {
    int lane = c.lane; asm volatile("" : "+v"(lane));
    const int tok0 = b * SEQ + n * 64, piece = lane & 15;
    const bf16_t* P = WSP(bf16_t, WS_P) + (size_t)tok0 * NP + 2560 + hb * 128 + piece * 8;
#pragma unroll
    for (int k = 0; k < 16; ++k) { const int row = 4 * k + (lane >> 4); *(LAS u32x4*)(wl + row * B0_STRIDE + piece * 16) = *(const u32x4*)(P + (size_t)row * NP); }
    const float* vp = WSP(float, WS_VSS) + (size_t)(tok0 + lane) * 8; const f32x4 p0 = *(const f32x4*)vp, p1 = *(const f32x4*)(vp + 4);
    const float rs = rsqrtf((((p0.x + p0.y) + (p0.z + p0.w)) + ((p1.x + p1.y) + (p1.z + p1.w))) * (1.0f / 512.0f) + EPS);
    const float* vg = c.v_norm_g + l * 512 + hb * 128;
    bf16_t* vbt = WSP(bf16_t, WS_VBT) + ((size_t)((b * 16 + (n >> 1)) * 4 + hb) * 128) * 128 + (n & 1) * 64 + lane;
#pragma unroll 2
    for (int i = 0; i < 16; ++i) { const u32x4 v = *(const LAS u32x4*)(wl + lane * B0_STRIDE + i * 16);
#pragma unroll
        for (int e = 0; e < 8; ++e) { const float pv = (e & 1) ? bfhi(v[e >> 1]) : bflo(v[e >> 1]); vbt[(size_t)(8 * i + e) * 128] = f2bf(pv * rs * vg[8 * i + e]); } }
}
DI void b0_task_sample(const Ctx& c, int l, int bs) {
    const float* ps = WSP(float, WS_PS) + (size_t)bs * NPS;
    if (c.lane < 4) { const int hh = c.lane;
        WSP(float, WS_GS)[bs * 4 + hh] = -__expf(c.A_log[l * 4 + hh]) * softplus_f(ps[3072 + hh] + c.dt_bias[l * 4 + hh]);
        WSP(float, WS_BS)[bs * 4 + hh] = sigmoid_f(ps[3076 + hh]); }
    const float* sc = c.state_conv + (size_t)(l * SBATCH + bs) * 3 * QKV;
    const float* cw = c.conv_w + (size_t)l * 4 * QKV;
    float* ocs = c.out + O_CS + (size_t)(l * SBATCH + bs) * 3 * QKV;
    float* qkvs = WSP(float, WS_QS) + bs * 512;
#pragma unroll 1
    for (int sh = 0; sh < 12; ++sh) {
        float y[2];
#pragma unroll
        for (int t = 0; t < 2; ++t) { const int ch = sh * 128 + t * 64 + c.lane; const float s0 = sc[ch], s1 = sc[QKV + ch], s2 = sc[2 * QKV + ch], cur = ps[ch];
            ocs[ch] = s1; ocs[QKV + ch] = s2; ocs[2 * QKV + ch] = cur;
            y[t] = silu_f(s0 * cw[ch] + s1 * cw[QKV + ch] + s2 * cw[2 * QKV + ch] + cur * cw[3 * QKV + ch]); }
        float scale = 1.0f;
        if (sh < 8) { const float ssum = wave_sum(y[0] * y[0] + y[1] * y[1], c.lane); scale = rsqrtf(ssum + EPS) * (sh < 4 ? 0.08838834764831845f : 1.0f); }
        float* o = qkvs + (size_t)(sh >> 2) * SBATCH * 512 + (sh & 3) * 128;
        o[c.lane] = y[0] * scale; o[64 + c.lane] = y[1] * scale;
    }
    float pv[8]; float ss = 0.f;
#pragma unroll
    for (int i = 0; i < 8; ++i) { pv[i] = ps[2560 + c.lane + 64 * i]; ss += pv[i] * pv[i]; }
    ss = wave_sum(ss, c.lane); const float rs = rsqrtf(ss * (1.0f / 512.0f) + EPS);
    float* am = WSP(float, WS_AMIXS) + (size_t)bs * DM; float* ovs = c.out + O_VS + (size_t)(l * SBATCH + bs) * 512;
#pragma unroll
    for (int i = 0; i < 8; ++i) { const int ch = c.lane + 64 * i, hb = ch >> 7; const float vb = pv[i] * rs * c.v_norm_g[l * 512 + ch];
        ovs[ch] = vb; am[512 + ch] = ps[2048 + ch] * (c.w_s[(size_t)(l * 4 + hb) * 128 * 128] * vb + c.b_s[(l * 4 + hb) * 128]); }
}
DI void phase_b0(const Ctx& c, int l, LAS unsigned char* lds) {
    for (int ch = c.bx; ch < 256; ch += c.nb) b0_block_ab(c, l, ch, lds);
    constexpr int NPT = 256 * 12;
    LAS unsigned char* wl = lds + c.wave * B0_WAVE_LDS;
    for (int t = c.wave * c.nb + c.bx; t < NPT + SBATCH; t += c.ngw) {
        if (t >= NPT) { if (SUB(0)) b0_task_sample(c, l, t - NPT); continue; }
        const int chunk = t / 12, k = t % 12, b = chunk >> 5, n = chunk & 31;
        if (SUB(3)) b0_task_conv(c, l, b, n, k >> 2, k & 3, wl);
    }
}

DI void b1_prep(const Ctx& c, int l, int unit, int part, LAS unsigned char* wl, LAS float* sg, LAS float* sb) {
    int lane = c.lane; asm volatile("" : "+v"(lane));
    const int r = lane & 31, h = lane >> 5;
    const int n = unit & 31, bh = unit >> 5, hh = bh & 3, b = bh >> 2, tok0 = b * SEQ + n * 64;
    const float bt = WSP(float, WS_BETA)[(tok0 + lane) * 4 + hh];
    float gc = WSP(float, WS_G)[(tok0 + lane) * 4 + hh];
#pragma unroll
    for (int o = 1; o < 64; o <<= 1) { const float t = xlane(gc, lane - o); if (lane >= o) gc += t; }
    sg[lane] = gc; sb[lane] = bt;
    const float glast = __builtin_bit_cast(float, __builtin_amdgcn_readlane(__builtin_bit_cast(int, gc), 63));
    if (part == 0 && lane == 0) WSP(float, WS_EG)[unit] = __expf(glast);
    unsigned char* img = c.ws + WS_IMG + (size_t)unit * IMG_BYTES;
    const bf16_t* Kn = WSP(bf16_t, WS_KN) + (size_t)tok0 * 512 + hh * 128;
    const bf16_t* Qn = WSP(bf16_t, WS_QN) + (size_t)tok0 * 512 + hh * 128;
    const bf16_t* KnT = WSP(bf16_t, WS_KNT) + (size_t)unit * 128 * 64;
    const bf16_t* VT = WSP(bf16_t, WS_VT) + (size_t)unit * 128 * 64;
    LAS float* L = (LAS float*)wl;
    {
        bf16x8 Kf[2][8];
#pragma unroll
        for (int t = 0; t < 2; ++t)
#pragma unroll
            for (int ks = 0; ks < 8; ++ks) Kf[t][ks] = *(const bf16x8*)(Kn + (size_t)(32 * t + r) * 512 + 16 * ks + 8 * h);
        if (part == 0) {
#pragma unroll
        for (int tt = 0; tt < 3; ++tt) { const int mt = tt == 0 ? 0 : 1, nt = tt == 2 ? 1 : 0;
            f32x16 acc = zero16();
#pragma unroll
            for (int ks = 0; ks < 8; ++ks) acc = MFMA32(Kf[mt][ks], Kf[nt][ks], acc);
            const int j = 32 * nt + r; const float gj = sg[j];
#pragma unroll
            for (int g4 = 0; g4 < 4; ++g4) { const f32x4 gi4 = *(const LAS f32x4*)(sg + 32 * mt + 8 * g4 + 4 * h), bi4 = *(const LAS f32x4*)(sb + 32 * mt + 8 * g4 + 4 * h);
#pragma unroll
                for (int q = 0; q < 4; ++q) { const int i = 32 * mt + 8 * g4 + 4 * h + q; const float arg = i > j ? gi4[q] - gj : 0.f;
                    L[i * 64 + j] = i > j ? acc[4 * g4 + q] * bi4[q] * __expf(arg) : 0.f; } } }
        }
        if (part == 1) {
#pragma unroll
        for (int mt = 0; mt < 2; ++mt) {
            bf16x8 Qf[8];
#pragma unroll
            for (int ks = 0; ks < 8; ++ks) Qf[ks] = *(const bf16x8*)(Qn + (size_t)(32 * mt + r) * 512 + 16 * ks + 8 * h);
            const int i = 32 * mt + r; const float gi = sg[i];
#pragma unroll
            for (int mp = 0; mp <= mt; ++mp) {
                f32x16 acc = zero16();
#pragma unroll
                for (int ks = 0; ks < 8; ++ks) acc = MFMA32(Kf[mp][ks], Qf[ks], acc);
#pragma unroll
                for (int g4 = 0; g4 < 4; ++g4) { const f32x4 gj4 = *(const LAS f32x4*)(sg + 32 * mp + 8 * g4 + 4 * h);
#pragma unroll
                    for (int q = 0; q < 4; ++q) { const int j = 32 * mp + 8 * g4 + 4 * h + q; const float arg = i >= j ? gi - gj4[q] : 0.f;
                        acc[4 * g4 + q] = i >= j ? acc[4 * g4 + q] * __expf(arg) : 0.f; } }
                const int fb = (mt == 0 ? 0 : 1 + mp) * 2;
#pragma unroll
                for (int s = 0; s < 2; ++s) *(u32x4*)(img + 49152 + (fb + s) * 1024 + lane * 16) = pack8(acc, s);
            }
        }
        }
    }
    if (part == 0) {
    float Tr[64];
    {
        f32x4 lb[2][16];
#pragma unroll
        for (int i = 0; i < 64; ++i) {
            if (i + 1 < 64) {
#pragma unroll
                for (int j4 = 0; j4 < (i + 1 + 3) / 4; ++j4) lb[(i + 1) & 1][j4] = *(const LAS f32x4*)(L + (i + 1) * 64 + 4 * j4); }
            asm volatile("" ::: "memory");
            float a0 = lane == i ? 1.f : 0.f, a1 = 0.f;
#pragma unroll
            for (int j4 = 0; j4 < (i + 3) / 4; ++j4) {
#pragma unroll
                for (int q = 0; q < 4; ++q) { const int j = 4 * j4 + q; if (j < i) { if (q & 1) a1 -= lb[i & 1][j4][q] * Tr[j]; else a0 -= lb[i & 1][j4][q] * Tr[j]; } } }
            Tr[i] = a0 + a1;
        }
    }
    LAS bf16_t* T1 = (LAS bf16_t*)wl;
    asm volatile("" ::: "memory");
    {
        const float sc1 = bt * __expf(gc);
#pragma unroll
        for (int i = 0; i < 64; ++i) T1[i * 72 + lane] = f2bf(Tr[i] * sc1);
        bf16x8 Tf[2][4];
#pragma unroll
        for (int mt = 0; mt < 2; ++mt)
#pragma unroll
            for (int ks = 0; ks < 4; ++ks) Tf[mt][ks] = *(const LAS bf16x8*)(T1 + (32 * mt + r) * 72 + 16 * ks + 8 * h);
#pragma unroll
        for (int dt = 0; dt < 4; ++dt) {
            bf16x8 Kt[4];
#pragma unroll
            for (int ks = 0; ks < 4; ++ks) Kt[ks] = *(const bf16x8*)(KnT + (size_t)(32 * dt + r) * 64 + 16 * ks + 8 * h);
#pragma unroll
            for (int mt = 0; mt < 2; ++mt) { f32x16 acc = zero16();
#pragma unroll
                for (int ks = 0; ks < 2 * (mt + 1); ++ks) acc = MFMA32(Kt[ks], Tf[mt][ks], acc);
                acc = -acc;
#pragma unroll
                for (int s = 0; s < 2; ++s) *(u32x4*)(img + ((mt * 4 + dt) * 2 + s) * 1024 + lane * 16) = pack8(acc, s); }
        }
    }
    asm volatile("" ::: "memory");
    {
#pragma unroll
        for (int i = 0; i < 64; ++i) T1[i * 72 + lane] = f2bf(Tr[i] * bt);
        bf16x8 Tf[2][4];
#pragma unroll
        for (int mt = 0; mt < 2; ++mt)
#pragma unroll
            for (int ks = 0; ks < 4; ++ks) Tf[mt][ks] = *(const LAS bf16x8*)(T1 + (32 * mt + r) * 72 + 16 * ks + 8 * h);
        bf16_t* uimg = WSP(bf16_t, WS_UIMG) + (size_t)unit * 8192;
#pragma unroll
        for (int et = 0; et < 4; ++et) {
            bf16x8 Vt[4];
#pragma unroll
            for (int ks = 0; ks < 4; ++ks) Vt[ks] = *(const bf16x8*)(VT + (size_t)(32 * et + r) * 64 + 16 * ks + 8 * h);
#pragma unroll
            for (int mt = 0; mt < 2; ++mt) { f32x16 acc = zero16();
#pragma unroll
                for (int ks = 0; ks < 2 * (mt + 1); ++ks) acc = MFMA32(Tf[mt][ks], Vt[ks], acc);
#pragma unroll
                for (int g4 = 0; g4 < 4; ++g4) { u32x2 w; w.x = pk2(acc[4 * g4], acc[4 * g4 + 1]); w.y = pk2(acc[4 * g4 + 2], acc[4 * g4 + 3]); *(u32x2*)(uimg + ((et * 2 + mt) * 4 + g4) * 256 + lane * 4) = w; } }
        }
    }
    }
    if (part == 1) {
#pragma unroll
    for (int mt = 0; mt < 2; ++mt) { const float ei = __expf(sg[32 * mt + r]);
#pragma unroll
        for (int dt = 0; dt < 4; ++dt)
#pragma unroll
            for (int s = 0; s < 2; ++s) { const bf16_t* qp = Qn + (size_t)(32 * mt + r) * 512 + 32 * dt + 16 * s + 4 * h;
                const u32x2 p0 = *(const u32x2*)qp, p1 = *(const u32x2*)(qp + 8);
                u32x4 w; w.x = pk2(bflo(p0.x) * ei, bfhi(p0.x) * ei); w.y = pk2(bflo(p0.y) * ei, bfhi(p0.y) * ei); w.z = pk2(bflo(p1.x) * ei, bfhi(p1.x) * ei); w.w = pk2(bflo(p1.y) * ei, bfhi(p1.y) * ei);
                *(u32x4*)(img + 16384 + ((mt * 4 + dt) * 2 + s) * 1024 + lane * 16) = w; } }
#pragma unroll
    for (int mp = 0; mp < 2; ++mp)
#pragma unroll
        for (int s = 0; s < 2; ++s) { const f32x4 ga = *(const LAS f32x4*)(sg + 32 * mp + 16 * s + 4 * h), gb = *(const LAS f32x4*)(sg + 32 * mp + 16 * s + 8 + 4 * h);
            float sc[8];
#pragma unroll
            for (int q = 0; q < 4; ++q) { sc[q] = __expf(glast - ga[q]); sc[4 + q] = __expf(glast - gb[q]); }
#pragma unroll
            for (int dt = 0; dt < 4; ++dt) { const bf16_t* kp = KnT + (size_t)(32 * dt + r) * 64 + 32 * mp + 16 * s + 4 * h;
                const u32x2 p0 = *(const u32x2*)kp, p1 = *(const u32x2*)(kp + 8);
                u32x4 w; w.x = pk2(bflo(p0.x) * sc[0], bfhi(p0.x) * sc[1]); w.y = pk2(bflo(p0.y) * sc[2], bfhi(p0.y) * sc[3]); w.z = pk2(bflo(p1.x) * sc[4], bfhi(p1.x) * sc[5]); w.w = pk2(bflo(p1.y) * sc[6], bfhi(p1.y) * sc[7]);
                *(u32x4*)(img + 32768 + ((dt * 2 + mp) * 2 + s) * 1024 + lane * 16) = w; } }
    }
}
DI void b1_gmlp(const Ctx& c, int l, int unit) {
    int lane = c.lane; asm volatile("" : "+v"(lane));
    const int r = lane & 31, h = lane >> 5;
    const int hb = unit & 3, cc = (unit >> 2) & 15, b = unit >> 6, tokc0 = b * SEQ + cc * 128;
    const bf16_t* A = WSP(bf16_t, WS_VBT) + (size_t)unit * 128 * 128;
    const bf16_t* B = WSP(bf16_t, WS_WM) + (size_t)(l * 4 + hb) * 128 * 128;
    const bf16_t* P = WSP(bf16_t, WS_P); bf16_t* AM = WSP(bf16_t, WS_AMIX);
#pragma unroll
    for (int nt = 0; nt < 4; ++nt) {
        f32x16 acc[4];
#pragma unroll
        for (int mt = 0; mt < 4; ++mt) acc[mt] = zero16();
#pragma unroll
        for (int ks = 0; ks < 2 * (nt + 1); ++ks) { const bf16x8 bf = *(const bf16x8*)(B + (size_t)(32 * nt + r) * 128 + 16 * ks + 8 * h);
#pragma unroll
            for (int mt = 0; mt < 4; ++mt) { const bf16x8 af = *(const bf16x8*)(A + (size_t)(32 * mt + r) * 128 + 16 * ks + 8 * h); acc[mt] = MFMA32(af, bf, acc[mt]); } }
        const int tok = tokc0 + 32 * nt + r; const float bsi = c.b_s[(l * 4 + hb) * 128 + 32 * nt + r];
#pragma unroll
        for (int mt = 0; mt < 4; ++mt)
#pragma unroll
            for (int g4 = 0; g4 < 4; ++g4) { const int dch0 = 32 * mt + 8 * g4 + 4 * h;
                const u32x2 u4 = *(const u32x2*)(P + (size_t)tok * NP + 2048 + hb * 128 + dch0);
                u32x2 w; w.x = pk2(bflo(u4.x) * (acc[mt][4 * g4] + bsi), bfhi(u4.x) * (acc[mt][4 * g4 + 1] + bsi)); w.y = pk2(bflo(u4.y) * (acc[mt][4 * g4 + 2] + bsi), bfhi(u4.y) * (acc[mt][4 * g4 + 3] + bsi));
                *(u32x2*)(AM + (size_t)tok * DM + 512 + hb * 128 + dch0) = w; }
    }
}
DI void phase_b1(const Ctx& c, int l, LAS unsigned char* lds) {
    LAS unsigned char* wl = lds + c.wave * 16384; LAS float* sg = (LAS float*)(lds + 131072 + c.wave * 512); LAS float* sb = sg + 64;
    for (int t = c.bx * 4 + (c.wave & 3); t < 1024; t += c.nb * 4) {
        if (SUB(0)) b1_prep(c, l, t, c.wave >> 2, wl, sg, sb);
    }
}


constexpr int OB_STRIDE = 136;
constexpr int IMG_LDS = 57344;
constexpr int LDS_OBUF = 2 * IMG_LDS, OBUF_BYTES = 64 * OB_STRIDE * 2;
static_assert(LDS_OBUF + 2 * OBUF_BYTES <= LDS_BYTES, "scan LDS");
DI void scan_post(const Ctx& c, int l, int b, int hh, int n, const LAS bf16_t* ob, int lid, const u32x4 (&gt4)[4]) {
    const int i = lid >> 2, q = lid & 3, tok = b * SEQ + n * 64 + i;
    u32x4 ov[4]; float ss = 0.f;
#pragma unroll
    for (int x = 0; x < 4; ++x) { ov[x] = *(const LAS u32x4*)(ob + i * OB_STRIDE + 32 * q + 8 * x);
#pragma unroll
        for (int e = 0; e < 4; ++e) { const float a = bflo(ov[x][e]), bq = bfhi(ov[x][e]); ss += a * a + bq * bq; } }
    ss += xlane(ss, (lid & 63) ^ 1); ss += xlane(ss, (lid & 63) ^ 2);
    const float rs = rsqrtf(ss * (1.0f / 128.0f) + EPS);
    bf16_t* op = WSP(bf16_t, WS_AMIX) + (size_t)tok * DM + hh * 128 + 32 * q;
#pragma unroll
    for (int x = 0; x < 4; ++x) { u32x4 w;
#pragma unroll
        for (int e = 0; e < 4; ++e) w[e] = pk2(bflo(ov[x][e]) * rs * bflo(gt4[x][e]), bfhi(ov[x][e]) * rs * bfhi(gt4[x][e]));
        *(u32x4*)(op + 8 * x) = w; }
}
DI void scan_loader_step(const Ctx& c, int l, int b, int hh, int n, LAS unsigned char* lds, const unsigned char* img0, const bf16_t* gbase, int lw, int lane, int lid, u32x4 (&regs)[14], u32x4 (&gt)[4]) {
    u32x4 gcur[4];
#pragma unroll
    for (int x = 0; x < 4; ++x) gcur[x] = gt[x];
#pragma unroll
    for (int x = 0; x < 4; ++x) gt[x] = *(const u32x4*)(gbase + (size_t)n * 64 * NP + 8 * x);
    const unsigned voff = (unsigned)(lw * 14336 + lane * 16);
    if (n + 1 < 32) { LAS unsigned char* dst = lds + ((n + 1) & 1) * IMG_LDS + voff;
#pragma unroll
        for (int i = 0; i < 14; ++i) *(LAS u32x4*)(dst + i * 1024) = regs[i]; }
    if (n + 3 < 32) { const unsigned char* src = img0 + (size_t)(n + 3) * IMG_BYTES;
#pragma unroll
        for (int i = 0; i < 14; ++i) regs[i] = *(const u32x4*)(src + voff + i * 1024); }
    if (n >= 1) scan_post(c, l, b, hh, n - 1, (const LAS bf16_t*)(lds + LDS_OBUF + ((n - 1) & 1) * OBUF_BYTES), lid, gcur);
    __syncthreads();
}
DI void scan_consumer_step(int n, LAS unsigned char* lds, f32x16 (&S)[4], u32x2 (&ucur)[8], float& egc, const bf16_t* uimg0, const float* egp, int lane, int ws, int r, int h) {
    const LAS unsigned char* buf = lds + (n & 1) * IMG_LDS + lane * 16;
    f32x16 av[2], ao[2]; ao[0] = zero16(); ao[1] = zero16();
#pragma unroll
    for (int mt = 0; mt < 2; ++mt)
#pragma unroll
        for (int g4 = 0; g4 < 4; ++g4) { const u32x2 w = ucur[mt * 4 + g4]; av[mt][4 * g4] = bflo(w.x); av[mt][4 * g4 + 1] = bfhi(w.x); av[mt][4 * g4 + 2] = bflo(w.y); av[mt][4 * g4 + 3] = bfhi(w.y); }
    const float eg = egc;
    if (n + 2 < 32) { const bf16_t* up = uimg0 + (size_t)(n + 2) * 8192;
#pragma unroll
        for (int x = 0; x < 8; ++x) ucur[x] = *(const u32x2*)(up + x * 256);
        egc = egp[n + 2]; }
    {
        bf16x8 fg[2][4];
#pragma unroll
        for (int mt = 0; mt < 2; ++mt) { fg[0][mt] = *(const LAS bf16x8*)(buf + (mt * 8) * 1024); fg[0][2 + mt] = *(const LAS bf16x8*)(buf + 16384 + (mt * 8) * 1024); }
#pragma unroll
        for (int gI = 0; gI < 8; ++gI) { const int dt = gI >> 1, s = gI & 1;
            if (gI + 1 < 8) {
#pragma unroll
                for (int mt = 0; mt < 2; ++mt) { fg[(gI + 1) & 1][mt] = *(const LAS bf16x8*)(buf + (mt * 8 + gI + 1) * 1024); fg[(gI + 1) & 1][2 + mt] = *(const LAS bf16x8*)(buf + 16384 + (mt * 8 + gI + 1) * 1024); } }
            asm volatile("" ::: "memory");
            const bf16x8 sb = as_bf(pack8(S[dt], s));
            av[0] = MFMA32(fg[gI & 1][0], sb, av[0]); av[1] = MFMA32(fg[gI & 1][1], sb, av[1]);
            ao[0] = MFMA32(sb, fg[gI & 1][2], ao[0]); ao[1] = MFMA32(sb, fg[gI & 1][3], ao[1]); }
    }
    bf16x8 vb[2][2];
#pragma unroll
    for (int mp = 0; mp < 2; ++mp)
#pragma unroll
        for (int s = 0; s < 2; ++s) vb[mp][s] = as_bf(pack8(av[mp], s));
    {
        bf16x8 qf[6];
#pragma unroll
        for (int f = 0; f < 6; ++f) qf[f] = *(const LAS bf16x8*)(buf + 49152 + f * 1024);
        asm volatile("" ::: "memory");
#pragma unroll
        for (int s = 0; s < 2; ++s) { ao[0] = MFMA32(vb[0][s], qf[s], ao[0]); ao[1] = MFMA32(vb[0][s], qf[2 + s], ao[1]); ao[1] = MFMA32(vb[1][s], qf[4 + s], ao[1]); }
    }
    LAS bf16_t* ob = (LAS bf16_t*)(lds + LDS_OBUF + (n & 1) * OBUF_BYTES);
#pragma unroll
    for (int mt = 0; mt < 2; ++mt)
#pragma unroll
        for (int g4 = 0; g4 < 4; ++g4) { u32x2 w; w.x = pk2(ao[mt][4 * g4], ao[mt][4 * g4 + 1]); w.y = pk2(ao[mt][4 * g4 + 2], ao[mt][4 * g4 + 3]);
            *(LAS u32x2*)(ob + (32 * mt + r) * OB_STRIDE + 32 * ws + 8 * g4 + 4 * h) = w; }
    bf16x8 kf[2][4];
#pragma unroll
    for (int f = 0; f < 4; ++f) kf[0][f] = *(const LAS bf16x8*)(buf + 32768 + f * 1024);
#pragma unroll
    for (int dt = 0; dt < 4; ++dt) {
        if (dt + 1 < 4) {
#pragma unroll
            for (int f = 0; f < 4; ++f) kf[(dt + 1) & 1][f] = *(const LAS bf16x8*)(buf + 32768 + ((dt + 1) * 4 + f) * 1024); }
        asm volatile("" ::: "memory");
        S[dt] = S[dt] * eg;
#pragma unroll
        for (int mp = 0; mp < 2; ++mp)
#pragma unroll
            for (int s = 0; s < 2; ++s) S[dt] = MFMA32(kf[dt & 1][mp * 2 + s], vb[mp][s], S[dt]); }
    __syncthreads();
}
DI void scan_block(const Ctx& c, int l, int bh, LAS unsigned char* lds) {
    const int wave = c.wave, b = bh >> 2, hh = bh & 3;
    const unsigned char* img0 = c.ws + WS_IMG + (size_t)bh * 32 * IMG_BYTES;
    if (wave >= 4) { if (SUB2(0)) {
        int lane = c.lane; asm volatile("" : "+v"(lane));
        const int lw = wave - 4, lid = lw * 64 + lane;
        u32x4 regs0[14], regs1[14], gt0[4];
        const bf16_t* gbase = WSP(bf16_t, WS_P) + (size_t)(b * SEQ + (lid >> 2)) * NP + 1536 + hh * 128 + 32 * (lid & 3);
        const unsigned voff0 = (unsigned)(lw * 14336 + lane * 16);
#pragma unroll
        for (int i = 0; i < 14; ++i) regs0[i] = *(const u32x4*)(img0 + voff0 + i * 1024);
#pragma unroll
        for (int i = 0; i < 14; ++i) *(LAS u32x4*)(lds + voff0 + i * 1024) = regs0[i];
#pragma unroll
        for (int i = 0; i < 14; ++i) { regs1[i] = *(const u32x4*)(img0 + (size_t)IMG_BYTES + voff0 + i * 1024); regs0[i] = *(const u32x4*)(img0 + (size_t)2 * IMG_BYTES + voff0 + i * 1024); }
#pragma unroll
        for (int x = 0; x < 4; ++x) gt0[x] = (u32x4){0u, 0u, 0u, 0u};
        __syncthreads();
        for (int n = 0; n < 32; n += 2) {
            scan_loader_step(c, l, b, hh, n, lds, img0, gbase, lw, lane, lid, regs1, gt0);
            scan_loader_step(c, l, b, hh, n + 1, lds, img0, gbase, lw, lane, lid, regs0, gt0);
        }
        scan_post(c, l, b, hh, 31, (const LAS bf16_t*)(lds + LDS_OBUF + (31 & 1) * OBUF_BYTES), lid, gt0);
    } } else if (SUB2(1)) {
        int lane = c.lane; asm volatile("" : "+v"(lane));
        __builtin_amdgcn_s_setprio(3);
        const int ws = wave, r = lane & 31, h = lane >> 5;
        f32x16 S[4];
#pragma unroll
        for (int dt = 0; dt < 4; ++dt) S[dt] = zero16();
        const bf16_t* uimg0 = WSP(bf16_t, WS_UIMG) + (size_t)bh * 32 * 8192 + (size_t)ws * 2 * 4 * 256 + lane * 4;
        const float* egp = WSP(float, WS_EG) + bh * 32;
        u32x2 u0[8], u1[8];
#pragma unroll
        for (int x = 0; x < 8; ++x) { u0[x] = *(const u32x2*)(uimg0 + x * 256); u1[x] = *(const u32x2*)(uimg0 + 8192 + x * 256); }
        float eg0 = egp[0], eg1 = egp[1];
        __syncthreads();
        for (int n = 0; n < 32; n += 2) {
            scan_consumer_step(n, lds, S, u0, eg0, uimg0, egp, lane, ws, r, h);
            scan_consumer_step(n + 1, lds, S, u1, eg1, uimg0, egp, lane, ws, r, h);
        }
        const char* od = (const char*)(c.out + O_DP + (size_t)(l * 32 + bh) * 128 * 128);
        unsigned voff = (unsigned)((4 * h) * 128 + 32 * ws + r) * 4u;
        asm volatile("" : "+v"(voff));
#pragma unroll
        for (int dt = 0; dt < 4; ++dt)
#pragma unroll
            for (int reg = 0; reg < 16; ++reg) *(float*)(od + (32 * dt + (reg & 3) + 8 * (reg >> 2)) * 512 + voff) = S[dt][reg];
        __builtin_amdgcn_s_setprio(0);
    }
}
DI float rdlane(float v, int l) { return __builtin_bit_cast(float, __builtin_amdgcn_readlane(__builtin_bit_cast(int, v), l)); }
DI void sample_recurrent(const Ctx& c, int l, int unit) {
    int lane = c.lane; asm volatile("" : "+v"(lane));
    const int bs = unit >> 2, hh = unit & 3, e2 = 2 * lane;
    const float* S0 = c.state_delta + (size_t)((l * SBATCH + bs) * 4 + hh) * 128 * 128 + e2;
    float* S1 = c.out + O_DS + (size_t)((l * SBATCH + bs) * 4 + hh) * 128 * 128 + e2;
    const float* q = WSP(float, WS_QS) + bs * 512 + hh * 128; const float* k = WSP(float, WS_KS) + bs * 512 + hh * 128; const float* v = WSP(float, WS_VS) + bs * 512 + hh * 128;
    const float eg = __expf(WSP(float, WS_GS)[bs * 4 + hh]), beta = WSP(float, WS_BS)[bs * 4 + hh];
    const float k0 = k[lane], k1 = k[64 + lane], q0 = q[lane], q1 = q[64 + lane];
    f32x2 kv = {0.f, 0.f};
#pragma unroll
    for (int d0 = 0; d0 < 128; d0 += 32) { f32x2 sv[32];
#pragma unroll
        for (int j = 0; j < 32; ++j) sv[j] = *(const f32x2*)(S0 + (d0 + j) * 128);
#pragma unroll
        for (int j = 0; j < 32; ++j) { const int dd = d0 + j; kv += sv[j] * rdlane(dd < 64 ? k0 : k1, dd & 63); } }
    const f32x2 v2 = *(const f32x2*)(v + e2);
    const f32x2 delta = (v2 - kv * eg) * beta;
    f32x2 oo = {0.f, 0.f};
#pragma unroll
    for (int d0 = 0; d0 < 128; d0 += 32) { f32x2 sv[32];
#pragma unroll
        for (int j = 0; j < 32; ++j) sv[j] = *(const f32x2*)(S0 + (d0 + j) * 128);
#pragma unroll
        for (int j = 0; j < 32; ++j) { const int dd = d0 + j; const f32x2 sn = sv[j] * eg + delta * rdlane(dd < 64 ? k0 : k1, dd & 63); oo += sn * rdlane(dd < 64 ? q0 : q1, dd & 63); *(f32x2*)(S1 + dd * 128) = sn; } }
    const float ss = wave_sum(oo.x * oo.x + oo.y * oo.y, lane); const float rs = rsqrtf(ss * (1.0f / 128.0f) + EPS);
    const float* ps = WSP(float, WS_PS) + (size_t)bs * NPS + 1536 + hh * 128 + e2; float* am = WSP(float, WS_AMIXS) + (size_t)bs * DM + hh * 128 + e2;
    const float* og = c.o_norm_g + l * 128 + e2;
    am[0] = oo.x * rs * og[0] * silu_f(ps[0]); am[1] = oo.y * rs * og[1] * silu_f(ps[1]);
}
DI void phase_scan(const Ctx& c, int l, LAS unsigned char* lds) {
    if (c.bx < 32) { if (SUB(0)) scan_block(c, l, c.bx, lds); return; }
    const int w0 = c.wave * (c.nb - 32) + (c.bx - 32), nw = (c.nb - 32) * 8;
    LAS unsigned char* wl = lds + c.wave * B0_WAVE_LDS;
    for (int u = w0; u < SBATCH * 4 + 512; u += nw) {
        if (u < SBATCH * 4) { if (SUB(1)) sample_recurrent(c, l, u); continue; }
        const int g = u - SBATCH * 4, hb = g & 3, cc = (g >> 2) & 15, b = g >> 6;
        b0_task_vb(c, l, b, 2 * cc, hb, wl); b0_task_vb(c, l, b, 2 * cc + 1, hb, wl);
        asm volatile("s_waitcnt vmcnt(0)" ::: "memory");
        b1_gmlp(c, l, g);
    }
    if (l + 1 < DEPTH) convert_layer_weights(c, l + 1, w0, nw, lds);

}

DI void phase_final(const Ctx& c) {
    const f32x4* gr = (const f32x4*)c.norm_f_g + c.lane;
    for (int m = c.gw; m < MP + SBATCH; m += c.ngw) {
        f32x4 v[4]; float s = 0.f;
        if (m < MP) { const u32x2* xr = (const u32x2*)(WSP(bf16_t, WS_XB16) + (size_t)m * DM) + c.lane;
#pragma unroll
            for (int j = 0; j < 4; ++j) { const u32x2 w = xr[64 * j]; v[j] = (f32x4){bflo(w.x), bfhi(w.x), bflo(w.y), bfhi(w.y)}; } }
        else { const f32x4* xr = (const f32x4*)(WSP(float, WS_XS) + (size_t)(m - MP) * DM) + c.lane;
#pragma unroll
            for (int j = 0; j < 4; ++j) v[j] = xr[64 * j]; }
        float* dst = m < MP ? c.out + O_YP + (size_t)m * DM : c.out + O_YS + (size_t)(m - MP) * DM;
#pragma unroll
        for (int j = 0; j < 4; ++j) s += (v[j].x * v[j].x + v[j].y * v[j].y) + (v[j].z * v[j].z + v[j].w * v[j].w);
        const float rs = rsqrtf(wave_sum(s, c.lane) * (1.0f / DM) + EPS);
#pragma unroll
        for (int j = 0; j < 4; ++j) ((f32x4*)dst + c.lane)[64 * j] = v[j] * rs * gr[64 * j];
    }
}

#define XB_TMO      128
#define XB_XCNT(j)  (256  + 64 * (j))
#define XB_XSUB(j)  (1280 + 64 * (j))
#define XB_XGEN(j)  (2304 + 64 * (j))
#define XB_TOP      3328
#define XB_TOPGEN   3392
#define XCD_BAR_WORDS 3456
#define XB_SPIN_CAP (1u << 18)

__device__ __forceinline__ unsigned xb_ld(unsigned* p)              { return __hip_atomic_load(p, __ATOMIC_RELAXED, __HIP_MEMORY_SCOPE_AGENT); }
__device__ __forceinline__ unsigned xb_add(unsigned* p, unsigned v) { return __hip_atomic_fetch_add(p, v, __ATOMIC_RELAXED, __HIP_MEMORY_SCOPE_AGENT); }
__device__ __forceinline__ unsigned xb_xcc_id() { return (unsigned)__builtin_amdgcn_s_getreg((3 << 11) | 20) & 0xFu; }
#define XB_SPIN(cond, bar) do { unsigned _sp = 0; while (cond) { __builtin_amdgcn_s_sleep(8); \
    if ((++_sp & 255u) == 0u) { if (xb_ld(&(bar)[XB_TMO])) break; if (_sp > XB_SPIN_CAP) { atomicAdd(&(bar)[XB_TMO], 1u); break; } } } } while (0)

struct XcdBarrier {
    unsigned* bar; unsigned x;
    volatile LAS unsigned* st;
};

__device__ __forceinline__ XcdBarrier xcd_barrier_post(unsigned* bar, volatile LAS unsigned* st) {
    XcdBarrier b; b.bar = bar; b.x = xb_xcc_id(); b.st = st;
    if (threadIdx.x == 0) (void)xb_add(&bar[XB_XCNT(b.x)], 1u);
    return b;
}
__device__ __forceinline__ void xcd_barrier_complete(unsigned* bar, unsigned x, unsigned& nloc, unsigned& nx) {
    const unsigned G = gridDim.x * gridDim.y * gridDim.z;
    unsigned sum, cnt, mine, sp = 0u;
    for (;;) {
        sum = 0u; cnt = 0u; mine = 0u;
#pragma unroll
        for (unsigned j = 0; j < 16; ++j) { const unsigned c = xb_ld(&bar[XB_XCNT(j)]); sum += c; cnt += (c > 0u) ? 1u : 0u; mine = (j == x) ? c : mine; }
        if (sum == G) break;
        __builtin_amdgcn_s_sleep(1);
        if ((++sp & 255u) == 0u) { if (xb_ld(&bar[XB_TMO])) break; if (sp > XB_SPIN_CAP) { atomicAdd(&bar[XB_TMO], 1u); break; } }
    }
    nloc = mine > 0u ? mine : 1u; nx = cnt > 0u ? cnt : 1u;
}

__device__ __forceinline__ void xcd_barrier(const XcdBarrier& b) {
    asm volatile("s_waitcnt vmcnt(0)" ::: "memory");
    __syncthreads();
    if (threadIdx.x == 0) {
        unsigned* bar = b.bar;
        __builtin_amdgcn_s_waitcnt(0);
        unsigned nloc = b.st[0], nx = b.st[1];
        if (nloc == 0u) { xcd_barrier_complete(bar, b.x, nloc, nx); b.st[0] = nloc; b.st[1] = nx; }
        const unsigned old = xb_add(&bar[XB_XSUB(b.x)], 1u);
        const unsigned gen = old / nloc;
        if (old + 1u == (gen + 1u) * nloc) {
            __builtin_amdgcn_fence(__ATOMIC_RELEASE, "agent");
            asm volatile("s_waitcnt vmcnt(0)" ::: "memory");
            const unsigned og = xb_add(&bar[XB_TOP], 1u);
            const unsigned tg = og / nx;
            if (og + 1u == (tg + 1u) * nx) xb_add(&bar[XB_TOPGEN], 1u);
            else XB_SPIN(xb_ld(&bar[XB_TOPGEN]) == tg, bar);
            __builtin_amdgcn_fence(__ATOMIC_ACQUIRE, "agent");
            xb_add(&bar[XB_XGEN(b.x)], 1u);
            asm volatile("s_waitcnt vmcnt(0)" ::: "memory");
        } else {
            XB_SPIN(xb_ld(&bar[XB_XGEN(b.x)]) == gen, bar);
            __builtin_amdgcn_fence(__ATOMIC_ACQUIRE, "agent");
            asm volatile("s_waitcnt vmcnt(0)" ::: "memory");
        }
    }
    __syncthreads();
}
#ifndef ONLY
#define ONLY -1
#endif
#ifndef REPMASK
#define REPMASK 0
#endif
#define EN(x) (ONLY < 0 || ONLY == (x))
__global__ void __launch_bounds__(512, 2) hymba_fwd(Args args) {
    extern __shared__ __attribute__((aligned(16))) unsigned char lds_raw[];
    LAS unsigned char* lds = (LAS unsigned char*)lds_raw;
    cg::grid_group grid = cg::this_grid();
    Ctx c;
    c.x_prompt = args.in[0]; c.x_sample = args.in[1]; c.state_delta = args.in[2]; c.state_conv = args.in[3]; c.norm_mix_g = args.in[4]; c.w_in = args.in[5]; c.conv_w = args.in[6];
    c.A_log = args.in[7]; c.dt_bias = args.in[8]; c.o_norm_g = args.in[9]; c.v_norm_g = args.in[10]; c.w_s = args.in[11]; c.b_s = args.in[12]; c.w_o = args.in[13]; c.norm_ffn_g = args.in[14];
    c.w_up = args.in[15]; c.w_down = args.in[16]; c.norm_f_g = args.in[17]; c.out = args.out; c.ws = args.ws;
    c.lane = threadIdx.x & 63; c.wave = __builtin_amdgcn_readfirstlane(threadIdx.x >> 6); c.gw = blockIdx.x * 8 + c.wave; c.ngw = gridDim.x * 8; c.bx = blockIdx.x; c.nb = gridDim.x;
    volatile LAS unsigned* bst = (volatile LAS unsigned*)(lds + LDS_BYTES - 16);
    if (threadIdx.x < 2) bst[threadIdx.x] = 0u;
    __syncthreads();
    XcdBarrier xbar = xcd_barrier_post((unsigned*)args.ws, bst);
    grid.sync();
    for (int step = 2 * args.ph_lo; step < 2 * args.ph_hi; ++step) {
        const int ph = step >> 1;
        const int ptype = ph == 0 ? 0 : (ph == 29 ? 8 : 1 + (ph - 1) % 7);
        if ((step & 1) && !((REPMASK >> ptype) & 1)) continue;
        { int tl = threadIdx.x; asm volatile("" : "+v"(tl)); c.lane = tl & 63; int bxo = blockIdx.x, nbo = gridDim.x; asm volatile("" : "+s"(bxo), "+s"(nbo)); c.bx = bxo; c.nb = nbo; c.wave = __builtin_amdgcn_readfirstlane(tl >> 6); c.gw = bxo * 8 + c.wave; c.ngw = nbo * 8; unsigned char* wsp = args.ws; asm volatile("" : "+s"(wsp)); c.ws = wsp; float* op = args.out; asm volatile("" : "+s"(op)); c.out = op; }
        if (step & 1) __syncthreads();
        if (ph == 0) { if (EN(0)) phase_prologue(c, lds); }
        else if (ph == 29) { if (EN(8)) phase_final(c); }
        else {
            const int l = (ph - 1) / 7, s = (ph - 1) % 7;
            float* ssq = WSP(float, WS_SSQ);
            if (s == 0) { if (EN(1)) { sgemm1(c, l, lds); if ((REPMASK >> 10) & 1) sgemm1(c, l, lds);
                pg8::Gemm g{WSP(bf16_t, WS_XB16), WSP(bf16_t, WS_WIN) + (size_t)l * NP * DM, MP, NP, DM}; pg8::StaticOrder S; S.init(MP, NP, c.nb, c.bx);
                pg8::EpiScaleBf16 E{WSP(bf16_t, WS_P), NP, ssq + (size_t)(2 * l) * MP * 16, 0, WSP(float, WS_VSS), c.o_norm_g + l * 128}; pg8::gemm_phase(lds, g, S, E); } }
            else if (s == 1) { if (EN(2)) phase_b0(c, l, lds); }
            else if (s == 2) { if (EN(3)) phase_b1(c, l, lds); }
            else if (s == 3) { if (EN(4)) phase_scan(c, l, lds); if ((REPMASK >> 12) & 1) { __syncthreads(); if (c.bx < 32) scan_block(c, l, c.bx, lds); } if ((REPMASK >> 13) & 1) { if (c.bx >= 32) { const int w0 = (c.bx - 32) * 8 + c.wave, nw = (c.nb - 32) * 8; for (int u = w0; u < SBATCH * 4; u += nw) sample_recurrent(c, l, u); } } }
            else if (s == 4) { if (EN(5)) { if (!(step & 1)) sgemm2(c, l, lds);
                pg8::Gemm g{WSP(bf16_t, WS_AMIX), WSP(bf16_t, WS_WO) + (size_t)l * DM * DM, MP, DM, DM}; pg8::StaticOrder S; S.init(MP, DM, c.nb, c.bx);
                pg8::EpiResid E{WSP(bf16_t, WS_XB16), ssq + (size_t)(2 * l + 1) * MP * 16}; pg8::gemm_phase(lds, g, S, E); } }
            else if (s == 5) { if (EN(6)) { sgemm3(c, l, lds); if ((REPMASK >> 11) & 1) sgemm3(c, l, lds);
                pg8::Gemm g{WSP(bf16_t, WS_XB16), WSP(bf16_t, WS_WUP) + (size_t)l * FF * DM, MP, FF, DM}; pg8::StaticOrder S; S.init(MP, FF, c.nb, c.bx);
                pg8::EpiScaleBf16 E{WSP(bf16_t, WS_UNION), FF, ssq + (size_t)(2 * l + 1) * MP * 16, 1, nullptr, nullptr}; pg8::gemm_phase(lds, g, S, E); } }
            else { if (EN(7)) { if (!(step & 1)) sgemm4(c, l, lds);
                pg8::Gemm g{WSP(bf16_t, WS_UNION), WSP(bf16_t, WS_WDN) + (size_t)l * DM * FF, MP, DM, FF}; pg8::StaticOrder S; S.init(MP, DM, c.nb, c.bx);
                pg8::EpiResid E{WSP(bf16_t, WS_XB16), ssq + (size_t)(2 * l + 2) * MP * 16}; pg8::gemm_phase(lds, g, S, E); } }
        }
        if (!(step & 1) && ((REPMASK >> ptype) & 1)) continue;
        if ((REPMASK >> 9) & 1) { if (ph + 1 < args.ph_hi) xcd_barrier(xbar); }
        if (ph + 1 < args.ph_hi) {
            xcd_barrier(xbar);
        }
    }
}

extern "C" void kernel_launch(void* const* d_in, const int* in_sizes, int n_in, void* d_out, int out_size, void* d_ws, size_t ws_size, hipStream_t stream) {
    static int grid = 0;
    if (grid == 0) {
        int dev = 0, cus = 0, per_cu = 0;
        (void)hipGetDevice(&dev); (void)hipDeviceGetAttribute(&cus, hipDeviceAttributeMultiprocessorCount, dev);
        if (hipFuncSetAttribute((const void*)hymba_fwd, hipFuncAttributeMaxDynamicSharedMemorySize, LDS_BYTES) != hipSuccess) fprintf(stderr, "kernel_launch: hipFuncSetAttribute failed\n");
        if (hipOccupancyMaxActiveBlocksPerMultiprocessor(&per_cu, (const void*)hymba_fwd, 512, LDS_BYTES) != hipSuccess || per_cu < 1) { fprintf(stderr, "kernel_launch: occupancy query says %d\n", per_cu); per_cu = 1; }
        (void)hipGetLastError();
        grid = cus * 1;
        if (ws_size < WS_END) fprintf(stderr, "kernel_launch: workspace too small: %zu < %zu\n", ws_size, (size_t)WS_END);
    }
    (void)hipMemsetAsync(d_ws, 0, 65536, stream);
    Args a{};
    for (int i = 0; i < 18; ++i) a.in[i] = (const float*)d_in[i];
    a.out = (float*)d_out; a.ws = (unsigned char*)d_ws; a.ph_lo = 0; a.ph_hi = 30;
    void* kargs[] = {&a};
    hipError_t e = hipLaunchCooperativeKernel((const void*)hymba_fwd, dim3(grid), dim3(512), kargs, LDS_BYTES, stream);
    if (e != hipSuccess) fprintf(stderr, "kernel_launch: cooperative launch failed: %s (grid %d)\n", hipGetErrorString(e), grid);
}
```

```cpp
#include <hip/hip_runtime.h>
#include <hip/hip_cooperative_groups.h>
#include <cstdio>
namespace cg = cooperative_groups;

#define LAS __attribute__((address_space(3)))
#define DI __device__ __forceinline__
typedef unsigned short bf16_t;
typedef short bf16x8 __attribute__((ext_vector_type(8)));
typedef float f32x4 __attribute__((ext_vector_type(4)));
typedef float f32x2 __attribute__((ext_vector_type(2)));
typedef float f32x16 __attribute__((ext_vector_type(16)));
typedef unsigned u32x4 __attribute__((ext_vector_type(4)));
typedef unsigned u32x2 __attribute__((ext_vector_type(2)));
typedef __bf16 bf2_t __attribute__((ext_vector_type(2)));
typedef unsigned u32x8 __attribute__((ext_vector_type(8)));

#ifndef SUBSEL
#define SUBSEL -1
#endif
#define SUB(x) (SUBSEL < 0 || SUBSEL == (x))
#ifndef SUBSEL2
#define SUBSEL2 -1
#endif
#define SUB2(x) (SUBSEL2 < 0 || SUBSEL2 == (x))
constexpr int DM = 1024, NBATCH = 8, SEQ = 2048, MP = NBATCH * SEQ, DEPTH = 4, SBATCH = 128;
constexpr int NH = 4, QKV = 1536, NP = 3072, PROJ = 3080, FF = 4096, NPS = 3088;
constexpr float EPS = 1e-6f;
constexpr int IMG_BYTES = 55296;
constexpr int LDS_BYTES = 150528;
constexpr size_t O_YP = 0, O_YS = 16777216, O_DP = 16908288, O_CP = 19005440, O_DS = 19152896, O_CS = 52707328, O_VS = 55066624;
constexpr size_t WS_WIN = 65536;
constexpr size_t WS_WAB = WS_WIN + (size_t)DEPTH * NP * DM * 2;
constexpr size_t WS_WO = WS_WAB + (size_t)DEPTH * 16 * DM * 2;
constexpr size_t WS_WUP = WS_WO + (size_t)DEPTH * DM * DM * 2;
constexpr size_t WS_WDN = WS_WUP + (size_t)DEPTH * FF * DM * 2;
constexpr size_t WS_WM = WS_WDN + (size_t)DEPTH * FF * DM * 2;
constexpr size_t WS_XBUF = WS_WM + (size_t)DEPTH * 4 * 128 * 128 * 2;
constexpr size_t WS_XB16 = WS_XBUF + (size_t)MP * DM * 4;
constexpr size_t WS_SSQ = WS_XB16 + (size_t)MP * DM * 2;
constexpr size_t WS_UNION = WS_SSQ + (size_t)9 * MP * 16 * 4;
constexpr size_t WS_P = WS_UNION;
constexpr size_t WS_QN = WS_P + (size_t)MP * NP * 2;
constexpr size_t WS_KN = WS_QN + (size_t)MP * 512 * 2;
constexpr size_t WS_KNT = WS_UNION + (size_t)MP * FF * 2;
constexpr size_t WS_VT = WS_KNT + (size_t)MP * 512 * 2;
constexpr size_t WS_VBT = WS_VT + (size_t)MP * 512 * 2;
constexpr size_t WS_G = WS_VBT + (size_t)MP * 512 * 2;
constexpr size_t WS_BETA = WS_G + (size_t)MP * 4 * 4;
constexpr size_t WS_EG = WS_BETA + (size_t)MP * 4 * 4;
constexpr size_t WS_IMG = WS_EG + 4096;
constexpr size_t WS_UIMG = WS_IMG + (size_t)1024 * IMG_BYTES;
constexpr size_t WS_AMIX = WS_UIMG + (size_t)1024 * 32768;
constexpr size_t WS_XS = WS_AMIX + (size_t)MP * DM * 2;
constexpr size_t WS_PS = WS_XS + (size_t)SBATCH * DM * 4;
constexpr size_t WS_QS = WS_PS + (size_t)SBATCH * NPS * 4;
constexpr size_t WS_KS = WS_QS + (size_t)SBATCH * 512 * 4;
constexpr size_t WS_VS = WS_KS + (size_t)SBATCH * 512 * 4;
constexpr size_t WS_GS = WS_VS + (size_t)SBATCH * 512 * 4;
constexpr size_t WS_BS = WS_GS + (size_t)SBATCH * 4 * 4;
constexpr size_t WS_AMIXS = WS_BS + (size_t)SBATCH * 4 * 4;
constexpr size_t WS_HS = WS_AMIXS + (size_t)SBATCH * DM * 4;
constexpr size_t WS_XP = WS_HS + (size_t)SBATCH * FF * 4;
constexpr size_t WS_VSS = WS_XP + (size_t)4 * SBATCH * DM * 4;
constexpr size_t WS_CWP = WS_VSS + (size_t)MP * 8 * 4;
constexpr size_t WS_END = WS_CWP + (size_t)DEPTH * 4 * QKV * 4;
static_assert(WS_QN + 2 * (size_t)MP * 512 * 2 == WS_KNT, "union");
static_assert(WS_END <= (size_t)536870912, "workspace");

DI unsigned pk2(float lo, float hi) { f32x2 v = {lo, hi}; return __builtin_bit_cast(unsigned, __builtin_convertvector(v, bf2_t)); }
DI float bflo(unsigned w) { return __uint_as_float(w << 16); }
DI float bfhi(unsigned w) { return __uint_as_float(w & 0xffff0000u); }
DI float bf2f(bf16_t b) { return __uint_as_float(((unsigned)b) << 16); }
DI bf16_t f2bf(float f) { return (bf16_t)(pk2(f, 0.f) & 0xffffu); }
DI float xlane(float v, int srclane) { return __builtin_bit_cast(float, __builtin_amdgcn_ds_bpermute(srclane << 2, __builtin_bit_cast(int, v))); }
DI float wave_sum(float v, int lane) {
#pragma unroll
    for (int o = 1; o < 64; o <<= 1) v += xlane(v, lane ^ o);
    return v;
}
DI float silu_f(float x) { return x * __builtin_amdgcn_rcpf(1.f + __expf(-x)); }
DI float sigmoid_f(float x) { return __builtin_amdgcn_rcpf(1.f + __expf(-x)); }
DI float softplus_f(float x) { const float e = __expf(-fabsf(x)); const float l = e < 0.01f ? e * (1.f - e * (0.5f - 0.33333334f * e)) : __logf(1.f + e); return fmaxf(x, 0.f) + l; }
DI u32x4 pack8(const f32x16& x, int s) {
    u32x4 p; p.x = pk2(x[8 * s], x[8 * s + 1]); p.y = pk2(x[8 * s + 2], x[8 * s + 3]); p.z = pk2(x[8 * s + 4], x[8 * s + 5]); p.w = pk2(x[8 * s + 6], x[8 * s + 7]); return p;
}
DI float ssq_sum(const float* p) {
    const f32x4 a = *(const f32x4*)p, b = *(const f32x4*)(p + 4), c2 = *(const f32x4*)(p + 8), d2 = *(const f32x4*)(p + 12);
    return ((a.x + a.y) + (a.z + a.w)) + ((b.x + b.y) + (b.z + b.w)) + ((c2.x + c2.y) + (c2.z + c2.w)) + ((d2.x + d2.y) + (d2.z + d2.w));
}
DI int crow(int reg, int h) { return (reg & 3) + 8 * (reg >> 2) + 4 * h; }
#define MFMA32(a, b, c) __builtin_amdgcn_mfma_f32_32x32x16_bf16((a), (b), (c), 0, 0, 0)
#define MFMA16(a, b, c) __builtin_amdgcn_mfma_f32_16x16x32_bf16((a), (b), (c), 0, 0, 0)
DI bf16x8 as_bf(u32x4 v) { return __builtin_bit_cast(bf16x8, v); }
DI f32x16 zero16() { f32x16 z;
#pragma unroll
    for (int i = 0; i < 16; ++i) z[i] = 0.f; return z; }

namespace pg8 {
constexpr int BM = 256, BK = 64, HALF = 128, HTB = HALF * BK * 2, STAGE_BYTES = 8 * HTB, NXCD = 8, WGM = 8;
DI int lds_byte(int r, int c) { const int st = (r >> 4) * 2 + (c >> 5), rr = r & 15, cc = c & 31, ob = rr * 64 + cc * 2; return st * 1024 + (ob ^ (((ob >> 9) & 1) << 5)); }
DI void stage_rc(int b, int& R, int& C) { const int st = b / 1024, sb = b % 1024, swz = sb ^ (((sb >> 9) & 1) << 5); R = (st >> 1) * 16 + swz / 64; C = (st & 1) * 32 + (swz % 64) / 2; }
DI int perm32(int rho) { const int n = rho >> 4, i = rho & 15; return 8 * (i >> 2) + 4 * n + (i & 3); }
struct Unit { int pm, pn; };
struct Gemm { const bf16_t* A; const bf16_t* Bt; int M, N, K; };
struct StaticOrder {
    int nM, nN, nwg, G, c;
    DI void init(int M, int N, int G_, int c_) { nM = M / BM; nN = N / BM; nwg = nM * nN; G = G_; c = c_; }
    DI bool next(int i, Unit& u) const {
        const long L = (long)i * G + c; if (L >= nwg) return false;
        int wgid = (int)L; { const int q = nwg / NXCD, r = nwg % NXCD, xcd = wgid % NXCD, off = wgid / NXCD; wgid = (xcd < r ? xcd * (q + 1) : r * (q + 1) + (xcd - r) * q) + off; }
        const int nig = WGM * nN, gid = wgid / nig, fm = gid * WGM, gsz = (nM - fm) < WGM ? (nM - fm) : WGM;
        u.pm = fm + ((wgid % nig) % gsz); u.pn = (wgid % nig) / gsz; return true;
    }
};
template <class Epi>
DI void gemm_phase(LAS unsigned char* lds, const Gemm g, const StaticOrder& S, const Epi& E) {
    int tid = threadIdx.x; asm volatile("" : "+v"(tid));
    const int wid = __builtin_amdgcn_readfirstlane(tid >> 6), lane = tid & 63, wr = wid >> 2, wc = wid & 3, fr = lane & 15, fq = lane >> 4;
    const int K = g.K, nt = K / BK;
    unsigned voffA[2], voffB[2];
#pragma unroll
    for (int i = 0; i < 2; ++i) { int R, C; stage_rc(tid * 16 + i * 8192, R, C); const int Rb = (R & ~31) + perm32(R & 31);
        voffA[i] = (unsigned)(R * K + C) * 2u; voffB[i] = (unsigned)(Rb * K + C) * 2u; }
    const size_t kstep = (size_t)(BK * 2);
    const size_t hstep = (size_t)HALF * K * 2;
    const size_t tstep = 2 * hstep;
    const unsigned ldsw = (unsigned)wid * 1024u;
    const int aoff = lds_byte(wr * 64 + fr, fq * 8), boff = lds_byte(wc * 32 + fr, fq * 8);
#define PG8_SA(b, h) (((b) * 2 + (h)) * HTB)
#define PG8_SB(b, h) ((4 + (b) * 2 + (h)) * HTB)
#define PG8_STAGE(bufoff, gbase, voff) do { _Pragma("unroll") for (int _i = 0; _i < 2; ++_i) \
        __builtin_amdgcn_global_load_lds((const unsigned*)((const char*)(gbase) + (voff)[_i]), (LAS unsigned*)(lds + (bufoff) + ldsw + _i * 8192), 16, 0, 0); } while (0)
#define PG8_LDA(dst, b, h) do { _Pragma("unroll") for (int m = 0; m < 4; ++m) _Pragma("unroll") for (int k = 0; k < 2; ++k) dst[m][k] = *(const LAS bf16x8*)(lds + PG8_SA(b, h) + aoff + m * 2048 + k * 1024); } while (0)
#define PG8_LDB(dst, b, h) do { _Pragma("unroll") for (int n = 0; n < 2; ++n) _Pragma("unroll") for (int k = 0; k < 2; ++k) dst[n][k] = *(const LAS bf16x8*)(lds + PG8_SB(b, h) + boff + n * 2048 + k * 1024); } while (0)
#define PG8_MMA(ai, bj, At, Bt) do { __builtin_amdgcn_s_setprio(1); _Pragma("unroll") for (int m = 0; m < 4; ++m) _Pragma("unroll") for (int n = 0; n < 2; ++n) _Pragma("unroll") for (int k = 0; k < 2; ++k) \
        acc[ai][bj][m][n] = __builtin_amdgcn_mfma_f32_16x16x32_bf16(Bt[n][k], At[m][k], acc[ai][bj][m][n], 0, 0, 0); __builtin_amdgcn_s_setprio(0); } while (0)
#define PG8_WAIT_V(n) asm volatile("s_waitcnt vmcnt(" #n ")" ::: "memory")
#define PG8_WAIT_L(n) asm volatile("s_waitcnt lgkmcnt(" #n ")" ::: "memory")
#define PG8_BAR __builtin_amdgcn_s_barrier()
#define PG8_SCHED __builtin_amdgcn_sched_barrier(0)
    Unit cur, nxt; int ui = 0;
    if (!S.next(0, cur)) return;
    f32x4 acc[2][2][4][2];
#pragma unroll
    for (int a = 0; a < 2; ++a)
#pragma unroll
        for (int b = 0; b < 2; ++b)
#pragma unroll
            for (int m = 0; m < 4; ++m)
#pragma unroll
                for (int n = 0; n < 2; ++n) acc[a][b][m][n] = (f32x4){0.f, 0.f, 0.f, 0.f};
    bf16x8 At[4][2], B0[2][2], B1[2][2];
    const char* cA = (const char*)g.A + (size_t)cur.pm * tstep; const char* cB = (const char*)g.Bt + (size_t)cur.pn * tstep;
    PG8_STAGE(PG8_SB(0, 0), cB, voffB); PG8_STAGE(PG8_SA(0, 0), cA, voffA); PG8_STAGE(PG8_SB(0, 1), cB + hstep, voffB); PG8_STAGE(PG8_SA(0, 1), cA + hstep, voffA);
    if (wr == 1) PG8_BAR;
    PG8_WAIT_V(4); PG8_BAR;
    PG8_STAGE(PG8_SB(1, 0), cB + kstep, voffB); PG8_STAGE(PG8_SA(1, 0), cA + kstep, voffA); PG8_STAGE(PG8_SB(1, 1), cB + hstep + kstep, voffB);
    PG8_WAIT_V(6); PG8_BAR;
    for (;;) {
        const bool has_next = S.next(ui + 1, nxt);
        const char* nA = has_next ? (const char*)g.A + (size_t)nxt.pm * tstep : cA; const char* nB = has_next ? (const char*)g.Bt + (size_t)nxt.pn * tstep : cB;
        for (int t = 0; t < nt; t += 2) {
            const bool last = (t == nt - 2);
            const char* a1 = cA + (size_t)(t + 1) * kstep;
            const char* a2 = last ? nA : cA + (size_t)(t + 2) * kstep; const char* b2 = last ? nB : cB + (size_t)(t + 2) * kstep;
            const char* a3 = a2 + kstep; const char* b3 = b2 + kstep;
            PG8_LDB(B0, 0, 0); PG8_SCHED; PG8_LDA(At, 0, 0); PG8_STAGE(PG8_SA(1, 1), a1 + hstep, voffA);
            PG8_WAIT_L(8); PG8_BAR; PG8_WAIT_L(0); PG8_MMA(0, 0, At, B0); PG8_BAR; PG8_SCHED;
            PG8_LDB(B1, 0, 1); PG8_STAGE(PG8_SB(0, 0), b2, voffB);
            PG8_BAR; PG8_WAIT_L(0); PG8_MMA(0, 1, At, B1); PG8_BAR;
            PG8_LDA(At, 0, 1); PG8_STAGE(PG8_SA(0, 0), a2, voffA);
            PG8_BAR; PG8_WAIT_L(0); PG8_MMA(1, 0, At, B0); PG8_BAR; PG8_SCHED;
            PG8_STAGE(PG8_SB(0, 1), b2 + hstep, voffB);
            PG8_WAIT_V(6); PG8_BAR; PG8_MMA(1, 1, At, B1); PG8_BAR;
            PG8_LDB(B0, 1, 0); PG8_SCHED; PG8_LDA(At, 1, 0); PG8_STAGE(PG8_SA(0, 1), a2 + hstep, voffA);
            PG8_WAIT_L(8); PG8_BAR; PG8_WAIT_L(0); PG8_MMA(0, 0, At, B0); PG8_BAR; PG8_SCHED;
            PG8_LDB(B1, 1, 1); PG8_STAGE(PG8_SB(1, 0), b3, voffB);
            PG8_BAR; PG8_WAIT_L(0); PG8_MMA(0, 1, At, B1); PG8_BAR;
            PG8_LDA(At, 1, 1); PG8_STAGE(PG8_SA(1, 0), a3, voffA);
            PG8_BAR; PG8_WAIT_L(0); PG8_MMA(1, 0, At, B0); PG8_BAR; PG8_SCHED;
            PG8_STAGE(PG8_SB(1, 1), b3 + hstep, voffB);
            PG8_WAIT_V(6); PG8_BAR; PG8_MMA(1, 1, At, B1); PG8_BAR;
        }
        E(acc, cur, wr, wc, fr, fq);
        if (!has_next) break;
#pragma unroll
        for (int a = 0; a < 2; ++a)
#pragma unroll
            for (int b = 0; b < 2; ++b)
#pragma unroll
                for (int m = 0; m < 4; ++m)
#pragma unroll
                    for (int n = 0; n < 2; ++n) acc[a][b][m][n] = (f32x4){0.f, 0.f, 0.f, 0.f};
        cur = nxt; cA = nA; cB = nB; ++ui;
    }
    PG8_WAIT_V(0);
    if (wr == 0) PG8_BAR;
    PG8_BAR;
#undef PG8_SA
#undef PG8_SB
#undef PG8_STAGE
#undef PG8_LDA
#undef PG8_LDB
#undef PG8_MMA
#undef PG8_WAIT_V
#undef PG8_WAIT_L
#undef PG8_BAR
#undef PG8_SCHED
}
struct EpiScaleBf16 {
    bf16_t* O; int ldc; const float* ssq; int act; float* vss; const float* og;
    DI void operator()(const f32x4 (&acc)[2][2][4][2], const Unit& u, int wr, int wc, int fr, int fq) const {
        const int row0 = u.pm * BM + wr * 64 + fr, col0 = u.pn * BM + wc * 32 + 8 * fq;
        float rsv[2][4];
#pragma unroll
        for (int ai = 0; ai < 2; ++ai)
#pragma unroll
            for (int m = 0; m < 4; ++m) { const f32x4 p4 = *(const f32x4*)(ssq + (size_t)(row0 + ai * HALF + m * 16) * 16 + 4 * fq); rsv[ai][m] = (p4.x + p4.y) + (p4.z + p4.w); }
#pragma unroll
        for (int ai = 0; ai < 2; ++ai)
#pragma unroll
            for (int m = 0; m < 4; ++m) { const int ln = fq * 16 + fr; float rq = rsv[ai][m]; rq += xlane(rq, ln ^ 16); rq += xlane(rq, ln ^ 32); rsv[ai][m] = rsqrtf(rq * (1.0f / DM) + EPS); }
#pragma unroll
        for (int ai = 0; ai < 2; ++ai)
#pragma unroll
            for (int m = 0; m < 4; ++m) { const int row = row0 + ai * HALF + m * 16;
                const float rs = rsv[ai][m];
                bf16_t* rowp = O + (size_t)row * ldc + col0; float vs = 0.f;
#pragma unroll
                for (int bj = 0; bj < 2; ++bj) { f32x4 v0 = acc[ai][bj][m][0] * rs, v1 = acc[ai][bj][m][1] * rs;
                    if (act) {
#pragma unroll
                        for (int j = 0; j < 4; ++j) { const float a = fmaxf(v0[j], 0.f), b = fmaxf(v1[j], 0.f); v0[j] = a * a; v1[j] = b * b; } }
                    if (og != nullptr && (u.pn == 6 || u.pn == 7)) { const float* gp = og + ((col0 + bj * HALF) & 127); const f32x4 g0 = *(const f32x4*)gp, g1 = *(const f32x4*)(gp + 4);
#pragma unroll
                        for (int j = 0; j < 4; ++j) { v0[j] = silu_f(v0[j]) * g0[j]; v1[j] = silu_f(v1[j]) * g1[j]; } }
                    u32x4 w; w.x = pk2(v0[0], v0[1]); w.y = pk2(v0[2], v0[3]); w.z = pk2(v1[0], v1[1]); w.w = pk2(v1[2], v1[3]);
                    *(u32x4*)(rowp + bj * HALF) = w;
                    vs += (v0[0] * v0[0] + v0[1] * v0[1]) + (v0[2] * v0[2] + v0[3] * v0[3]) + (v1[0] * v1[0] + v1[1] * v1[1]) + (v1[2] * v1[2] + v1[3] * v1[3]); }
                if (vss != nullptr && u.pn >= 10) { { const int ln = fq * 16 + fr; vs += xlane(vs, ln ^ 16); vs += xlane(vs, ln ^ 32); } if (fq == 0) vss[(size_t)row * 8 + (u.pn - 10) * 4 + wc] = vs; } }
    }
};
struct EpiResid {
    bf16_t* xb; float* ssq;
    DI void operator()(const f32x4 (&acc)[2][2][4][2], const Unit& u, int wr, int wc, int fr, int fq) const {
        const int row0 = u.pm * BM + wr * 64 + fr, col0 = u.pn * BM + wc * 32 + 8 * fq;
#pragma unroll
        for (int ai = 0; ai < 2; ++ai) {
            u32x4 bv[4][2];
#pragma unroll
            for (int m = 0; m < 4; ++m)
#pragma unroll
                for (int bj = 0; bj < 2; ++bj) bv[m][bj] = *(const u32x4*)(xb + (size_t)(row0 + ai * HALF + m * 16) * DM + col0 + bj * HALF);
#pragma unroll
            for (int m = 0; m < 4; ++m) { const int row = row0 + ai * HALF + m * 16; const size_t off = (size_t)row * DM + col0; float ss = 0.f;
#pragma unroll
                for (int bj = 0; bj < 2; ++bj) {
                    const u32x4 b = bv[m][bj];
                    const f32x4 o0 = (f32x4){bflo(b.x), bfhi(b.x), bflo(b.y), bfhi(b.y)} + acc[ai][bj][m][0], o1 = (f32x4){bflo(b.z), bfhi(b.z), bflo(b.w), bfhi(b.w)} + acc[ai][bj][m][1];
                    u32x4 w; w.x = pk2(o0[0], o0[1]); w.y = pk2(o0[2], o0[3]); w.z = pk2(o1[0], o1[1]); w.w = pk2(o1[2], o1[3]);
                    *(u32x4*)(xb + off + bj * HALF) = w;
                    ss += (o0[0] * o0[0] + o0[1] * o0[1]) + (o0[2] * o0[2] + o0[3] * o0[3]) + (o1[0] * o1[0] + o1[1] * o1[1]) + (o1[2] * o1[2] + o1[3] * o1[3]); }
                { const int ln = fq * 16 + fr; ss += xlane(ss, ln ^ 16); ss += xlane(ss, ln ^ 32); }
                if (fq == 0) ssq[(size_t)row * 16 + u.pn * 4 + wc] = ss; }
        }
    }
};
}

struct Args { const float* in[18]; float* out; unsigned char* ws; int ph_lo, ph_hi; };
struct Ctx {
    const float *x_prompt, *x_sample, *state_delta, *state_conv, *norm_mix_g, *w_in, *conv_w, *A_log, *dt_bias, *o_norm_g, *v_norm_g, *w_s, *b_s, *w_o, *norm_ffn_g, *w_up, *w_down, *norm_f_g;
    float* out; unsigned char* ws;
    int lane, wave, gw, ngw, bx, nb;
};
#define WSP(T, off) ((T*)(c.ws + (off)))

DI void transpose_item(const float* W, int K, int N, const float* kscale, bf16_t* WT, bf16_t* WAB, int mode, int item, int nblk, LAS float* scr, int lane) {
    const int kb = item / nblk, nb = item % nblk, k0 = 64 * kb, n0 = 64 * nb;
    const int c4 = lane & 15, rsub = lane >> 4;
    const bool cval = n0 + 4 * c4 + 3 < N;
#pragma unroll 4
    for (int kk = 0; kk < 64; kk += 4) { const int row = kk + rsub;
        f32x4 v = (f32x4){0.f, 0.f, 0.f, 0.f}; if (cval) { v = *(const f32x4*)(W + (size_t)(k0 + row) * N + n0 + 4 * c4); if (kscale) v = v * kscale[k0 + row]; }
        LAS float* p = scr + row * 65 + 4 * c4; p[0] = v.x; p[1] = v.y; p[2] = v.z; p[3] = v.w; }
    asm volatile("s_waitcnt lgkmcnt(0)" ::: "memory");
    const int kc = lane & 7;
#pragma unroll
    for (int it = 0; it < 8; ++it) { const int n = 8 * it + (lane >> 3), ns = n0 + n; const LAS float* s = scr + (8 * kc) * 65 + n;
        u32x4 o; o.x = pk2(s[0 * 65], s[1 * 65]); o.y = pk2(s[2 * 65], s[3 * 65]); o.z = pk2(s[4 * 65], s[5 * 65]); o.w = pk2(s[6 * 65], s[7 * 65]);
        if (ns < N) {
            bf16_t* rowp;
            if (mode == 0) rowp = WT + (size_t)ns * K;
            else rowp = ns < 2048 ? WT + (size_t)ns * K : (ns < 2056 ? WAB + (size_t)(ns - 2048) * K : WT + (size_t)(ns - 8) * K);
            *(u32x4*)(rowp + k0 + 8 * kc) = o; } }
    asm volatile("s_waitcnt lgkmcnt(0)" ::: "memory");
}
DI void convert_layer_weights(const Ctx& c, int l, int w0, int nw, LAS unsigned char* lds) {
    LAS float* scr = (LAS float*)(lds + c.wave * 18432);
    constexpr int I_IN = 16 * 49, I_O = 16 * 16, I_UP = 16 * 64, I_DN = 64 * 16, I_L = I_IN + I_O + I_UP + I_DN;
    for (int it = w0; it < I_L; it += nw) {
        int r = it;
        if (r < I_IN) { transpose_item(c.w_in + (size_t)l * DM * PROJ, DM, PROJ, c.norm_mix_g + l * DM, WSP(bf16_t, WS_WIN) + (size_t)l * NP * DM, WSP(bf16_t, WS_WAB) + (size_t)l * 16 * DM, 1, r, 49, scr, c.lane); continue; } r -= I_IN;
        if (r < I_O) { transpose_item(c.w_o + (size_t)l * DM * DM, DM, DM, nullptr, WSP(bf16_t, WS_WO) + (size_t)l * DM * DM, nullptr, 0, r, 16, scr, c.lane); continue; } r -= I_O;
        if (r < I_UP) { transpose_item(c.w_up + (size_t)l * DM * FF, DM, FF, c.norm_ffn_g + l * DM, WSP(bf16_t, WS_WUP) + (size_t)l * FF * DM, nullptr, 0, r, 64, scr, c.lane); continue; } r -= I_UP;
        transpose_item(c.w_down + (size_t)l * FF * DM, FF, DM, nullptr, WSP(bf16_t, WS_WDN) + (size_t)l * DM * FF, nullptr, 0, r, 16, scr, c.lane);
    }
}
DI void phase_prologue(const Ctx& c, LAS unsigned char* lds) {
    convert_layer_weights(c, 0, c.gw, c.ngw, lds);
    float* ssq = WSP(float, WS_SSQ);
    for (int m = c.gw; m < MP; m += c.ngw) {
        const f32x4* xr = (const f32x4*)(c.x_prompt + (size_t)m * DM) + c.lane; u32x2* o8 = (u32x2*)(WSP(bf16_t, WS_XB16) + (size_t)m * DM) + c.lane; float s = 0.f;
#pragma unroll
        for (int j = 0; j < 4; ++j) { const f32x4 v = xr[64 * j]; s += (v.x * v.x + v.y * v.y) + (v.z * v.z + v.w * v.w); u32x2 w; w.x = pk2(v.x, v.y); w.y = pk2(v.z, v.w); o8[64 * j] = w; }
        s = wave_sum(s, c.lane); if (c.lane < 16) ssq[(size_t)m * 16 + c.lane] = c.lane == 0 ? s : 0.f;
    }
    const int gt = c.gw * 64 + c.lane, ngt = c.ngw * 64;
    float* xs = WSP(float, WS_XS);
    for (int i = gt; i < SBATCH * DM; i += ngt) xs[i] = c.x_sample[i];
    bf16_t* wab = WSP(bf16_t, WS_WAB);
    for (int i = gt; i < DEPTH * 8 * DM; i += ngt) { const int l = i / (8 * DM), r = i % (8 * DM); wab[(size_t)l * 16 * DM + 8 * DM + r] = 0; }
    unsigned* wm = WSP(unsigned, WS_WM);
    for (int i = gt; i < DEPTH * 4 * 128 * 64; i += ngt) { const int e = 2 * i, ii = (e >> 7) & 127, jj = e & 127;
        const float a = ii >= jj ? c.w_s[e] : 0.f, b = ii >= jj + 1 ? c.w_s[e + 1] : 0.f; wm[i] = pk2(a, b); }
}

template <int NT, bool NORM, int EPI>
DI void sgemm_block(const Ctx& c, const float* A, int lda, int K, const bf16_t* Bt, int ncg, float* out, int ldo, LAS unsigned char* lds, const bf16_t* Bab) {
    int lane = c.lane; asm volatile("" : "+v"(lane));
    const int wave = c.wave, fr = lane & 15, fq = lane >> 4;
    LAS f32x4* red = (LAS f32x4*)lds;
    LAS float* ssr = (LAS float*)(lds + 8 * NT * 64 * 16);
    const int kw = K / 8, k0 = wave * kw;
    for (int u = c.bx; u < 8 * ncg; u += c.nb) {
        const int rt = u & 7, cg = u >> 3;
        const bool abg = (Bab != nullptr) && (cg == ncg - 1);
        const bf16_t* bp = (abg ? Bab : Bt + (size_t)cg * NT * 16 * K) + (size_t)fr * K + k0 + 8 * fq;
        const float* ap = A + (size_t)(rt * 16 + fr) * lda + k0 + 8 * fq;
        f32x4 acc[NT]; float ss = 0.f;
#pragma unroll
        for (int nt = 0; nt < NT; ++nt) acc[nt] = (f32x4){0.f, 0.f, 0.f, 0.f};
#pragma unroll 4
        for (int k = 0; k < kw; k += 32) {
            const f32x4 a0 = *(const f32x4*)(ap + k), a1 = *(const f32x4*)(ap + k + 4);
            if (NORM) ss += (a0.x * a0.x + a0.y * a0.y) + (a0.z * a0.z + a0.w * a0.w) + (a1.x * a1.x + a1.y * a1.y) + (a1.z * a1.z + a1.w * a1.w);
            u32x4 a; a.x = pk2(a0.x, a0.y); a.y = pk2(a0.z, a0.w); a.z = pk2(a1.x, a1.y); a.w = pk2(a1.z, a1.w);
#pragma unroll
            for (int nt = 0; nt < NT; ++nt) if (nt == 0 || !abg) { const bf16x8 bf = *(const bf16x8*)(bp + (size_t)nt * 16 * K + k); acc[nt] = MFMA16(as_bf(a), bf, acc[nt]); }
        }
        if (NORM) { ss += xlane(ss, lane ^ 16); ss += xlane(ss, lane ^ 32); if (fq == 0) ssr[wave * 16 + fr] = ss; }
#pragma unroll
        for (int nt = 0; nt < NT; ++nt) red[(wave * NT + nt) * 64 + lane] = acc[nt];
        __syncthreads();
        if (wave < NT && (wave == 0 || !abg)) {
            f32x4 t = red[wave * 64 + lane];
#pragma unroll
            for (int w = 1; w < 8; ++w) t += red[(w * NT + wave) * 64 + lane];
            const int col = (cg * NT + wave) * 16 + fr;
            float prev[4];
            if (EPI == 1) {
#pragma unroll
                for (int j = 0; j < 4; ++j) prev[j] = out[(size_t)(rt * 16 + 4 * fq + j) * ldo + col]; }
#pragma unroll
            for (int j = 0; j < 4; ++j) { const int rl = 4 * fq + j; float rs = 1.f;
                if (NORM) { float sq = 0.f;
#pragma unroll
                    for (int w = 0; w < 8; ++w) sq += ssr[w * 16 + rl];
                    rs = rsqrtf(sq * (1.0f / DM) + EPS); }
                float* o = out + (size_t)(rt * 16 + rl) * ldo + col;
                if (EPI == 0) *o = t[j] * rs; else if (EPI == 1) *o = prev[j] + t[j]; else { const float v = fmaxf(t[j] * rs, 0.f); *o = v * v; } }
        }
        __syncthreads();
    }
}
DI void sgemm1(const Ctx& c, int l, LAS unsigned char* lds) {
    sgemm_block<4, true, 0>(c, WSP(float, WS_XS), DM, DM, WSP(bf16_t, WS_WIN) + (size_t)l * NP * DM, 49, WSP(float, WS_PS), NPS, lds, WSP(bf16_t, WS_WAB) + (size_t)l * 16 * DM);
}
DI void sgemm2(const Ctx& c, int l, LAS unsigned char* lds) {
    sgemm_block<2, false, 1>(c, WSP(float, WS_AMIXS), DM, DM, WSP(bf16_t, WS_WO) + (size_t)l * DM * DM, 32, WSP(float, WS_XS), DM, lds, nullptr);
}
DI void sgemm3(const Ctx& c, int l, LAS unsigned char* lds) {
    sgemm_block<4, true, 2>(c, WSP(float, WS_XS), DM, DM, WSP(bf16_t, WS_WUP) + (size_t)l * FF * DM, 64, WSP(float, WS_HS), FF, lds, nullptr);
}
DI void sgemm4(const Ctx& c, int l, LAS unsigned char* lds) {
    sgemm_block<2, false, 1>(c, WSP(float, WS_HS), FF, FF, WSP(bf16_t, WS_WDN) + (size_t)l * DM * FF, 32, WSP(float, WS_XS), DM, lds, nullptr);
}

DI void b0_block_ab(const Ctx& c, int l, int chunk, LAS unsigned char* lds) {
    int lane = c.lane; asm volatile("" : "+v"(lane));
    const int wave = c.wave, fr = lane & 15, fq = lane >> 4, tok0 = chunk * 64, k0 = wave * 128;
    const bf16_t* ap = WSP(bf16_t, WS_XB16) + (size_t)(tok0 + fr) * DM + k0 + 8 * fq;
    const bf16_t* bp = WSP(bf16_t, WS_WAB) + (size_t)l * 16 * DM + (size_t)fr * DM + k0 + 8 * fq;
    f32x4 acc[4];
#pragma unroll
    for (int mt = 0; mt < 4; ++mt) acc[mt] = (f32x4){0.f, 0.f, 0.f, 0.f};
#pragma unroll
    for (int k = 0; k < 128; k += 32) {
        const bf16x8 bf = *(const bf16x8*)(bp + k);
#pragma unroll
        for (int mt = 0; mt < 4; ++mt) { const bf16x8 a = *(const bf16x8*)(ap + (size_t)mt * 16 * DM + k); acc[mt] = MFMA16(a, bf, acc[mt]); }
    }
    LAS f32x4* red = (LAS f32x4*)lds;
#pragma unroll
    for (int mt = 0; mt < 4; ++mt) red[(wave * 4 + mt) * 64 + lane] = acc[mt];
    __syncthreads();
    if (wave < 4 && fr < 8) { const int mt = wave;
        f32x4 t = red[mt * 64 + lane];
#pragma unroll
        for (int w = 1; w < 8; ++w) t += red[(w * 4 + mt) * 64 + lane];
        const float* ssq = WSP(float, WS_SSQ) + (size_t)(2 * l) * MP * 16;
        float* gb = WSP(float, WS_G); float* bb = WSP(float, WS_BETA);
        const int hh = fr & 3; const float al = -__expf(c.A_log[l * 4 + hh]), dtb = c.dt_bias[l * 4 + hh];
#pragma unroll
        for (int j = 0; j < 4; ++j) { const int tok = tok0 + 16 * mt + 4 * fq + j; const float v = t[j] * rsqrtf(ssq_sum(ssq + (size_t)tok * 16) * (1.0f / DM) + EPS);
            if (fr < 4) gb[tok * 4 + hh] = al * softplus_f(v + dtb); else bb[tok * 4 + hh] = sigmoid_f(v); } }
    __syncthreads();
}
DI float dot2bf(unsigned a, unsigned b, float c) { float r; asm("v_dot2c_f32_bf16 %0, %1, %2" : "=v"(r) : "s"(b), "v"(a), "0"(c)); return r; }
constexpr int B0_STRIDE = 272, B0_WAVE_LDS = 18432;
DI void b0_task_conv(const Ctx& c, int l, int b, int n, int s, int hh, LAS unsigned char* wl) {
    int lane = c.lane; asm volatile("" : "+v"(lane));
    const int tok0 = b * SEQ + n * 64, cb = s * 512 + hh * 128, piece = lane & 15;
    const bf16_t* P = WSP(bf16_t, WS_P) + (size_t)tok0 * NP + cb + piece * 8;
#pragma unroll
    for (int k = 0; k < 17; ++k) { const int row = 4 * k + (lane >> 4);
        if (row < 67) { u32x4 v = (u32x4){0u, 0u, 0u, 0u}; if (n > 0 || row >= 3) v = *(const u32x4*)(P + (long)(row - 3) * NP);
            *(LAS u32x4*)(wl + row * B0_STRIDE + piece * 16) = v; } }
    const unsigned* cwl = (const unsigned*)(c.conv_w + (size_t)l * 4 * QKV + cb);
    if (n == 31) {
        float* ocp = c.out + O_CP + ((size_t)(l * NBATCH + b) * 3) * QKV + cb;
#pragma unroll
        for (int t = 0; t < 6; ++t) { const int idx = lane + 64 * t, row = idx >> 7, ch = idx & 127; ocp[(size_t)row * QKV + ch] = bf2f(*(const LAS bf16_t*)(wl + (64 + row) * B0_STRIDE + ch * 2)); } }
    float ss = 0.f;
#pragma unroll 1
    for (int i = 0; i < 16; ++i) {
        u32x4 rws[4];
#pragma unroll
        for (int j = 0; j < 4; ++j) rws[j] = *(const LAS u32x4*)(wl + (lane + j) * B0_STRIDE + i * 16);
        u32x8 w0, w1, w2, w3; const unsigned* wp = cwl + 8 * i;
        asm volatile("s_load_dwordx8 %0, %4, 0x0\n\ts_load_dwordx8 %1, %4, 0x1800\n\ts_load_dwordx8 %2, %4, 0x3000\n\ts_load_dwordx8 %3, %4, 0x4800\n\ts_waitcnt lgkmcnt(0)"
                     : "=&s"(w0), "=&s"(w1), "=&s"(w2), "=&s"(w3) : "s"(wp) : "memory");
        float y[8];
#pragma unroll
        for (int e = 0; e < 8; ++e) { float a = 0.f;
            a = dot2bf(rws[0][e >> 1], (e & 1) ? ((w0[e] + 0x8000u) & 0xffff0000u) : ((w0[e] + 0x8000u) >> 16), a);
            a = dot2bf(rws[1][e >> 1], (e & 1) ? ((w1[e] + 0x8000u) & 0xffff0000u) : ((w1[e] + 0x8000u) >> 16), a);
            a = dot2bf(rws[2][e >> 1], (e & 1) ? ((w2[e] + 0x8000u) & 0xffff0000u) : ((w2[e] + 0x8000u) >> 16), a);
            a = dot2bf(rws[3][e >> 1], (e & 1) ? ((w3[e] + 0x8000u) & 0xffff0000u) : ((w3[e] + 0x8000u) >> 16), a);
            y[e] = silu_f(a); ss += y[e] * y[e]; }
        u32x4 w; w.x = pk2(y[0], y[1]); w.y = pk2(y[2], y[3]); w.z = pk2(y[4], y[5]); w.w = pk2(y[6], y[7]);
        *(LAS u32x4*)(wl + (lane + 3) * B0_STRIDE + i * 16) = w;
    }
    const float sc = s == 0 ? rsqrtf(ss + EPS) * 0.08838834764831845f : (s == 1 ? rsqrtf(ss + EPS) : 1.0f);
    const size_t unit = (size_t)((b * 4 + hh) * 32 + n);
    bf16_t* ot = (s == 1 ? WSP(bf16_t, WS_KNT) : WSP(bf16_t, WS_VT)) + unit * 128 * 64 + lane;
#pragma unroll 2
    for (int i = 0; i < 16; ++i) { const u32x4 v = *(const LAS u32x4*)(wl + (lane + 3) * B0_STRIDE + i * 16); u32x4 w;
#pragma unroll
        for (int e = 0; e < 4; ++e) w[e] = pk2(bflo(v[e]) * sc, bfhi(v[e]) * sc);
        if (s < 2) *(LAS u32x4*)(wl + (lane + 3) * B0_STRIDE + i * 16) = w;
        if (s >= 1) {
#pragma unroll
            for (int e = 0; e < 8; ++e) ot[(8 * i + e) * 64] = (bf16_t)((e & 1) ? (w[e >> 1] >> 16) : (w[e >> 1] & 0xffffu)); } }
    if (s < 2) { bf16_t* o = (s == 0 ? WSP(bf16_t, WS_QN) : WSP(bf16_t, WS_KN)) + (size_t)tok0 * 512 + hh * 128 + piece * 8;
#pragma unroll
        for (int k = 0; k < 16; ++k) { const int row = 4 * k + (lane >> 4); *(u32x4*)(o + (size_t)row * 512) = *(const LAS u32x4*)(wl + (row + 3) * B0_STRIDE + piece * 16); } }
}
DI void b0_task_vb(const Ctx& c, int l, int b, int n, int hb, LAS unsigned char* wl) {
    int lane = c.lane; asm volatile("" : "+v"(lane));
    const int tok0 = b * SEQ + n * 64, piece = lane & 15;
    const bf16_t* P = WSP(bf16_t, WS_P) + (size_t)tok0 * NP + 2560 + hb * 128 + piece * 8;
#pragma unroll
    for (int k = 0; k < 16; ++k) { const int row = 4 * k + (lane >> 4); *(LAS u32x4*)(wl + row * B0_STRIDE + piece * 16) = *(const u32x4*)(P + (size_t)row * NP); }
    const float* vp = WSP(float, WS_VSS) + (size_t)(tok0 + lane) * 8; const f32x4 p0 = *(const f32x4*)vp, p1 = *(const f32x4*)(vp + 4);
    const float rs = rsqrtf((((p0.x + p0.y) + (p0.z + p0.w)) + ((p1.x + p1.y) + (p1.z + p1.w))) * (1.0f / 512.0f) + EPS);
    const float* vg = c.v_norm_g + l * 512 + hb * 128;
    bf16_t* vbt = WSP(bf16_t, WS_VBT) + ((size_t)((b * 16 + (n >> 1)) * 4 + hb) * 128) * 128 + (n & 1) * 64 + lane;
#pragma unroll 2
    for (int i = 0; i < 16; ++i) { const u32x4 v = *(const LAS u32x4*)(wl + lane * B0_STRIDE + i * 16);
#pragma unroll
        for (int e = 0; e < 8; ++e) { const float pv = (e & 1) ? bfhi(v[e >> 1]) : bflo(v[e >> 1]); vbt[(size_t)(8 * i + e) * 128] = f2bf(pv * rs * vg[8 * i + e]); } }
}
DI void b0_task_sample(const Ctx& c, int l, int bs) {
    const float* ps = WSP(float, WS_PS) + (size_t)bs * NPS;
    if (c.lane < 4) { const int hh = c.lane;
        WSP(float, WS_GS)[bs * 4 + hh] = -__expf(c.A_log[l * 4 + hh]) * softplus_f(ps[3072 + hh] + c.dt_bias[l * 4 + hh]);
        WSP(float, WS_BS)[bs * 4 + hh] = sigmoid_f(ps[3076 + hh]); }
    const float* sc = c.state_conv + (size_t)(l * SBATCH + bs) * 3 * QKV;
    const float* cw = c.conv_w + (size_t)l * 4 * QKV;
    float* ocs = c.out + O_CS + (size_t)(l * SBATCH + bs) * 3 * QKV;
    float* qkvs = WSP(float, WS_QS) + bs * 512;
#pragma unroll 1
    for (int sh = 0; sh < 12; ++sh) {
        float y[2];
#pragma unroll
        for (int t = 0; t < 2; ++t) { const int ch = sh * 128 + t * 64 + c.lane; const float s0 = sc[ch], s1 = sc[QKV + ch], s2 = sc[2 * QKV + ch], cur = ps[ch];
            ocs[ch] = s1; ocs[QKV + ch] = s2; ocs[2 * QKV + ch] = cur;
            y[t] = silu_f(s0 * cw[ch] + s1 * cw[QKV + ch] + s2 * cw[2 * QKV + ch] + cur * cw[3 * QKV + ch]); }
        float scale = 1.0f;
        if (sh < 8) { const float ssum = wave_sum(y[0] * y[0] + y[1] * y[1], c.lane); scale = rsqrtf(ssum + EPS) * (sh < 4 ? 0.08838834764831845f : 1.0f); }
        float* o = qkvs + (size_t)(sh >> 2) * SBATCH * 512 + (sh & 3) * 128;
        o[c.lane] = y[0] * scale; o[64 + c.lane] = y[1] * scale;
    }
    float pv[8]; float ss = 0.f;
#pragma unroll
    for (int i = 0; i < 8; ++i) { pv[i] = ps[2560 + c.lane + 64 * i]; ss += pv[i] * pv[i]; }
    ss = wave_sum(ss, c.lane); const float rs = rsqrtf(ss * (1.0f / 512.0f) + EPS);
    float* am = WSP(float, WS_AMIXS) + (size_t)bs * DM; float* ovs = c.out + O_VS + (size_t)(l * SBATCH + bs) * 512;
#pragma unroll
    for (int i = 0; i < 8; ++i) { const int ch = c.lane + 64 * i, hb = ch >> 7; const float vb = pv[i] * rs * c.v_norm_g[l * 512 + ch];
        ovs[ch] = vb; am[512 + ch] = ps[2048 + ch] * (c.w_s[(size_t)(l * 4 + hb) * 128 * 128] * vb + c.b_s[(l * 4 + hb) * 128]); }
}
DI void phase_b0(const Ctx& c, int l, LAS unsigned char* lds) {
    for (int ch = c.bx; ch < 256; ch += c.nb) b0_block_ab(c, l, ch, lds);
    constexpr int NPT = 256 * 12;
    LAS unsigned char* wl = lds + c.wave * B0_WAVE_LDS;
    for (int t = c.wave * c.nb + c.bx; t < NPT + SBATCH; t += c.ngw) {
        if (t >= NPT) { if (SUB(0)) b0_task_sample(c, l, t - NPT); continue; }
        const int chunk = t / 12, k = t % 12, b = chunk >> 5, n = chunk & 31;
        if (SUB(3)) b0_task_conv(c, l, b, n, k >> 2, k & 3, wl);
    }
}

DI void b1_prep(const Ctx& c, int l, int unit, int part, LAS unsigned char* wl, LAS float* sg, LAS float* sb) {
    int lane = c.lane; asm volatile("" : "+v"(lane));
    const int r = lane & 31, h = lane >> 5;
    const int n = unit & 31, bh = unit >> 5, hh = bh & 3, b = bh >> 2, tok0 = b * SEQ + n * 64;
    const float bt = WSP(float, WS_BETA)[(tok0 + lane) * 4 + hh];
    float gc = WSP(float, WS_G)[(tok0 + lane) * 4 + hh];
#pragma unroll
    for (int o = 1; o < 64; o <<= 1) { const float t = xlane(gc, lane - o); if (lane >= o) gc += t; }
    sg[lane] = gc; sb[lane] = bt;
    const float glast = __builtin_bit_cast(float, __builtin_amdgcn_readlane(__builtin_bit_cast(int, gc), 63));
    if (part == 0 && lane == 0) WSP(float, WS_EG)[unit] = __expf(glast);
    unsigned char* img = c.ws + WS_IMG + (size_t)unit * IMG_BYTES;
    const bf16_t* Kn = WSP(bf16_t, WS_KN) + (size_t)tok0 * 512 + hh * 128;
    const bf16_t* Qn = WSP(bf16_t, WS_QN) + (size_t)tok0 * 512 + hh * 128;
    const bf16_t* KnT = WSP(bf16_t, WS_KNT) + (size_t)unit * 128 * 64;
    const bf16_t* VT = WSP(bf16_t, WS_VT) + (size_t)unit * 128 * 64;
    LAS float* L = (LAS float*)wl;
    {
        bf16x8 Kf[2][8];
#pragma unroll
        for (int t = 0; t < 2; ++t)
#pragma unroll
            for (int ks = 0; ks < 8; ++ks) Kf[t][ks] = *(const bf16x8*)(Kn + (size_t)(32 * t + r) * 512 + 16 * ks + 8 * h);
        if (part == 0) {
#pragma unroll
        for (int tt = 0; tt < 3; ++tt) { const int mt = tt == 0 ? 0 : 1, nt = tt == 2 ? 1 : 0;
            f32x16 acc = zero16();
#pragma unroll
            for (int ks = 0; ks < 8; ++ks) acc = MFMA32(Kf[mt][ks], Kf[nt][ks], acc);
            const int j = 32 * nt + r; const float gj = sg[j];
#pragma unroll
            for (int g4 = 0; g4 < 4; ++g4) { const f32x4 gi4 = *(const LAS f32x4*)(sg + 32 * mt + 8 * g4 + 4 * h), bi4 = *(const LAS f32x4*)(sb + 32 * mt + 8 * g4 + 4 * h);
#pragma unroll
                for (int q = 0; q < 4; ++q) { const int i = 32 * mt + 8 * g4 + 4 * h + q; const float arg = i > j ? gi4[q] - gj : 0.f;
                    L[i * 64 + j] = i > j ? acc[4 * g4 + q] * bi4[q] * __expf(arg) : 0.f; } } }
        }
        if (part == 1) {
#pragma unroll
        for (int mt = 0; mt < 2; ++mt) {
            bf16x8 Qf[8];
#pragma unroll
            for (int ks = 0; ks < 8; ++ks) Qf[ks] = *(const bf16x8*)(Qn + (size_t)(32 * mt + r) * 512 + 16 * ks + 8 * h);
            const int i = 32 * mt + r; const float gi = sg[i];
#pragma unroll
            for (int mp = 0; mp <= mt; ++mp) {
                f32x16 acc = zero16();
#pragma unroll
                for (int ks = 0; ks < 8; ++ks) acc = MFMA32(Kf[mp][ks], Qf[ks], acc);
#pragma unroll
                for (int g4 = 0; g4 < 4; ++g4) { const f32x4 gj4 = *(const LAS f32x4*)(sg + 32 * mp + 8 * g4 + 4 * h);
#pragma unroll
                    for (int q = 0; q < 4; ++q) { const int j = 32 * mp + 8 * g4 + 4 * h + q; const float arg = i >= j ? gi - gj4[q] : 0.f;
                        acc[4 * g4 + q] = i >= j ? acc[4 * g4 + q] * __expf(arg) : 0.f; } }
                const int fb = (mt == 0 ? 0 : 1 + mp) * 2;
#pragma unroll
                for (int s = 0; s < 2; ++s) *(u32x4*)(img + 49152 + (fb + s) * 1024 + lane * 16) = pack8(acc, s);
            }
        }
        }
    }
    if (part == 0) {
    float Tr[64];
    {
        f32x4 lb[2][16];
#pragma unroll
        for (int i = 0; i < 64; ++i) {
            if (i + 1 < 64) {
#pragma unroll
                for (int j4 = 0; j4 < (i + 1 + 3) / 4; ++j4) lb[(i + 1) & 1][j4] = *(const LAS f32x4*)(L + (i + 1) * 64 + 4 * j4); }
            asm volatile("" ::: "memory");
            float a0 = lane == i ? 1.f : 0.f, a1 = 0.f;
#pragma unroll
            for (int j4 = 0; j4 < (i + 3) / 4; ++j4) {
#pragma unroll
                for (int q = 0; q < 4; ++q) { const int j = 4 * j4 + q; if (j < i) { if (q & 1) a1 -= lb[i & 1][j4][q] * Tr[j]; else a0 -= lb[i & 1][j4][q] * Tr[j]; } } }
            Tr[i] = a0 + a1;
        }
    }
    LAS bf16_t* T1 = (LAS bf16_t*)wl;
    asm volatile("" ::: "memory");
    {
        const float sc1 = bt * __expf(gc);
#pragma unroll
        for (int i = 0; i < 64; ++i) T1[i * 72 + lane] = f2bf(Tr[i] * sc1);
        bf16x8 Tf[2][4];
#pragma unroll
        for (int mt = 0; mt < 2; ++mt)
#pragma unroll
            for (int ks = 0; ks < 4; ++ks) Tf[mt][ks] = *(const LAS bf16x8*)(T1 + (32 * mt + r) * 72 + 16 * ks + 8 * h);
#pragma unroll
        for (int dt = 0; dt < 4; ++dt) {
            bf16x8 Kt[4];
#pragma unroll
            for (int ks = 0; ks < 4; ++ks) Kt[ks] = *(const bf16x8*)(KnT + (size_t)(32 * dt + r) * 64 + 16 * ks + 8 * h);
#pragma unroll
            for (int mt = 0; mt < 2; ++mt) { f32x16 acc = zero16();
#pragma unroll
                for (int ks = 0; ks < 2 * (mt + 1); ++ks) acc = MFMA32(Kt[ks], Tf[mt][ks], acc);
                acc = -acc;
#pragma unroll
                for (int s = 0; s < 2; ++s) *(u32x4*)(img + ((mt * 4 + dt) * 2 + s) * 1024 + lane * 16) = pack8(acc, s); }
        }
    }
    asm volatile("" ::: "memory");
    {
#pragma unroll
        for (int i = 0; i < 64; ++i) T1[i * 72 + lane] = f2bf(Tr[i] * bt);
        bf16x8 Tf[2][4];
#pragma unroll
        for (int mt = 0; mt < 2; ++mt)
#pragma unroll
            for (int ks = 0; ks < 4; ++ks) Tf[mt][ks] = *(const LAS bf16x8*)(T1 + (32 * mt + r) * 72 + 16 * ks + 8 * h);
        bf16_t* uimg = WSP(bf16_t, WS_UIMG) + (size_t)unit * 8192;
#pragma unroll
        for (int et = 0; et < 4; ++et) {
            bf16x8 Vt[4];
#pragma unroll
            for (int ks = 0; ks < 4; ++ks) Vt[ks] = *(const bf16x8*)(VT + (size_t)(32 * et + r) * 64 + 16 * ks + 8 * h);
#pragma unroll
            for (int mt = 0; mt < 2; ++mt) { f32x16 acc = zero16();
#pragma unroll
                for (int ks = 0; ks < 2 * (mt + 1); ++ks) acc = MFMA32(Tf[mt][ks], Vt[ks], acc);
#pragma unroll
                for (int g4 = 0; g4 < 4; ++g4) { u32x2 w; w.x = pk2(acc[4 * g4], acc[4 * g4 + 1]); w.y = pk2(acc[4 * g4 + 2], acc[4 * g4 + 3]); *(u32x2*)(uimg + ((et * 2 + mt) * 4 + g4) * 256 + lane * 4) = w; } }
        }
    }
    }
    if (part == 1) {
#pragma unroll
    for (int mt = 0; mt < 2; ++mt) { const float ei = __expf(sg[32 * mt + r]);
#pragma unroll
        for (int dt = 0; dt < 4; ++dt)
#pragma unroll
            for (int s = 0; s < 2; ++s) { const bf16_t* qp = Qn + (size_t)(32 * mt + r) * 512 + 32 * dt + 16 * s + 4 * h;
                const u32x2 p0 = *(const u32x2*)qp, p1 = *(const u32x2*)(qp + 8);
                u32x4 w; w.x = pk2(bflo(p0.x) * ei, bfhi(p0.x) * ei); w.y = pk2(bflo(p0.y) * ei, bfhi(p0.y) * ei); w.z = pk2(bflo(p1.x) * ei, bfhi(p1.x) * ei); w.w = pk2(bflo(p1.y) * ei, bfhi(p1.y) * ei);
                *(u32x4*)(img + 16384 + ((mt * 4 + dt) * 2 + s) * 1024 + lane * 16) = w; } }
#pragma unroll
    for (int mp = 0; mp < 2; ++mp)
#pragma unroll
        for (int s = 0; s < 2; ++s) { const f32x4 ga = *(const LAS f32x4*)(sg + 32 * mp + 16 * s + 4 * h), gb = *(const LAS f32x4*)(sg + 32 * mp + 16 * s + 8 + 4 * h);
            float sc[8];
#pragma unroll
            for (int q = 0; q < 4; ++q) { sc[q] = __expf(glast - ga[q]); sc[4 + q] = __expf(glast - gb[q]); }
#pragma unroll
            for (int dt = 0; dt < 4; ++dt) { const bf16_t* kp = KnT + (size_t)(32 * dt + r) * 64 + 32 * mp + 16 * s + 4 * h;
                const u32x2 p0 = *(const u32x2*)kp, p1 = *(const u32x2*)(kp + 8);
                u32x4 w; w.x = pk2(bflo(p0.x) * sc[0], bfhi(p0.x) * sc[1]); w.y = pk2(bflo(p0.y) * sc[2], bfhi(p0.y) * sc[3]); w.z = pk2(bflo(p1.x) * sc[4], bfhi(p1.x) * sc[5]); w.w = pk2(bflo(p1.y) * sc[6], bfhi(p1.y) * sc[7]);
                *(u32x4*)(img + 32768 + ((dt * 2 + mp) * 2 + s) * 1024 + lane * 16) = w; } }
    }
}
DI void b1_gmlp(const Ctx& c, int l, int unit) {
    int lane = c.lane; asm volatile("" : "+v"(lane));
    const int r = lane & 31, h = lane >> 5;
    const int hb = unit & 3, cc = (unit >> 2) & 15, b = unit >> 6, tokc0 = b * SEQ + cc * 128;
    const bf16_t* A = WSP(bf16_t, WS_VBT) + (size_t)unit * 128 * 128;
    const bf16_t* B = WSP(bf16_t, WS_WM) + (size_t)(l * 4 + hb) * 128 * 128;
    const bf16_t* P = WSP(bf16_t, WS_P); bf16_t* AM = WSP(bf16_t, WS_AMIX);
#pragma unroll
    for (int nt = 0; nt < 4; ++nt) {
        f32x16 acc[4];
#pragma unroll
        for (int mt = 0; mt < 4; ++mt) acc[mt] = zero16();
#pragma unroll
        for (int ks = 0; ks < 2 * (nt + 1); ++ks) { const bf16x8 bf = *(const bf16x8*)(B + (size_t)(32 * nt + r) * 128 + 16 * ks + 8 * h);
#pragma unroll
            for (int mt = 0; mt < 4; ++mt) { const bf16x8 af = *(const bf16x8*)(A + (size_t)(32 * mt + r) * 128 + 16 * ks + 8 * h); acc[mt] = MFMA32(af, bf, acc[mt]); } }
        const int tok = tokc0 + 32 * nt + r; const float bsi = c.b_s[(l * 4 + hb) * 128 + 32 * nt + r];
        u32x2 uv[4][4];
#pragma unroll
        for (int mt = 0; mt < 4; ++mt)
#pragma unroll
            for (int g4 = 0; g4 < 4; ++g4) uv[mt][g4] = *(const u32x2*)(P + (size_t)tok * NP + 2048 + hb * 128 + 32 * mt + 8 * g4 + 4 * h);
#pragma unroll
        for (int mt = 0; mt < 4; ++mt)
#pragma unroll
            for (int g4 = 0; g4 < 4; ++g4) { const int dch0 = 32 * mt + 8 * g4 + 4 * h;
                const u32x2 u4 = uv[mt][g4];
                u32x2 w; w.x = pk2(bflo(u4.x) * (acc[mt][4 * g4] + bsi), bfhi(u4.x) * (acc[mt][4 * g4 + 1] + bsi)); w.y = pk2(bflo(u4.y) * (acc[mt][4 * g4 + 2] + bsi), bfhi(u4.y) * (acc[mt][4 * g4 + 3] + bsi));
                *(u32x2*)(AM + (size_t)tok * DM + 512 + hb * 128 + dch0) = w; }
    }
}
DI void phase_b1(const Ctx& c, int l, LAS unsigned char* lds) {
    LAS unsigned char* wl = lds + c.wave * 16384; LAS float* sg = (LAS float*)(lds + 131072 + c.wave * 512); LAS float* sb = sg + 64;
    for (int t = c.bx * 4 + (c.wave & 3); t < 1024; t += c.nb * 4) {
        if (SUB(0)) b1_prep(c, l, t, c.wave >> 2, wl, sg, sb);
    }
}


constexpr int OB_STRIDE = 136;
constexpr int IMG_LDS = 57344;
constexpr int LDS_OBUF = 2 * IMG_LDS, OBUF_BYTES = 64 * OB_STRIDE * 2;
static_assert(LDS_OBUF + 2 * OBUF_BYTES <= LDS_BYTES, "scan LDS");
DI void scan_post(const Ctx& c, int l, int b, int hh, int n, const LAS bf16_t* ob, int lid, const u32x4 (&gt4)[4]) {
    const int i = lid >> 2, q = lid & 3, tok = b * SEQ + n * 64 + i;
    u32x4 ov[4]; float ss = 0.f;
#pragma unroll
    for (int x = 0; x < 4; ++x) { ov[x] = *(const LAS u32x4*)(ob + i * OB_STRIDE + 32 * q + 8 * x);
#pragma unroll
        for (int e = 0; e < 4; ++e) { const float a = bflo(ov[x][e]), bq = bfhi(ov[x][e]); ss += a * a + bq * bq; } }
    ss += xlane(ss, (lid & 63) ^ 1); ss += xlane(ss, (lid & 63) ^ 2);
    const float rs = rsqrtf(ss * (1.0f / 128.0f) + EPS);
    bf16_t* op = WSP(bf16_t, WS_AMIX) + (size_t)tok * DM + hh * 128 + 32 * q;
#pragma unroll
    for (int x = 0; x < 4; ++x) { u32x4 w;
#pragma unroll
        for (int e = 0; e < 4; ++e) w[e] = pk2(bflo(ov[x][e]) * rs * bflo(gt4[x][e]), bfhi(ov[x][e]) * rs * bfhi(gt4[x][e]));
        *(u32x4*)(op + 8 * x) = w; }
}
DI void scan_loader_step(const Ctx& c, int l, int b, int hh, int n, LAS unsigned char* lds, const unsigned char* img0, const bf16_t* gbase, int lw, int lane, int lid, u32x4 (&regs)[14], u32x4 (&gt)[4]) {
    u32x4 gcur[4];
#pragma unroll
    for (int x = 0; x < 4; ++x) gcur[x] = gt[x];
#pragma unroll
    for (int x = 0; x < 4; ++x) gt[x] = *(const u32x4*)(gbase + (size_t)n * 64 * NP + 8 * x);
    const unsigned voff = (unsigned)(lw * 14336 + lane * 16);
    if (n + 1 < 32) { LAS unsigned char* dst = lds + ((n + 1) & 1) * IMG_LDS + voff;
#pragma unroll
        for (int i = 0; i < 14; ++i) *(LAS u32x4*)(dst + i * 1024) = regs[i]; }
    if (n + 3 < 32) { const unsigned char* src = img0 + (size_t)(n + 3) * IMG_BYTES;
#pragma unroll
        for (int i = 0; i < 14; ++i) regs[i] = *(const u32x4*)(src + voff + i * 1024); }
    if (n >= 1) scan_post(c, l, b, hh, n - 1, (const LAS bf16_t*)(lds + LDS_OBUF + ((n - 1) & 1) * OBUF_BYTES), lid, gcur);
    __syncthreads();
}
DI void scan_consumer_step(int n, LAS unsigned char* lds, f32x16 (&S)[4], u32x2 (&ucur)[8], float& egc, const bf16_t* uimg0, const float* egp, int lane, int ws, int r, int h) {
    const LAS unsigned char* buf = lds + (n & 1) * IMG_LDS + lane * 16;
    f32x16 av[2], ao[2]; ao[0] = zero16(); ao[1] = zero16();
#pragma unroll
    for (int mt = 0; mt < 2; ++mt)
#pragma unroll
        for (int g4 = 0; g4 < 4; ++g4) { const u32x2 w = ucur[mt * 4 + g4]; av[mt][4 * g4] = bflo(w.x); av[mt][4 * g4 + 1] = bfhi(w.x); av[mt][4 * g4 + 2] = bflo(w.y); av[mt][4 * g4 + 3] = bfhi(w.y); }
    const float eg = egc;
    if (n + 2 < 32) { const bf16_t* up = uimg0 + (size_t)(n + 2) * 8192;
#pragma unroll
        for (int x = 0; x < 8; ++x) ucur[x] = *(const u32x2*)(up + x * 256);
        egc = egp[n + 2]; }
    {
        bf16x8 fg[2][4];
#pragma unroll
        for (int mt = 0; mt < 2; ++mt) { fg[0][mt] = *(const LAS bf16x8*)(buf + (mt * 8) * 1024); fg[0][2 + mt] = *(const LAS bf16x8*)(buf + 16384 + (mt * 8) * 1024); }
#pragma unroll
        for (int gI = 0; gI < 8; ++gI) { const int dt = gI >> 1, s = gI & 1;
            if (gI + 1 < 8) {
#pragma unroll
                for (int mt = 0; mt < 2; ++mt) { fg[(gI + 1) & 1][mt] = *(const LAS bf16x8*)(buf + (mt * 8 + gI + 1) * 1024); fg[(gI + 1) & 1][2 + mt] = *(const LAS bf16x8*)(buf + 16384 + (mt * 8 + gI + 1) * 1024); } }
            asm volatile("" ::: "memory");
            const bf16x8 sb = as_bf(pack8(S[dt], s));
            av[0] = MFMA32(fg[gI & 1][0], sb, av[0]); av[1] = MFMA32(fg[gI & 1][1], sb, av[1]);
            ao[0] = MFMA32(sb, fg[gI & 1][2], ao[0]); ao[1] = MFMA32(sb, fg[gI & 1][3], ao[1]); }
    }
    bf16x8 vb[2][2];
#pragma unroll
    for (int mp = 0; mp < 2; ++mp)
#pragma unroll
        for (int s = 0; s < 2; ++s) vb[mp][s] = as_bf(pack8(av[mp], s));
    {
        bf16x8 qf[6];
#pragma unroll
        for (int f = 0; f < 6; ++f) qf[f] = *(const LAS bf16x8*)(buf + 49152 + f * 1024);
        asm volatile("" ::: "memory");
#pragma unroll
        for (int s = 0; s < 2; ++s) { ao[0] = MFMA32(vb[0][s], qf[s], ao[0]); ao[1] = MFMA32(vb[0][s], qf[2 + s], ao[1]); ao[1] = MFMA32(vb[1][s], qf[4 + s], ao[1]); }
    }
    LAS bf16_t* ob = (LAS bf16_t*)(lds + LDS_OBUF + (n & 1) * OBUF_BYTES);
#pragma unroll
    for (int mt = 0; mt < 2; ++mt)
#pragma unroll
        for (int g4 = 0; g4 < 4; ++g4) { u32x2 w; w.x = pk2(ao[mt][4 * g4], ao[mt][4 * g4 + 1]); w.y = pk2(ao[mt][4 * g4 + 2], ao[mt][4 * g4 + 3]);
            *(LAS u32x2*)(ob + (32 * mt + r) * OB_STRIDE + 32 * ws + 8 * g4 + 4 * h) = w; }
    bf16x8 kf[2][4];
#pragma unroll
    for (int f = 0; f < 4; ++f) kf[0][f] = *(const LAS bf16x8*)(buf + 32768 + f * 1024);
#pragma unroll
    for (int dt = 0; dt < 4; ++dt) {
        if (dt + 1 < 4) {
#pragma unroll
            for (int f = 0; f < 4; ++f) kf[(dt + 1) & 1][f] = *(const LAS bf16x8*)(buf + 32768 + ((dt + 1) * 4 + f) * 1024); }
        asm volatile("" ::: "memory");
        S[dt] = S[dt] * eg;
#pragma unroll
        for (int mp = 0; mp < 2; ++mp)
#pragma unroll
            for (int s = 0; s < 2; ++s) S[dt] = MFMA32(kf[dt & 1][mp * 2 + s], vb[mp][s], S[dt]); }
    __syncthreads();
}
DI void scan_block(const Ctx& c, int l, int bh, LAS unsigned char* lds) {
    const int wave = c.wave, b = bh >> 2, hh = bh & 3;
    const unsigned char* img0 = c.ws + WS_IMG + (size_t)bh * 32 * IMG_BYTES;
    if (wave >= 4) { if (SUB2(0)) {
        int lane = c.lane; asm volatile("" : "+v"(lane));
        const int lw = wave - 4, lid = lw * 64 + lane;
        u32x4 regs0[14], regs1[14], gt0[4];
        const bf16_t* gbase = WSP(bf16_t, WS_P) + (size_t)(b * SEQ + (lid >> 2)) * NP + 1536 + hh * 128 + 32 * (lid & 3);
        const unsigned voff0 = (unsigned)(lw * 14336 + lane * 16);
#pragma unroll
        for (int i = 0; i < 14; ++i) regs0[i] = *(const u32x4*)(img0 + voff0 + i * 1024);
#pragma unroll
        for (int i = 0; i < 14; ++i) *(LAS u32x4*)(lds + voff0 + i * 1024) = regs0[i];
#pragma unroll
        for (int i = 0; i < 14; ++i) { regs1[i] = *(const u32x4*)(img0 + (size_t)IMG_BYTES + voff0 + i * 1024); regs0[i] = *(const u32x4*)(img0 + (size_t)2 * IMG_BYTES + voff0 + i * 1024); }
#pragma unroll
        for (int x = 0; x < 4; ++x) gt0[x] = (u32x4){0u, 0u, 0u, 0u};
        __syncthreads();
        for (int n = 0; n < 32; n += 2) {
            scan_loader_step(c, l, b, hh, n, lds, img0, gbase, lw, lane, lid, regs1, gt0);
            scan_loader_step(c, l, b, hh, n + 1, lds, img0, gbase, lw, lane, lid, regs0, gt0);
        }
        scan_post(c, l, b, hh, 31, (const LAS bf16_t*)(lds + LDS_OBUF + (31 & 1) * OBUF_BYTES), lid, gt0);
    } } else if (SUB2(1)) {
        int lane = c.lane; asm volatile("" : "+v"(lane));
        __builtin_amdgcn_s_setprio(3);
        const int ws = wave, r = lane & 31, h = lane >> 5;
        f32x16 S[4];
#pragma unroll
        for (int dt = 0; dt < 4; ++dt) S[dt] = zero16();
        const bf16_t* uimg0 = WSP(bf16_t, WS_UIMG) + (size_t)bh * 32 * 8192 + (size_t)ws * 2 * 4 * 256 + lane * 4;
        const float* egp = WSP(float, WS_EG) + bh * 32;
        u32x2 u0[8], u1[8];
#pragma unroll
        for (int x = 0; x < 8; ++x) { u0[x] = *(const u32x2*)(uimg0 + x * 256); u1[x] = *(const u32x2*)(uimg0 + 8192 + x * 256); }
        float eg0 = egp[0], eg1 = egp[1];
        __syncthreads();
        for (int n = 0; n < 32; n += 2) {
            scan_consumer_step(n, lds, S, u0, eg0, uimg0, egp, lane, ws, r, h);
            scan_consumer_step(n + 1, lds, S, u1, eg1, uimg0, egp, lane, ws, r, h);
        }
        const char* od = (const char*)(c.out + O_DP + (size_t)(l * 32 + bh) * 128 * 128);
        unsigned voff = (unsigned)((4 * h) * 128 + 32 * ws + r) * 4u;
        asm volatile("" : "+v"(voff));
#pragma unroll
        for (int dt = 0; dt < 4; ++dt)
#pragma unroll
            for (int reg = 0; reg < 16; ++reg) *(float*)(od + (32 * dt + (reg & 3) + 8 * (reg >> 2)) * 512 + voff) = S[dt][reg];
        __builtin_amdgcn_s_setprio(0);
    }
}
DI float rdlane(float v, int l) { return __builtin_bit_cast(float, __builtin_amdgcn_readlane(__builtin_bit_cast(int, v), l)); }
DI void sample_recurrent(const Ctx& c, int l, int unit) {
    int lane = c.lane; asm volatile("" : "+v"(lane));
    const int bs = unit >> 2, hh = unit & 3, e2 = 2 * lane;
    const float* S0 = c.state_delta + (size_t)((l * SBATCH + bs) * 4 + hh) * 128 * 128 + e2;
    float* S1 = c.out + O_DS + (size_t)((l * SBATCH + bs) * 4 + hh) * 128 * 128 + e2;
    const float* q = WSP(float, WS_QS) + bs * 512 + hh * 128; const float* k = WSP(float, WS_KS) + bs * 512 + hh * 128; const float* v = WSP(float, WS_VS) + bs * 512 + hh * 128;
    const float eg = __expf(WSP(float, WS_GS)[bs * 4 + hh]), beta = WSP(float, WS_BS)[bs * 4 + hh];
    const float k0 = k[lane], k1 = k[64 + lane], q0 = q[lane], q1 = q[64 + lane];
    f32x2 kv = {0.f, 0.f};
#pragma unroll
    for (int d0 = 0; d0 < 128; d0 += 32) { f32x2 sv[32];
#pragma unroll
        for (int j = 0; j < 32; ++j) sv[j] = *(const f32x2*)(S0 + (d0 + j) * 128);
#pragma unroll
        for (int j = 0; j < 32; ++j) { const int dd = d0 + j; kv += sv[j] * rdlane(dd < 64 ? k0 : k1, dd & 63); } }
    const f32x2 v2 = *(const f32x2*)(v + e2);
    const f32x2 delta = (v2 - kv * eg) * beta;
    f32x2 oo = {0.f, 0.f};
#pragma unroll
    for (int d0 = 0; d0 < 128; d0 += 32) { f32x2 sv[32];
#pragma unroll
        for (int j = 0; j < 32; ++j) sv[j] = *(const f32x2*)(S0 + (d0 + j) * 128);
#pragma unroll
        for (int j = 0; j < 32; ++j) { const int dd = d0 + j; const f32x2 sn = sv[j] * eg + delta * rdlane(dd < 64 ? k0 : k1, dd & 63); oo += sn * rdlane(dd < 64 ? q0 : q1, dd & 63); *(f32x2*)(S1 + dd * 128) = sn; } }
    const float ss = wave_sum(oo.x * oo.x + oo.y * oo.y, lane); const float rs = rsqrtf(ss * (1.0f / 128.0f) + EPS);
    const float* ps = WSP(float, WS_PS) + (size_t)bs * NPS + 1536 + hh * 128 + e2; float* am = WSP(float, WS_AMIXS) + (size_t)bs * DM + hh * 128 + e2;
    const float* og = c.o_norm_g + l * 128 + e2;
    am[0] = oo.x * rs * og[0] * silu_f(ps[0]); am[1] = oo.y * rs * og[1] * silu_f(ps[1]);
}
DI void phase_scan(const Ctx& c, int l, LAS unsigned char* lds) {
    if (c.bx < 32) { if (SUB(0)) scan_block(c, l, c.bx, lds); return; }
    const int w0 = c.wave * (c.nb - 32) + (c.bx - 32), nw = (c.nb - 32) * 8;
    LAS unsigned char* wl = lds + c.wave * B0_WAVE_LDS;
    for (int u = w0; u < SBATCH * 4 + 512; u += nw) {
        if (u < SBATCH * 4) { if (SUB(1)) sample_recurrent(c, l, u); continue; }
        const int g = u - SBATCH * 4, hb = g & 3, cc = (g >> 2) & 15, b = g >> 6;
        b0_task_vb(c, l, b, 2 * cc, hb, wl); b0_task_vb(c, l, b, 2 * cc + 1, hb, wl);
        asm volatile("s_waitcnt vmcnt(0)" ::: "memory");
        b1_gmlp(c, l, g);
    }
    if (l + 1 < DEPTH) convert_layer_weights(c, l + 1, w0, nw, lds);

}

DI void phase_final(const Ctx& c) {
    const f32x4* gr = (const f32x4*)c.norm_f_g + c.lane;
    for (int m = c.gw; m < MP + SBATCH; m += c.ngw) {
        f32x4 v[4]; float s = 0.f;
        if (m < MP) { const u32x2* xr = (const u32x2*)(WSP(bf16_t, WS_XB16) + (size_t)m * DM) + c.lane;
#pragma unroll
            for (int j = 0; j < 4; ++j) { const u32x2 w = xr[64 * j]; v[j] = (f32x4){bflo(w.x), bfhi(w.x), bflo(w.y), bfhi(w.y)}; } }
        else { const f32x4* xr = (const f32x4*)(WSP(float, WS_XS) + (size_t)(m - MP) * DM) + c.lane;
#pragma unroll
            for (int j = 0; j < 4; ++j) v[j] = xr[64 * j]; }
        float* dst = m < MP ? c.out + O_YP + (size_t)m * DM : c.out + O_YS + (size_t)(m - MP) * DM;
#pragma unroll
        for (int j = 0; j < 4; ++j) s += (v[j].x * v[j].x + v[j].y * v[j].y) + (v[j].z * v[j].z + v[j].w * v[j].w);
        const float rs = rsqrtf(wave_sum(s, c.lane) * (1.0f / DM) + EPS);
#pragma unroll
        for (int j = 0; j < 4; ++j) ((f32x4*)dst + c.lane)[64 * j] = v[j] * rs * gr[64 * j];
    }
}

#define XB_TMO      128
#define XB_XCNT(j)  (256  + 64 * (j))
#define XB_XSUB(j)  (1280 + 64 * (j))
#define XB_XGEN(j)  (2304 + 64 * (j))
#define XB_TOP      3328
#define XB_TOPGEN   3392
#define XCD_BAR_WORDS 3456
#define XB_SPIN_CAP (1u << 18)

__device__ __forceinline__ unsigned xb_ld(unsigned* p)              { return __hip_atomic_load(p, __ATOMIC_RELAXED, __HIP_MEMORY_SCOPE_AGENT); }
__device__ __forceinline__ unsigned xb_add(unsigned* p, unsigned v) { return __hip_atomic_fetch_add(p, v, __ATOMIC_RELAXED, __HIP_MEMORY_SCOPE_AGENT); }
__device__ __forceinline__ unsigned xb_xcc_id() { return (unsigned)__builtin_amdgcn_s_getreg((3 << 11) | 20) & 0xFu; }
#define XB_SPIN(cond, bar) do { unsigned _sp = 0; while (cond) { __builtin_amdgcn_s_sleep(8); \
    if ((++_sp & 255u) == 0u) { if (xb_ld(&(bar)[XB_TMO])) break; if (_sp > XB_SPIN_CAP) { atomicAdd(&(bar)[XB_TMO], 1u); break; } } } } while (0)

struct XcdBarrier {
    unsigned* bar; unsigned x;
    volatile LAS unsigned* st;
};

__device__ __forceinline__ XcdBarrier xcd_barrier_post(unsigned* bar, volatile LAS unsigned* st) {
    XcdBarrier b; b.bar = bar; b.x = xb_xcc_id(); b.st = st;
    if (threadIdx.x == 0) (void)xb_add(&bar[XB_XCNT(b.x)], 1u);
    return b;
}
__device__ __forceinline__ void xcd_barrier_complete(unsigned* bar, unsigned x, unsigned& nloc, unsigned& nx) {
    const unsigned G = gridDim.x * gridDim.y * gridDim.z;
    unsigned sum, cnt, mine, sp = 0u;
    for (;;) {
        sum = 0u; cnt = 0u; mine = 0u;
#pragma unroll
        for (unsigned j = 0; j < 16; ++j) { const unsigned c = xb_ld(&bar[XB_XCNT(j)]); sum += c; cnt += (c > 0u) ? 1u : 0u; mine = (j == x) ? c : mine; }
        if (sum == G) break;
        __builtin_amdgcn_s_sleep(1);
        if ((++sp & 255u) == 0u) { if (xb_ld(&bar[XB_TMO])) break; if (sp > XB_SPIN_CAP) { atomicAdd(&bar[XB_TMO], 1u); break; } }
    }
    nloc = mine > 0u ? mine : 1u; nx = cnt > 0u ? cnt : 1u;
}

__device__ __forceinline__ void xcd_barrier(const XcdBarrier& b) {
    asm volatile("s_waitcnt vmcnt(0)" ::: "memory");
    __syncthreads();
    if (threadIdx.x == 0) {
        unsigned* bar = b.bar;
        __builtin_amdgcn_s_waitcnt(0);
        unsigned nloc = b.st[0], nx = b.st[1];
        if (nloc == 0u) { xcd_barrier_complete(bar, b.x, nloc, nx); b.st[0] = nloc; b.st[1] = nx; }
        const unsigned old = xb_add(&bar[XB_XSUB(b.x)], 1u);
        const unsigned gen = old / nloc;
        if (old + 1u == (gen + 1u) * nloc) {
            __builtin_amdgcn_fence(__ATOMIC_RELEASE, "agent");
            asm volatile("s_waitcnt vmcnt(0)" ::: "memory");
            const unsigned og = xb_add(&bar[XB_TOP], 1u);
            const unsigned tg = og / nx;
            if (og + 1u == (tg + 1u) * nx) xb_add(&bar[XB_TOPGEN], 1u);
            else XB_SPIN(xb_ld(&bar[XB_TOPGEN]) == tg, bar);
            __builtin_amdgcn_fence(__ATOMIC_ACQUIRE, "agent");
            xb_add(&bar[XB_XGEN(b.x)], 1u);
            asm volatile("s_waitcnt vmcnt(0)" ::: "memory");
        } else {
            XB_SPIN(xb_ld(&bar[XB_XGEN(b.x)]) == gen, bar);
            __builtin_amdgcn_fence(__ATOMIC_ACQUIRE, "agent");
            asm volatile("s_waitcnt vmcnt(0)" ::: "memory");
        }
    }
    __syncthreads();
}
#ifndef ONLY
#define ONLY -1
#endif
#ifndef REPMASK
#define REPMASK 0
#endif
#define EN(x) (ONLY < 0 || ONLY == (x))
__global__ void __launch_bounds__(512, 2) hymba_fwd(Args args) {
    extern __shared__ __attribute__((aligned(16))) unsigned char lds_raw[];
    LAS unsigned char* lds = (LAS unsigned char*)lds_raw;
    cg::grid_group grid = cg::this_grid();
    Ctx c;
    c.x_prompt = args.in[0]; c.x_sample = args.in[1]; c.state_delta = args.in[2]; c.state_conv = args.in[3]; c.norm_mix_g = args.in[4]; c.w_in = args.in[5]; c.conv_w = args.in[6];
    c.A_log = args.in[7]; c.dt_bias = args.in[8]; c.o_norm_g = args.in[9]; c.v_norm_g = args.in[10]; c.w_s = args.in[11]; c.b_s = args.in[12]; c.w_o = args.in[13]; c.norm_ffn_g = args.in[14];
    c.w_up = args.in[15]; c.w_down = args.in[16]; c.norm_f_g = args.in[17]; c.out = args.out; c.ws = args.ws;
    c.lane = threadIdx.x & 63; c.wave = __builtin_amdgcn_readfirstlane(threadIdx.x >> 6); c.gw = blockIdx.x * 8 + c.wave; c.ngw = gridDim.x * 8; c.bx = blockIdx.x; c.nb = gridDim.x;
    volatile LAS unsigned* bst = (volatile LAS unsigned*)(lds + LDS_BYTES - 16);
    if (threadIdx.x < 2) bst[threadIdx.x] = 0u;
    __syncthreads();
    XcdBarrier xbar = xcd_barrier_post((unsigned*)args.ws, bst);
    grid.sync();
    for (int step = 2 * args.ph_lo; step < 2 * args.ph_hi; ++step) {
        const int ph = step >> 1;
        const int ptype = ph == 0 ? 0 : (ph == 29 ? 8 : 1 + (ph - 1) % 7);
        if ((step & 1) && !((REPMASK >> ptype) & 1)) continue;
        { int tl = threadIdx.x; asm volatile("" : "+v"(tl)); c.lane = tl & 63; int bxo = blockIdx.x, nbo = gridDim.x; asm volatile("" : "+s"(bxo), "+s"(nbo)); c.bx = bxo; c.nb = nbo; c.wave = __builtin_amdgcn_readfirstlane(tl >> 6); c.gw = bxo * 8 + c.wave; c.ngw = nbo * 8; unsigned char* wsp = args.ws; asm volatile("" : "+s"(wsp)); c.ws = wsp; float* op = args.out; asm volatile("" : "+s"(op)); c.out = op; }
        if (step & 1) __syncthreads();
        if (ph == 0) { if (EN(0)) phase_prologue(c, lds); }
        else if (ph == 29) { if (EN(8)) phase_final(c); }
        else {
            const int l = (ph - 1) / 7, s = (ph - 1) % 7;
            float* ssq = WSP(float, WS_SSQ);
            if (s == 0) { if (EN(1)) { sgemm1(c, l, lds); if ((REPMASK >> 10) & 1) sgemm1(c, l, lds);
                pg8::Gemm g{WSP(bf16_t, WS_XB16), WSP(bf16_t, WS_WIN) + (size_t)l * NP * DM, MP, NP, DM}; pg8::StaticOrder S; S.init(MP, NP, c.nb, c.bx);
                pg8::EpiScaleBf16 E{WSP(bf16_t, WS_P), NP, ssq + (size_t)(2 * l) * MP * 16, 0, WSP(float, WS_VSS), c.o_norm_g + l * 128}; pg8::gemm_phase(lds, g, S, E); } }
            else if (s == 1) { if (EN(2)) phase_b0(c, l, lds); }
            else if (s == 2) { if (EN(3)) phase_b1(c, l, lds); }
            else if (s == 3) { if (EN(4)) phase_scan(c, l, lds); if ((REPMASK >> 12) & 1) { __syncthreads(); if (c.bx < 32) scan_block(c, l, c.bx, lds); } if ((REPMASK >> 13) & 1) { if (c.bx >= 32) { const int w0 = (c.bx - 32) * 8 + c.wave, nw = (c.nb - 32) * 8; for (int u = w0; u < SBATCH * 4; u += nw) sample_recurrent(c, l, u); } } }
            else if (s == 4) { if (EN(5)) { if (!(step & 1)) sgemm2(c, l, lds);
                pg8::Gemm g{WSP(bf16_t, WS_AMIX), WSP(bf16_t, WS_WO) + (size_t)l * DM * DM, MP, DM, DM}; pg8::StaticOrder S; S.init(MP, DM, c.nb, c.bx);
                pg8::EpiResid E{WSP(bf16_t, WS_XB16), ssq + (size_t)(2 * l + 1) * MP * 16}; pg8::gemm_phase(lds, g, S, E); } }
            else if (s == 5) { if (EN(6)) { sgemm3(c, l, lds); if ((REPMASK >> 11) & 1) sgemm3(c, l, lds);
                pg8::Gemm g{WSP(bf16_t, WS_XB16), WSP(bf16_t, WS_WUP) + (size_t)l * FF * DM, MP, FF, DM}; pg8::StaticOrder S; S.init(MP, FF, c.nb, c.bx);
                pg8::EpiScaleBf16 E{WSP(bf16_t, WS_UNION), FF, ssq + (size_t)(2 * l + 1) * MP * 16, 1, nullptr, nullptr}; pg8::gemm_phase(lds, g, S, E); } }
            else { if (EN(7)) { if (!(step & 1)) sgemm4(c, l, lds);
                pg8::Gemm g{WSP(bf16_t, WS_UNION), WSP(bf16_t, WS_WDN) + (size_t)l * DM * FF, MP, DM, FF}; pg8::StaticOrder S; S.init(MP, DM, c.nb, c.bx);
                pg8::EpiResid E{WSP(bf16_t, WS_XB16), ssq + (size_t)(2 * l + 2) * MP * 16}; pg8::gemm_phase(lds, g, S, E); } }
        }
        if (!(step & 1) && ((REPMASK >> ptype) & 1)) continue;
        if ((REPMASK >> 9) & 1) { if (ph + 1 < args.ph_hi) xcd_barrier(xbar); }
        if (ph + 1 < args.ph_hi) {
            xcd_barrier(xbar);
        }
    }
}

extern "C" void kernel_launch(void* const* d_in, const int* in_sizes, int n_in, void* d_out, int out_size, void* d_ws, size_t ws_size, hipStream_t stream) {
    static int grid = 0;
    if (grid == 0) {
        int dev = 0, cus = 0, per_cu = 0;
        (void)hipGetDevice(&dev); (void)hipDeviceGetAttribute(&cus, hipDeviceAttributeMultiprocessorCount, dev);
        if (hipFuncSetAttribute((const void*)hymba_fwd, hipFuncAttributeMaxDynamicSharedMemorySize, LDS_BYTES) != hipSuccess) fprintf(stderr, "kernel_launch: hipFuncSetAttribute failed\n");
        if (hipOccupancyMaxActiveBlocksPerMultiprocessor(&per_cu, (const void*)hymba_fwd, 512, LDS_BYTES) != hipSuccess || per_cu < 1) { fprintf(stderr, "kernel_launch: occupancy query says %d\n", per_cu); per_cu = 1; }
        (void)hipGetLastError();
        grid = cus * 1;
        if (ws_size < WS_END) fprintf(stderr, "kernel_launch: workspace too small: %zu < %zu\n", ws_size, (size_t)WS_END);
    }
    (void)hipMemsetAsync(d_ws, 0, 65536, stream);
    Args a{};
    for (int i = 0; i < 18; ++i) a.in[i] = (const float*)d_in[i];
    a.out = (float*)d_out; a.ws = (unsigned char*)d_ws; a.ph_lo = 0; a.ph_hi = 30;
    void* kargs[] = {&a};
    hipError_t e = hipLaunchCooperativeKernel((const void*)hymba_fwd, dim3(grid), dim3(512), kargs, LDS_BYTES, stream);
    if (e != hipSuccess) fprintf(stderr, "kernel_launch: cooperative launch failed: %s (grid %d)\n", hipGetErrorString(e), grid);
}
```
